# Optimizing an MI355X kernel written in HIP

```python
import jax
import jax.numpy as jnp
from jax import lax
import numpy as np

D_MODEL = 1024
BATCH = 2
SEQ = 8192
DEPTH = 2

GRID_W = 64
CTX_LEN = 256
EPS = 1e-6

N_BRANCH = 4
BRANCH_W = D_MODEL // 2
CHUNK = GRID_W
CONV_W = 4
CONV_LEFT = 2

RG_W = BRANCH_W
RG_BLOCKS = 8
RG_BW = RG_W // RG_BLOCKS
RG_C = 8.0
GLA_H = 4
GLA_DK = BRANCH_W // (2 * GLA_H)
GLA_DV = BRANCH_W // GLA_H
GLA_RANK = 16
GLA_GATE_NORM = 16.0
HG_H = 4
HG_DK = 128
HG_DV = BRANCH_W // HG_H
ML_H = 4
ML_DK = BRANCH_W // ML_H
ML_DV = BRANCH_W // ML_H
N_GROUPS = 4
EXPERTS_PER_GROUP = 4
N_EXPERTS = N_GROUPS * EXPERTS_PER_GROUP
TOP_K = 2
D_EXPERT = D_MODEL // 2
MOE_BLOCK = 128

IN_PARTS = (
    ('rg_x', RG_W), ('rg_y', RG_W),
    ('gla_q', GLA_H * GLA_DK), ('gla_k', GLA_H * GLA_DK), ('gla_v', GLA_H * GLA_DV),
    ('gla_g', GLA_H * GLA_DV), ('gla_lr', 2 * GLA_RANK),
    ('hg_q', HG_H * HG_DK), ('hg_i', HG_H * HG_DV), ('hg_f', 2 * HG_H * HG_DK), ('hg_g', HG_H * HG_DV),
    ('ml_q', ML_H * ML_DK), ('ml_k', ML_H * ML_DK), ('ml_v', ML_H * ML_DV), ('ml_o', ML_H * ML_DV),
    ('ml_if', 2 * 2 * ML_H),
)
IN_WIDTH = sum(w for _, w in IN_PARTS)

kernel_name = 'hybrid_bidir_recurrent_hmoe_dit'


def _rmsnorm(x, g):
    xf = x.astype(jnp.float32)
    y = xf * lax.rsqrt(jnp.mean(jnp.square(xf), axis=-1, keepdims=True) + EPS)
    return (y * g.astype(jnp.float32)).astype(x.dtype)


def _modulate(h, g, shift, scale):
    return _rmsnorm(h, g) * (1.0 + scale) + shift


def _split_in(z):
    parts, off = {}, 0
    for name, width in IN_PARTS:
        parts[name] = z[..., off:off + width]
        off += width
    return parts


def _seg_flip(a, n_ctx, axis):
    ctx_part, lat_part = jnp.split(a, [n_ctx], axis=axis)
    return jnp.concatenate([jnp.flip(ctx_part, axis), jnp.flip(lat_part, axis)], axis=axis)


def _bidirectional(scan_fn, n_ctx, axis, fwd_args, bwd_args):
    y_fwd = scan_fn(*fwd_args)
    y_bwd = scan_fn(*[_seg_flip(a, n_ctx, axis) for a in bwd_args])
    return y_fwd + _seg_flip(y_bwd, n_ctx, axis)


def _dwconv_centred(u, w, b):
    t = u.shape[1]
    up = jnp.pad(u, ((0, 0), (CONV_LEFT, CONV_W - 1 - CONV_LEFT), (0, 0)))
    return b + sum(w[j] * up[:, j:j + t] for j in range(CONV_W))


def _conv_two_seqs(u, n_ctx, w, b):
    return jnp.concatenate([_dwconv_centred(u[:, :n_ctx], w, b), _dwconv_centred(u[:, n_ctx:], w, b)], axis=1)


def _heads(a, h):
    bsz, n, _ = a.shape
    return a.reshape(bsz, n, h, -1).transpose(0, 2, 1, 3)


def _unheads(a):
    bsz, h, n, d = a.shape
    return a.transpose(0, 2, 1, 3).reshape(bsz, n, h * d)


def _to_chunks(a):
    bsz, h, n = a.shape[:3]
    return jnp.moveaxis(a.reshape((bsz, h, n // CHUNK, CHUNK) + a.shape[3:]), 2, 0)


def _from_chunks(a):
    nc, bsz, h, l = a.shape[:4]
    return jnp.moveaxis(a, 0, 2).reshape((bsz, h, nc * l) + a.shape[4:])


def _lin_combine(left, right):
    a_l, b_l = left
    a_r, b_r = right
    return a_l * a_r, a_r * b_l + b_r


def _linear_scan(a, bterm):
    _, h = lax.associative_scan(_lin_combine, (a, bterm), axis=1)
    return h


def _gated_linear_scan(q, k, v, log_g):
    bsz, h, _, dk = q.shape
    dv = v.shape[-1]
    tril = jnp.tril(jnp.ones((CHUNK, CHUNK), dtype=bool))

    def chunk_step(state, blk):
        qc, kc, vc, gc = blk
        b = jnp.cumsum(gc, axis=2)
        rel = jnp.where(tril[:, :, None], b[:, :, :, None, :] - b[:, :, None, :, :], -jnp.inf)
        scores = jnp.einsum('bhid,bhjd,bhijd->bhij', qc, kc, jnp.exp(rel))
        o = (jnp.einsum('bhij,bhjv->bhiv', scores, vc)
             + jnp.einsum('bhid,bhdv->bhiv', qc * jnp.exp(b), state))
        b_end = b[:, :, -1:, :]
        state = (jnp.exp(b_end[:, :, 0, :, None]) * state
                 + jnp.einsum('bhjd,bhjv->bhdv', kc * jnp.exp(b_end - b), vc))
        return state, o

    s0 = jnp.zeros((bsz, h, dk, dv), jnp.float32)
    _, o = lax.scan(chunk_step, s0, tuple(_to_chunks(a.astype(jnp.float32)) for a in (q, k, v, log_g)))
    return _from_chunks(o)


def _mlstm_scan(q, k, v, i_pre, log_f):
    bsz, h, _, dk = q.shape
    dv = v.shape[-1]
    tril = jnp.tril(jnp.ones((CHUNK, CHUNK), dtype=bool))

    def chunk_step(carry, blk):
        c_mat, n_vec, m_prev = carry
        qc, kc, vc, ic, fc = blk
        b = jnp.cumsum(fc, axis=-1)
        log_w = jnp.where(tril, b[..., :, None] - b[..., None, :] + ic[..., None, :], -jnp.inf)
        log_inter = b + m_prev[..., None]
        m = jnp.maximum(log_inter, jnp.max(log_w, axis=-1))
        w_inter = jnp.exp(log_inter - m)
        s = jnp.einsum('bhid,bhjd->bhij', qc, kc) * jnp.exp(log_w - m[..., None])
        num = (jnp.einsum('bhij,bhjv->bhiv', s, vc)
               + w_inter[..., None] * jnp.einsum('bhid,bhdv->bhiv', qc, c_mat))
        den = jnp.sum(s, axis=-1) + w_inter * jnp.einsum('bhid,bhd->bhi', qc, n_vec)
        h_out = num / jnp.maximum(jnp.abs(den), jnp.exp(-m))[..., None]
        m_new = m[..., -1]
        w_end = jnp.exp(b[..., -1:] - b + ic - m_new[..., None])
        decay = jnp.exp(b[..., -1] + m_prev - m_new)
        c_mat = decay[..., None, None] * c_mat + jnp.einsum('bhj,bhjd,bhjv->bhdv', w_end, kc, vc)
        n_vec = decay[..., None] * n_vec + jnp.einsum('bhj,bhjd->bhd', w_end, kc)
        return (c_mat, n_vec, m_new), h_out

    init = (jnp.zeros((bsz, h, dk, dv), jnp.float32), jnp.zeros((bsz, h, dk), jnp.float32),
            jnp.zeros((bsz, h), jnp.float32))
    _, o = lax.scan(chunk_step, init, tuple(_to_chunks(a.astype(jnp.float32)) for a in (q, k, v, i_pre, log_f)))
    return _from_chunks(o)


def _rglru_coeffs(xb, gate_w, gate_b, lam):
    bsz, n, _ = xb.shape
    blk = xb.reshape(bsz, n, RG_BLOCKS, RG_BW)
    pre = (jnp.einsum('bnki,gkij->gbnkj', blk, gate_w.astype(jnp.float32)).reshape(2, bsz, n, RG_W)
           + gate_b.astype(jnp.float32)[:, None, None, :])
    r, i = jax.nn.sigmoid(pre[0]), jax.nn.sigmoid(pre[1])
    log_a = -RG_C * r * jax.nn.softplus(-lam.astype(jnp.float32))
    return jnp.exp(log_a), jnp.sqrt(-jnp.expm1(2.0 * log_a)) * (i * xb)


def _rglru_branch(p, lp, n_ctx):
    xb = _conv_two_seqs(p['rg_x'], n_ctx, lp['rg_conv_w'], lp['rg_conv_b']).astype(jnp.float32)
    a_f, b_f = _rglru_coeffs(xb, lp['rg_gate_w'][0], lp['rg_gate_b'][0], lp['rg_lambda'][0])
    a_b, b_b = _rglru_coeffs(xb, lp['rg_gate_w'][1], lp['rg_gate_b'][1], lp['rg_lambda'][1])
    h = _bidirectional(_linear_scan, n_ctx, 1, (a_f, b_f), (a_b, b_b))
    return (jax.nn.gelu(p['rg_y'].astype(jnp.float32)) * h).astype(p['rg_x'].dtype)


def _gla_branch(p, lp, n_ctx):
    f32 = jnp.float32
    bsz, n, _ = p['gla_q'].shape
    q = _heads(p['gla_q'].astype(f32), GLA_H) * GLA_DK ** -0.5
    k = _heads(p['gla_k'].astype(f32), GLA_H)
    v = _heads(p['gla_v'].astype(f32), GLA_H)
    lr = p['gla_lr'].astype(f32).reshape(bsz, n, 2, GLA_RANK)
    pre = (jnp.einsum('bndr,drk->dbnk', lr, lp['gla_w_lr'].astype(f32))
           + lp['gla_b_lr'].astype(f32)[:, None, None, :])
    log_a = jax.nn.log_sigmoid(pre) / GLA_GATE_NORM
    o = _bidirectional(_gated_linear_scan, n_ctx, 2,
                       (q, k, v, _heads(log_a[0], GLA_H)), (q, k, v, _heads(log_a[1], GLA_H)))
    o = _rmsnorm(o, lp['gla_norm_g'])
    return (_unheads(o) * jax.nn.silu(p['gla_g'].astype(f32))).astype(p['gla_q'].dtype)


def _hgrn2_branch(p, lp, lb, n_ctx):
    f32 = jnp.float32
    bsz, n, _ = p['hg_q'].shape
    q = _heads(jax.nn.silu(p['hg_q'].astype(f32)), HG_H) * HG_DK ** -0.5
    v = _heads(p['hg_i'].astype(f32), HG_H)
    f = p['hg_f'].astype(f32).reshape(bsz, n, 2, HG_H * HG_DK)
    log_forget = jnp.logaddexp(jnp.log(lb), jnp.log1p(-lb) + jax.nn.log_sigmoid(f))
    key = (1.0 - lb) * jax.nn.sigmoid(-f)
    o = _bidirectional(_gated_linear_scan, n_ctx, 2,
                       (q, _heads(key[:, :, 0], HG_H), v, _heads(log_forget[:, :, 0], HG_H)),
                       (q, _heads(key[:, :, 1], HG_H), v, _heads(log_forget[:, :, 1], HG_H)))
    o = _rmsnorm(o, lp['hgrn_norm_g'])
    return (_unheads(o) * jax.nn.silu(p['hg_g'].astype(f32))).astype(p['hg_q'].dtype)


def _mlstm_branch(p, lp, n_ctx):
    f32 = jnp.float32
    bsz, n, _ = p['ml_q'].shape
    qk = _conv_two_seqs(jnp.concatenate([p['ml_q'], p['ml_k']], axis=-1), n_ctx, lp['ml_conv_w'], lp['ml_conv_b'])
    qk = jax.nn.silu(qk.astype(f32))
    q = _heads(qk[..., :ML_H * ML_DK], ML_H) * ML_DK ** -0.5
    k = _heads(qk[..., ML_H * ML_DK:], ML_H)
    v = _heads(p['ml_v'].astype(f32), ML_H)
    g = p['ml_if'].astype(f32).reshape(bsz, n, 2, 2, ML_H) + lp['ml_gate_b'].astype(f32)
    g = g.transpose(2, 3, 0, 4, 1)
    i_pre, log_f = g[:, 0], jax.nn.log_sigmoid(g[:, 1])
    h = _bidirectional(_mlstm_scan, n_ctx, 2, (q, k, v, i_pre[0], log_f[0]), (q, k, v, i_pre[1], log_f[1]))
    h = _rmsnorm(h, lp['ml_norm_g'])
    return (jax.nn.sigmoid(p['ml_o'].astype(f32)) * _unheads(h)).astype(p['ml_q'].dtype)


def _token_mixer(u, n_ctx, lp, lb, latent_only):
    p = _split_in(u @ lp['w_in'])
    ys = jnp.stack([_rglru_branch(p, lp, n_ctx), _gla_branch(p, lp, n_ctx),
                    _hgrn2_branch(p, lp, lb, n_ctx), _mlstm_branch(p, lp, n_ctx)], axis=2)
    if latent_only:
        ys, u = ys[:, n_ctx:], u[:, n_ctx:]
    bsz, n, _ = u.shape
    gates = jax.nn.sigmoid(u @ lp['w_merge'] + lp['b_merge']).reshape(bsz, n, N_BRANCH, D_MODEL)
    branch_out = jnp.einsum('bnkc,kcd->bnkd', ys, lp['w_branch'])
    return jnp.sum(gates * branch_out, axis=2) @ lp['w_out']


def _routed_experts(xf, experts, weights, w1, w3, w2):
    n_tok, d = xf.shape
    n_asg = n_tok * TOP_K
    n_blocks = (n_asg + N_EXPERTS * (MOE_BLOCK - 1) + MOE_BLOCK - 1) // MOE_BLOCK
    flat_e = experts.reshape(-1)
    order = jnp.argsort(flat_e)
    e_sorted = flat_e[order]
    counts = jnp.bincount(flat_e, length=N_EXPERTS)
    padded = (counts + MOE_BLOCK - 1) // MOE_BLOCK * MOE_BLOCK
    pad_end = jnp.cumsum(padded)
    seg_start = jnp.cumsum(counts) - counts
    slot = (pad_end - padded)[e_sorted] + jnp.arange(n_asg) - seg_start[e_sorted]
    tok_sorted = (order // TOP_K).astype(jnp.int32)
    slot_tok = jnp.full((n_blocks * MOE_BLOCK,), n_tok, jnp.int32).at[slot].set(tok_sorted)
    x_pad = jnp.concatenate([xf, jnp.zeros((1, d), xf.dtype)], axis=0)
    x_blocks = x_pad[slot_tok].reshape(n_blocks, MOE_BLOCK, d)
    block_expert = jnp.minimum(jnp.searchsorted(pad_end, jnp.arange(n_blocks) * MOE_BLOCK, side='right'),
                               N_EXPERTS - 1)

    def expert_mlp(args):
        xb, e = args
        return (jax.nn.silu(xb @ w1[e]) * (xb @ w3[e])) @ w2[e]

    y_slots = lax.map(expert_mlp, (x_blocks, block_expert)).reshape(-1, d)
    y_asg = (y_slots[slot] * weights.reshape(-1)[order][:, None]).astype(xf.dtype)
    return jnp.zeros_like(xf).at[tok_sorted].add(y_asg)


def _hier_moe(u, lp):
    bsz, n, d = u.shape
    xf = u.reshape(-1, d)
    n_tok = xf.shape[0]
    g_logits = (xf @ lp['moe_w_group'] + lp['moe_b_group']).astype(jnp.float32)
    g_top, grp = lax.top_k(g_logits, 1)
    p_grp = jnp.exp(g_top - jax.nn.logsumexp(g_logits, axis=-1, keepdims=True))
    e_logits = (xf @ lp['moe_w_expert'] + lp['moe_b_expert']).astype(jnp.float32)
    e_logits = e_logits.reshape(n_tok, N_GROUPS, EXPERTS_PER_GROUP)
    idx = jnp.broadcast_to(grp[:, :, None], (n_tok, 1, EXPERTS_PER_GROUP))
    e_in = jnp.take_along_axis(e_logits, idx, axis=1)[:, 0]
    e_top, e_idx = lax.top_k(e_in, TOP_K)
    weights = p_grp * jax.nn.softmax(e_top, axis=-1)
    experts = grp * EXPERTS_PER_GROUP + e_idx
    y = _routed_experts(xf, experts, weights, lp['moe_w1'], lp['moe_w3'], lp['moe_w2'])
    return y.reshape(bsz, n, d)


def _layer(h_ctx, h_lat, c, c_ctx, lp, lb, last):
    n_ctx = h_ctx.shape[1]
    mod_lat = jax.nn.silu(c) @ lp['ada_w'] + lp['ada_b']
    mod_ctx = jax.nn.silu(c_ctx) @ lp['ada_w'] + lp['ada_b']
    sh1_l, sc1_l, g1_l, sh2_l, sc2_l, g2_l = jnp.split(mod_lat[:, None, :], 6, axis=-1)
    sh1_c, sc1_c, g1_c, sh2_c, sc2_c, g2_c = jnp.split(mod_ctx, 6, axis=-1)
    u = jnp.concatenate([_modulate(h_ctx, lp['norm_mix_g'], sh1_c, sc1_c),
                         _modulate(h_lat, lp['norm_mix_g'], sh1_l, sc1_l)], axis=1)
    mix = _token_mixer(u, n_ctx, lp, lb, latent_only=last)
    if last:
        h_lat = h_lat + g1_l * mix
        u2 = _modulate(h_lat, lp['norm_ffn_g'], sh2_l, sc2_l)
        return None, h_lat + g2_l * _hier_moe(u2, lp)
    h_ctx = h_ctx + g1_c * mix[:, :n_ctx]
    h_lat = h_lat + g1_l * mix[:, n_ctx:]
    u2 = jnp.concatenate([_modulate(h_ctx, lp['norm_ffn_g'], sh2_c, sc2_c),
                          _modulate(h_lat, lp['norm_ffn_g'], sh2_l, sc2_l)], axis=1)
    ffn = _hier_moe(u2, lp)
    return h_ctx + g2_c * ffn[:, :n_ctx], h_lat + g2_l * ffn[:, n_ctx:]


def setup_inputs(seed: int = 0) -> dict:
    key = jax.random.key(seed)
    ks = iter(jax.random.split(key, 48))

    def nrm(shape, scale):
        return scale * jax.random.normal(next(ks), shape, jnp.float32)

    def gain(shape):
        return 1.0 + nrm(shape, 0.05)

    d = D_MODEL
    return {
        'x': nrm((BATCH, SEQ, d), 1.0),
        'c': nrm((BATCH, d), 1.0),
        'ctx': nrm((BATCH, CTX_LEN, d), 1.0),
        'c_ctx': nrm((d,), 1.0),
        'ada_w': nrm((DEPTH, d, 6 * d), 0.5 * d ** -0.5),
        'ada_b': nrm((DEPTH, 6 * d), 0.01),
        'norm_mix_g': gain((DEPTH, d)),
        'norm_ffn_g': gain((DEPTH, d)),
        'w_in': nrm((DEPTH, d, IN_WIDTH), d ** -0.5),
        'rg_conv_w': nrm((DEPTH, CONV_W, RG_W), 0.5),
        'rg_conv_b': nrm((DEPTH, RG_W), 0.01),
        'rg_gate_w': nrm((DEPTH, 2, 2, RG_BLOCKS, RG_BW, RG_BW), RG_BW ** -0.5),
        'rg_gate_b': nrm((DEPTH, 2, 2, RG_W), 0.1),
        'rg_lambda': 5.0 + nrm((DEPTH, 2, RG_W), 0.5),
        'gla_w_lr': nrm((DEPTH, 2, GLA_RANK, GLA_H * GLA_DK), GLA_RANK ** -0.5),
        'gla_b_lr': nrm((DEPTH, 2, GLA_H * GLA_DK), 0.1),
        'gla_norm_g': gain((DEPTH, GLA_DV)),
        'hgrn_lb_logits': nrm((DEPTH, 2, HG_H * HG_DK), 1.0),
        'hgrn_norm_g': gain((DEPTH, HG_DV)),
        'ml_conv_w': nrm((DEPTH, CONV_W, 2 * ML_H * ML_DK), 0.5),
        'ml_conv_b': nrm((DEPTH, 2 * ML_H * ML_DK), 0.01),
        'ml_gate_b': nrm((DEPTH, 2, 2, ML_H), 0.5) + jnp.array([0.0, 3.0], jnp.float32)[:, None],
        'ml_norm_g': gain((DEPTH, ML_DV)),
        'w_branch': nrm((DEPTH, N_BRANCH, BRANCH_W, d), BRANCH_W ** -0.5),
        'w_merge': nrm((DEPTH, d, N_BRANCH * d), d ** -0.5),
        'b_merge': nrm((DEPTH, N_BRANCH * d), 0.1),
        'w_out': nrm((DEPTH, d, d), d ** -0.5),
        'moe_w_group': nrm((DEPTH, d, N_GROUPS), d ** -0.5),
        'moe_b_group': nrm((DEPTH, N_GROUPS), 0.01),
        'moe_w_expert': nrm((DEPTH, d, N_EXPERTS), d ** -0.5),
        'moe_b_expert': nrm((DEPTH, N_EXPERTS), 0.01),
        'moe_w1': nrm((DEPTH, N_EXPERTS, d, D_EXPERT), d ** -0.5),
        'moe_w3': nrm((DEPTH, N_EXPERTS, d, D_EXPERT), d ** -0.5),
        'moe_w2': nrm((DEPTH, N_EXPERTS, D_EXPERT, d), D_EXPERT ** -0.5),
        'final_norm_g': gain((d,)),
    }


def reference(x, c, ctx, c_ctx, ada_w, ada_b, norm_mix_g, norm_ffn_g, w_in, rg_conv_w, rg_conv_b,
              rg_gate_w, rg_gate_b, rg_lambda, gla_w_lr, gla_b_lr, gla_norm_g, hgrn_lb_logits,
              hgrn_norm_g, ml_conv_w, ml_conv_b, ml_gate_b, ml_norm_g, w_branch, w_merge, b_merge,
              w_out, moe_w_group, moe_b_group, moe_w_expert, moe_b_expert, moe_w1, moe_w3, moe_w2,
              final_norm_g):
    lb_cum = jnp.cumsum(jax.nn.softmax(hgrn_lb_logits.astype(jnp.float32), axis=0), axis=0)
    hgrn_lb = lb_cum - lb_cum[:1]
    h_ctx, h_lat = ctx, x
    for l in range(DEPTH):
        lp = dict(ada_w=ada_w[l], ada_b=ada_b[l], norm_mix_g=norm_mix_g[l], norm_ffn_g=norm_ffn_g[l],
                  w_in=w_in[l], rg_conv_w=rg_conv_w[l], rg_conv_b=rg_conv_b[l], rg_gate_w=rg_gate_w[l],
                  rg_gate_b=rg_gate_b[l], rg_lambda=rg_lambda[l], gla_w_lr=gla_w_lr[l], gla_b_lr=gla_b_lr[l],
                  gla_norm_g=gla_norm_g[l], hgrn_norm_g=hgrn_norm_g[l], ml_conv_w=ml_conv_w[l],
                  ml_conv_b=ml_conv_b[l], ml_gate_b=ml_gate_b[l], ml_norm_g=ml_norm_g[l],
                  w_branch=w_branch[l], w_merge=w_merge[l], b_merge=b_merge[l], w_out=w_out[l],
                  moe_w_group=moe_w_group[l], moe_b_group=moe_b_group[l], moe_w_expert=moe_w_expert[l],
                  moe_b_expert=moe_b_expert[l], moe_w1=moe_w1[l], moe_w3=moe_w3[l], moe_w2=moe_w2[l])
        h_ctx, h_lat = _layer(h_ctx, h_lat, c, c_ctx, lp, hgrn_lb[l], last=(l == DEPTH - 1))
    return _rmsnorm(h_lat, final_norm_g)
```

```cpp
#include <hip/hip_runtime.h>
#include <cstdio>
#include <cstdint>

#define LAS __attribute__((address_space(3)))
typedef unsigned short bf16_t;
typedef short bf16x8 __attribute__((ext_vector_type(8)));
typedef float f32x4 __attribute__((ext_vector_type(4)));

constexpr int DM = 1024, NBATCH = 2, SEQL = 8192, CTXL = 256, NTOK = 8448, TT = 16896, NCHUNK = 132, MT = 66;
constexpr int ZLD = 2560;
constexpr float EPS = 1e-6f;
constexpr int RGX = 0, RGY = 512, GQ = 1024, GK = 1280, GV = 1536, GG = 2048;
constexpr int HQ = 0, HI = 512, HF = 1024, HGT = 2048;
constexpr int MQ = 0, MK = 512, MV = 1024, MO = 1536;
constexpr int MISC_LR = 0, MISC_IF = 32;
constexpr int NSLOT_MAX = 37888;

enum { I_X = 0, I_C, I_CTX, I_CCTX, I_ADAW, I_ADAB, I_NMIXG, I_NFFNG, I_WIN, I_RGCW, I_RGCB, I_RGGW, I_RGGB, I_RGLAM, I_GLAWLR, I_GLABLR, I_GLANG,
       I_HGLB, I_HGNG, I_MLCW, I_MLCB, I_MLGB, I_MLNG, I_WBR, I_WMERGE, I_BMERGE, I_WOUT, I_MWG, I_MBG, I_MWE, I_MBE, I_MW1, I_MW3, I_MW2, I_FNG, N_IN };

constexpr size_t WS_CTL = 0;
constexpr size_t WS_MOD = 65536;
constexpr size_t WS_HCTX = 262144;
constexpr size_t WS_ROUTE = WS_HCTX + 2097152;
constexpr size_t WS_MISC = WS_ROUTE + 1048576;
constexpr size_t WS_SMALL = WS_MISC + 4325376;
constexpr size_t WS_WB = WS_SMALL + 8388608;
constexpr size_t WB_WIN = 0, WB_WM = WB_WIN + 15204352, WB_WB = WB_WM + 8388608, WB_WO = WB_WB + 4194304, WB_W13 = WB_WO + 2097152,
                 WB_W2 = WB_W13 + 33554432, WB_GW = WB_W2 + 16777216, WB_END = WB_GW + 131072;
constexpr size_t WS_U = WS_WB + WB_END;
constexpr size_t WS_BIG = WS_U + 34603008;
constexpr size_t BIG_Z = 0, BIG_ST = 86507520, BIG_YS = BIG_ST + 69206016 + 65536, BIG_END = BIG_YS + 69206016;
constexpr size_t WS_END = WS_BIG + BIG_END;
constexpr size_t BIG_BO = 0;
constexpr size_t BIG_MERGED = BIG_YS;
constexpr size_t BIG_XS = 0;
constexpr size_t BIG_HS = 77594624;
constexpr size_t BIG_YM = BIG_HS + 38797312;
static_assert(BIG_YM + 77594624 <= BIG_END, "moe alias");
static_assert(138412032 <= BIG_YS, "BO alias");
constexpr int CW_CNT = 4096;

struct P { const float* in[N_IN]; float* out; unsigned char* ws; int ph_lo, ph_hi; };

__device__ __forceinline__ float bf2f(bf16_t b) { return __uint_as_float(((unsigned)b) << 16); }
__device__ __forceinline__ bf16_t f2bf(float f) { unsigned u = __float_as_uint(f); u += 0x7FFFu + ((u >> 16) & 1u); return (bf16_t)(u >> 16); }
__device__ __forceinline__ unsigned pack2(float lo, float hi) { return (unsigned)f2bf(lo) | ((unsigned)f2bf(hi) << 16); }
__device__ __forceinline__ float sigm(float x) { return 1.f / (1.f + __expf(-x)); }
__device__ __forceinline__ float siluf(float x) { return x * sigm(x); }
__device__ __forceinline__ float logsig(float x) { return fminf(x, 0.f) - log1pf(__expf(-fabsf(x))); }
__device__ __forceinline__ float softplusf(float x) { return fmaxf(x, 0.f) + log1pf(__expf(-fabsf(x))); }
__device__ __forceinline__ float gelu_tanh(float x) { const float y = 0.7978845608028654f * (x + 0.044715f * x * x * x); const float t = 1.f - 2.f / (__expf(2.f * y) + 1.f); return 0.5f * x * (1.f + t); }
__device__ __forceinline__ float wave_sum(float v) {
#pragma unroll
    for (int o = 32; o > 0; o >>= 1) v += __shfl_xor(v, o);
    return v;
}
__device__ __forceinline__ int otid() { int t = threadIdx.x; asm volatile("" : "+v"(t)); return t; }
__device__ __forceinline__ const float* hrow_c(const float* HL, const float* HC, int r) { const int b = r / NTOK, p = r - b * NTOK; return p < CTXL ? HC + ((size_t)b * CTXL + p) * DM : HL + ((size_t)b * SEQL + (p - CTXL)) * DM; }
__device__ __forceinline__ float* hrow_m(float* HL, float* HC, int r) { const int b = r / NTOK, p = r - b * NTOK; return p < CTXL ? HC + ((size_t)b * CTXL + p) * DM : HL + ((size_t)b * SEQL + (p - CTXL)) * DM; }
__device__ __forceinline__ int mod_idx(int r) { const int b = r / NTOK, p = r - b * NTOK; return p < CTXL ? 2 : b; }

struct Unit { int pm, pn; };
struct Gemm { const bf16_t* A; const bf16_t* Bt; int lda; int K; };

struct TileOrder {
    int nM, nN, G, c;
    __device__ void init(int nM_, int nN_, int G_, int c_) { nM = nM_; nN = nN_; G = G_; c = c_; }
    __device__ __forceinline__ bool base(int i, Unit& u) const { const long L = (long)i * G + c; if (L >= (long)nM * nN) return false; u.pm = (int)(L / nN); u.pn = (int)(L % nN); return true; }
};
struct OrderPlain : TileOrder { int skipctx; __device__ __forceinline__ bool next(int i, Unit& u) const { if (!base(i, u)) return false; if (skipctx) u.pm = u.pm < 32 ? u.pm + 1 : u.pm + 2; return true; } };
struct OrderBranch : TileOrder { int skipctx; __device__ __forceinline__ bool next(int i, Unit& u) const { if (!base(i, u)) return false; int pm = u.pm; if (skipctx) pm = pm < 32 ? pm + 1 : pm + 2; u.pm = (u.pn >> 2) * MT + pm; return true; } };
struct OrderMoe : TileOrder { const LAS int* blk_e; __device__ __forceinline__ bool next(int i, Unit& u) const { if (!base(i, u)) return false; u.pn = blk_e[u.pm] * 4 + u.pn; return true; } };

template <class Epi, class Sched>
__device__ __forceinline__ void gemm_simple(const Gemm g, const Sched& S, const Epi& E) {
    const int tid = otid(), wid = tid >> 6, lane = tid & 63, wr = wid >> 2, wc = wid & 3, fr = lane & 15, fq = lane >> 4;
    Unit u;
    for (int it = 0; S.next(it, u); ++it) {
        f32x4 acc[2][2][4][2];
#pragma unroll
        for (int a = 0; a < 2; ++a)
#pragma unroll
            for (int b = 0; b < 2; ++b)
#pragma unroll
                for (int m = 0; m < 4; ++m)
#pragma unroll
                    for (int n = 0; n < 2; ++n) acc[a][b][m][n] = (f32x4){0.f, 0.f, 0.f, 0.f};
        const bf16_t* Ap = g.A + (size_t)(u.pm * 256 + wr * 64 + fr) * g.lda + fq * 8;
        const bf16_t* Bp = g.Bt + (size_t)(u.pn * 256 + wc * 32 + fr) * g.K + fq * 8;
        for (int k0 = 0; k0 < g.K; k0 += 32) {
            bf16x8 b[2][2];
#pragma unroll
            for (int bj = 0; bj < 2; ++bj)
#pragma unroll
                for (int n = 0; n < 2; ++n) b[bj][n] = *(const bf16x8*)(Bp + (size_t)(bj * 128 + n * 16) * g.K + k0);
#pragma unroll
            for (int ai = 0; ai < 2; ++ai) {
                bf16x8 a[4];
#pragma unroll
                for (int m = 0; m < 4; ++m) a[m] = *(const bf16x8*)(Ap + (size_t)(ai * 128 + m * 16) * g.lda + k0);
#pragma unroll
                for (int bj = 0; bj < 2; ++bj)
#pragma unroll
                    for (int m = 0; m < 4; ++m)
#pragma unroll
                        for (int n = 0; n < 2; ++n) acc[ai][bj][m][n] = __builtin_amdgcn_mfma_f32_16x16x32_bf16(b[bj][n], a[m], acc[ai][bj][m][n], 0, 0, 0);
                __builtin_amdgcn_sched_barrier(0);
            }
        }
        E(acc, u, wr, wc, fr, fq);
    }
}
#define GEMM_RUN(EpiT, SchedT, g, S, E) gemm_simple<EpiT, SchedT>(g, S, E)

struct EpiZ {
    bf16_t* Z; float* MISC; int misc_pn;
    __device__ __forceinline__ void operator()(const f32x4 (&acc)[2][2][4][2], const Unit& u, int wr, int wc, int fr, int fq) const {
        const int row0 = u.pm * 256 + wr * 64 + fr, col0 = u.pn * 256 + wc * 32 + 4 * fq;
#pragma unroll
        for (int ai = 0; ai < 2; ++ai)
#pragma unroll
            for (int m = 0; m < 4; ++m) { const int row = row0 + ai * 128 + m * 16;
#pragma unroll
                for (int bj = 0; bj < 2; ++bj)
#pragma unroll
                    for (int n = 0; n < 2; ++n) { const int col = col0 + bj * 128 + n * 16; const f32x4 v = acc[ai][bj][m][n];
                        if (u.pn == misc_pn) { const int cc = col - misc_pn * 256; if (cc < 64) *(f32x4*)(MISC + (size_t)row * 64 + cc) = v; }
                        else *(uint2*)(Z + (size_t)row * ZLD + col) = make_uint2(pack2(v[0], v[1]), pack2(v[2], v[3])); } }
    }
};
struct EpiBO {
    bf16_t* BO;
    __device__ __forceinline__ void operator()(const f32x4 (&acc)[2][2][4][2], const Unit& u, int wr, int wc, int fr, int fq) const {
        const int kb = u.pn >> 2, pm = u.pm - kb * MT, pn = u.pn & 3;
        const int row0 = pm * 256 + wr * 64 + fr, col0 = pn * 256 + wc * 32 + 4 * fq;
        bf16_t* base = BO + (size_t)kb * TT * DM;
#pragma unroll
        for (int ai = 0; ai < 2; ++ai)
#pragma unroll
            for (int m = 0; m < 4; ++m) { const int row = row0 + ai * 128 + m * 16;
#pragma unroll
                for (int bj = 0; bj < 2; ++bj)
#pragma unroll
                    for (int n = 0; n < 2; ++n) { const int col = col0 + bj * 128 + n * 16; const f32x4 v = acc[ai][bj][m][n];
                        *(uint2*)(base + (size_t)row * DM + col) = make_uint2(pack2(v[0], v[1]), pack2(v[2], v[3])); } }
    }
};
struct EpiMerge {
    const bf16_t* BO; const float* bm; bf16_t* MG;
    __device__ __forceinline__ void operator()(const f32x4 (&acc)[2][2][4][2], const Unit& u, int wr, int wc, int fr, int fq) const {
        const int row0 = u.pm * 256 + wr * 64 + fr, c0 = u.pn * 64 + wc * 16 + 4 * fq;
#pragma unroll
        for (int ai = 0; ai < 2; ++ai)
#pragma unroll
            for (int m = 0; m < 4; ++m) { const int row = row0 + ai * 128 + m * 16; f32x4 s = (f32x4){0.f, 0.f, 0.f, 0.f};
#pragma unroll
                for (int bj = 0; bj < 2; ++bj)
#pragma unroll
                    for (int n = 0; n < 2; ++n) { const int kb = 2 * bj + n; const f32x4 a = acc[ai][bj][m][n]; const f32x4 bb = *(const f32x4*)(bm + kb * DM + c0);
                        const uint2 bo = *(const uint2*)(BO + ((size_t)kb * TT + row) * DM + c0);
                        s[0] += sigm(a[0] + bb[0]) * bf2f((bf16_t)(bo.x & 0xffff)); s[1] += sigm(a[1] + bb[1]) * bf2f((bf16_t)(bo.x >> 16));
                        s[2] += sigm(a[2] + bb[2]) * bf2f((bf16_t)(bo.y & 0xffff)); s[3] += sigm(a[3] + bb[3]) * bf2f((bf16_t)(bo.y >> 16)); }
                *(uint2*)(MG + (size_t)row * DM + c0) = make_uint2(pack2(s[0], s[1]), pack2(s[2], s[3])); }
    }
};
struct EpiOut {
    const float* sL; const float* sC; float* dL; float* dC; const float* mod;
    __device__ __forceinline__ void operator()(const f32x4 (&acc)[2][2][4][2], const Unit& u, int wr, int wc, int fr, int fq) const {
        const int row0 = u.pm * 256 + wr * 64 + fr, col0 = u.pn * 256 + wc * 32 + 4 * fq;
        const int mv = mod_idx(u.pm * 256);
        const float* g1 = mod + mv * 6144 + 2 * DM;
#pragma unroll
        for (int ai = 0; ai < 2; ++ai)
#pragma unroll
            for (int m = 0; m < 4; ++m) { const int row = row0 + ai * 128 + m * 16; const float* src = hrow_c(sL, sC, row); float* dst = hrow_m(dL, dC, row);
#pragma unroll
                for (int bj = 0; bj < 2; ++bj)
#pragma unroll
                    for (int n = 0; n < 2; ++n) { const int col = col0 + bj * 128 + n * 16; const f32x4 v = acc[ai][bj][m][n];
                        const f32x4 h = *(const f32x4*)(src + col), gg = *(const f32x4*)(g1 + col);
                        *(f32x4*)(dst + col) = h + gg * v; } }
    }
};
struct EpiH {
    bf16_t* HS;
    __device__ __forceinline__ void operator()(const f32x4 (&acc)[2][2][4][2], const Unit& u, int wr, int wc, int fr, int fq) const {
        const int pn = u.pn & 3, row0 = u.pm * 256 + wr * 64 + fr, hc0 = pn * 128 + wc * 16 + 4 * fq;
#pragma unroll
        for (int ai = 0; ai < 2; ++ai)
#pragma unroll
            for (int m = 0; m < 4; ++m) { const int row = row0 + ai * 128 + m * 16;
#pragma unroll
                for (int bj = 0; bj < 2; ++bj) { const f32x4 a = acc[ai][bj][m][0], c = acc[ai][bj][m][1];
                    *(uint2*)(HS + (size_t)row * 512 + hc0 + bj * 64) = make_uint2(pack2(siluf(a[0]) * c[0], siluf(a[1]) * c[1]), pack2(siluf(a[2]) * c[2], siluf(a[3]) * c[3])); } }
    }
};
struct EpiY {
    bf16_t* YM;
    __device__ __forceinline__ void operator()(const f32x4 (&acc)[2][2][4][2], const Unit& u, int wr, int wc, int fr, int fq) const {
        const int pn = u.pn & 3, row0 = u.pm * 256 + wr * 64 + fr, col0 = pn * 256 + wc * 32 + 4 * fq;
#pragma unroll
        for (int ai = 0; ai < 2; ++ai)
#pragma unroll
            for (int m = 0; m < 4; ++m) { const int row = row0 + ai * 128 + m * 16;
#pragma unroll
                for (int bj = 0; bj < 2; ++bj)
#pragma unroll
                    for (int n = 0; n < 2; ++n) { const int col = col0 + bj * 128 + n * 16; const f32x4 v = acc[ai][bj][m][n];
                        *(uint2*)(YM + (size_t)row * DM + col) = make_uint2(pack2(v[0], v[1]), pack2(v[2], v[3])); } }
    }
};

__device__ void phase_mods(const P& p, LAS float* lds) {
    const int tid = otid();
    float* MOD = (float*)(p.ws + WS_MOD);
    LAS float* sc = lds;
    LAS float* red = lds + 3072;
    for (int i = tid; i < 3072; i += 512) { const int v = i >> 10, k = i & 1023; const float x = v < 2 ? p.in[I_C][v * DM + k] : p.in[I_CCTX][k]; sc[i] = siluf(x); }
    __syncthreads();
    for (int u = blockIdx.x; u < 96; u += gridDim.x) {
        const int l = u / 48, cg = u % 48, col = cg * 128 + (tid & 127), kp = tid >> 7;
        const float* W = p.in[I_ADAW] + (size_t)l * DM * 6144 + col;
        float s0 = 0.f, s1 = 0.f, s2 = 0.f;
        for (int k = kp * 256; k < kp * 256 + 256; ++k) { const float w = W[(size_t)k * 6144]; s0 += sc[k] * w; s1 += sc[1024 + k] * w; s2 += sc[2048 + k] * w; }
        red[(kp * 3 + 0) * 128 + (tid & 127)] = s0; red[(kp * 3 + 1) * 128 + (tid & 127)] = s1; red[(kp * 3 + 2) * 128 + (tid & 127)] = s2;
        __syncthreads();
        if (tid < 384) { const int v = tid >> 7, cc = tid & 127; const float s = red[(0 * 3 + v) * 128 + cc] + red[(1 * 3 + v) * 128 + cc] + red[(2 * 3 + v) * 128 + cc] + red[(3 * 3 + v) * 128 + cc];
            MOD[((size_t)l * 3 + v) * 6144 + cg * 128 + cc] = s + p.in[I_ADAB][l * 6144 + cg * 128 + cc]; }
        __syncthreads();
    }
}

__device__ __forceinline__ const float* conv_src(const P& p, int l, int mat, int sub, int n, int& ld) {
    switch (mat) {
    case 0: { ld = 7216; int c; if (n < 2592) c = n; else if (n < 2608) c = 7200 + (n - 2592); else if (n < 2816) return nullptr; else if (n < 5376) c = 2592 + (n - 2816); else c = 5152 + (n - 5376);
              return p.in[I_WIN] + (size_t)l * DM * 7216 + c; }
    case 1: { ld = 4096; const int pn = n >> 8, ct = n & 255, bj = ct >> 7, wc = (ct >> 5) & 3, nn = (ct >> 4) & 1, i = ct & 15; const int kb = 2 * bj + nn, c = 64 * pn + 16 * wc + i;
              return p.in[I_WMERGE] + (size_t)l * DM * 4096 + kb * DM + c; }
    case 2: { ld = 1024; return p.in[I_WBR] + ((size_t)l * 4 + sub) * 512 * DM + n; }
    case 3: { ld = 1024; return p.in[I_WOUT] + (size_t)l * DM * DM + n; }
    case 4: { ld = 512; const int g = n >> 5, nn = (n >> 4) & 1, i = n & 15, hc = 16 * g + i; return (nn ? p.in[I_MW3] : p.in[I_MW1]) + ((size_t)l * 16 + sub) * DM * 512 + hc; }
    case 5: { ld = 1024; return p.in[I_MW2] + ((size_t)l * 16 + sub) * 512 * DM + n; }
    default: { ld = 64; return p.in[I_RGGW] + ((size_t)l * 32 + sub) * 4096 + n; }
    }
}
__device__ void phase_convert(const P& p, int l, LAS float* tile  ) {
    const int tid = otid();
    unsigned char* wb = p.ws + WS_WB;
    for (int u = blockIdx.x; u < 9824; u += gridDim.x) {
        int mat, sub = 0, nt, kt, K; bf16_t* dst;
        if (u < 1856) { mat = 0; nt = u >> 4; kt = u & 15; K = 1024; dst = (bf16_t*)(wb + WB_WIN); }
        else if (u < 2880) { const int v = u - 1856; mat = 1; nt = v >> 4; kt = v & 15; K = 1024; dst = (bf16_t*)(wb + WB_WM); }
        else if (u < 3392) { const int v = u - 2880; mat = 2; sub = v >> 7; nt = (v & 127) >> 3; kt = v & 7; K = 512; dst = (bf16_t*)(wb + WB_WB) + (size_t)sub * 1024 * 512; }
        else if (u < 3648) { const int v = u - 3392; mat = 3; nt = v >> 4; kt = v & 15; K = 1024; dst = (bf16_t*)(wb + WB_WO); }
        else if (u < 7744) { const int v = u - 3648; mat = 4; sub = v >> 8; nt = (v & 255) >> 4; kt = v & 15; K = 1024; dst = (bf16_t*)(wb + WB_W13) + (size_t)sub * 1024 * 1024; }
        else if (u < 9792) { const int v = u - 7744; mat = 5; sub = v >> 7; nt = (v & 127) >> 3; kt = v & 7; K = 512; dst = (bf16_t*)(wb + WB_W2) + (size_t)sub * 1024 * 512; }
        else { mat = 6; sub = u - 9792; nt = 0; kt = 0; K = 64; dst = (bf16_t*)(wb + WB_GW) + (size_t)sub * 4096; }
        const int n0 = nt * 64, k0 = kt * 64;
        int ld; const float* sp = conv_src(p, l, mat, sub, n0 + (tid & 63), ld);
#pragma unroll
        for (int i = 0; i < 8; ++i) { const int kk = (tid >> 6) + 8 * i; tile[kk * 65 + (tid & 63)] = sp ? sp[(size_t)(k0 + kk) * ld] : 0.f; }
        __syncthreads();
        { const int nn = tid >> 3, ks = (tid & 7) * 8; unsigned w[4];
#pragma unroll
          for (int j = 0; j < 4; ++j) w[j] = pack2(tile[(ks + 2 * j) * 65 + nn], tile[(ks + 2 * j + 1) * 65 + nn]);
          *(uint4*)(dst + (size_t)(n0 + nn) * K + k0 + ks) = make_uint4(w[0], w[1], w[2], w[3]); }
        __syncthreads();
    }
}

__device__ __forceinline__ void norm_row(const P& p, int l, int which, const float* src, int mv, int lane, float (&u)[4][4]) {
    const float* MOD = (const float*)(p.ws + WS_MOD) + ((size_t)l * 3 + mv) * 6144;
    const float* gain = (which ? p.in[I_NFFNG] : p.in[I_NMIXG]) + l * DM;
    const float* sh = MOD + (which ? 3 : 0) * DM; const float* sc = MOD + (which ? 4 : 1) * DM;
    float ss = 0.f;
#pragma unroll
    for (int i = 0; i < 4; ++i) { const f32x4 v = *(const f32x4*)(src + 256 * i + 4 * lane); u[i][0] = v[0]; u[i][1] = v[1]; u[i][2] = v[2]; u[i][3] = v[3]; ss += v[0] * v[0] + v[1] * v[1] + v[2] * v[2] + v[3] * v[3]; }
    ss = wave_sum(ss);
    const float rs = rsqrtf(ss * (1.f / DM) + EPS);
#pragma unroll
    for (int i = 0; i < 4; ++i) { const int col = 256 * i + 4 * lane; const f32x4 g = *(const f32x4*)(gain + col), a = *(const f32x4*)(sc + col), b = *(const f32x4*)(sh + col);
#pragma unroll
        for (int j = 0; j < 4; ++j) u[i][j] = u[i][j] * rs * g[j] * (1.f + a[j]) + b[j]; }
}
__device__ void phase_norm1(const P& p, int l) {
    const int tid_ = otid(), lane = tid_ & 63, gw = blockIdx.x * 8 + (tid_ >> 6), nw = gridDim.x * 8;
    const float* sL = l == 0 ? p.in[I_X] : p.out; const float* sC = l == 0 ? p.in[I_CTX] : (const float*)(p.ws + WS_HCTX);
    bf16_t* U = (bf16_t*)(p.ws + WS_U);
    for (int r = gw; r < TT; r += nw) {
        float u[4][4]; norm_row(p, l, 0, hrow_c(sL, sC, r), mod_idx(r), lane, u);
#pragma unroll
        for (int i = 0; i < 4; ++i) *(uint2*)(U + (size_t)r * DM + 256 * i + 4 * lane) = make_uint2(pack2(u[i][0], u[i][1]), pack2(u[i][2], u[i][3]));
    }
}

__device__ void phase_route(const P& p, int l) {
    const int tid_ = otid(), lane = tid_ & 63, gw = blockIdx.x * 8 + (tid_ >> 6), nw = gridDim.x * 8;
    const float* sL = p.out; const float* sC = (const float*)(p.ws + WS_HCTX);
    int* tok_e = (int*)(p.ws + WS_ROUTE); float* tok_w = (float*)(p.ws + WS_ROUTE + 262144); int* tok_pos = (int*)(p.ws + WS_ROUTE + 524288);
    unsigned* cnt = (unsigned*)(p.ws + WS_CTL) + CW_CNT + l * 16;
    const float* wg = p.in[I_MWG] + (size_t)l * DM * 4; const float* we = p.in[I_MWE] + (size_t)l * DM * 16;
    for (int r = gw; r < TT; r += nw) {
        if (l == 1 && (r % NTOK) < CTXL) continue;
        float u[4][4]; norm_row(p, l, 1, hrow_c(sL, sC, r), mod_idx(r), lane, u);
        float acc[20];
#pragma unroll
        for (int q = 0; q < 20; ++q) acc[q] = 0.f;
#pragma unroll
        for (int i = 0; i < 4; ++i)
#pragma unroll
            for (int j = 0; j < 4; ++j) { const int col = 256 * i + 4 * lane + j; const float x = u[i][j];
                const f32x4 g = *(const f32x4*)(wg + (size_t)col * 4);
                acc[0] += x * g[0]; acc[1] += x * g[1]; acc[2] += x * g[2]; acc[3] += x * g[3];
#pragma unroll
                for (int q = 0; q < 4; ++q) { const f32x4 e = *(const f32x4*)(we + (size_t)col * 16 + 4 * q); acc[4 + 4 * q] += x * e[0]; acc[5 + 4 * q] += x * e[1]; acc[6 + 4 * q] += x * e[2]; acc[7 + 4 * q] += x * e[3]; }
                if (j == 3) asm volatile("" ::: "memory"); }
#pragma unroll
        for (int q = 0; q < 20; ++q) acc[q] = wave_sum(acc[q]);
        if (lane == 0) {
            float gl[4];
#pragma unroll
            for (int q = 0; q < 4; ++q) gl[q] = acc[q] + p.in[I_MBG][l * 4 + q];
            int grp = 0; float gm = gl[0];
#pragma unroll
            for (int q = 1; q < 4; ++q) if (gl[q] > gm) { gm = gl[q]; grp = q; }
            float se = 0.f;
#pragma unroll
            for (int q = 0; q < 4; ++q) se += __expf(gl[q] - gm);
            const float pg = 1.f / se;
            float el[4];
#pragma unroll
            for (int q = 0; q < 4; ++q) { float v = 0.f;
#pragma unroll
                for (int gg = 0; gg < 4; ++gg) v = (gg == grp) ? acc[4 + gg * 4 + q] : v;
                el[q] = v + p.in[I_MBE][l * 16 + grp * 4 + q]; }
            int i0 = 0; float m0 = el[0];
#pragma unroll
            for (int q = 1; q < 4; ++q) if (el[q] > m0) { m0 = el[q]; i0 = q; }
            int i1 = -1; float m1 = -3.4e38f;
#pragma unroll
            for (int q = 0; q < 4; ++q) if (q != i0 && el[q] > m1) { m1 = el[q]; i1 = q; }
            const float e1 = __expf(m1 - m0), w0 = pg / (1.f + e1), w1 = pg * e1 / (1.f + e1);
            const int ex0 = grp * 4 + i0, ex1 = grp * 4 + i1;
            const unsigned p0 = atomicAdd(&cnt[ex0], 1u), p1 = atomicAdd(&cnt[ex1], 1u);
            tok_e[2 * r] = ex0; tok_e[2 * r + 1] = ex1; tok_w[2 * r] = w0; tok_w[2 * r + 1] = w1; tok_pos[2 * r] = (int)p0; tok_pos[2 * r + 1] = (int)p1;
        }
    }
}
__device__ __forceinline__ int moe_tables(const P& p, int l, LAS int* tbl  ) {
    const unsigned* cnt = (const unsigned*)(p.ws + WS_CTL) + CW_CNT + l * 16;
    __syncthreads();
    if (otid() == 0) { int s = 0;
        for (int e = 0; e < 16; ++e) { const int c = (int)__hip_atomic_load(cnt + e, __ATOMIC_RELAXED, __HIP_MEMORY_SCOPE_AGENT); const int nb = (c + 255) >> 8; tbl[e] = s * 256; for (int b = 0; b < nb; ++b) tbl[32 + s + b] = e; s += nb; }
        tbl[16] = s; }
    __syncthreads();
    return tbl[16];
}
__device__ void phase_dispatch(const P& p, int l, LAS int* tbl) {
    const int tid_ = otid(), lane = tid_ & 63, gw = blockIdx.x * 8 + (tid_ >> 6), nw = gridDim.x * 8;
    moe_tables(p, l, tbl);
    const float* sL = p.out; const float* sC = (const float*)(p.ws + WS_HCTX);
    const int* tok_e = (const int*)(p.ws + WS_ROUTE); const int* tok_pos = (const int*)(p.ws + WS_ROUTE + 524288); int* tok_slot = (int*)(p.ws + WS_ROUTE + 786432);
    bf16_t* XS = (bf16_t*)(p.ws + WS_BIG + BIG_XS);
    for (int r = gw; r < TT; r += nw) {
        if (l == 1 && (r % NTOK) < CTXL) continue;
        float u[4][4]; norm_row(p, l, 1, hrow_c(sL, sC, r), mod_idx(r), lane, u);
        const int s0 = tbl[tok_e[2 * r]] + tok_pos[2 * r], s1 = tbl[tok_e[2 * r + 1]] + tok_pos[2 * r + 1];
        if (lane == 0) { tok_slot[2 * r] = s0; tok_slot[2 * r + 1] = s1; }
#pragma unroll
        for (int i = 0; i < 4; ++i) { const uint2 v = make_uint2(pack2(u[i][0], u[i][1]), pack2(u[i][2], u[i][3]));
            *(uint2*)(XS + (size_t)s0 * DM + 256 * i + 4 * lane) = v; *(uint2*)(XS + (size_t)s1 * DM + 256 * i + 4 * lane) = v; }
    }
}
__device__ void phase_combine(const P& p, int l) {
    const int tid_ = otid(), lane = tid_ & 63, gw = blockIdx.x * 8 + (tid_ >> 6), nw = gridDim.x * 8;
    float* HL = p.out; float* HC = (float*)(p.ws + WS_HCTX);
    const float* tok_w = (const float*)(p.ws + WS_ROUTE + 262144); const int* tok_slot = (const int*)(p.ws + WS_ROUTE + 786432);
    const bf16_t* YM = (const bf16_t*)(p.ws + WS_BIG + BIG_YM);
    for (int r = gw; r < TT; r += nw) {
        if (l == 1 && (r % NTOK) < CTXL) continue;
        const float* g2 = (const float*)(p.ws + WS_MOD) + ((size_t)l * 3 + mod_idx(r)) * 6144 + 5 * DM;
        float* hp = hrow_m(HL, HC, r);
        const int s0 = tok_slot[2 * r], s1 = tok_slot[2 * r + 1]; const float w0 = tok_w[2 * r], w1 = tok_w[2 * r + 1];
        float x[4][4]; float ss = 0.f;
#pragma unroll
        for (int i = 0; i < 4; ++i) { const int col = 256 * i + 4 * lane; const f32x4 h = *(const f32x4*)(hp + col), g = *(const f32x4*)(g2 + col);
            const uint2 a = *(const uint2*)(YM + (size_t)s0 * DM + col), b = *(const uint2*)(YM + (size_t)s1 * DM + col);
            x[i][0] = h[0] + g[0] * (w0 * bf2f((bf16_t)(a.x & 0xffff)) + w1 * bf2f((bf16_t)(b.x & 0xffff)));
            x[i][1] = h[1] + g[1] * (w0 * bf2f((bf16_t)(a.x >> 16)) + w1 * bf2f((bf16_t)(b.x >> 16)));
            x[i][2] = h[2] + g[2] * (w0 * bf2f((bf16_t)(a.y & 0xffff)) + w1 * bf2f((bf16_t)(b.y & 0xffff)));
            x[i][3] = h[3] + g[3] * (w0 * bf2f((bf16_t)(a.y >> 16)) + w1 * bf2f((bf16_t)(b.y >> 16)));
            ss += x[i][0] * x[i][0] + x[i][1] * x[i][1] + x[i][2] * x[i][2] + x[i][3] * x[i][3]; }
        if (l == 1) {
            ss = wave_sum(ss); const float rs = rsqrtf(ss * (1.f / DM) + EPS);
#pragma unroll
            for (int i = 0; i < 4; ++i) { const int col = 256 * i + 4 * lane; const f32x4 g = *(const f32x4*)(p.in[I_FNG] + col);
                *(f32x4*)(hp + col) = (f32x4){x[i][0] * rs * g[0], x[i][1] * rs * g[1], x[i][2] * rs * g[2], x[i][3] * rs * g[3]}; }
        } else {
#pragma unroll
            for (int i = 0; i < 4; ++i) *(f32x4*)(hp + 256 * i + 4 * lane) = (f32x4){x[i][0], x[i][1], x[i][2], x[i][3]};
        }
    }
}

constexpr int LDS_BYTES = 147456;
template <int PH> __global__ void __launch_bounds__(512, 2) mega(P p) {
    extern __shared__ __attribute__((aligned(16))) unsigned char lds[];
    LAS unsigned char* L = (LAS unsigned char*)lds;
    LAS int* tbl = (LAS int*)(L + 131072 + 1024);
    const int lo = p.ph_lo, hi = p.ph_hi;
#define IN(k) ((PH < 0 || ((k) == 0 ? 0 : (((k) - 1) % 16) + 1) == PH) && lo <= (k) && (k) < hi)
    unsigned char* ws = p.ws; unsigned char* wb = ws + WS_WB; unsigned char* big = ws + WS_BIG;
    if (IN(0)) phase_mods(p, (LAS float*)L);
#pragma unroll
    for (int l = 0; l < 2; ++l) {
        const int pb = 1 + 16 * l;
        if (IN(pb + 0)) phase_convert(p, l, (LAS float*)L);
        if (IN(pb + 1)) phase_norm1(p, l);
        if (IN(pb + 2)) { Gemm g{(const bf16_t*)(ws + WS_U), (const bf16_t*)(wb + WB_WIN), DM, DM}; OrderPlain S; S.init(MT, 11, gridDim.x, blockIdx.x); S.skipctx = 0;
            EpiZ E{(bf16_t*)(big + BIG_Z), (float*)(ws + WS_MISC), 10}; GEMM_RUN(EpiZ, OrderPlain, g, S, E); }
        if (IN(pb + 3)) { Gemm g{(const bf16_t*)(ws + WS_U), (const bf16_t*)(wb + WB_WIN) + (size_t)2816 * DM, DM, DM}; OrderPlain S; S.init(MT, 10, gridDim.x, blockIdx.x); S.skipctx = 0;
            EpiZ E{(bf16_t*)(big + BIG_Z), (float*)(ws + WS_MISC), -1}; GEMM_RUN(EpiZ, OrderPlain, g, S, E); }
        if (IN(pb + 4)) { Gemm g{(const bf16_t*)(ws + WS_U), (const bf16_t*)(wb + WB_WIN) + (size_t)5376 * DM, DM, DM}; OrderPlain S; S.init(MT, 8, gridDim.x, blockIdx.x); S.skipctx = 0;
            EpiZ E{(bf16_t*)(big + BIG_Z), (float*)(ws + WS_MISC), -1}; GEMM_RUN(EpiZ, OrderPlain, g, S, E); }
        if (IN(pb + 5)) { Gemm g{(const bf16_t*)(big + BIG_YS), (const bf16_t*)(wb + WB_WB), 512, 512}; OrderBranch S; S.init(l ? 64 : MT, 16, gridDim.x, blockIdx.x); S.skipctx = l;
            EpiBO E{(bf16_t*)(big + BIG_BO)}; GEMM_RUN(EpiBO, OrderBranch, g, S, E); }
        if (IN(pb + 6)) { Gemm g{(const bf16_t*)(ws + WS_U), (const bf16_t*)(wb + WB_WM), DM, DM}; OrderPlain S; S.init(l ? 64 : MT, 16, gridDim.x, blockIdx.x); S.skipctx = l;
            EpiMerge E{(const bf16_t*)(big + BIG_BO), p.in[I_BMERGE] + (size_t)l * 4096, (bf16_t*)(big + BIG_MERGED)}; GEMM_RUN(EpiMerge, OrderPlain, g, S, E); }
        if (IN(pb + 7)) { Gemm g{(const bf16_t*)(big + BIG_MERGED), (const bf16_t*)(wb + WB_WO), DM, DM}; OrderPlain S; S.init(l ? 64 : MT, 4, gridDim.x, blockIdx.x); S.skipctx = l;
            EpiOut E{l == 0 ? p.in[I_X] : p.out, l == 0 ? p.in[I_CTX] : (const float*)(ws + WS_HCTX), p.out, (float*)(ws + WS_HCTX), (const float*)(ws + WS_MOD) + (size_t)l * 3 * 6144};
            GEMM_RUN(EpiOut, OrderPlain, g, S, E); }
        if (IN(pb + 8)) phase_route(p, l);
        if (IN(pb + 9)) phase_dispatch(p, l, tbl);
        if (IN(pb + 10)) { const int nblk = moe_tables(p, l, tbl); Gemm g{(const bf16_t*)(big + BIG_XS), (const bf16_t*)(wb + WB_W13), DM, DM}; OrderMoe S; S.init(nblk, 4, gridDim.x, blockIdx.x); S.blk_e = tbl + 32;
            EpiH E{(bf16_t*)(big + BIG_HS)}; GEMM_RUN(EpiH, OrderMoe, g, S, E); }
        if (IN(pb + 11)) { const int nblk = moe_tables(p, l, tbl); Gemm g{(const bf16_t*)(big + BIG_HS), (const bf16_t*)(wb + WB_W2), 512, 512}; OrderMoe S; S.init(nblk, 4, gridDim.x, blockIdx.x); S.blk_e = tbl + 32;
            EpiY E{(bf16_t*)(big + BIG_YM)}; GEMM_RUN(EpiY, OrderMoe, g, S, E); }
        if (IN(pb + 12)) phase_combine(p, l);
    }
#undef IN
}

__device__ __forceinline__ int chain_chunk(int dir, int ci) { return dir == 0 ? ci : (ci < 4 ? 3 - ci : 135 - ci); }

__global__ void __launch_bounds__(64) seq_rg(P p, int l) {
    const int u = blockIdx.x, lane = threadIdx.x, blk = u & 7, dir = (u >> 3) & 1, b = u >> 4, ch = blk * 64 + lane;
    const bf16_t* Z = (const bf16_t*)(p.ws + WS_BIG + BIG_Z);
    float* O = (float*)(p.ws + WS_BIG + BIG_ST) + (size_t)dir * TT * 512;
    float Wr[64], Wi[64];
    const float* gw = p.in[I_RGGW] + ((((size_t)l * 2 + dir) * 2) * 8 + blk) * 4096;
#pragma unroll
    for (int i = 0; i < 64; ++i) { Wr[i] = gw[i * 64 + lane]; Wi[i] = gw[8 * 4096 + i * 64 + lane]; }
    const float br = p.in[I_RGGB][((l * 2 + dir) * 2 + 0) * 512 + ch], bi = p.in[I_RGGB][((l * 2 + dir) * 2 + 1) * 512 + ch];
    const float sp = softplusf(-p.in[I_RGLAM][(l * 2 + dir) * 512 + ch]);
    float cw[4];
#pragma unroll
    for (int j = 0; j < 4; ++j) cw[j] = p.in[I_RGCW][(l * 4 + j) * 512 + ch];
    const float cb = p.in[I_RGCB][l * 512 + ch];
    float h = 0.f;
    for (int s = 0; s < NTOK; ++s) {
        int pp; if (dir == 0) pp = s; else pp = s < CTXL ? CTXL - 1 - s : NTOK - 1 - (s - CTXL);
        const int lo = pp < CTXL ? 0 : CTXL, hi = pp < CTXL ? CTXL : NTOK;
        float xb = cb;
#pragma unroll
        for (int j = 0; j < 4; ++j) { const int q = pp + j - 2; if (q >= lo && q < hi) xb += cw[j] * bf2f(Z[((size_t)b * NTOK + q) * ZLD + RGX + ch]); }
        float pr = br, pi = bi;
#pragma unroll
        for (int i = 0; i < 64; ++i) { const float xi = __uint_as_float(__builtin_amdgcn_readlane(__float_as_uint(xb), i)); pr += xi * Wr[i]; pi += xi * Wi[i]; }
        const float r = sigm(pr), ig = sigm(pi), la = -8.f * r * sp, a = __expf(la), bt = sqrtf(-expm1f(2.f * la)) * (ig * xb);
        h = a * h + bt;
        O[((size_t)b * NTOK + pp) * 512 + ch] = h;
    }
}
__global__ void __launch_bounds__(256) epi_rg(P p) {
    const bf16_t* Z = (const bf16_t*)(p.ws + WS_BIG + BIG_Z); const float* OF = (const float*)(p.ws + WS_BIG + BIG_ST); const float* OB = OF + (size_t)TT * 512;
    bf16_t* YS = (bf16_t*)(p.ws + WS_BIG + BIG_YS);
    for (size_t i = (size_t)blockIdx.x * 256 + threadIdx.x; i < (size_t)TT * 512; i += (size_t)gridDim.x * 256) { const size_t r = i >> 9; const int ch = (int)(i & 511);
        YS[i] = f2bf(gelu_tanh(bf2f(Z[r * ZLD + RGY + ch])) * (OF[i] + OB[i])); }
}
template <int BR> __global__ void __launch_bounds__(512) seq_gl(P p, int l) {
    constexpr int DK = BR == 1 ? 64 : 128, DP = DK / 4;
    extern __shared__ __attribute__((aligned(16))) float sm[];
    float* LA = sm; float* LK = sm + 64 * DK; float* LQ = sm + 2 * 64 * DK; float* LV = sm + 3 * 64 * DK;
    const int u = blockIdx.x, tid = threadIdx.x, dir = u & 1, h = (u >> 1) & 3, b = u >> 3, v = tid >> 2, part = tid & 3;
    const bf16_t* Z = (const bf16_t*)(p.ws + WS_BIG + BIG_Z); const float* MISC = (const float*)(p.ws + WS_MISC);
    float* O = (float*)(p.ws + WS_BIG + BIG_ST) + (size_t)dir * TT * 512;
    float S[DP];
#pragma unroll
    for (int i = 0; i < DP; ++i) S[i] = 0.f;
    for (int ci = 0; ci < NCHUNK; ++ci) {
        const int c = chain_chunk(dir, ci); const size_t r0 = (size_t)b * NTOK + c * 64;
        __syncthreads();
        for (int idx = tid; idx < 64 * DK; idx += 512) { const int t = idx / DK, d = idx % DK; const size_t r = r0 + t;
            float a, k, q;
            if (BR == 1) { float pre = p.in[I_GLABLR][(l * 2 + dir) * 256 + h * 64 + d];
                for (int rr = 0; rr < 16; ++rr) pre += MISC[r * 64 + MISC_LR + dir * 16 + rr] * p.in[I_GLAWLR][((size_t)(l * 2 + dir) * 16 + rr) * 256 + h * 64 + d];
                a = __expf(logsig(pre) * (1.f / 16.f)); k = bf2f(Z[r * ZLD + GK + h * 64 + d]); q = bf2f(Z[r * ZLD + GQ + h * 64 + d]) * 0.125f; }
            else { float lb = 0.f; if (l == 1) { const float l0 = p.in[I_HGLB][(0 * 2 + dir) * 512 + h * 128 + d], l1 = p.in[I_HGLB][(1 * 2 + dir) * 512 + h * 128 + d]; lb = 1.f / (1.f + __expf(l0 - l1)); }
                const float f = bf2f(Z[r * ZLD + HF + dir * 512 + h * 128 + d]); const float s = sigm(f);
                a = lb + (1.f - lb) * s; k = (1.f - lb) * sigm(-f); q = siluf(bf2f(Z[r * ZLD + HQ + h * 128 + d])) * 0.08838834764831845f; }
            LA[idx] = a; LK[idx] = k; LQ[idx] = q; }
        for (int idx = tid; idx < 64 * 128; idx += 512) { const int t = idx >> 7, vv = idx & 127; LV[idx] = bf2f(Z[(r0 + t) * ZLD + (BR == 1 ? GV : HI) + h * 128 + vv]); }
        __syncthreads();
        for (int j = 0; j < 64; ++j) { const int t = dir == 0 ? j : 63 - j; const float vv = LV[t * 128 + v]; float o = 0.f;
#pragma unroll
            for (int i = 0; i < DP; ++i) { const int d = part * DP + i; S[i] = LA[t * DK + d] * S[i] + LK[t * DK + d] * vv; o += S[i] * LQ[t * DK + d]; }
            o += __shfl_xor(o, 1); o += __shfl_xor(o, 2);
            if (part == 0) O[(r0 + t) * 512 + h * 128 + v] = o; }
    }
}
__global__ void __launch_bounds__(512) seq_ml(P p, int l) {
    extern __shared__ __attribute__((aligned(16))) float sm[];
    float* LK = sm; float* LQ = sm + 8192; float* LV = sm + 16384; float* LI = sm + 24576; float* LF = LI + 64;
    const int u = blockIdx.x, tid = threadIdx.x, dir = u & 1, h = (u >> 1) & 3, b = u >> 3, v = tid >> 2, part = tid & 3;
    const bf16_t* Z = (const bf16_t*)(p.ws + WS_BIG + BIG_Z); const float* MISC = (const float*)(p.ws + WS_MISC);
    float* O = (float*)(p.ws + WS_BIG + BIG_ST) + (size_t)dir * TT * 512;
    float C[32], N[32]; float m = 0.f;
#pragma unroll
    for (int i = 0; i < 32; ++i) { C[i] = 0.f; N[i] = 0.f; }
    for (int ci = 0; ci < NCHUNK; ++ci) {
        const int c = chain_chunk(dir, ci); const int p0 = c * 64; const size_t r0 = (size_t)b * NTOK + p0;
        const int lo = p0 < CTXL ? 0 : CTXL, hi = p0 < CTXL ? CTXL : NTOK;
        __syncthreads();
        for (int idx = tid; idx < 64 * 128; idx += 512) { const int t = idx >> 7, d = idx & 127, ch = h * 128 + d; const int pp = p0 + t;
            float q = p.in[I_MLCB][l * 1024 + ch], k = p.in[I_MLCB][l * 1024 + 512 + ch];
#pragma unroll
            for (int j = 0; j < 4; ++j) { const int qq = pp + j - 2; if (qq >= lo && qq < hi) { const size_t rr = (size_t)b * NTOK + qq;
                q += p.in[I_MLCW][(l * 4 + j) * 1024 + ch] * bf2f(Z[rr * ZLD + MQ + ch]); k += p.in[I_MLCW][(l * 4 + j) * 1024 + 512 + ch] * bf2f(Z[rr * ZLD + MK + ch]); } }
            LQ[idx] = siluf(q) * 0.08838834764831845f; LK[idx] = siluf(k); LV[idx] = bf2f(Z[(r0 + t) * ZLD + MV + ch]); }
        if (tid < 64) { const size_t r = r0 + tid; LI[tid] = MISC[r * 64 + MISC_IF + dir * 8 + h] + p.in[I_MLGB][(l * 2 + dir) * 8 + h];
            LF[tid] = logsig(MISC[r * 64 + MISC_IF + dir * 8 + 4 + h] + p.in[I_MLGB][(l * 2 + dir) * 8 + 4 + h]); }
        __syncthreads();
        for (int j = 0; j < 64; ++j) { const int t = dir == 0 ? j : 63 - j; const float it = LI[t], lf = LF[t];
            const float mn = fmaxf(lf + m, it), fd = __expf(lf + m - mn), iw = __expf(it - mn); m = mn;
            const float vv = LV[t * 128 + v]; float num = 0.f, den = 0.f;
#pragma unroll
            for (int i = 0; i < 32; ++i) { const int d = part * 32 + i; const float kd = LK[t * 128 + d], qd = LQ[t * 128 + d]; C[i] = fd * C[i] + iw * kd * vv; N[i] = fd * N[i] + iw * kd; num += C[i] * qd; den += N[i] * qd; }
            num += __shfl_xor(num, 1); num += __shfl_xor(num, 2); den += __shfl_xor(den, 1); den += __shfl_xor(den, 2);
            if (part == 0) O[(r0 + t) * 512 + h * 128 + v] = num / fmaxf(fabsf(den), __expf(-mn)); }
    }
}
template <int BR> __global__ void __launch_bounds__(256) epi_norm(P p, int l) {
    const int lane = threadIdx.x & 63; const bf16_t* Z = (const bf16_t*)(p.ws + WS_BIG + BIG_Z);
    const float* OF = (const float*)(p.ws + WS_BIG + BIG_ST); const float* OB = OF + (size_t)TT * 512;
    bf16_t* YS = (bf16_t*)(p.ws + WS_BIG + BIG_YS) + (size_t)BR * TT * 512;
    const float* gain = (BR == 1 ? p.in[I_GLANG] : BR == 2 ? p.in[I_HGNG] : p.in[I_MLNG]) + l * 128;
    const int goff = BR == 1 ? GG : BR == 2 ? HGT : MO;
    for (int w = blockIdx.x * 4 + (threadIdx.x >> 6); w < TT * 4; w += gridDim.x * 4) { const size_t r = w >> 2; const int h = w & 3;
        const size_t i0 = r * 512 + h * 128 + lane, i1 = i0 + 64; const float o0 = OF[i0] + OB[i0], o1 = OF[i1] + OB[i1];
        const float ss = wave_sum(o0 * o0 + o1 * o1), rs = rsqrtf(ss * (1.f / 128.f) + EPS);
        const float g0 = bf2f(Z[r * ZLD + goff + h * 128 + lane]), g1 = bf2f(Z[r * ZLD + goff + h * 128 + lane + 64]);
        const float a0 = BR == 3 ? sigm(g0) : siluf(g0), a1 = BR == 3 ? sigm(g1) : siluf(g1);
        YS[i0] = f2bf(o0 * rs * gain[lane] * a0); YS[i1] = f2bf(o1 * rs * gain[lane + 64] * a1); }
}

static const void* mega_fn(int k) {
    switch (k) { case 0: return (const void*)mega<0>; case 1: return (const void*)mega<1>; case 2: return (const void*)mega<2>; case 3: return (const void*)mega<3>; case 4: return (const void*)mega<4>;
    case 5: return (const void*)mega<5>; case 6: return (const void*)mega<6>; case 7: return (const void*)mega<7>; case 8: return (const void*)mega<8>; case 9: return (const void*)mega<9>;
    case 10: return (const void*)mega<10>; case 11: return (const void*)mega<11>; case 12: return (const void*)mega<12>; default: return (const void*)mega<13>; }
}
extern "C" void kernel_launch(void* const* d_in, const int* in_sizes, int n_in, void* d_out, int out_size, void* d_ws, size_t ws_size, hipStream_t stream) {
    static int grid = 0;
    if (grid == 0) {
        if (n_in != N_IN || out_size != NBATCH * SEQL * DM || ws_size < WS_END) { fprintf(stderr, "kernel_launch: unexpected shapes (n_in %d out %d ws %zu need %zu)\n", n_in, out_size, ws_size, (size_t)WS_END); grid = -1; return; }
        int dev = 0, cus = 0;
        if (hipGetDevice(&dev) != hipSuccess || hipDeviceGetAttribute(&cus, hipDeviceAttributeMultiprocessorCount, dev) != hipSuccess) { grid = -1; return; }
        for (int k = 0; k < 14; ++k) if (hipFuncSetAttribute(mega_fn(k), hipFuncAttributeMaxDynamicSharedMemorySize, LDS_BYTES) != hipSuccess) { grid = -1; return; }
        (void)hipFuncSetAttribute((const void*)seq_gl<1>, hipFuncAttributeMaxDynamicSharedMemorySize, 4 * 64 * 128 * 4);
        (void)hipFuncSetAttribute((const void*)seq_gl<2>, hipFuncAttributeMaxDynamicSharedMemorySize, 4 * 64 * 128 * 4);
        (void)hipFuncSetAttribute((const void*)seq_ml, hipFuncAttributeMaxDynamicSharedMemorySize, 4 * 64 * 128 * 4);
        grid = cus;
    }
    if (grid < 0) return;
    (void)hipMemsetAsync((char*)d_ws + WS_CTL, 0, 65536, stream);
    P p{};
    for (int i = 0; i < N_IN; ++i) p.in[i] = (const float*)d_in[i];
    p.out = (float*)d_out; p.ws = (unsigned char*)d_ws;
    auto run = [&](int lo, int hi) { p.ph_lo = lo; p.ph_hi = hi; void* args[] = {&p}; (void)hipLaunchKernel(mega_fn(lo == 0 ? 0 : ((lo - 1) % 16) + 1), dim3(grid), dim3(512), args, LDS_BYTES, stream); };
    run(0, 1);
    for (int l = 0; l < 2; ++l) {
        const int pb = 1 + 16 * l;
        run(pb + 0, pb + 1); run(pb + 1, pb + 2);
        run(pb + 2, pb + 3);
        hipLaunchKernelGGL(seq_rg, dim3(32), dim3(64), 0, stream, p, l);
        hipLaunchKernelGGL(epi_rg, dim3(2048), dim3(256), 0, stream, p);
        hipLaunchKernelGGL(seq_gl<1>, dim3(16), dim3(512), 4 * 64 * 128 * 4, stream, p, l);
        hipLaunchKernelGGL(epi_norm<1>, dim3(2048), dim3(256), 0, stream, p, l);
        run(pb + 3, pb + 4);
        hipLaunchKernelGGL(seq_gl<2>, dim3(16), dim3(512), 4 * 64 * 128 * 4, stream, p, l);
        hipLaunchKernelGGL(epi_norm<2>, dim3(2048), dim3(256), 0, stream, p, l);
        run(pb + 4, pb + 5);
        hipLaunchKernelGGL(seq_ml, dim3(16), dim3(512), 4 * 64 * 128 * 4, stream, p, l);
        hipLaunchKernelGGL(epi_norm<3>, dim3(2048), dim3(256), 0, stream, p, l);
        for (int k = 5; k <= 12; ++k) run(pb + k, pb + k + 1);
    }
}
```

```cpp
#include <hip/hip_runtime.h>
#include <cstdio>
#include <cstdint>

#define LAS __attribute__((address_space(3)))
typedef unsigned short bf16_t;
typedef short bf16x8 __attribute__((ext_vector_type(8)));
typedef float f32x4 __attribute__((ext_vector_type(4)));

#define XB_TMO      128
#define XB_XCNT(j)  (256  + 64 * (j))
#define XB_XSUB(j)  (1280 + 64 * (j))
#define XB_XGEN(j)  (2304 + 64 * (j))
#define XB_TOP      3328
#define XB_TOPGEN   3392
#define XCD_BAR_WORDS 3456
#define XB_SPIN_CAP (1u << 18)

__device__ __forceinline__ unsigned xb_ld(unsigned* p)              { return __hip_atomic_load(p, __ATOMIC_RELAXED, __HIP_MEMORY_SCOPE_AGENT); }
__device__ __forceinline__ unsigned xb_add(unsigned* p, unsigned v) { return __hip_atomic_fetch_add(p, v, __ATOMIC_RELAXED, __HIP_MEMORY_SCOPE_AGENT); }
__device__ __forceinline__ unsigned xb_xcc_id() { return (unsigned)__builtin_amdgcn_s_getreg((3 << 11) | 20) & 0xFu; }
#define XB_SPIN(cond, bar) do { unsigned _sp = 0; while (cond) { __builtin_amdgcn_s_sleep(1); \
    if ((++_sp & 255u) == 0u) { if (xb_ld(&(bar)[XB_TMO])) break; if (_sp > XB_SPIN_CAP) { atomicAdd(&(bar)[XB_TMO], 1u); break; } } } } while (0)

struct XcdBarrier {
    unsigned* bar; unsigned x;
    volatile LAS unsigned* st;
};

__device__ __forceinline__ XcdBarrier xcd_barrier_post(unsigned* bar, volatile LAS unsigned* st) {
    XcdBarrier b; b.bar = bar; b.x = xb_xcc_id(); b.st = st;
    if (threadIdx.x == 0) (void)xb_add(&bar[XB_XCNT(b.x)], 1u);
    return b;
}
__device__ __forceinline__ void xcd_barrier_complete(unsigned* bar, unsigned x, unsigned& nloc, unsigned& nx) {
    const unsigned G = gridDim.x * gridDim.y * gridDim.z;
    unsigned sum, cnt, mine, sp = 0u;
    for (;;) {
        sum = 0u; cnt = 0u; mine = 0u;
#pragma unroll
        for (unsigned j = 0; j < 16; ++j) { const unsigned c = xb_ld(&bar[XB_XCNT(j)]); sum += c; cnt += (c > 0u) ? 1u : 0u; mine = (j == x) ? c : mine; }
        if (sum == G) break;
        __builtin_amdgcn_s_sleep(1);
        if ((++sp & 255u) == 0u) { if (xb_ld(&bar[XB_TMO])) break; if (sp > XB_SPIN_CAP) { atomicAdd(&bar[XB_TMO], 1u); break; } }
    }
    nloc = mine > 0u ? mine : 1u; nx = cnt > 0u ? cnt : 1u;
}

__device__ __forceinline__ void xcd_barrier(const XcdBarrier& b) {
    asm volatile("s_waitcnt vmcnt(0)" ::: "memory");
    __syncthreads();
    if (threadIdx.x == 0) {
        unsigned* bar = b.bar;
        __builtin_amdgcn_s_waitcnt(0);
        unsigned nloc = b.st[0], nx = b.st[1];
        if (nloc == 0u) { xcd_barrier_complete(bar, b.x, nloc, nx); b.st[0] = nloc; b.st[1] = nx; }
        const unsigned old = xb_add(&bar[XB_XSUB(b.x)], 1u);
        const unsigned gen = old / nloc;
        if (old + 1u == (gen + 1u) * nloc) {
            __builtin_amdgcn_fence(__ATOMIC_RELEASE, "agent");
            asm volatile("s_waitcnt vmcnt(0)" ::: "memory");
            const unsigned og = xb_add(&bar[XB_TOP], 1u);
            const unsigned tg = og / nx;
            if (og + 1u == (tg + 1u) * nx) xb_add(&bar[XB_TOPGEN], 1u);
            else XB_SPIN(xb_ld(&bar[XB_TOPGEN]) == tg, bar);
            __builtin_amdgcn_fence(__ATOMIC_ACQUIRE, "agent");
            xb_add(&bar[XB_XGEN(b.x)], 1u);
            asm volatile("s_waitcnt vmcnt(0)" ::: "memory");
        } else {
            XB_SPIN(xb_ld(&bar[XB_XGEN(b.x)]) == gen, bar);
            __builtin_amdgcn_fence(__ATOMIC_ACQUIRE, "agent");
            asm volatile("s_waitcnt vmcnt(0)" ::: "memory");
        }
    }
    __syncthreads();
}


constexpr int DM = 1024, NBATCH = 2, SEQL = 8192, CTXL = 256, NTOK = 8448, TT = 16896, NCHUNK = 132, MT = 66;
constexpr int ZLD = 2560;
constexpr float EPS = 1e-6f;
constexpr int RGX = 0, RGY = 512, GQ = 1024, GK = 1280, GV = 1536, GG = 2048;
constexpr int HQ = 0, HI = 512, HF = 1024, HGT = 2048;
constexpr int MQ = 0, MK = 512, MV = 1024, MO = 1536;
constexpr int MISC_LR = 0, MISC_IF = 32;
constexpr int NSLOT_MAX = 37888;

enum { I_X = 0, I_C, I_CTX, I_CCTX, I_ADAW, I_ADAB, I_NMIXG, I_NFFNG, I_WIN, I_RGCW, I_RGCB, I_RGGW, I_RGGB, I_RGLAM, I_GLAWLR, I_GLABLR, I_GLANG,
       I_HGLB, I_HGNG, I_MLCW, I_MLCB, I_MLGB, I_MLNG, I_WBR, I_WMERGE, I_BMERGE, I_WOUT, I_MWG, I_MBG, I_MWE, I_MBE, I_MW1, I_MW3, I_MW2, I_FNG, N_IN };

constexpr size_t WS_CTL = 0;
constexpr size_t WS_MOD = 65536;
constexpr size_t WS_HCTX = 262144;
constexpr size_t WS_ROUTE = WS_HCTX + 2097152;
constexpr size_t WS_MISC = WS_ROUTE + 1048576;
constexpr size_t WS_SMALL = WS_MISC + 4325376;
constexpr size_t WS_WB = WS_SMALL + 8388608;
constexpr size_t WB_WIN = 0, WB_WM = WB_WIN + 15204352, WB_WB = WB_WM + 8388608, WB_WO = WB_WB + 4194304, WB_W13 = WB_WO + 2097152,
                 WB_W2 = WB_W13 + 33554432, WB_GW = WB_W2 + 16777216, WB_END = WB_GW + 131072;
constexpr size_t WS_U = WS_WB + WB_END;
constexpr size_t WS_BIG = WS_U + 34603008;
constexpr size_t BIG_Z = 0, BIG_ST = 86507520, BIG_YS = BIG_ST + 69206016 + 65536, BIG_END = BIG_YS + 69206016;
constexpr size_t WS_END = WS_BIG + BIG_END;
constexpr size_t BIG_BO = 0;
constexpr size_t BIG_MERGED = BIG_YS;
constexpr size_t BIG_XS = 0;
constexpr size_t BIG_HS = 77594624;
constexpr size_t BIG_YM = BIG_HS + 38797312;
static_assert(BIG_YM + 77594624 <= BIG_END, "moe alias");
static_assert(138412032 <= BIG_YS, "BO alias");
constexpr int CW_CNT = 4096;

struct P { const float* in[N_IN]; float* out; unsigned char* ws; int ph_lo, ph_hi; };

__device__ __forceinline__ float bf2f(bf16_t b) { return __uint_as_float(((unsigned)b) << 16); }
__device__ __forceinline__ bf16_t f2bf(float f) { unsigned u = __float_as_uint(f); u += 0x7FFFu + ((u >> 16) & 1u); return (bf16_t)(u >> 16); }
__device__ __forceinline__ unsigned pack2(float lo, float hi) { return (unsigned)f2bf(lo) | ((unsigned)f2bf(hi) << 16); }
__device__ __forceinline__ float sigm(float x) { return 1.f / (1.f + __expf(-x)); }
__device__ __forceinline__ float siluf(float x) { return x * sigm(x); }
__device__ __forceinline__ float logsig(float x) { return fminf(x, 0.f) - log1pf(__expf(-fabsf(x))); }
__device__ __forceinline__ float softplusf(float x) { return fmaxf(x, 0.f) + log1pf(__expf(-fabsf(x))); }
__device__ __forceinline__ float gelu_tanh(float x) { const float y = 0.7978845608028654f * (x + 0.044715f * x * x * x); const float t = 1.f - 2.f / (__expf(2.f * y) + 1.f); return 0.5f * x * (1.f + t); }
__device__ __forceinline__ float wave_sum(float v) {
#pragma unroll
    for (int o = 32; o > 0; o >>= 1) v += __shfl_xor(v, o);
    return v;
}
__device__ __forceinline__ int otid() { int t = threadIdx.x; asm volatile("" : "+v"(t)); return t; }
__device__ __forceinline__ const float* hrow_c(const float* HL, const float* HC, int r) { const int b = r / NTOK, p = r - b * NTOK; return p < CTXL ? HC + ((size_t)b * CTXL + p) * DM : HL + ((size_t)b * SEQL + (p - CTXL)) * DM; }
__device__ __forceinline__ float* hrow_m(float* HL, float* HC, int r) { const int b = r / NTOK, p = r - b * NTOK; return p < CTXL ? HC + ((size_t)b * CTXL + p) * DM : HL + ((size_t)b * SEQL + (p - CTXL)) * DM; }
__device__ __forceinline__ int mod_idx(int r) { const int b = r / NTOK, p = r - b * NTOK; return p < CTXL ? 2 : b; }

typedef const __attribute__((address_space(4))) P* KP;
__device__ __forceinline__ P load_args() { unsigned long long a = (unsigned long long)__builtin_amdgcn_kernarg_segment_ptr(); asm volatile("" : "+s"(a)); KP k = (KP)a; P r;
#pragma unroll
    for (int i = 0; i < N_IN; ++i) r.in[i] = k->in[i];
    r.out = k->out; r.ws = k->ws; r.ph_lo = k->ph_lo; r.ph_hi = k->ph_hi; return r; }
struct Unit { int pm, pn; };
struct Gemm { const bf16_t* A; const bf16_t* Bt; int lda; int K; };

struct TileOrder {
    int nM, nN, G, c;
    __device__ void init(int nM_, int nN_, int G_, int c_) { nM = nM_; nN = nN_; G = G_; c = c_; }
    __device__ __forceinline__ bool base(int i, Unit& u) const { const long L = (long)i * G + c; if (L >= (long)nM * nN) return false; u.pm = (int)(L / nN); u.pn = (int)(L % nN); return true; }
};
struct OrderPlain : TileOrder { int skipctx; __device__ __forceinline__ bool next(int i, Unit& u) const { if (!base(i, u)) return false; if (skipctx) u.pm = u.pm < 32 ? u.pm + 1 : u.pm + 2; return true; } };
struct OrderBranch : TileOrder { int skipctx; __device__ __forceinline__ bool next(int i, Unit& u) const { if (!base(i, u)) return false; int pm = u.pm; if (skipctx) pm = pm < 32 ? pm + 1 : pm + 2; u.pm = (u.pn >> 2) * MT + pm; return true; } };
struct OrderMoe : TileOrder { const LAS int* blk_e; __device__ __forceinline__ bool next(int i, Unit& u) const { if (!base(i, u)) return false; u.pn = blk_e[u.pm] * 4 + u.pn; return true; } };

template <class Epi, class Sched>
__device__ __forceinline__ void gemm_simple(const Gemm g, const Sched& S, const Epi& E) {
    const int tid = otid(), wid = tid >> 6, lane = tid & 63, wr = wid >> 2, wc = wid & 3, fr = lane & 15, fq = lane >> 4;
    Unit u;
    for (int it = 0; S.next(it, u); ++it) {
        f32x4 acc[2][2][4][2];
#pragma unroll
        for (int a = 0; a < 2; ++a)
#pragma unroll
            for (int b = 0; b < 2; ++b)
#pragma unroll
                for (int m = 0; m < 4; ++m)
#pragma unroll
                    for (int n = 0; n < 2; ++n) acc[a][b][m][n] = (f32x4){0.f, 0.f, 0.f, 0.f};
        const bf16_t* Ap = g.A + (size_t)(u.pm * 256 + wr * 64 + fr) * g.lda + fq * 8;
        const bf16_t* Bp = g.Bt + (size_t)(u.pn * 256 + wc * 32 + fr) * g.K + fq * 8;
        for (int k0 = 0; k0 < g.K; k0 += 32) {
            bf16x8 b[2][2];
#pragma unroll
            for (int bj = 0; bj < 2; ++bj)
#pragma unroll
                for (int n = 0; n < 2; ++n) b[bj][n] = *(const bf16x8*)(Bp + (size_t)(bj * 128 + n * 16) * g.K + k0);
#pragma unroll
            for (int ai = 0; ai < 2; ++ai) {
                bf16x8 a[4];
#pragma unroll
                for (int m = 0; m < 4; ++m) a[m] = *(const bf16x8*)(Ap + (size_t)(ai * 128 + m * 16) * g.lda + k0);
#pragma unroll
                for (int bj = 0; bj < 2; ++bj)
#pragma unroll
                    for (int m = 0; m < 4; ++m)
#pragma unroll
                        for (int n = 0; n < 2; ++n) acc[ai][bj][m][n] = __builtin_amdgcn_mfma_f32_16x16x32_bf16(b[bj][n], a[m], acc[ai][bj][m][n], 0, 0, 0);
                __builtin_amdgcn_sched_barrier(0);
            }
        }
        E(acc, u, wr, wc, fr, fq);
    }
}
#define GEMM_RUN(EpiT, SchedT, g, S, E) gemm_simple<EpiT, SchedT>(g, S, E)

struct EpiZ {
    bf16_t* Z; float* MISC; int misc_pn;
    __device__ __forceinline__ void operator()(const f32x4 (&acc)[2][2][4][2], const Unit& u, int wr, int wc, int fr, int fq) const {
        const int row0 = u.pm * 256 + wr * 64 + fr, col0 = u.pn * 256 + wc * 32 + 4 * fq;
#pragma unroll
        for (int ai = 0; ai < 2; ++ai)
#pragma unroll
            for (int m = 0; m < 4; ++m) { const int row = row0 + ai * 128 + m * 16;
#pragma unroll
                for (int bj = 0; bj < 2; ++bj)
#pragma unroll
                    for (int n = 0; n < 2; ++n) { const int col = col0 + bj * 128 + n * 16; const f32x4 v = acc[ai][bj][m][n];
                        if (u.pn == misc_pn) { const int cc = col - misc_pn * 256; if (cc < 64) *(f32x4*)(MISC + (size_t)row * 64 + cc) = v; }
                        else *(uint2*)(Z + (size_t)row * ZLD + col) = make_uint2(pack2(v[0], v[1]), pack2(v[2], v[3])); } }
    }
};
struct EpiBO {
    bf16_t* BO;
    __device__ __forceinline__ void operator()(const f32x4 (&acc)[2][2][4][2], const Unit& u, int wr, int wc, int fr, int fq) const {
        const int kb = u.pn >> 2, pm = u.pm - kb * MT, pn = u.pn & 3;
        const int row0 = pm * 256 + wr * 64 + fr, col0 = pn * 256 + wc * 32 + 4 * fq;
        bf16_t* base = BO + (size_t)kb * TT * DM;
#pragma unroll
        for (int ai = 0; ai < 2; ++ai)
#pragma unroll
            for (int m = 0; m < 4; ++m) { const int row = row0 + ai * 128 + m * 16;
#pragma unroll
                for (int bj = 0; bj < 2; ++bj)
#pragma unroll
                    for (int n = 0; n < 2; ++n) { const int col = col0 + bj * 128 + n * 16; const f32x4 v = acc[ai][bj][m][n];
                        *(uint2*)(base + (size_t)row * DM + col) = make_uint2(pack2(v[0], v[1]), pack2(v[2], v[3])); } }
    }
};
struct EpiMerge {
    const bf16_t* BO; const float* bm; bf16_t* MG;
    __device__ __forceinline__ void operator()(const f32x4 (&acc)[2][2][4][2], const Unit& u, int wr, int wc, int fr, int fq) const {
        const int row0 = u.pm * 256 + wr * 64 + fr, c0 = u.pn * 64 + wc * 16 + 4 * fq;
#pragma unroll
        for (int ai = 0; ai < 2; ++ai)
#pragma unroll
            for (int m = 0; m < 4; ++m) { const int row = row0 + ai * 128 + m * 16; f32x4 s = (f32x4){0.f, 0.f, 0.f, 0.f};
#pragma unroll
                for (int bj = 0; bj < 2; ++bj)
#pragma unroll
                    for (int n = 0; n < 2; ++n) { const int kb = 2 * bj + n; const f32x4 a = acc[ai][bj][m][n]; const f32x4 bb = *(const f32x4*)(bm + kb * DM + c0);
                        const uint2 bo = *(const uint2*)(BO + ((size_t)kb * TT + row) * DM + c0);
                        s[0] += sigm(a[0] + bb[0]) * bf2f((bf16_t)(bo.x & 0xffff)); s[1] += sigm(a[1] + bb[1]) * bf2f((bf16_t)(bo.x >> 16));
                        s[2] += sigm(a[2] + bb[2]) * bf2f((bf16_t)(bo.y & 0xffff)); s[3] += sigm(a[3] + bb[3]) * bf2f((bf16_t)(bo.y >> 16)); }
                *(uint2*)(MG + (size_t)row * DM + c0) = make_uint2(pack2(s[0], s[1]), pack2(s[2], s[3])); }
    }
};
struct EpiOut {
    const float* sL; const float* sC; float* dL; float* dC; const float* mod;
    __device__ __forceinline__ void operator()(const f32x4 (&acc)[2][2][4][2], const Unit& u, int wr, int wc, int fr, int fq) const {
        const int row0 = u.pm * 256 + wr * 64 + fr, col0 = u.pn * 256 + wc * 32 + 4 * fq;
        const int mv = mod_idx(u.pm * 256);
        const float* g1 = mod + mv * 6144 + 2 * DM;
#pragma unroll
        for (int ai = 0; ai < 2; ++ai)
#pragma unroll
            for (int m = 0; m < 4; ++m) { const int row = row0 + ai * 128 + m * 16; const float* src = hrow_c(sL, sC, row); float* dst = hrow_m(dL, dC, row);
#pragma unroll
                for (int bj = 0; bj < 2; ++bj)
#pragma unroll
                    for (int n = 0; n < 2; ++n) { const int col = col0 + bj * 128 + n * 16; const f32x4 v = acc[ai][bj][m][n];
                        const f32x4 h = *(const f32x4*)(src + col), gg = *(const f32x4*)(g1 + col);
                        *(f32x4*)(dst + col) = h + gg * v; } }
    }
};
struct EpiH {
    bf16_t* HS;
    __device__ __forceinline__ void operator()(const f32x4 (&acc)[2][2][4][2], const Unit& u, int wr, int wc, int fr, int fq) const {
        const int pn = u.pn & 3, row0 = u.pm * 256 + wr * 64 + fr, hc0 = pn * 128 + wc * 16 + 4 * fq;
#pragma unroll
        for (int ai = 0; ai < 2; ++ai)
#pragma unroll
            for (int m = 0; m < 4; ++m) { const int row = row0 + ai * 128 + m * 16;
#pragma unroll
                for (int bj = 0; bj < 2; ++bj) { const f32x4 a = acc[ai][bj][m][0], c = acc[ai][bj][m][1];
                    *(uint2*)(HS + (size_t)row * 512 + hc0 + bj * 64) = make_uint2(pack2(siluf(a[0]) * c[0], siluf(a[1]) * c[1]), pack2(siluf(a[2]) * c[2], siluf(a[3]) * c[3])); } }
    }
};
struct EpiY {
    bf16_t* YM;
    __device__ __forceinline__ void operator()(const f32x4 (&acc)[2][2][4][2], const Unit& u, int wr, int wc, int fr, int fq) const {
        const int pn = u.pn & 3, row0 = u.pm * 256 + wr * 64 + fr, col0 = pn * 256 + wc * 32 + 4 * fq;
#pragma unroll
        for (int ai = 0; ai < 2; ++ai)
#pragma unroll
            for (int m = 0; m < 4; ++m) { const int row = row0 + ai * 128 + m * 16;
#pragma unroll
                for (int bj = 0; bj < 2; ++bj)
#pragma unroll
                    for (int n = 0; n < 2; ++n) { const int col = col0 + bj * 128 + n * 16; const f32x4 v = acc[ai][bj][m][n];
                        *(uint2*)(YM + (size_t)row * DM + col) = make_uint2(pack2(v[0], v[1]), pack2(v[2], v[3])); } }
    }
};

__device__ __forceinline__ void phase_mods(const P& p, LAS float* lds) {
    const int tid = otid();
    float* MOD = (float*)(p.ws + WS_MOD);
    LAS float* sc = lds;
    LAS float* red = lds + 3072;
    for (int i = tid; i < 3072; i += 512) { const int v = i >> 10, k = i & 1023; const float x = v < 2 ? p.in[I_C][v * DM + k] : p.in[I_CCTX][k]; sc[i] = siluf(x); }
    __syncthreads();
    for (int u = blockIdx.x; u < 96; u += gridDim.x) {
        const int l = u / 48, cg = u % 48, col = cg * 128 + (tid & 127), kp = tid >> 7;
        const float* W = p.in[I_ADAW] + (size_t)l * DM * 6144 + col;
        float s0 = 0.f, s1 = 0.f, s2 = 0.f;
        for (int k = kp * 256; k < kp * 256 + 256; ++k) { const float w = W[(size_t)k * 6144]; s0 += sc[k] * w; s1 += sc[1024 + k] * w; s2 += sc[2048 + k] * w; }
        red[(kp * 3 + 0) * 128 + (tid & 127)] = s0; red[(kp * 3 + 1) * 128 + (tid & 127)] = s1; red[(kp * 3 + 2) * 128 + (tid & 127)] = s2;
        __syncthreads();
        if (tid < 384) { const int v = tid >> 7, cc = tid & 127; const float s = red[(0 * 3 + v) * 128 + cc] + red[(1 * 3 + v) * 128 + cc] + red[(2 * 3 + v) * 128 + cc] + red[(3 * 3 + v) * 128 + cc];
            MOD[((size_t)l * 3 + v) * 6144 + cg * 128 + cc] = s + p.in[I_ADAB][l * 6144 + cg * 128 + cc]; }
        __syncthreads();
    }
}

__device__ __forceinline__ const float* conv_src(const P& p, int l, int mat, int sub, int n, int& ld) {
    switch (mat) {
    case 0: { ld = 7216; int c; if (n < 2592) c = n; else if (n < 2608) c = 7200 + (n - 2592); else if (n < 2816) return nullptr; else if (n < 5376) c = 2592 + (n - 2816); else c = 5152 + (n - 5376);
              return p.in[I_WIN] + (size_t)l * DM * 7216 + c; }
    case 1: { ld = 4096; const int pn = n >> 8, ct = n & 255, bj = ct >> 7, wc = (ct >> 5) & 3, nn = (ct >> 4) & 1, i = ct & 15; const int kb = 2 * bj + nn, c = 64 * pn + 16 * wc + i;
              return p.in[I_WMERGE] + (size_t)l * DM * 4096 + kb * DM + c; }
    case 2: { ld = 1024; return p.in[I_WBR] + ((size_t)l * 4 + sub) * 512 * DM + n; }
    case 3: { ld = 1024; return p.in[I_WOUT] + (size_t)l * DM * DM + n; }
    case 4: { ld = 512; const int g = n >> 5, nn = (n >> 4) & 1, i = n & 15, hc = 16 * g + i; return (nn ? p.in[I_MW3] : p.in[I_MW1]) + ((size_t)l * 16 + sub) * DM * 512 + hc; }
    case 5: { ld = 1024; return p.in[I_MW2] + ((size_t)l * 16 + sub) * 512 * DM + n; }
    default: { ld = 64; return p.in[I_RGGW] + ((size_t)l * 32 + sub) * 4096 + n; }
    }
}
__device__ __forceinline__ void phase_convert(const P& p, int l, LAS float* tile  ) {
    const int tid = otid();
    unsigned char* wb = p.ws + WS_WB;
    for (int u = blockIdx.x; u < 9824; u += gridDim.x) {
        int mat, sub = 0, nt, kt, K; bf16_t* dst;
        if (u < 1856) { mat = 0; nt = u >> 4; kt = u & 15; K = 1024; dst = (bf16_t*)(wb + WB_WIN); }
        else if (u < 2880) { const int v = u - 1856; mat = 1; nt = v >> 4; kt = v & 15; K = 1024; dst = (bf16_t*)(wb + WB_WM); }
        else if (u < 3392) { const int v = u - 2880; mat = 2; sub = v >> 7; nt = (v & 127) >> 3; kt = v & 7; K = 512; dst = (bf16_t*)(wb + WB_WB) + (size_t)sub * 1024 * 512; }
        else if (u < 3648) { const int v = u - 3392; mat = 3; nt = v >> 4; kt = v & 15; K = 1024; dst = (bf16_t*)(wb + WB_WO); }
        else if (u < 7744) { const int v = u - 3648; mat = 4; sub = v >> 8; nt = (v & 255) >> 4; kt = v & 15; K = 1024; dst = (bf16_t*)(wb + WB_W13) + (size_t)sub * 1024 * 1024; }
        else if (u < 9792) { const int v = u - 7744; mat = 5; sub = v >> 7; nt = (v & 127) >> 3; kt = v & 7; K = 512; dst = (bf16_t*)(wb + WB_W2) + (size_t)sub * 1024 * 512; }
        else { mat = 6; sub = u - 9792; nt = 0; kt = 0; K = 64; dst = (bf16_t*)(wb + WB_GW) + (size_t)sub * 4096; }
        const int n0 = nt * 64, k0 = kt * 64;
        int ld; const float* sp = conv_src(p, l, mat, sub, n0 + (tid & 63), ld);
#pragma unroll
        for (int i = 0; i < 8; ++i) { const int kk = (tid >> 6) + 8 * i; tile[kk * 65 + (tid & 63)] = sp ? sp[(size_t)(k0 + kk) * ld] : 0.f; }
        __syncthreads();
        { const int nn = tid >> 3, ks = (tid & 7) * 8; unsigned w[4];
#pragma unroll
          for (int j = 0; j < 4; ++j) w[j] = pack2(tile[(ks + 2 * j) * 65 + nn], tile[(ks + 2 * j + 1) * 65 + nn]);
          *(uint4*)(dst + (size_t)(n0 + nn) * K + k0 + ks) = make_uint4(w[0], w[1], w[2], w[3]); }
        __syncthreads();
    }
}

__device__ __forceinline__ void norm_row(const P& p, int l, int which, const float* src, int mv, int lane, float (&u)[4][4]) {
    const float* MOD = (const float*)(p.ws + WS_MOD) + ((size_t)l * 3 + mv) * 6144;
    const float* gain = (which ? p.in[I_NFFNG] : p.in[I_NMIXG]) + l * DM;
    const float* sh = MOD + (which ? 3 : 0) * DM; const float* sc = MOD + (which ? 4 : 1) * DM;
    float ss = 0.f;
#pragma unroll
    for (int i = 0; i < 4; ++i) { const f32x4 v = *(const f32x4*)(src + 256 * i + 4 * lane); u[i][0] = v[0]; u[i][1] = v[1]; u[i][2] = v[2]; u[i][3] = v[3]; ss += v[0] * v[0] + v[1] * v[1] + v[2] * v[2] + v[3] * v[3]; }
    ss = wave_sum(ss);
    const float rs = rsqrtf(ss * (1.f / DM) + EPS);
#pragma unroll
    for (int i = 0; i < 4; ++i) { const int col = 256 * i + 4 * lane; const f32x4 g = *(const f32x4*)(gain + col), a = *(const f32x4*)(sc + col), b = *(const f32x4*)(sh + col);
#pragma unroll
        for (int j = 0; j < 4; ++j) u[i][j] = u[i][j] * rs * g[j] * (1.f + a[j]) + b[j]; }
}
__device__ __forceinline__ void phase_norm1(const P& p, int l) {
    const int tid_ = otid(), lane = tid_ & 63, gw = blockIdx.x * 8 + (tid_ >> 6), nw = gridDim.x * 8;
    const float* sL = l == 0 ? p.in[I_X] : p.out; const float* sC = l == 0 ? p.in[I_CTX] : (const float*)(p.ws + WS_HCTX);
    bf16_t* U = (bf16_t*)(p.ws + WS_U);
    for (int r = gw; r < TT; r += nw) {
        float u[4][4]; norm_row(p, l, 0, hrow_c(sL, sC, r), mod_idx(r), lane, u);
#pragma unroll
        for (int i = 0; i < 4; ++i) *(uint2*)(U + (size_t)r * DM + 256 * i + 4 * lane) = make_uint2(pack2(u[i][0], u[i][1]), pack2(u[i][2], u[i][3]));
    }
}

__device__ __forceinline__ void phase_route(const P& p, int l) {
    const int tid_ = otid(), lane = tid_ & 63, gw = blockIdx.x * 8 + (tid_ >> 6), nw = gridDim.x * 8;
    const float* sL = p.out; const float* sC = (const float*)(p.ws + WS_HCTX);
    int* tok_e = (int*)(p.ws + WS_ROUTE); float* tok_w = (float*)(p.ws + WS_ROUTE + 262144); int* tok_pos = (int*)(p.ws + WS_ROUTE + 524288);
    unsigned* cnt = (unsigned*)(p.ws + WS_CTL) + CW_CNT + l * 16;
    const float* wg = p.in[I_MWG] + (size_t)l * DM * 4; const float* we = p.in[I_MWE] + (size_t)l * DM * 16;
    for (int r = gw; r < TT; r += nw) {
        if (l == 1 && (r % NTOK) < CTXL) continue;
        float u[4][4]; norm_row(p, l, 1, hrow_c(sL, sC, r), mod_idx(r), lane, u);
        float acc[20];
#pragma unroll
        for (int q = 0; q < 20; ++q) acc[q] = 0.f;
#pragma unroll
        for (int i = 0; i < 4; ++i)
#pragma unroll
            for (int j = 0; j < 4; ++j) { const int col = 256 * i + 4 * lane + j; const float x = u[i][j];
                const f32x4 g = *(const f32x4*)(wg + (size_t)col * 4);
                acc[0] += x * g[0]; acc[1] += x * g[1]; acc[2] += x * g[2]; acc[3] += x * g[3];
#pragma unroll
                for (int q = 0; q < 4; ++q) { const f32x4 e = *(const f32x4*)(we + (size_t)col * 16 + 4 * q); acc[4 + 4 * q] += x * e[0]; acc[5 + 4 * q] += x * e[1]; acc[6 + 4 * q] += x * e[2]; acc[7 + 4 * q] += x * e[3]; }
                if (j == 3) asm volatile("" ::: "memory"); }
#pragma unroll
        for (int q = 0; q < 20; ++q) acc[q] = wave_sum(acc[q]);
        if (lane == 0) {
            float gl[4];
#pragma unroll
            for (int q = 0; q < 4; ++q) gl[q] = acc[q] + p.in[I_MBG][l * 4 + q];
            int grp = 0; float gm = gl[0];
#pragma unroll
            for (int q = 1; q < 4; ++q) if (gl[q] > gm) { gm = gl[q]; grp = q; }
            float se = 0.f;
#pragma unroll
            for (int q = 0; q < 4; ++q) se += __expf(gl[q] - gm);
            const float pg = 1.f / se;
            float el[4];
#pragma unroll
            for (int q = 0; q < 4; ++q) { float v = 0.f;
#pragma unroll
                for (int gg = 0; gg < 4; ++gg) v = (gg == grp) ? acc[4 + gg * 4 + q] : v;
                el[q] = v + p.in[I_MBE][l * 16 + grp * 4 + q]; }
            int i0 = 0; float m0 = el[0];
#pragma unroll
            for (int q = 1; q < 4; ++q) if (el[q] > m0) { m0 = el[q]; i0 = q; }
            int i1 = -1; float m1 = -3.4e38f;
#pragma unroll
            for (int q = 0; q < 4; ++q) if (q != i0 && el[q] > m1) { m1 = el[q]; i1 = q; }
            const float e1 = __expf(m1 - m0), w0 = pg / (1.f + e1), w1 = pg * e1 / (1.f + e1);
            const int ex0 = grp * 4 + i0, ex1 = grp * 4 + i1;
            const unsigned p0 = atomicAdd(&cnt[ex0], 1u), p1 = atomicAdd(&cnt[ex1], 1u);
            tok_e[2 * r] = ex0; tok_e[2 * r + 1] = ex1; tok_w[2 * r] = w0; tok_w[2 * r + 1] = w1; tok_pos[2 * r] = (int)p0; tok_pos[2 * r + 1] = (int)p1;
        }
    }
}
__device__ __forceinline__ int moe_tables(const P& p, int l, LAS int* tbl  ) {
    const unsigned* cnt = (const unsigned*)(p.ws + WS_CTL) + CW_CNT + l * 16;
    __syncthreads();
    if (otid() == 0) { int s = 0;
        for (int e = 0; e < 16; ++e) { const int c = (int)__hip_atomic_load(cnt + e, __ATOMIC_RELAXED, __HIP_MEMORY_SCOPE_AGENT); const int nb = (c + 255) >> 8; tbl[e] = s * 256; for (int b = 0; b < nb; ++b) tbl[32 + s + b] = e; s += nb; }
        tbl[16] = s; }
    __syncthreads();
    return tbl[16];
}
__device__ __forceinline__ void phase_dispatch(const P& p, int l, LAS int* tbl) {
    const int tid_ = otid(), lane = tid_ & 63, gw = blockIdx.x * 8 + (tid_ >> 6), nw = gridDim.x * 8;
    moe_tables(p, l, tbl);
    const float* sL = p.out; const float* sC = (const float*)(p.ws + WS_HCTX);
    const int* tok_e = (const int*)(p.ws + WS_ROUTE); const int* tok_pos = (const int*)(p.ws + WS_ROUTE + 524288); int* tok_slot = (int*)(p.ws + WS_ROUTE + 786432);
    bf16_t* XS = (bf16_t*)(p.ws + WS_BIG + BIG_XS);
    for (int r = gw; r < TT; r += nw) {
        if (l == 1 && (r % NTOK) < CTXL) continue;
        float u[4][4]; norm_row(p, l, 1, hrow_c(sL, sC, r), mod_idx(r), lane, u);
        const int s0 = tbl[tok_e[2 * r]] + tok_pos[2 * r], s1 = tbl[tok_e[2 * r + 1]] + tok_pos[2 * r + 1];
        if (lane == 0) { tok_slot[2 * r] = s0; tok_slot[2 * r + 1] = s1; }
#pragma unroll
        for (int i = 0; i < 4; ++i) { const uint2 v = make_uint2(pack2(u[i][0], u[i][1]), pack2(u[i][2], u[i][3]));
            *(uint2*)(XS + (size_t)s0 * DM + 256 * i + 4 * lane) = v; *(uint2*)(XS + (size_t)s1 * DM + 256 * i + 4 * lane) = v; }
    }
}
__device__ __forceinline__ void phase_combine(const P& p, int l) {
    const int tid_ = otid(), lane = tid_ & 63, gw = blockIdx.x * 8 + (tid_ >> 6), nw = gridDim.x * 8;
    float* HL = p.out; float* HC = (float*)(p.ws + WS_HCTX);
    const float* tok_w = (const float*)(p.ws + WS_ROUTE + 262144); const int* tok_slot = (const int*)(p.ws + WS_ROUTE + 786432);
    const bf16_t* YM = (const bf16_t*)(p.ws + WS_BIG + BIG_YM);
    for (int r = gw; r < TT; r += nw) {
        if (l == 1 && (r % NTOK) < CTXL) continue;
        const float* g2 = (const float*)(p.ws + WS_MOD) + ((size_t)l * 3 + mod_idx(r)) * 6144 + 5 * DM;
        float* hp = hrow_m(HL, HC, r);
        const int s0 = tok_slot[2 * r], s1 = tok_slot[2 * r + 1]; const float w0 = tok_w[2 * r], w1 = tok_w[2 * r + 1];
        float x[4][4]; float ss = 0.f;
#pragma unroll
        for (int i = 0; i < 4; ++i) { const int col = 256 * i + 4 * lane; const f32x4 h = *(const f32x4*)(hp + col), g = *(const f32x4*)(g2 + col);
            const uint2 a = *(const uint2*)(YM + (size_t)s0 * DM + col), b = *(const uint2*)(YM + (size_t)s1 * DM + col);
            x[i][0] = h[0] + g[0] * (w0 * bf2f((bf16_t)(a.x & 0xffff)) + w1 * bf2f((bf16_t)(b.x & 0xffff)));
            x[i][1] = h[1] + g[1] * (w0 * bf2f((bf16_t)(a.x >> 16)) + w1 * bf2f((bf16_t)(b.x >> 16)));
            x[i][2] = h[2] + g[2] * (w0 * bf2f((bf16_t)(a.y & 0xffff)) + w1 * bf2f((bf16_t)(b.y & 0xffff)));
            x[i][3] = h[3] + g[3] * (w0 * bf2f((bf16_t)(a.y >> 16)) + w1 * bf2f((bf16_t)(b.y >> 16)));
            ss += x[i][0] * x[i][0] + x[i][1] * x[i][1] + x[i][2] * x[i][2] + x[i][3] * x[i][3]; }
        if (l == 1) {
            ss = wave_sum(ss); const float rs = rsqrtf(ss * (1.f / DM) + EPS);
#pragma unroll
            for (int i = 0; i < 4; ++i) { const int col = 256 * i + 4 * lane; const f32x4 g = *(const f32x4*)(p.in[I_FNG] + col);
                *(f32x4*)(hp + col) = (f32x4){x[i][0] * rs * g[0], x[i][1] * rs * g[1], x[i][2] * rs * g[2], x[i][3] * rs * g[3]}; }
        } else {
#pragma unroll
            for (int i = 0; i < 4; ++i) *(f32x4*)(hp + 256 * i + 4 * lane) = (f32x4){x[i][0], x[i][1], x[i][2], x[i][3]};
        }
    }
}

__device__ __forceinline__ int chain_chunk(int dir, int ci) { return dir == 0 ? ci : (ci < 4 ? 3 - ci : 135 - ci); }

__device__ __forceinline__ void phase_seq_rg(const P& p, int l) {
    const int tid_ = otid(); if (tid_ >= 64 || blockIdx.x >= 32) return;
    const int u = blockIdx.x, lane = tid_, blk = u & 7, dir = (u >> 3) & 1, b = u >> 4, ch = blk * 64 + lane;
    const bf16_t* Z = (const bf16_t*)(p.ws + WS_BIG + BIG_Z);
    float* O = (float*)(p.ws + WS_BIG + BIG_ST) + (size_t)dir * TT * 512;
    float Wr[64], Wi[64];
    const float* gw = p.in[I_RGGW] + ((((size_t)l * 2 + dir) * 2) * 8 + blk) * 4096;
#pragma unroll
    for (int i = 0; i < 64; ++i) { Wr[i] = gw[i * 64 + lane]; Wi[i] = gw[8 * 4096 + i * 64 + lane]; }
    const float br = p.in[I_RGGB][((l * 2 + dir) * 2 + 0) * 512 + ch], bi = p.in[I_RGGB][((l * 2 + dir) * 2 + 1) * 512 + ch];
    const float sp = softplusf(-p.in[I_RGLAM][(l * 2 + dir) * 512 + ch]);
    float cw[4];
#pragma unroll
    for (int j = 0; j < 4; ++j) cw[j] = p.in[I_RGCW][(l * 4 + j) * 512 + ch];
    const float cb = p.in[I_RGCB][l * 512 + ch];
    float h = 0.f;
    for (int s = 0; s < NTOK; ++s) {
        int pp; if (dir == 0) pp = s; else pp = s < CTXL ? CTXL - 1 - s : NTOK - 1 - (s - CTXL);
        const int lo = pp < CTXL ? 0 : CTXL, hi = pp < CTXL ? CTXL : NTOK;
        float xb = cb;
#pragma unroll
        for (int j = 0; j < 4; ++j) { const int q = pp + j - 2; if (q >= lo && q < hi) xb += cw[j] * bf2f(Z[((size_t)b * NTOK + q) * ZLD + RGX + ch]); }
        float pr = br, pi = bi;
#pragma unroll
        for (int i = 0; i < 64; ++i) { const float xi = __uint_as_float(__builtin_amdgcn_readlane(__float_as_uint(xb), i)); pr += xi * Wr[i]; pi += xi * Wi[i]; }
        const float r = sigm(pr), ig = sigm(pi), la = -8.f * r * sp, a = __expf(la), bt = sqrtf(-expm1f(2.f * la)) * (ig * xb);
        h = a * h + bt;
        O[((size_t)b * NTOK + pp) * 512 + ch] = h;
    }
}
__device__ __forceinline__ void phase_epi_rg(const P& p) {
    const int tid_ = otid();
    const bf16_t* Z = (const bf16_t*)(p.ws + WS_BIG + BIG_Z); const float* OF = (const float*)(p.ws + WS_BIG + BIG_ST); const float* OB = OF + (size_t)TT * 512;
    bf16_t* YS = (bf16_t*)(p.ws + WS_BIG + BIG_YS);
    for (size_t i = (size_t)blockIdx.x * 512 + tid_; i < (size_t)TT * 512; i += (size_t)gridDim.x * 512) { const size_t r = i >> 9; const int ch = (int)(i & 511);
        YS[i] = f2bf(gelu_tanh(bf2f(Z[r * ZLD + RGY + ch])) * (OF[i] + OB[i])); }
}
template <int BR> __device__ __forceinline__ void phase_seq_gl(const P& p, int l, LAS float* sm) {
    constexpr int DK = BR == 1 ? 64 : 128, DP = DK / 4;
    if (blockIdx.x >= 16) return;
    LAS float* LA = sm; LAS float* LK = sm + 64 * DK; LAS float* LQ = sm + 2 * 64 * DK; LAS float* LV = sm + 3 * 64 * DK;
    const int u = blockIdx.x, tid = otid(), dir = u & 1, h = (u >> 1) & 3, b = u >> 3, v = tid >> 2, part = tid & 3;
    const bf16_t* Z = (const bf16_t*)(p.ws + WS_BIG + BIG_Z); const float* MISC = (const float*)(p.ws + WS_MISC);
    float* O = (float*)(p.ws + WS_BIG + BIG_ST) + (size_t)dir * TT * 512;
    float S[DP];
#pragma unroll
    for (int i = 0; i < DP; ++i) S[i] = 0.f;
    for (int ci = 0; ci < NCHUNK; ++ci) {
        const int c = chain_chunk(dir, ci); const size_t r0 = (size_t)b * NTOK + c * 64;
        __syncthreads();
        for (int idx = tid; idx < 64 * DK; idx += 512) { const int t = idx / DK, d = idx % DK; const size_t r = r0 + t;
            float a, k, q;
            if (BR == 1) { float pre = p.in[I_GLABLR][(l * 2 + dir) * 256 + h * 64 + d];
                for (int rr = 0; rr < 16; ++rr) pre += MISC[r * 64 + MISC_LR + dir * 16 + rr] * p.in[I_GLAWLR][((size_t)(l * 2 + dir) * 16 + rr) * 256 + h * 64 + d];
                a = __expf(logsig(pre) * (1.f / 16.f)); k = bf2f(Z[r * ZLD + GK + h * 64 + d]); q = bf2f(Z[r * ZLD + GQ + h * 64 + d]) * 0.125f; }
            else { float lb = 0.f; if (l == 1) { const float l0 = p.in[I_HGLB][(0 * 2 + dir) * 512 + h * 128 + d], l1 = p.in[I_HGLB][(1 * 2 + dir) * 512 + h * 128 + d]; lb = 1.f / (1.f + __expf(l0 - l1)); }
                const float f = bf2f(Z[r * ZLD + HF + dir * 512 + h * 128 + d]); const float s = sigm(f);
                a = lb + (1.f - lb) * s; k = (1.f - lb) * sigm(-f); q = siluf(bf2f(Z[r * ZLD + HQ + h * 128 + d])) * 0.08838834764831845f; }
            LA[idx] = a; LK[idx] = k; LQ[idx] = q; }
        for (int idx = tid; idx < 64 * 128; idx += 512) { const int t = idx >> 7, vv = idx & 127; LV[idx] = bf2f(Z[(r0 + t) * ZLD + (BR == 1 ? GV : HI) + h * 128 + vv]); }
        __syncthreads();
        for (int j = 0; j < 64; ++j) { const int t = dir == 0 ? j : 63 - j; const float vv = LV[t * 128 + v]; float o = 0.f;
#pragma unroll
            for (int i = 0; i < DP; ++i) { const int d = part * DP + i; S[i] = LA[t * DK + d] * S[i] + LK[t * DK + d] * vv; o += S[i] * LQ[t * DK + d]; }
            o += __shfl_xor(o, 1); o += __shfl_xor(o, 2);
            if (part == 0) O[(r0 + t) * 512 + h * 128 + v] = o; }
    }
}
__device__ __forceinline__ void phase_seq_ml(const P& p, int l, LAS float* sm) {
    if (blockIdx.x >= 16) return;
    LAS float* LK = sm; LAS float* LQ = sm + 8192; LAS float* LV = sm + 16384; LAS float* LI = sm + 24576; LAS float* LF = LI + 64;
    const int u = blockIdx.x, tid = otid(), dir = u & 1, h = (u >> 1) & 3, b = u >> 3, v = tid >> 2, part = tid & 3;
    const bf16_t* Z = (const bf16_t*)(p.ws + WS_BIG + BIG_Z); const float* MISC = (const float*)(p.ws + WS_MISC);
    float* O = (float*)(p.ws + WS_BIG + BIG_ST) + (size_t)dir * TT * 512;
    float C[32], N[32]; float m = 0.f;
#pragma unroll
    for (int i = 0; i < 32; ++i) { C[i] = 0.f; N[i] = 0.f; }
    for (int ci = 0; ci < NCHUNK; ++ci) {
        const int c = chain_chunk(dir, ci); const int p0 = c * 64; const size_t r0 = (size_t)b * NTOK + p0;
        const int lo = p0 < CTXL ? 0 : CTXL, hi = p0 < CTXL ? CTXL : NTOK;
        __syncthreads();
        for (int idx = tid; idx < 64 * 128; idx += 512) { const int t = idx >> 7, d = idx & 127, ch = h * 128 + d; const int pp = p0 + t;
            float q = p.in[I_MLCB][l * 1024 + ch], k = p.in[I_MLCB][l * 1024 + 512 + ch];
#pragma unroll
            for (int j = 0; j < 4; ++j) { const int qq = pp + j - 2; if (qq >= lo && qq < hi) { const size_t rr = (size_t)b * NTOK + qq;
                q += p.in[I_MLCW][(l * 4 + j) * 1024 + ch] * bf2f(Z[rr * ZLD + MQ + ch]); k += p.in[I_MLCW][(l * 4 + j) * 1024 + 512 + ch] * bf2f(Z[rr * ZLD + MK + ch]); } }
            LQ[idx] = siluf(q) * 0.08838834764831845f; LK[idx] = siluf(k); LV[idx] = bf2f(Z[(r0 + t) * ZLD + MV + ch]); }
        if (tid < 64) { const size_t r = r0 + tid; LI[tid] = MISC[r * 64 + MISC_IF + dir * 8 + h] + p.in[I_MLGB][(l * 2 + dir) * 8 + h];
            LF[tid] = logsig(MISC[r * 64 + MISC_IF + dir * 8 + 4 + h] + p.in[I_MLGB][(l * 2 + dir) * 8 + 4 + h]); }
        __syncthreads();
        for (int j = 0; j < 64; ++j) { const int t = dir == 0 ? j : 63 - j; const float it = LI[t], lf = LF[t];
            const float mn = fmaxf(lf + m, it), fd = __expf(lf + m - mn), iw = __expf(it - mn); m = mn;
            const float vv = LV[t * 128 + v]; float num = 0.f, den = 0.f;
#pragma unroll
            for (int i = 0; i < 32; ++i) { const int d = part * 32 + i; const float kd = LK[t * 128 + d], qd = LQ[t * 128 + d]; C[i] = fd * C[i] + iw * kd * vv; N[i] = fd * N[i] + iw * kd; num += C[i] * qd; den += N[i] * qd; }
            num += __shfl_xor(num, 1); num += __shfl_xor(num, 2); den += __shfl_xor(den, 1); den += __shfl_xor(den, 2);
            if (part == 0) O[(r0 + t) * 512 + h * 128 + v] = num / fmaxf(fabsf(den), __expf(-mn)); }
    }
}
template <int BR> __device__ __forceinline__ void phase_epi_norm(const P& p, int l) {
    const int tid_ = otid(), lane = tid_ & 63; const bf16_t* Z = (const bf16_t*)(p.ws + WS_BIG + BIG_Z);
    const float* OF = (const float*)(p.ws + WS_BIG + BIG_ST); const float* OB = OF + (size_t)TT * 512;
    bf16_t* YS = (bf16_t*)(p.ws + WS_BIG + BIG_YS) + (size_t)BR * TT * 512;
    const float* gain = (BR == 1 ? p.in[I_GLANG] : BR == 2 ? p.in[I_HGNG] : p.in[I_MLNG]) + l * 128;
    const int goff = BR == 1 ? GG : BR == 2 ? HGT : MO;
    for (int w = blockIdx.x * 8 + (tid_ >> 6); w < TT * 4; w += gridDim.x * 8) { const size_t r = w >> 2; const int h = w & 3;
        const size_t i0 = r * 512 + h * 128 + lane, i1 = i0 + 64; const float o0 = OF[i0] + OB[i0], o1 = OF[i1] + OB[i1];
        const float ss = wave_sum(o0 * o0 + o1 * o1), rs = rsqrtf(ss * (1.f / 128.f) + EPS);
        const float g0 = bf2f(Z[r * ZLD + goff + h * 128 + lane]), g1 = bf2f(Z[r * ZLD + goff + h * 128 + lane + 64]);
        const float a0 = BR == 3 ? sigm(g0) : siluf(g0), a1 = BR == 3 ? sigm(g1) : siluf(g1);
        YS[i0] = f2bf(o0 * rs * gain[lane] * a0); YS[i1] = f2bf(o1 * rs * gain[lane + 64] * a1); }
}

constexpr int LDS_BYTES = 147456, NPH_LAYER = 21, NPH = 1 + 2 * NPH_LAYER;
__global__ void __launch_bounds__(512, 2) mega(P p_unused) {
    extern __shared__ __attribute__((aligned(16))) unsigned char lds[];
    LAS unsigned char* L = (LAS unsigned char*)lds;
    LAS int* tbl = (LAS int*)(L + 131072 + 1024);
    int lo, hi; unsigned* barw;
    { const P p = load_args(); lo = p.ph_lo; hi = p.ph_hi; barw = (unsigned*)(p.ws + WS_CTL); }
    if (threadIdx.x < 4) ((LAS unsigned*)(L + LDS_BYTES - 16))[threadIdx.x] = 0u;
    __syncthreads();
    XcdBarrier bar; bar.bar = barw; bar.x = 0; bar.st = nullptr;
    if (hi - lo > 1) bar = xcd_barrier_post(barw, (volatile LAS unsigned*)(L + LDS_BYTES - 16));
#define IN(k) (lo <= (k) && (k) < hi)
#define SEAM(k) do { if (IN((k) + 1)) xcd_barrier(bar); } while (0)
#define PHASE(k, ...) if (IN(k)) { const P p = load_args(); unsigned char* ws = p.ws; unsigned char* wb = ws + WS_WB; unsigned char* big = ws + WS_BIG; (void)wb; (void)big; __VA_ARGS__ SEAM(k); }
    PHASE(0, phase_mods(p, (LAS float*)L);)
#define LAYER_BODY(l) { constexpr int pb = 1 + NPH_LAYER * (l); \
    PHASE(pb + 0, phase_convert(p, l, (LAS float*)L);) \
    PHASE(pb + 1, phase_norm1(p, l);) \
    PHASE(pb + 2, Gemm g{(const bf16_t*)(ws + WS_U), (const bf16_t*)(wb + WB_WIN), DM, DM}; OrderPlain S; S.init(MT, 11, gridDim.x, blockIdx.x); S.skipctx = 0; \
        EpiZ E{(bf16_t*)(big + BIG_Z), (float*)(ws + WS_MISC), 10}; GEMM_RUN(EpiZ, OrderPlain, g, S, E);) \
    PHASE(pb + 3, phase_seq_rg(p, l);) \
    PHASE(pb + 4, phase_epi_rg(p);) \
    PHASE(pb + 5, phase_seq_gl<1>(p, l, (LAS float*)L);) \
    PHASE(pb + 6, phase_epi_norm<1>(p, l);) \
    PHASE(pb + 7, Gemm g{(const bf16_t*)(ws + WS_U), (const bf16_t*)(wb + WB_WIN) + (size_t)2816 * DM, DM, DM}; OrderPlain S; S.init(MT, 10, gridDim.x, blockIdx.x); S.skipctx = 0; \
        EpiZ E{(bf16_t*)(big + BIG_Z), (float*)(ws + WS_MISC), -1}; GEMM_RUN(EpiZ, OrderPlain, g, S, E);) \
    PHASE(pb + 8, phase_seq_gl<2>(p, l, (LAS float*)L);) \
    PHASE(pb + 9, phase_epi_norm<2>(p, l);) \
    PHASE(pb + 10, Gemm g{(const bf16_t*)(ws + WS_U), (const bf16_t*)(wb + WB_WIN) + (size_t)5376 * DM, DM, DM}; OrderPlain S; S.init(MT, 8, gridDim.x, blockIdx.x); S.skipctx = 0; \
        EpiZ E{(bf16_t*)(big + BIG_Z), (float*)(ws + WS_MISC), -1}; GEMM_RUN(EpiZ, OrderPlain, g, S, E);) \
    PHASE(pb + 11, phase_seq_ml(p, l, (LAS float*)L);) \
    PHASE(pb + 12, phase_epi_norm<3>(p, l);) \
    PHASE(pb + 13, Gemm g{(const bf16_t*)(big + BIG_YS), (const bf16_t*)(wb + WB_WB), 512, 512}; OrderBranch S; S.init((l) ? 64 : MT, 16, gridDim.x, blockIdx.x); S.skipctx = (l); \
        EpiBO E{(bf16_t*)(big + BIG_BO)}; GEMM_RUN(EpiBO, OrderBranch, g, S, E);) \
    PHASE(pb + 14, Gemm g{(const bf16_t*)(ws + WS_U), (const bf16_t*)(wb + WB_WM), DM, DM}; OrderPlain S; S.init((l) ? 64 : MT, 16, gridDim.x, blockIdx.x); S.skipctx = (l); \
        EpiMerge E{(const bf16_t*)(big + BIG_BO), p.in[I_BMERGE] + (size_t)(l) * 4096, (bf16_t*)(big + BIG_MERGED)}; GEMM_RUN(EpiMerge, OrderPlain, g, S, E);) \
    PHASE(pb + 15, Gemm g{(const bf16_t*)(big + BIG_MERGED), (const bf16_t*)(wb + WB_WO), DM, DM}; OrderPlain S; S.init((l) ? 64 : MT, 4, gridDim.x, blockIdx.x); S.skipctx = (l); \
        EpiOut E{(l) == 0 ? p.in[I_X] : p.out, (l) == 0 ? p.in[I_CTX] : (const float*)(ws + WS_HCTX), p.out, (float*)(ws + WS_HCTX), (const float*)(ws + WS_MOD) + (size_t)(l) * 3 * 6144}; \
        GEMM_RUN(EpiOut, OrderPlain, g, S, E);) \
    PHASE(pb + 16, phase_route(p, l);) \
    PHASE(pb + 17, phase_dispatch(p, l, tbl);) \
    PHASE(pb + 18, const int nblk = moe_tables(p, l, tbl); Gemm g{(const bf16_t*)(big + BIG_XS), (const bf16_t*)(wb + WB_W13), DM, DM}; OrderMoe S; S.init(nblk, 4, gridDim.x, blockIdx.x); S.blk_e = tbl + 32; \
        EpiH E{(bf16_t*)(big + BIG_HS)}; GEMM_RUN(EpiH, OrderMoe, g, S, E);) \
    PHASE(pb + 19, const int nblk = moe_tables(p, l, tbl); Gemm g{(const bf16_t*)(big + BIG_HS), (const bf16_t*)(wb + WB_W2), 512, 512}; OrderMoe S; S.init(nblk, 4, gridDim.x, blockIdx.x); S.blk_e = tbl + 32; \
        EpiY E{(bf16_t*)(big + BIG_YM)}; GEMM_RUN(EpiY, OrderMoe, g, S, E);) \
    PHASE(pb + 20, phase_combine(p, l);) }
    LAYER_BODY(0)
    LAYER_BODY(1)
#undef LAYER_BODY
#undef PHASE
#undef SEAM
#undef IN
}

#ifndef N_LAUNCHES
#define N_LAUNCHES 1
#endif
extern "C" void kernel_launch(void* const* d_in, const int* in_sizes, int n_in, void* d_out, int out_size, void* d_ws, size_t ws_size, hipStream_t stream) {
    static int grid = 0;
    if (grid == 0) {
        if (n_in != N_IN || out_size != NBATCH * SEQL * DM || ws_size < WS_END) { fprintf(stderr, "kernel_launch: unexpected shapes (n_in %d out %d ws %zu need %zu)\n", n_in, out_size, ws_size, (size_t)WS_END); grid = -1; return; }
        int dev = 0, cus = 0, per_cu = 0;
        if (hipGetDevice(&dev) != hipSuccess || hipDeviceGetAttribute(&cus, hipDeviceAttributeMultiprocessorCount, dev) != hipSuccess) { grid = -1; return; }
        if (hipFuncSetAttribute((const void*)mega, hipFuncAttributeMaxDynamicSharedMemorySize, LDS_BYTES) != hipSuccess) { grid = -1; return; }
        if (hipOccupancyMaxActiveBlocksPerMultiprocessor(&per_cu, (const void*)mega, 512, LDS_BYTES) != hipSuccess || per_cu < 1) { fprintf(stderr, "kernel_launch: occupancy query says %d\n", per_cu); }
        (void)hipGetLastError();
        grid = cus;
    }
    if (grid < 0) return;
    (void)hipMemsetAsync((char*)d_ws + WS_CTL, 0, 65536, stream);
    P p{};
    for (int i = 0; i < N_IN; ++i) p.in[i] = (const float*)d_in[i];
    p.out = (float*)d_out; p.ws = (unsigned char*)d_ws;
    if (N_LAUNCHES == 1) { p.ph_lo = 0; p.ph_hi = NPH; hipLaunchKernelGGL(mega, dim3(grid), dim3(512), LDS_BYTES, stream, p); }
    else for (int k = 0; k < NPH; ++k) { p.ph_lo = k; p.ph_hi = k + 1; hipLaunchKernelGGL(mega, dim3(grid), dim3(512), LDS_BYTES, stream, p); }
}
```

```cpp
#include <hip/hip_runtime.h>
#include <cstdio>
#include <cstdint>

#define LAS __attribute__((address_space(3)))
typedef unsigned short bf16_t;
typedef short bf16x8 __attribute__((ext_vector_type(8)));
typedef float f32x4 __attribute__((ext_vector_type(4)));
typedef unsigned u32x4 __attribute__((ext_vector_type(4)));
typedef unsigned u32x2 __attribute__((ext_vector_type(2)));

#define XB_TMO      128
#define XB_XCNT(j)  (256  + 64 * (j))
#define XB_XSUB(j)  (1280 + 64 * (j))
#define XB_XGEN(j)  (2304 + 64 * (j))
#define XB_TOP      3328
#define XB_TOPGEN   3392
#define XCD_BAR_WORDS 3456
#define XB_SPIN_CAP (1u << 18)

__device__ __forceinline__ unsigned xb_ld(unsigned* p)              { return __hip_atomic_load(p, __ATOMIC_RELAXED, __HIP_MEMORY_SCOPE_AGENT); }
__device__ __forceinline__ unsigned xb_add(unsigned* p, unsigned v) { return __hip_atomic_fetch_add(p, v, __ATOMIC_RELAXED, __HIP_MEMORY_SCOPE_AGENT); }
__device__ __forceinline__ unsigned xb_xcc_id() { return (unsigned)__builtin_amdgcn_s_getreg((3 << 11) | 20) & 0xFu; }
#define XB_SPIN(cond, bar) do { unsigned _sp = 0; while (cond) { __builtin_amdgcn_s_sleep(1); \
    if ((++_sp & 255u) == 0u) { if (xb_ld(&(bar)[XB_TMO])) break; if (_sp > XB_SPIN_CAP) { atomicAdd(&(bar)[XB_TMO], 1u); break; } } } } while (0)

struct XcdBarrier {
    unsigned* bar; unsigned x;
    int swid;
    volatile LAS unsigned* st;
};

__device__ __forceinline__ XcdBarrier xcd_barrier_post(unsigned* bar, volatile LAS unsigned* st, int swid) {
    XcdBarrier b; b.bar = bar; b.x = xb_xcc_id(); b.st = st; b.swid = swid;
    if (swid == 0 && __builtin_amdgcn_mbcnt_hi(~0u, __builtin_amdgcn_mbcnt_lo(~0u, 0u)) == 0u) (void)xb_add(&bar[XB_XCNT(b.x)], 1u);
    return b;
}
__device__ __forceinline__ void xcd_barrier_complete(unsigned* bar, unsigned x, unsigned& nloc, unsigned& nx) {
    const unsigned G = gridDim.x * gridDim.y * gridDim.z;
    unsigned sum, cnt, mine, sp = 0u;
    for (;;) {
        sum = 0u; cnt = 0u; mine = 0u;
#pragma unroll
        for (unsigned j = 0; j < 16; ++j) { const unsigned c = xb_ld(&bar[XB_XCNT(j)]); sum += c; cnt += (c > 0u) ? 1u : 0u; mine = (j == x) ? c : mine; }
        if (sum == G) break;
        __builtin_amdgcn_s_sleep(1);
        if ((++sp & 255u) == 0u) { if (xb_ld(&bar[XB_TMO])) break; if (sp > XB_SPIN_CAP) { atomicAdd(&bar[XB_TMO], 1u); break; } }
    }
    nloc = mine > 0u ? mine : 1u; nx = cnt > 0u ? cnt : 1u;
}

__device__ __forceinline__ void xcd_barrier(const XcdBarrier& b) {
    asm volatile("s_waitcnt vmcnt(0)" ::: "memory");
    __syncthreads();
    if (b.swid == 0 && __builtin_amdgcn_mbcnt_hi(~0u, __builtin_amdgcn_mbcnt_lo(~0u, 0u)) == 0u) {
        unsigned* bar = b.bar;
        __builtin_amdgcn_s_waitcnt(0);
        unsigned nloc = b.st[0], nx = b.st[1];
        if (nloc == 0u) { xcd_barrier_complete(bar, b.x, nloc, nx); b.st[0] = nloc; b.st[1] = nx; }
        const unsigned old = xb_add(&bar[XB_XSUB(b.x)], 1u);
        const unsigned gen = old / nloc;
        if (old + 1u == (gen + 1u) * nloc) {
            __builtin_amdgcn_fence(__ATOMIC_RELEASE, "agent");
            asm volatile("s_waitcnt vmcnt(0)" ::: "memory");
            const unsigned og = xb_add(&bar[XB_TOP], 1u);
            const unsigned tg = og / nx;
            if (og + 1u == (tg + 1u) * nx) xb_add(&bar[XB_TOPGEN], 1u);
            else XB_SPIN(xb_ld(&bar[XB_TOPGEN]) == tg, bar);
            __builtin_amdgcn_fence(__ATOMIC_ACQUIRE, "agent");
            xb_add(&bar[XB_XGEN(b.x)], 1u);
            asm volatile("s_waitcnt vmcnt(0)" ::: "memory");
        } else {
            XB_SPIN(xb_ld(&bar[XB_XGEN(b.x)]) == gen, bar);
            __builtin_amdgcn_fence(__ATOMIC_ACQUIRE, "agent");
            asm volatile("s_waitcnt vmcnt(0)" ::: "memory");
        }
    }
    __syncthreads();
}


constexpr int DM = 1024, NBATCH = 2, SEQL = 8192, CTXL = 256, NTOK = 8448, TT = 16896, NCHUNK = 132, MT = 66;
constexpr int ZLD = 2560;
constexpr float EPS = 1e-6f;
constexpr int RGX = 0, RGY = 512, GQ = 1024, GK = 1280, GV = 1536, GG = 2048;
constexpr int HQ = 0, HI = 512, HF = 1024, HGT = 2048;
constexpr int MQ = 0, MK = 512, MV = 1024, MO = 1536;
constexpr int MISC_LR = 0, MISC_IF = 32;
constexpr int NSLOT_MAX = 37888;

enum { I_X = 0, I_C, I_CTX, I_CCTX, I_ADAW, I_ADAB, I_NMIXG, I_NFFNG, I_WIN, I_RGCW, I_RGCB, I_RGGW, I_RGGB, I_RGLAM, I_GLAWLR, I_GLABLR, I_GLANG,
       I_HGLB, I_HGNG, I_MLCW, I_MLCB, I_MLGB, I_MLNG, I_WBR, I_WMERGE, I_BMERGE, I_WOUT, I_MWG, I_MBG, I_MWE, I_MBE, I_MW1, I_MW3, I_MW2, I_FNG, N_IN };

constexpr size_t WS_CTL = 0;
constexpr size_t WS_MOD = 65536;
constexpr size_t WS_HCTX = 262144;
constexpr size_t WS_ROUTE = WS_HCTX + 2097152;
constexpr size_t WS_MISC = WS_ROUTE + 1048576;
constexpr size_t WS_SMALL = WS_MISC + 4325376;
constexpr size_t WS_WB = WS_SMALL + 8388608;
constexpr size_t WB_WIN = 0, WB_WM = WB_WIN + 15204352, WB_WB = WB_WM + 8388608, WB_WO = WB_WB + 4194304, WB_W13 = WB_WO + 2097152,
                 WB_W2 = WB_W13 + 33554432, WB_GW = WB_W2 + 16777216, WB_END = WB_GW + 262144;
constexpr size_t WS_U = WS_WB + WB_END;
constexpr size_t WS_BIG = WS_U + 34603008;
constexpr size_t BIG_Z = 0, BIG_ST = 86507520, BIG_YS = BIG_ST + 69206016 + 65536, BIG_END = BIG_YS + 69206016;
constexpr size_t WS_END = WS_BIG + BIG_END;
constexpr size_t BIG_BO = 0;
constexpr size_t BIG_MERGED = BIG_YS;
constexpr size_t BIG_XS = 0;
constexpr size_t BIG_HS = 77594624;
constexpr size_t BIG_YM = BIG_HS + 38797312;
static_assert(BIG_YM + 77594624 <= BIG_END, "moe alias");
static_assert(138412032 <= BIG_YS, "BO alias");
constexpr int CW_CNT = 4096;

struct P { const float* in[N_IN]; float* out; unsigned char* ws; int ph_lo, ph_hi; };
struct PP : P { int swid; };

__device__ __forceinline__ float bf2f(bf16_t b) { return __uint_as_float(((unsigned)b) << 16); }
__device__ __forceinline__ bf16_t f2bf(float f) { unsigned u = __float_as_uint(f); u += 0x7FFFu + ((u >> 16) & 1u); return (bf16_t)(u >> 16); }
__device__ __forceinline__ unsigned pack2(float lo, float hi) { return (unsigned)f2bf(lo) | ((unsigned)f2bf(hi) << 16); }
__device__ __forceinline__ float sigm(float x) { return 1.f / (1.f + __expf(-x)); }
__device__ __forceinline__ float siluf(float x) { return x * sigm(x); }
__device__ __forceinline__ float logsig(float x) { return fminf(x, 0.f) - log1pf(__expf(-fabsf(x))); }
__device__ __forceinline__ float softplusf(float x) { return fmaxf(x, 0.f) + log1pf(__expf(-fabsf(x))); }
__device__ __forceinline__ float gelu_tanh(float x) { const float y = 0.7978845608028654f * (x + 0.044715f * x * x * x); const float t = 1.f - 2.f / (__expf(2.f * y) + 1.f); return 0.5f * x * (1.f + t); }
__device__ __forceinline__ float wave_sum(float v) {
#pragma unroll
    for (int o = 32; o > 0; o >>= 1) v += __shfl_xor(v, o);
    return v;
}
__device__ __forceinline__ int lane_id() { return (int)__builtin_amdgcn_mbcnt_hi(~0u, __builtin_amdgcn_mbcnt_lo(~0u, 0u)); }
__device__ __forceinline__ int otid(int swid) { int t = swid * 64 + lane_id(); asm volatile("" : "+v"(t)); return t; }
__device__ __forceinline__ const float* hrow_c(const float* HL, const float* HC, int r) { const int b = r / NTOK, p = r - b * NTOK; return p < CTXL ? HC + ((size_t)b * CTXL + p) * DM : HL + ((size_t)b * SEQL + (p - CTXL)) * DM; }
__device__ __forceinline__ float* hrow_m(float* HL, float* HC, int r) { const int b = r / NTOK, p = r - b * NTOK; return p < CTXL ? HC + ((size_t)b * CTXL + p) * DM : HL + ((size_t)b * SEQL + (p - CTXL)) * DM; }
__device__ __forceinline__ int mod_idx(int r) { const int b = r / NTOK, p = r - b * NTOK; return p < CTXL ? 2 : b; }

typedef const __attribute__((address_space(4))) P* KP;
__device__ __forceinline__ PP load_args(int swid) { unsigned long long a = (unsigned long long)__builtin_amdgcn_kernarg_segment_ptr(); asm volatile("" : "+s"(a)); KP k = (KP)a; PP r; r.swid = swid;
#pragma unroll
    for (int i = 0; i < N_IN; ++i) r.in[i] = k->in[i];
    r.out = k->out; r.ws = k->ws; r.ph_lo = k->ph_lo; r.ph_hi = k->ph_hi; return r; }
struct Unit { int pm, pn; };
struct Gemm { const bf16_t* A; const bf16_t* Bt; int lda; int K; int swid; };

struct TileOrder {
    int nM, nN, G, c;
    __device__ __forceinline__ void a_ready(const Unit&) const {}
    __device__ __forceinline__ void done(const Unit&) const {}
    __device__ void init(int nM_, int nN_, int G_, int c_) { nM = nM_; nN = nN_; G = G_; c = c_; }
    __device__ __forceinline__ bool base(int i, Unit& u) const { const long L = (long)i * G + c; if (L >= (long)nM * nN) return false; u.pm = (int)(L / nN); u.pn = (int)(L % nN); return true; }
};
struct OrderPlain : TileOrder { int skipctx; __device__ __forceinline__ bool next(int i, Unit& u) const { if (!base(i, u)) return false; if (skipctx) u.pm = u.pm < 32 ? u.pm + 1 : u.pm + 2; return true; } };
struct OrderBranch : TileOrder { int skipctx; __device__ __forceinline__ bool next(int i, Unit& u) const { if (!base(i, u)) return false; int pm = u.pm; if (skipctx) pm = pm < 32 ? pm + 1 : pm + 2; u.pm = (u.pn >> 2) * MT + pm; return true; } };
struct OrderMoe : TileOrder { const LAS int* blk_e; __device__ __forceinline__ bool next(int i, Unit& u) const { if (!base(i, u)) return false; u.pn = blk_e[u.pm] * 4 + u.pn; return true; } };

template <class Epi, class Sched>
__device__ __forceinline__ void gemm_simple(const Gemm g, const Sched& S, const Epi& E) {
    const int tid = otid(g.swid), wid = tid >> 6, lane = tid & 63, wr = wid >> 2, wc = wid & 3, fr = lane & 15, fq = lane >> 4;
    Unit u;
    for (int it = 0; S.next(it, u); ++it) {
        f32x4 acc[2][2][4][2];
#pragma unroll
        for (int a = 0; a < 2; ++a)
#pragma unroll
            for (int b = 0; b < 2; ++b)
#pragma unroll
                for (int m = 0; m < 4; ++m)
#pragma unroll
                    for (int n = 0; n < 2; ++n) acc[a][b][m][n] = (f32x4){0.f, 0.f, 0.f, 0.f};
        const bf16_t* Ap = g.A + (size_t)(u.pm * 256 + wr * 64 + fr) * g.lda + fq * 8;
        const bf16_t* Bp = g.Bt + (size_t)(u.pn * 256 + wc * 32 + fr) * g.K + fq * 8;
        for (int k0 = 0; k0 < g.K; k0 += 32) {
            bf16x8 b[2][2];
#pragma unroll
            for (int bj = 0; bj < 2; ++bj)
#pragma unroll
                for (int n = 0; n < 2; ++n) b[bj][n] = *(const bf16x8*)(Bp + (size_t)(bj * 128 + n * 16) * g.K + k0);
#pragma unroll
            for (int ai = 0; ai < 2; ++ai) {
                bf16x8 a[4];
#pragma unroll
                for (int m = 0; m < 4; ++m) a[m] = *(const bf16x8*)(Ap + (size_t)(ai * 128 + m * 16) * g.lda + k0);
#pragma unroll
                for (int bj = 0; bj < 2; ++bj)
#pragma unroll
                    for (int m = 0; m < 4; ++m)
#pragma unroll
                        for (int n = 0; n < 2; ++n) acc[ai][bj][m][n] = __builtin_amdgcn_mfma_f32_16x16x32_bf16(b[bj][n], a[m], acc[ai][bj][m][n], 0, 0, 0);
                __builtin_amdgcn_sched_barrier(0);
            }
        }
        E(acc, u, wr, wc, fr, fq);
    }
}

#define PG8_LAS __attribute__((address_space(3)))
constexpr int BM = 256, BK = 64, HALF = 128, HTB = HALF * BK * 2  , STAGE_BYTES = 8 * HTB;
__host__ __device__ __forceinline__ int lds_byte(int r, int c) { const int st = (r >> 4) * 2 + (c >> 5), rr = r & 15, cc = c & 31, ob = rr * 64 + cc * 2; return st * 1024 + (ob ^ (((ob >> 9) & 1) << 5)); }
__host__ __device__ __forceinline__ void stage_rc(int b, int& R, int& C) { const int st = b / 1024, sb = b % 1024, swz = sb ^ (((sb >> 9) & 1) << 5); R = (st >> 1) * 16 + swz / 64; C = (st & 1) * 32 + (swz % 64) / 2; }
__host__ __device__ __forceinline__ int perm32(int rho) { const int n = rho >> 4, i = rho & 15; return 8 * (i >> 2) + 4 * n + (i & 3); }
template <class Epi, class Sched, bool STAMP = false>
__device__ __forceinline__ void gemm_phase(PG8_LAS unsigned char* lds, const Gemm g, const Sched& S, const Epi& E, unsigned long long* stamps = nullptr) {
    const int tid = otid(g.swid), wid = g.swid, lane = tid & 63, wr = wid >> 2, wc = wid & 3, fr = lane & 15, fq = lane >> 4;
    const int K = g.K, nt = K / BK;
    int ts_lo = 0, ts_hi = 0, nts = 0; const unsigned long long rt_entry = STAMP ? (unsigned long long)wall_clock64() : 0ull;
#define PG8_STAMP() do { if (STAMP && wid == 0 && nts < 64) { const unsigned long long _c = (unsigned long long)clock64(); \
        ts_lo = (lane == nts) ? (int)(unsigned)_c : ts_lo; ts_hi = (lane == nts) ? (int)(unsigned)(_c >> 32) : ts_hi; ++nts; } } while (0)
    PG8_STAMP();
    unsigned voffA[2], voffB[2];
#pragma unroll
    for (int i = 0; i < 2; ++i) { int R, C; stage_rc(tid * 16 + i * 8192, R, C); const int Rb = Epi::PERM ? ((R & ~31) + perm32(R & 31)) : R;
        voffA[i] = (unsigned)(R * K + C) * 2u; voffB[i] = (unsigned)(Rb * K + C) * 2u; }
    const size_t kstep = (size_t)(BK * 2);
    const size_t hstep = (size_t)HALF * K * 2;
    const size_t tstep = 2 * hstep;
    const unsigned ldsw = (unsigned)wid * 1024u;
    const int aoff = lds_byte(wr * 64 + fr, fq * 8), boff = lds_byte(wc * 32 + fr, fq * 8);
#define PG8_SA(b, h) (((b) * 2 + (h)) * HTB)
#define PG8_SB(b, h) ((4 + (b) * 2 + (h)) * HTB)
#define PG8_STAGE(bufoff, gbase, voff) do { _Pragma("unroll") for (int _i = 0; _i < 2; ++_i) \
        __builtin_amdgcn_global_load_lds((const unsigned*)((const char*)(gbase) + (voff)[_i]), (PG8_LAS unsigned*)(lds + (bufoff) + ldsw + _i * 8192), 16, 0, 0); } while (0)
#define PG8_LDA(dst, b, h) do { _Pragma("unroll") for (int m = 0; m < 4; ++m) _Pragma("unroll") for (int k = 0; k < 2; ++k) dst[m][k] = *(const PG8_LAS bf16x8*)(lds + PG8_SA(b, h) + aoff + m * 2048 + k * 1024); } while (0)
#define PG8_LDB(dst, b, h) do { _Pragma("unroll") for (int n = 0; n < 2; ++n) _Pragma("unroll") for (int k = 0; k < 2; ++k) dst[n][k] = *(const PG8_LAS bf16x8*)(lds + PG8_SB(b, h) + boff + n * 2048 + k * 1024); } while (0)
#define PG8_MMA(ai, bj, At, Bt) do { __builtin_amdgcn_s_setprio(1); _Pragma("unroll") for (int m = 0; m < 4; ++m) _Pragma("unroll") for (int n = 0; n < 2; ++n) _Pragma("unroll") for (int k = 0; k < 2; ++k) \
        acc[ai][bj][m][n] = __builtin_amdgcn_mfma_f32_16x16x32_bf16(Bt[n][k], At[m][k], acc[ai][bj][m][n], 0, 0, 0); __builtin_amdgcn_s_setprio(0); } while (0)
#define PG8_WAIT_V(n) asm volatile("s_waitcnt vmcnt(" #n ")" ::: "memory")
#define PG8_WAIT_L(n) asm volatile("s_waitcnt lgkmcnt(" #n ")" ::: "memory")
#define PG8_BAR __builtin_amdgcn_s_barrier()
#define PG8_SCHED __builtin_amdgcn_sched_barrier(0)
    Unit cur, nxt; int ui = 0;
    if (!S.next(0, cur)) return;
    f32x4 acc[2][2][4][2];
#pragma unroll
    for (int a = 0; a < 2; ++a)
#pragma unroll
        for (int b = 0; b < 2; ++b)
#pragma unroll
            for (int m = 0; m < 4; ++m)
#pragma unroll
                for (int n = 0; n < 2; ++n) acc[a][b][m][n] = (f32x4){0.f, 0.f, 0.f, 0.f};
    bf16x8 At[4][2], B0[2][2], B1[2][2];
    const char* cA = (const char*)g.A + (size_t)cur.pm * tstep; const char* cB = (const char*)g.Bt + (size_t)cur.pn * tstep;
    S.a_ready(cur);
    PG8_STAGE(PG8_SB(0, 0), cB, voffB); PG8_STAGE(PG8_SA(0, 0), cA, voffA); PG8_STAGE(PG8_SB(0, 1), cB + hstep, voffB); PG8_STAGE(PG8_SA(0, 1), cA + hstep, voffA);
    if (wr == 1) PG8_BAR;
    PG8_WAIT_V(4); PG8_BAR;
    PG8_STAGE(PG8_SB(1, 0), cB + kstep, voffB); PG8_STAGE(PG8_SA(1, 0), cA + kstep, voffA); PG8_STAGE(PG8_SB(1, 1), cB + hstep + kstep, voffB);
    PG8_WAIT_V(6); PG8_BAR;
    PG8_STAMP();
    for (;;) {
        const bool has_next = S.next(ui + 1, nxt);
        const char* nA = has_next ? (const char*)g.A + (size_t)nxt.pm * tstep : cA; const char* nB = has_next ? (const char*)g.Bt + (size_t)nxt.pn * tstep : cB;
        for (int t = 0; t < nt; t += 2) {
            const bool last = (t == nt - 2);
            const char* a1 = cA + (size_t)(t + 1) * kstep;
            const char* a2 = last ? nA : cA + (size_t)(t + 2) * kstep; const char* b2 = last ? nB : cB + (size_t)(t + 2) * kstep;
            const char* a3 = a2 + kstep; const char* b3 = b2 + kstep;
            if (last && has_next) S.a_ready(nxt);
            PG8_LDB(B0, 0, 0); PG8_SCHED; PG8_LDA(At, 0, 0); PG8_STAGE(PG8_SA(1, 1), a1 + hstep, voffA);
            PG8_WAIT_L(8); PG8_BAR; PG8_WAIT_L(0); PG8_MMA(0, 0, At, B0); PG8_BAR; PG8_SCHED;
            PG8_LDB(B1, 0, 1); PG8_STAGE(PG8_SB(0, 0), b2, voffB);
            PG8_BAR; PG8_WAIT_L(0); PG8_MMA(0, 1, At, B1); PG8_BAR;
            PG8_LDA(At, 0, 1); PG8_STAGE(PG8_SA(0, 0), a2, voffA);
            PG8_BAR; PG8_WAIT_L(0); PG8_MMA(1, 0, At, B0); PG8_BAR; PG8_SCHED;
            PG8_STAGE(PG8_SB(0, 1), b2 + hstep, voffB);
            PG8_WAIT_V(6); PG8_BAR; PG8_MMA(1, 1, At, B1); PG8_BAR;
            PG8_LDB(B0, 1, 0); PG8_SCHED; PG8_LDA(At, 1, 0); PG8_STAGE(PG8_SA(0, 1), a2 + hstep, voffA);
            PG8_WAIT_L(8); PG8_BAR; PG8_WAIT_L(0); PG8_MMA(0, 0, At, B0); PG8_BAR; PG8_SCHED;
            PG8_LDB(B1, 1, 1); PG8_STAGE(PG8_SB(1, 0), b3, voffB);
            PG8_BAR; PG8_WAIT_L(0); PG8_MMA(0, 1, At, B1); PG8_BAR;
            PG8_LDA(At, 1, 1); PG8_STAGE(PG8_SA(1, 0), a3, voffA);
            PG8_BAR; PG8_WAIT_L(0); PG8_MMA(1, 0, At, B0); PG8_BAR; PG8_SCHED;
            PG8_STAGE(PG8_SB(1, 1), b3 + hstep, voffB);
            PG8_WAIT_V(6); PG8_BAR; PG8_MMA(1, 1, At, B1); PG8_BAR;
        }
        PG8_STAMP();
        if constexpr (!Epi::AFTER_DRAIN) { E(acc, cur, wr, wc, fr, fq); S.done(cur); }
        PG8_STAMP();
        if (!has_next) break;
#pragma unroll
        for (int a = 0; a < 2; ++a)
#pragma unroll
            for (int b = 0; b < 2; ++b)
#pragma unroll
                for (int m = 0; m < 4; ++m)
#pragma unroll
                    for (int n = 0; n < 2; ++n) acc[a][b][m][n] = (f32x4){0.f, 0.f, 0.f, 0.f};
        cur = nxt; cA = nA; cB = nB; ++ui;
    }
    PG8_WAIT_V(0);
    if (wr == 0) PG8_BAR;
    PG8_BAR;
    if constexpr (Epi::AFTER_DRAIN) { E.fused(acc, cur, wr, wc, fr, fq, lds, wid, lane); S.done(cur); }
    PG8_STAMP();
    if (STAMP && wid == 0) { stamps[lane] = lane < nts ? (((unsigned long long)(unsigned)ts_hi << 32) | (unsigned)ts_lo) : 0ull;
        if (lane == 62) stamps[62] = rt_entry; if (lane == 63) stamps[63] = (unsigned long long)wall_clock64(); }
#undef PG8_STAMP
#undef PG8_SA
#undef PG8_SB
#undef PG8_STAGE
#undef PG8_LDA
#undef PG8_LDB
#undef PG8_MMA
#undef PG8_WAIT_V
#undef PG8_WAIT_L
#undef PG8_BAR
#undef PG8_SCHED
}

#ifdef USE_SIMPLE_GEMM
#define GEMM_RUN(EpiT, SchedT, g, S, E) gemm_simple<EpiT, SchedT>(g, S, E)
#else
#define GEMM_RUN(EpiT, SchedT, g, S, E) gemm_phase<EpiT, SchedT>(L, g, S, E)
#endif


struct EpiZ {
    static constexpr bool PERM = false, AFTER_DRAIN = false;
    bf16_t* Z; float* MISC; int misc_pn;
    __device__ __forceinline__ void operator()(const f32x4 (&acc)[2][2][4][2], const Unit& u, int wr, int wc, int fr, int fq) const {
        const int row0 = u.pm * 256 + wr * 64 + fr, col0 = u.pn * 256 + wc * 32 + 4 * fq;
#pragma unroll
        for (int ai = 0; ai < 2; ++ai)
#pragma unroll
            for (int m = 0; m < 4; ++m) { const int row = row0 + ai * 128 + m * 16;
#pragma unroll
                for (int bj = 0; bj < 2; ++bj)
#pragma unroll
                    for (int n = 0; n < 2; ++n) { const int col = col0 + bj * 128 + n * 16; const f32x4 v = acc[ai][bj][m][n];
                        if (u.pn == misc_pn) { const int cc = col - misc_pn * 256; if (cc < 64) *(f32x4*)(MISC + (size_t)row * 64 + cc) = v; }
                        else *(uint2*)(Z + (size_t)row * ZLD + col) = make_uint2(pack2(v[0], v[1]), pack2(v[2], v[3])); } }
    }
};
struct EpiBO {
    static constexpr bool PERM = false, AFTER_DRAIN = false;
    bf16_t* BO;
    __device__ __forceinline__ void operator()(const f32x4 (&acc)[2][2][4][2], const Unit& u, int wr, int wc, int fr, int fq) const {
        const int kb = u.pn >> 2, pm = u.pm - kb * MT, pn = u.pn & 3;
        const int row0 = pm * 256 + wr * 64 + fr, col0 = pn * 256 + wc * 32 + 4 * fq;
        bf16_t* base = BO + (size_t)kb * TT * DM;
#pragma unroll
        for (int ai = 0; ai < 2; ++ai)
#pragma unroll
            for (int m = 0; m < 4; ++m) { const int row = row0 + ai * 128 + m * 16;
#pragma unroll
                for (int bj = 0; bj < 2; ++bj)
#pragma unroll
                    for (int n = 0; n < 2; ++n) { const int col = col0 + bj * 128 + n * 16; const f32x4 v = acc[ai][bj][m][n];
                        *(uint2*)(base + (size_t)row * DM + col) = make_uint2(pack2(v[0], v[1]), pack2(v[2], v[3])); } }
    }
};
struct EpiMerge {
    static constexpr bool PERM = false, AFTER_DRAIN = false;
    const bf16_t* BO; const float* bm; bf16_t* MG;
    __device__ __forceinline__ void operator()(const f32x4 (&acc)[2][2][4][2], const Unit& u, int wr, int wc, int fr, int fq) const {
        const int row0 = u.pm * 256 + wr * 64 + fr, c0 = u.pn * 64 + wc * 16 + 4 * fq;
#pragma unroll
        for (int ai = 0; ai < 2; ++ai)
#pragma unroll
            for (int m = 0; m < 4; ++m) { const int row = row0 + ai * 128 + m * 16; f32x4 s = (f32x4){0.f, 0.f, 0.f, 0.f};
#pragma unroll
                for (int bj = 0; bj < 2; ++bj)
#pragma unroll
                    for (int n = 0; n < 2; ++n) { const int kb = 2 * bj + n; const f32x4 a = acc[ai][bj][m][n]; const f32x4 bb = *(const f32x4*)(bm + kb * DM + c0);
                        const uint2 bo = *(const uint2*)(BO + ((size_t)kb * TT + row) * DM + c0);
                        s[0] += sigm(a[0] + bb[0]) * bf2f((bf16_t)(bo.x & 0xffff)); s[1] += sigm(a[1] + bb[1]) * bf2f((bf16_t)(bo.x >> 16));
                        s[2] += sigm(a[2] + bb[2]) * bf2f((bf16_t)(bo.y & 0xffff)); s[3] += sigm(a[3] + bb[3]) * bf2f((bf16_t)(bo.y >> 16)); }
                *(uint2*)(MG + (size_t)row * DM + c0) = make_uint2(pack2(s[0], s[1]), pack2(s[2], s[3])); }
    }
};
struct EpiOut {
    static constexpr bool PERM = false, AFTER_DRAIN = false;
    const float* sL; const float* sC; float* dL; float* dC; const float* mod;
    __device__ __forceinline__ void operator()(const f32x4 (&acc)[2][2][4][2], const Unit& u, int wr, int wc, int fr, int fq) const {
        const int row0 = u.pm * 256 + wr * 64 + fr, col0 = u.pn * 256 + wc * 32 + 4 * fq;
        const int mv = mod_idx(u.pm * 256);
        const float* g1 = mod + mv * 6144 + 2 * DM;
#pragma unroll
        for (int ai = 0; ai < 2; ++ai)
#pragma unroll
            for (int m = 0; m < 4; ++m) { const int row = row0 + ai * 128 + m * 16; const float* src = hrow_c(sL, sC, row); float* dst = hrow_m(dL, dC, row);
#pragma unroll
                for (int bj = 0; bj < 2; ++bj)
#pragma unroll
                    for (int n = 0; n < 2; ++n) { const int col = col0 + bj * 128 + n * 16; const f32x4 v = acc[ai][bj][m][n];
                        const f32x4 h = *(const f32x4*)(src + col), gg = *(const f32x4*)(g1 + col);
                        *(f32x4*)(dst + col) = h + gg * v; } }
    }
};
struct EpiH {
    static constexpr bool PERM = false, AFTER_DRAIN = false;
    bf16_t* HS;
    __device__ __forceinline__ void operator()(const f32x4 (&acc)[2][2][4][2], const Unit& u, int wr, int wc, int fr, int fq) const {
        const int pn = u.pn & 3, row0 = u.pm * 256 + wr * 64 + fr, hc0 = pn * 128 + wc * 16 + 4 * fq;
#pragma unroll
        for (int ai = 0; ai < 2; ++ai)
#pragma unroll
            for (int m = 0; m < 4; ++m) { const int row = row0 + ai * 128 + m * 16;
#pragma unroll
                for (int bj = 0; bj < 2; ++bj) { const f32x4 a = acc[ai][bj][m][0], c = acc[ai][bj][m][1];
                    *(uint2*)(HS + (size_t)row * 512 + hc0 + bj * 64) = make_uint2(pack2(siluf(a[0]) * c[0], siluf(a[1]) * c[1]), pack2(siluf(a[2]) * c[2], siluf(a[3]) * c[3])); } }
    }
};
struct EpiY {
    static constexpr bool PERM = false, AFTER_DRAIN = false;
    bf16_t* YM;
    __device__ __forceinline__ void operator()(const f32x4 (&acc)[2][2][4][2], const Unit& u, int wr, int wc, int fr, int fq) const {
        const int pn = u.pn & 3, row0 = u.pm * 256 + wr * 64 + fr, col0 = pn * 256 + wc * 32 + 4 * fq;
#pragma unroll
        for (int ai = 0; ai < 2; ++ai)
#pragma unroll
            for (int m = 0; m < 4; ++m) { const int row = row0 + ai * 128 + m * 16;
#pragma unroll
                for (int bj = 0; bj < 2; ++bj)
#pragma unroll
                    for (int n = 0; n < 2; ++n) { const int col = col0 + bj * 128 + n * 16; const f32x4 v = acc[ai][bj][m][n];
                        *(uint2*)(YM + (size_t)row * DM + col) = make_uint2(pack2(v[0], v[1]), pack2(v[2], v[3])); } }
    }
};

__device__ __forceinline__ void phase_mods(const PP& p, LAS float* lds) {
    const int tid = otid(p.swid);
    float* MOD = (float*)(p.ws + WS_MOD);
    LAS float* sc = lds;
    LAS float* red = lds + 3072;
    for (int i = tid; i < 3072; i += 512) { const int v = i >> 10, k = i & 1023; const float x = v < 2 ? p.in[I_C][v * DM + k] : p.in[I_CCTX][k]; sc[i] = siluf(x); }
    __syncthreads();
    for (int u = blockIdx.x; u < 96; u += gridDim.x) {
        const int l = u / 48, cg = u % 48, col = cg * 128 + (tid & 127), kp = tid >> 7;
        const float* W = p.in[I_ADAW] + (size_t)l * DM * 6144 + col;
        float s0 = 0.f, s1 = 0.f, s2 = 0.f;
        for (int k = kp * 256; k < kp * 256 + 256; ++k) { const float w = W[(size_t)k * 6144]; s0 += sc[k] * w; s1 += sc[1024 + k] * w; s2 += sc[2048 + k] * w; }
        red[(kp * 3 + 0) * 128 + (tid & 127)] = s0; red[(kp * 3 + 1) * 128 + (tid & 127)] = s1; red[(kp * 3 + 2) * 128 + (tid & 127)] = s2;
        __syncthreads();
        if (tid < 384) { const int v = tid >> 7, cc = tid & 127; const float s = red[(0 * 3 + v) * 128 + cc] + red[(1 * 3 + v) * 128 + cc] + red[(2 * 3 + v) * 128 + cc] + red[(3 * 3 + v) * 128 + cc];
            MOD[((size_t)l * 3 + v) * 6144 + cg * 128 + cc] = s + p.in[I_ADAB][l * 6144 + cg * 128 + cc]; }
        __syncthreads();
    }
}

__device__ __forceinline__ const float* conv_src(const PP& p, int l, int mat, int sub, int n, int& ld) {
    switch (mat) {
    case 0: { ld = 7216; int c; if (n < 2592) c = n; else if (n < 2608) c = 7200 + (n - 2592); else if (n < 2816) return nullptr; else if (n < 5376) c = 2592 + (n - 2816); else c = 5152 + (n - 5376);
              return p.in[I_WIN] + (size_t)l * DM * 7216 + c; }
    case 1: { ld = 4096; const int pn = n >> 8, ct = n & 255, bj = ct >> 7, wc = (ct >> 5) & 3, nn = (ct >> 4) & 1, i = ct & 15; const int kb = 2 * bj + nn, c = 64 * pn + 16 * wc + i;
              return p.in[I_WMERGE] + (size_t)l * DM * 4096 + kb * DM + c; }
    case 2: { ld = 1024; return p.in[I_WBR] + ((size_t)l * 4 + sub) * 512 * DM + n; }
    case 3: { ld = 1024; return p.in[I_WOUT] + (size_t)l * DM * DM + n; }
    case 4: { ld = 512; const int g = n >> 5, nn = (n >> 4) & 1, i = n & 15, hc = 16 * g + i; return (nn ? p.in[I_MW3] : p.in[I_MW1]) + ((size_t)l * 16 + sub) * DM * 512 + hc; }
    case 5: { ld = 1024; return p.in[I_MW2] + ((size_t)l * 16 + sub) * 512 * DM + n; }
    default: { ld = 64; return p.in[I_RGGW] + ((size_t)l * 32 + sub) * 4096 + n; }
    }
}
__device__ __forceinline__ void phase_convert(const PP& p, int l, LAS float* tile  ) {
    const int tid = otid(p.swid);
    unsigned char* wb = p.ws + WS_WB;
    for (int u = blockIdx.x; u < 9824; u += gridDim.x) {
        int mat, sub = 0, nt, kt, K; bf16_t* dst;
        if (u < 1856) { mat = 0; nt = u >> 4; kt = u & 15; K = 1024; dst = (bf16_t*)(wb + WB_WIN); }
        else if (u < 2880) { const int v = u - 1856; mat = 1; nt = v >> 4; kt = v & 15; K = 1024; dst = (bf16_t*)(wb + WB_WM); }
        else if (u < 3392) { const int v = u - 2880; mat = 2; sub = v >> 7; nt = (v & 127) >> 3; kt = v & 7; K = 512; dst = (bf16_t*)(wb + WB_WB) + (size_t)sub * 1024 * 512; }
        else if (u < 3648) { const int v = u - 3392; mat = 3; nt = v >> 4; kt = v & 15; K = 1024; dst = (bf16_t*)(wb + WB_WO); }
        else if (u < 7744) { const int v = u - 3648; mat = 4; sub = v >> 8; nt = (v & 255) >> 4; kt = v & 15; K = 1024; dst = (bf16_t*)(wb + WB_W13) + (size_t)sub * 1024 * 1024; }
        else if (u < 9792) { const int v = u - 7744; mat = 5; sub = v >> 7; nt = (v & 127) >> 3; kt = v & 7; K = 512; dst = (bf16_t*)(wb + WB_W2) + (size_t)sub * 1024 * 512; }
        else { mat = 6; sub = u - 9792; nt = 0; kt = 0; K = 64; dst = (bf16_t*)(wb + WB_GW) + (size_t)sub * 4096; }
        const int n0 = nt * 64, k0 = kt * 64;
        int ld; const float* sp = conv_src(p, l, mat, sub, n0 + (tid & 63), ld);
#pragma unroll
        for (int i = 0; i < 8; ++i) { const int kk = (tid >> 6) + 8 * i; tile[kk * 65 + (tid & 63)] = sp ? sp[(size_t)(k0 + kk) * ld] : 0.f; }
        __syncthreads();
        { const int nn = tid >> 3, ks = (tid & 7) * 8; unsigned w[4];
#pragma unroll
          for (int j = 0; j < 4; ++j) w[j] = pack2(tile[(ks + 2 * j) * 65 + nn], tile[(ks + 2 * j + 1) * 65 + nn]);
          *(uint4*)(dst + (size_t)(n0 + nn) * K + k0 + ks) = make_uint4(w[0], w[1], w[2], w[3]); }
        __syncthreads();
    }
}

__device__ __forceinline__ void norm_row(const PP& p, int l, int which, const float* src, int mv, int lane, float (&u)[4][4]) {
    const float* MOD = (const float*)(p.ws + WS_MOD) + ((size_t)l * 3 + mv) * 6144;
    const float* gain = (which ? p.in[I_NFFNG] : p.in[I_NMIXG]) + l * DM;
    const float* sh = MOD + (which ? 3 : 0) * DM; const float* sc = MOD + (which ? 4 : 1) * DM;
    float ss = 0.f;
#pragma unroll
    for (int i = 0; i < 4; ++i) { const f32x4 v = *(const f32x4*)(src + 256 * i + 4 * lane); u[i][0] = v[0]; u[i][1] = v[1]; u[i][2] = v[2]; u[i][3] = v[3]; ss += v[0] * v[0] + v[1] * v[1] + v[2] * v[2] + v[3] * v[3]; }
    ss = wave_sum(ss);
    const float rs = rsqrtf(ss * (1.f / DM) + EPS);
#pragma unroll
    for (int i = 0; i < 4; ++i) { const int col = 256 * i + 4 * lane; const f32x4 g = *(const f32x4*)(gain + col), a = *(const f32x4*)(sc + col), b = *(const f32x4*)(sh + col);
#pragma unroll
        for (int j = 0; j < 4; ++j) u[i][j] = u[i][j] * rs * g[j] * (1.f + a[j]) + b[j]; }
}
__device__ __forceinline__ void phase_norm1(const PP& p, int l) {
    const int tid_ = otid(p.swid), lane = tid_ & 63, gw = blockIdx.x * 8 + (tid_ >> 6), nw = gridDim.x * 8;
    const float* sL = l == 0 ? p.in[I_X] : p.out; const float* sC = l == 0 ? p.in[I_CTX] : (const float*)(p.ws + WS_HCTX);
    bf16_t* U = (bf16_t*)(p.ws + WS_U);
    for (int r = gw; r < TT; r += nw) {
        float u[4][4]; norm_row(p, l, 0, hrow_c(sL, sC, r), mod_idx(r), lane, u);
#pragma unroll
        for (int i = 0; i < 4; ++i) *(uint2*)(U + (size_t)r * DM + 256 * i + 4 * lane) = make_uint2(pack2(u[i][0], u[i][1]), pack2(u[i][2], u[i][3]));
    }
}

__device__ __forceinline__ void phase_route(const PP& p, int l) {
    const int tid_ = otid(p.swid), lane = tid_ & 63, gw = blockIdx.x * 8 + (tid_ >> 6), nw = gridDim.x * 8;
    const float* sL = p.out; const float* sC = (const float*)(p.ws + WS_HCTX);
    int* tok_e = (int*)(p.ws + WS_ROUTE); float* tok_w = (float*)(p.ws + WS_ROUTE + 262144); int* tok_pos = (int*)(p.ws + WS_ROUTE + 524288);
    unsigned* cnt = (unsigned*)(p.ws + WS_CTL) + CW_CNT + l * 16;
    const float* wg = p.in[I_MWG] + (size_t)l * DM * 4; const float* we = p.in[I_MWE] + (size_t)l * DM * 16;
    for (int r = gw; r < TT; r += nw) {
        if (l == 1 && (r % NTOK) < CTXL) continue;
        const float* src = hrow_c(sL, sC, r); const int mv = mod_idx(r);
        const float* MOD = (const float*)(p.ws + WS_MOD) + ((size_t)l * 3 + mv) * 6144;
        const float* gain = p.in[I_NFFNG] + l * DM; const float* sh = MOD + 3 * DM; const float* sc = MOD + 4 * DM;
        float ss = 0.f;
#pragma unroll 1
        for (int i = 0; i < 4; ++i) { const f32x4 v = *(const f32x4*)(src + 256 * i + 4 * lane); ss += v[0] * v[0] + v[1] * v[1] + v[2] * v[2] + v[3] * v[3]; }
        ss = wave_sum(ss);
        const float rs = rsqrtf(ss * (1.f / DM) + EPS);
        float acc[20];
#pragma unroll
        for (int q = 0; q < 20; ++q) acc[q] = 0.f;
#pragma unroll 1
        for (int i = 0; i < 4; ++i) { const int col0 = 256 * i + 4 * lane;
            const f32x4 v = *(const f32x4*)(src + col0), g = *(const f32x4*)(gain + col0), a = *(const f32x4*)(sc + col0), bsh = *(const f32x4*)(sh + col0);
            const float* wgp = wg + (size_t)col0 * 4; const float* wep = we + (size_t)col0 * 16;
#pragma unroll
            for (int j = 0; j < 4; ++j) { const float x = v[j] * rs * g[j] * (1.f + a[j]) + bsh[j];
                const f32x4 gq = *(const f32x4*)(wgp + j * 4);
                acc[0] += x * gq[0]; acc[1] += x * gq[1]; acc[2] += x * gq[2]; acc[3] += x * gq[3];
#pragma unroll
                for (int q = 0; q < 4; ++q) { const f32x4 e = *(const f32x4*)(wep + j * 16 + 4 * q); acc[4 + 4 * q] += x * e[0]; acc[5 + 4 * q] += x * e[1]; acc[6 + 4 * q] += x * e[2]; acc[7 + 4 * q] += x * e[3]; } } }
#pragma unroll
        for (int q = 0; q < 20; ++q) acc[q] = wave_sum(acc[q]);
        if (lane == 0) {
            float gl[4];
#pragma unroll
            for (int q = 0; q < 4; ++q) gl[q] = acc[q] + p.in[I_MBG][l * 4 + q];
            int grp = 0; float gm = gl[0];
#pragma unroll
            for (int q = 1; q < 4; ++q) if (gl[q] > gm) { gm = gl[q]; grp = q; }
            float se = 0.f;
#pragma unroll
            for (int q = 0; q < 4; ++q) se += __expf(gl[q] - gm);
            const float pg = 1.f / se;
            float el[4];
#pragma unroll
            for (int q = 0; q < 4; ++q) { float v = 0.f;
#pragma unroll
                for (int gg = 0; gg < 4; ++gg) v = (gg == grp) ? acc[4 + gg * 4 + q] : v;
                el[q] = v + p.in[I_MBE][l * 16 + grp * 4 + q]; }
            int i0 = 0; float m0 = el[0];
#pragma unroll
            for (int q = 1; q < 4; ++q) if (el[q] > m0) { m0 = el[q]; i0 = q; }
            int i1 = -1; float m1 = -3.4e38f;
#pragma unroll
            for (int q = 0; q < 4; ++q) if (q != i0 && el[q] > m1) { m1 = el[q]; i1 = q; }
            const float e1 = __expf(m1 - m0), w0 = pg / (1.f + e1), w1 = pg * e1 / (1.f + e1);
            const int ex0 = grp * 4 + i0, ex1 = grp * 4 + i1;
            const unsigned p0 = atomicAdd(&cnt[ex0], 1u), p1 = atomicAdd(&cnt[ex1], 1u);
            tok_e[2 * r] = ex0; tok_e[2 * r + 1] = ex1; tok_w[2 * r] = w0; tok_w[2 * r + 1] = w1; tok_pos[2 * r] = (int)p0; tok_pos[2 * r + 1] = (int)p1;
        }
    }
}
__device__ __forceinline__ int moe_tables(const PP& p, int l, LAS int* tbl  ) {
    const unsigned* cnt = (const unsigned*)(p.ws + WS_CTL) + CW_CNT + l * 16;
    __syncthreads();
    if (otid(p.swid) == 0) { int s = 0;
        for (int e = 0; e < 16; ++e) { const int c = (int)__hip_atomic_load(cnt + e, __ATOMIC_RELAXED, __HIP_MEMORY_SCOPE_AGENT); const int nb = (c + 255) >> 8; tbl[e] = s * 256; for (int b = 0; b < nb; ++b) tbl[32 + s + b] = e; s += nb; }
        tbl[16] = s; }
    __syncthreads();
    return tbl[16];
}
__device__ __forceinline__ void phase_dispatch(const PP& p, int l, LAS int* tbl) {
    const int tid_ = otid(p.swid), lane = tid_ & 63, gw = blockIdx.x * 8 + (tid_ >> 6), nw = gridDim.x * 8;
    moe_tables(p, l, tbl);
    const float* sL = p.out; const float* sC = (const float*)(p.ws + WS_HCTX);
    const int* tok_e = (const int*)(p.ws + WS_ROUTE); const int* tok_pos = (const int*)(p.ws + WS_ROUTE + 524288); int* tok_slot = (int*)(p.ws + WS_ROUTE + 786432);
    bf16_t* XS = (bf16_t*)(p.ws + WS_BIG + BIG_XS);
    for (int r = gw; r < TT; r += nw) {
        if (l == 1 && (r % NTOK) < CTXL) continue;
        float u[4][4]; norm_row(p, l, 1, hrow_c(sL, sC, r), mod_idx(r), lane, u);
        const int s0 = tbl[tok_e[2 * r]] + tok_pos[2 * r], s1 = tbl[tok_e[2 * r + 1]] + tok_pos[2 * r + 1];
        if (lane == 0) { tok_slot[2 * r] = s0; tok_slot[2 * r + 1] = s1; }
#pragma unroll
        for (int i = 0; i < 4; ++i) { const uint2 v = make_uint2(pack2(u[i][0], u[i][1]), pack2(u[i][2], u[i][3]));
            *(uint2*)(XS + (size_t)s0 * DM + 256 * i + 4 * lane) = v; *(uint2*)(XS + (size_t)s1 * DM + 256 * i + 4 * lane) = v; }
    }
}
__device__ __forceinline__ void phase_combine(const PP& p, int l) {
    const int tid_ = otid(p.swid), lane = tid_ & 63, gw = blockIdx.x * 8 + (tid_ >> 6), nw = gridDim.x * 8;
    float* HL = p.out; float* HC = (float*)(p.ws + WS_HCTX);
    const float* tok_w = (const float*)(p.ws + WS_ROUTE + 262144); const int* tok_slot = (const int*)(p.ws + WS_ROUTE + 786432);
    const bf16_t* YM = (const bf16_t*)(p.ws + WS_BIG + BIG_YM);
    for (int r = gw; r < TT; r += nw) {
        if (l == 1 && (r % NTOK) < CTXL) continue;
        const float* g2 = (const float*)(p.ws + WS_MOD) + ((size_t)l * 3 + mod_idx(r)) * 6144 + 5 * DM;
        float* hp = hrow_m(HL, HC, r);
        const int s0 = tok_slot[2 * r], s1 = tok_slot[2 * r + 1]; const float w0 = tok_w[2 * r], w1 = tok_w[2 * r + 1];
        float x[4][4]; float ss = 0.f;
#pragma unroll
        for (int i = 0; i < 4; ++i) { const int col = 256 * i + 4 * lane; const f32x4 h = *(const f32x4*)(hp + col), g = *(const f32x4*)(g2 + col);
            const uint2 a = *(const uint2*)(YM + (size_t)s0 * DM + col), b = *(const uint2*)(YM + (size_t)s1 * DM + col);
            x[i][0] = h[0] + g[0] * (w0 * bf2f((bf16_t)(a.x & 0xffff)) + w1 * bf2f((bf16_t)(b.x & 0xffff)));
            x[i][1] = h[1] + g[1] * (w0 * bf2f((bf16_t)(a.x >> 16)) + w1 * bf2f((bf16_t)(b.x >> 16)));
            x[i][2] = h[2] + g[2] * (w0 * bf2f((bf16_t)(a.y & 0xffff)) + w1 * bf2f((bf16_t)(b.y & 0xffff)));
            x[i][3] = h[3] + g[3] * (w0 * bf2f((bf16_t)(a.y >> 16)) + w1 * bf2f((bf16_t)(b.y >> 16)));
            ss += x[i][0] * x[i][0] + x[i][1] * x[i][1] + x[i][2] * x[i][2] + x[i][3] * x[i][3]; }
        if (l == 1) {
            ss = wave_sum(ss); const float rs = rsqrtf(ss * (1.f / DM) + EPS);
#pragma unroll
            for (int i = 0; i < 4; ++i) { const int col = 256 * i + 4 * lane; const f32x4 g = *(const f32x4*)(p.in[I_FNG] + col);
                *(f32x4*)(hp + col) = (f32x4){x[i][0] * rs * g[0], x[i][1] * rs * g[1], x[i][2] * rs * g[2], x[i][3] * rs * g[3]}; }
        } else {
#pragma unroll
            for (int i = 0; i < 4; ++i) *(f32x4*)(hp + 256 * i + 4 * lane) = (f32x4){x[i][0], x[i][1], x[i][2], x[i][3]};
        }
    }
}

__device__ __forceinline__ int chain_chunk(int dir, int ci) { return dir == 0 ? ci : (ci < 4 ? 3 - ci : 135 - ci); }

__device__ __forceinline__ void phase_seq_rg(const PP& p, int l) {
    const int tid_ = otid(p.swid); if (tid_ >= 64 || blockIdx.x >= 32) return;
    const int u = blockIdx.x, lane = tid_, blk = u & 7, dir = (u >> 3) & 1, b = u >> 4, ch = blk * 64 + lane;
    const bf16_t* Z = (const bf16_t*)(p.ws + WS_BIG + BIG_Z);
    float* O = (float*)(p.ws + WS_BIG + BIG_ST) + (size_t)dir * TT * 512;
    float Wr[64], Wi[64];
    const float* gw = p.in[I_RGGW] + ((((size_t)l * 2 + dir) * 2) * 8 + blk) * 4096;
#pragma unroll
    for (int i = 0; i < 64; ++i) { Wr[i] = gw[i * 64 + lane]; Wi[i] = gw[8 * 4096 + i * 64 + lane]; }
    const float br = p.in[I_RGGB][((l * 2 + dir) * 2 + 0) * 512 + ch], bi = p.in[I_RGGB][((l * 2 + dir) * 2 + 1) * 512 + ch];
    const float sp = softplusf(-p.in[I_RGLAM][(l * 2 + dir) * 512 + ch]);
    float cw[4];
#pragma unroll
    for (int j = 0; j < 4; ++j) cw[j] = p.in[I_RGCW][(l * 4 + j) * 512 + ch];
    const float cb = p.in[I_RGCB][l * 512 + ch];
    float h = 0.f;
    for (int s = 0; s < NTOK; ++s) {
        int pp; if (dir == 0) pp = s; else pp = s < CTXL ? CTXL - 1 - s : NTOK - 1 - (s - CTXL);
        const int lo = pp < CTXL ? 0 : CTXL, hi = pp < CTXL ? CTXL : NTOK;
        float xb = cb;
#pragma unroll
        for (int j = 0; j < 4; ++j) { const int q = pp + j - 2; if (q >= lo && q < hi) xb += cw[j] * bf2f(Z[((size_t)b * NTOK + q) * ZLD + RGX + ch]); }
        float pr = br, pi = bi;
#pragma unroll
        for (int i = 0; i < 64; ++i) { const float xi = __uint_as_float(__builtin_amdgcn_readlane(__float_as_uint(xb), i)); pr += xi * Wr[i]; pi += xi * Wi[i]; }
        const float r = sigm(pr), ig = sigm(pi), la = -8.f * r * sp, a = __expf(la), bt = sqrtf(-expm1f(2.f * la)) * (ig * xb);
        h = a * h + bt;
        O[((size_t)b * NTOK + pp) * 512 + ch] = h;
    }
}
__device__ __forceinline__ void phase_epi_rg(const PP& p) {
    const int tid_ = otid(p.swid);
    const bf16_t* Z = (const bf16_t*)(p.ws + WS_BIG + BIG_Z); const float* OF = (const float*)(p.ws + WS_BIG + BIG_ST); const float* OB = OF + (size_t)TT * 512;
    bf16_t* YS = (bf16_t*)(p.ws + WS_BIG + BIG_YS);
    for (size_t i = (size_t)blockIdx.x * 512 + tid_; i < (size_t)TT * 512; i += (size_t)gridDim.x * 512) { const size_t r = i >> 9; const int ch = (int)(i & 511);
        YS[i] = f2bf(gelu_tanh(bf2f(Z[r * ZLD + RGY + ch])) * (OF[i] + OB[i])); }
}
template <int BR> __device__ __forceinline__ void phase_seq_gl(const PP& p, int l, LAS float* sm) {
    constexpr int DK = BR == 1 ? 64 : 128, DP = DK / 4;
    if (blockIdx.x >= 16) return;
    LAS float* LA = sm; LAS float* LK = sm + 64 * DK; LAS float* LQ = sm + 2 * 64 * DK; LAS float* LV = sm + 3 * 64 * DK;
    const int u = blockIdx.x, tid = otid(p.swid), dir = u & 1, h = (u >> 1) & 3, b = u >> 3, v = tid >> 2, part = tid & 3;
    const bf16_t* Z = (const bf16_t*)(p.ws + WS_BIG + BIG_Z); const float* MISC = (const float*)(p.ws + WS_MISC);
    float* O = (float*)(p.ws + WS_BIG + BIG_ST) + (size_t)dir * TT * 512;
    float S[DP];
#pragma unroll
    for (int i = 0; i < DP; ++i) S[i] = 0.f;
    for (int ci = 0; ci < NCHUNK; ++ci) {
        const int c = chain_chunk(dir, ci); const size_t r0 = (size_t)b * NTOK + c * 64;
        __syncthreads();
        for (int idx = tid; idx < 64 * DK; idx += 512) { const int t = idx / DK, d = idx % DK; const size_t r = r0 + t;
            float a, k, q;
            if (BR == 1) { float pre = p.in[I_GLABLR][(l * 2 + dir) * 256 + h * 64 + d];
                for (int rr = 0; rr < 16; ++rr) pre += MISC[r * 64 + MISC_LR + dir * 16 + rr] * p.in[I_GLAWLR][((size_t)(l * 2 + dir) * 16 + rr) * 256 + h * 64 + d];
                a = __expf(logsig(pre) * (1.f / 16.f)); k = bf2f(Z[r * ZLD + GK + h * 64 + d]); q = bf2f(Z[r * ZLD + GQ + h * 64 + d]) * 0.125f; }
            else { float lb = 0.f; if (l == 1) { const float l0 = p.in[I_HGLB][(0 * 2 + dir) * 512 + h * 128 + d], l1 = p.in[I_HGLB][(1 * 2 + dir) * 512 + h * 128 + d]; lb = 1.f / (1.f + __expf(l0 - l1)); }
                const float f = bf2f(Z[r * ZLD + HF + dir * 512 + h * 128 + d]); const float s = sigm(f);
                a = lb + (1.f - lb) * s; k = (1.f - lb) * sigm(-f); q = siluf(bf2f(Z[r * ZLD + HQ + h * 128 + d])) * 0.08838834764831845f; }
            LA[idx] = a; LK[idx] = k; LQ[idx] = q; }
        for (int idx = tid; idx < 64 * 128; idx += 512) { const int t = idx >> 7, vv = idx & 127; LV[idx] = bf2f(Z[(r0 + t) * ZLD + (BR == 1 ? GV : HI) + h * 128 + vv]); }
        __syncthreads();
        for (int j = 0; j < 64; ++j) { const int t = dir == 0 ? j : 63 - j; const float vv = LV[t * 128 + v]; float o = 0.f;
#pragma unroll
            for (int i = 0; i < DP; ++i) { const int d = part * DP + i; S[i] = LA[t * DK + d] * S[i] + LK[t * DK + d] * vv; o += S[i] * LQ[t * DK + d]; }
            o += __shfl_xor(o, 1); o += __shfl_xor(o, 2);
            if (part == 0) O[(r0 + t) * 512 + h * 128 + v] = o; }
    }
}
__device__ __forceinline__ void phase_seq_ml(const PP& p, int l, LAS float* sm) {
    if (blockIdx.x >= 16) return;
    LAS float* LK = sm; LAS float* LQ = sm + 8192; LAS float* LV = sm + 16384; LAS float* LI = sm + 24576; LAS float* LF = LI + 64;
    const int u = blockIdx.x, tid = otid(p.swid), dir = u & 1, h = (u >> 1) & 3, b = u >> 3, v = tid >> 2, part = tid & 3;
    const bf16_t* Z = (const bf16_t*)(p.ws + WS_BIG + BIG_Z); const float* MISC = (const float*)(p.ws + WS_MISC);
    float* O = (float*)(p.ws + WS_BIG + BIG_ST) + (size_t)dir * TT * 512;
    float C[32], N[32]; float m = 0.f;
#pragma unroll
    for (int i = 0; i < 32; ++i) { C[i] = 0.f; N[i] = 0.f; }
    for (int ci = 0; ci < NCHUNK; ++ci) {
        const int c = chain_chunk(dir, ci); const int p0 = c * 64; const size_t r0 = (size_t)b * NTOK + p0;
        const int lo = p0 < CTXL ? 0 : CTXL, hi = p0 < CTXL ? CTXL : NTOK;
        __syncthreads();
        for (int idx = tid; idx < 64 * 128; idx += 512) { const int t = idx >> 7, d = idx & 127, ch = h * 128 + d; const int pp = p0 + t;
            float q = p.in[I_MLCB][l * 1024 + ch], k = p.in[I_MLCB][l * 1024 + 512 + ch];
#pragma unroll
            for (int j = 0; j < 4; ++j) { const int qq = pp + j - 2; if (qq >= lo && qq < hi) { const size_t rr = (size_t)b * NTOK + qq;
                q += p.in[I_MLCW][(l * 4 + j) * 1024 + ch] * bf2f(Z[rr * ZLD + MQ + ch]); k += p.in[I_MLCW][(l * 4 + j) * 1024 + 512 + ch] * bf2f(Z[rr * ZLD + MK + ch]); } }
            LQ[idx] = siluf(q) * 0.08838834764831845f; LK[idx] = siluf(k); LV[idx] = bf2f(Z[(r0 + t) * ZLD + MV + ch]); }
        if (tid < 64) { const size_t r = r0 + tid; LI[tid] = MISC[r * 64 + MISC_IF + dir * 8 + h] + p.in[I_MLGB][(l * 2 + dir) * 8 + h];
            LF[tid] = logsig(MISC[r * 64 + MISC_IF + dir * 8 + 4 + h] + p.in[I_MLGB][(l * 2 + dir) * 8 + 4 + h]); }
        __syncthreads();
        for (int j = 0; j < 64; ++j) { const int t = dir == 0 ? j : 63 - j; const float it = LI[t], lf = LF[t];
            const float mn = fmaxf(lf + m, it), fd = __expf(lf + m - mn), iw = __expf(it - mn); m = mn;
            const float vv = LV[t * 128 + v]; float num = 0.f, den = 0.f;
#pragma unroll
            for (int i = 0; i < 32; ++i) { const int d = part * 32 + i; const float kd = LK[t * 128 + d], qd = LQ[t * 128 + d]; C[i] = fd * C[i] + iw * kd * vv; N[i] = fd * N[i] + iw * kd; num += C[i] * qd; den += N[i] * qd; }
            num += __shfl_xor(num, 1); num += __shfl_xor(num, 2); den += __shfl_xor(den, 1); den += __shfl_xor(den, 2);
            if (part == 0) O[(r0 + t) * 512 + h * 128 + v] = num / fmaxf(fabsf(den), __expf(-mn)); }
    }
}
template <int BR> __device__ __forceinline__ void phase_epi_norm(const PP& p, int l) {
    const int tid_ = otid(p.swid), lane = tid_ & 63; const bf16_t* Z = (const bf16_t*)(p.ws + WS_BIG + BIG_Z);
    const float* OF = (const float*)(p.ws + WS_BIG + BIG_ST); const float* OB = OF + (size_t)TT * 512;
    bf16_t* YS = (bf16_t*)(p.ws + WS_BIG + BIG_YS) + (size_t)BR * TT * 512;
    const float* gain = (BR == 1 ? p.in[I_GLANG] : BR == 2 ? p.in[I_HGNG] : p.in[I_MLNG]) + l * 128;
    const int goff = BR == 1 ? GG : BR == 2 ? HGT : MO;
    for (int w = blockIdx.x * 8 + (tid_ >> 6); w < TT * 4; w += gridDim.x * 8) { const size_t r = w >> 2; const int h = w & 3;
        const size_t i0 = r * 512 + h * 128 + lane, i1 = i0 + 64; const float o0 = OF[i0] + OB[i0], o1 = OF[i1] + OB[i1];
        const float ss = wave_sum(o0 * o0 + o1 * o1), rs = rsqrtf(ss * (1.f / 128.f) + EPS);
        const float g0 = bf2f(Z[r * ZLD + goff + h * 128 + lane]), g1 = bf2f(Z[r * ZLD + goff + h * 128 + lane + 64]);
        const float a0 = BR == 3 ? sigm(g0) : siluf(g0), a1 = BR == 3 ? sigm(g1) : siluf(g1);
        YS[i0] = f2bf(o0 * rs * gain[lane] * a0); YS[i1] = f2bf(o1 * rs * gain[lane + 64] * a1); }
}

constexpr size_t SM_RGA = 0, SM_RGB = 1081344, SM_RGH = 2162688, SM_DEC = 3244032, SM_MLBE = 4325376, SM_MLML = SM_MLBE + 8448, SM_MLMIN = SM_MLML + 8448, SM_MLDN = 4350720;
__device__ __forceinline__ unsigned pack2f(float lo, float hi) { return pack2(lo, hi); }
__device__ __forceinline__ f32x4 mfma16(bf16x8 x, bf16x8 y, f32x4 c) { const f32x4 d = __builtin_amdgcn_mfma_f32_16x16x32_bf16(x, y, c, 0, 0, 0); asm volatile("" :: "v"(x), "v"(y), "v"(d)); return d; }

template <bool OUT> __device__ __forceinline__ void phase_rg(const PP& p, int l, LAS unsigned char* L) {
    const int tid = otid(p.swid), lane = tid & 63, wid = p.swid, fr = lane & 15, fq = lane >> 4;
    LAS bf16_t* XB = (LAS bf16_t*)L;
    LAS float* XF = (LAS float*)(L + 9216);
    LAS float* PRE = (LAS float*)(L + 9216 + 16384);
    const bf16_t* Z = (const bf16_t*)(p.ws + WS_BIG + BIG_Z); const bf16_t* GWT = (const bf16_t*)(p.ws + WS_WB + WB_GW);
    float* RA = (float*)(p.ws + WS_SMALL + SM_RGA); float* RB = (float*)(p.ws + WS_SMALL + SM_RGB); const float* RH = (const float*)(p.ws + WS_SMALL + SM_RGH);
    bf16_t* YS = (bf16_t*)(p.ws + WS_BIG + BIG_YS);
    for (int u = blockIdx.x; u < 2112; u += gridDim.x) {
        const int blk = u & 7, c = (u >> 3) % NCHUNK, b = u / (8 * NCHUNK), p0 = c * 64;
        const size_t rb = (size_t)b * NTOK; const int lo = p0 < CTXL ? 0 : CTXL, hi = p0 < CTXL ? CTXL : NTOK;
        const int j = tid & 63, tg = tid >> 6, ch = blk * 64 + j;
        {
            float cw[4];
#pragma unroll
            for (int q = 0; q < 4; ++q) cw[q] = p.in[I_RGCW][(l * 4 + q) * 512 + ch];
            const float cb = p.in[I_RGCB][l * 512 + ch];
            float win[11];
#pragma unroll
            for (int k = 0; k < 11; ++k) { const int q = p0 + tg * 8 - 2 + k; win[k] = (q >= lo && q < hi) ? bf2f(Z[(rb + q) * ZLD + RGX + ch]) : 0.f; }
#pragma unroll
            for (int k = 0; k < 8; ++k) { const int t = tg * 8 + k; const float xb = cb + cw[0] * win[k] + cw[1] * win[k + 1] + cw[2] * win[k + 2] + cw[3] * win[k + 3];
                XF[t * 64 + j] = xb; XB[t * 72 + j] = f2bf(xb); }
        }
        __syncthreads();
        {
            const int set = wid >> 1; const bf16_t* W = GWT + ((size_t)set * 8 + blk) * 4096;
#pragma unroll
            for (int tti = 0; tti < 2; ++tti) { const int tt = (wid & 1) * 2 + tti;
                const bf16x8 y0 = *(const LAS bf16x8*)(XB + (16 * tt + fr) * 72 + 8 * fq), y1 = *(const LAS bf16x8*)(XB + (16 * tt + fr) * 72 + 8 * fq + 32);
#pragma unroll
                for (int jt = 0; jt < 4; ++jt) { const bf16x8 x0 = *(const bf16x8*)(W + (16 * jt + fr) * 64 + 8 * fq), x1 = *(const bf16x8*)(W + (16 * jt + fr) * 64 + 8 * fq + 32);
                    f32x4 acc = (f32x4){0.f, 0.f, 0.f, 0.f}; acc = mfma16(x0, y0, acc); acc = mfma16(x1, y1, acc);
                    *(LAS f32x4*)(PRE + (set * 64 + 16 * tt + fr) * 68 + 16 * jt + 4 * fq) = acc; } }
        }
        __syncthreads();
        {
#pragma unroll
            for (int dir = 0; dir < 2; ++dir) { const float br = p.in[I_RGGB][((l * 2 + dir) * 2 + 0) * 512 + ch], bi = p.in[I_RGGB][((l * 2 + dir) * 2 + 1) * 512 + ch];
                const float sp = softplusf(-p.in[I_RGLAM][(l * 2 + dir) * 512 + ch]);
#pragma unroll
                for (int k = 0; k < 8; ++k) { const int t = tg * 8 + k; LAS float* pa = PRE + ((dir * 2 + 0) * 64 + t) * 68 + j; LAS float* pb = PRE + ((dir * 2 + 1) * 64 + t) * 68 + j;
                    const float r = sigm(*pa + br), ig = sigm(*pb + bi), la = -8.f * r * sp;
                    *pa = __expf(la); *pb = sqrtf(-expm1f(2.f * la)) * (ig * XF[t * 64 + j]); } }
        }
        __syncthreads();
        if (tid < 128) {
            const int dir = tid >> 6; const size_t sidx = ((size_t)(dir * 2 + b) * NCHUNK + c) * 512 + ch;
            float h = OUT ? RH[sidx] : 0.f, P = 1.f;
#pragma unroll 8
            for (int s2 = 0; s2 < 64; ++s2) { const int t = dir ? 63 - s2 : s2; const float a = PRE[((dir * 2 + 0) * 64 + t) * 68 + j], bt = PRE[((dir * 2 + 1) * 64 + t) * 68 + j];
                h = a * h + bt; if (OUT) PRE[((dir * 2 + 1) * 64 + t) * 68 + j] = h; else P *= a; }
            if (!OUT) { RA[sidx] = P; RB[sidx] = h; }
        }
        if (OUT) { __syncthreads();
#pragma unroll
            for (int k = 0; k < 8; ++k) { const int t = tg * 8 + k; const size_t r = rb + p0 + t;
                YS[r * 512 + ch] = f2bf(gelu_tanh(bf2f(Z[r * ZLD + RGY + ch])) * (PRE[((0 * 2 + 1) * 64 + t) * 68 + j] + PRE[((1 * 2 + 1) * 64 + t) * 68 + j])); } }
        __syncthreads();
    }
}
__device__ __forceinline__ void phase_rg_carry(const PP& p) {
    const int g = blockIdx.x * 512 + otid(p.swid); if (g >= 2048) return;
    const int dir = g >> 10, b = (g >> 9) & 1, ch = g & 511;
    const float* RA = (const float*)(p.ws + WS_SMALL + SM_RGA); const float* RB = (const float*)(p.ws + WS_SMALL + SM_RGB); float* RH = (float*)(p.ws + WS_SMALL + SM_RGH);
    float h = 0.f;
    for (int ci0 = 0; ci0 < NCHUNK; ci0 += 6) { float a[6], bb[6]; size_t idx[6];
#pragma unroll
        for (int k = 0; k < 6; ++k) { idx[k] = ((size_t)(dir * 2 + b) * NCHUNK + chain_chunk(dir, ci0 + k)) * 512 + ch; a[k] = RA[idx[k]]; bb[k] = RB[idx[k]]; }
#pragma unroll
        for (int k = 0; k < 6; ++k) { RH[idx[k]] = h; h = a[k] * h + bb[k]; } }
}

template <int BR> struct GlChan {
    float w[16]; float bias; float lb; int dir, h, d, l;
    __device__ __forceinline__ void init(const PP& p, int l_, int dir_, int h_, int d_) { l = l_; dir = dir_; h = h_; d = d_;
        if (BR == 1) {
#pragma unroll
            for (int r = 0; r < 16; ++r) w[r] = p.in[I_GLAWLR][((size_t)(l * 2 + dir) * 16 + r) * 256 + h * 64 + d];
            bias = p.in[I_GLABLR][(l * 2 + dir) * 256 + h * 64 + d]; lb = 0.f;
        } else { lb = 0.f; if (l == 1) { const float l0 = p.in[I_HGLB][(0 * 2 + dir) * 512 + h * 128 + d], l1 = p.in[I_HGLB][(1 * 2 + dir) * 512 + h * 128 + d]; lb = 1.f / (1.f + __expf(l0 - l1)); } bias = 0.f; }
    }
    __device__ __forceinline__ void gk(const bf16_t* zrow, const LAS float* lr, float& g, float& k) const {
        if (BR == 1) { float pre = bias;
#pragma unroll
            for (int r4 = 0; r4 < 4; ++r4) { const f32x4 x = *(const LAS f32x4*)(lr + 4 * r4); pre += x[0] * w[4 * r4] + x[1] * w[4 * r4 + 1] + x[2] * w[4 * r4 + 2] + x[3] * w[4 * r4 + 3]; }
            g = logsig(pre) * (1.f / 16.f); k = bf2f(zrow[GK + h * 64 + d]);
        } else { const float f = bf2f(zrow[HF + dir * 512 + h * 128 + d]); const float e = __expf(-f), sg = 1.f / (1.f + e);
            g = __logf(lb + (1.f - lb) * sg); k = (1.f - lb) * (e * sg); }
    }
};
template <int BR> __device__ __forceinline__ void phase_gl_local(const PP& p, int l, LAS unsigned char* L) {
    constexpr int DK = BR == 1 ? 64 : 128;
    const int tid = otid(p.swid), lane = tid & 63, wid = p.swid, fr = lane & 15, fq = lane >> 4;
    LAS bf16_t* KT = (LAS bf16_t*)L;
    LAS bf16_t* VT = KT + 2 * DK * 72;
    LAS float* LR = (LAS float*)(VT + 128 * 72);
    const bf16_t* Z = (const bf16_t*)(p.ws + WS_BIG + BIG_Z); const float* MISC = (const float*)(p.ws + WS_MISC);
    bf16_t* ST = (bf16_t*)(p.ws + WS_BIG + BIG_ST); float* DEC = (float*)(p.ws + WS_SMALL + SM_DEC);
    constexpr int VOFF = BR == 1 ? GV : HI;
    for (int u = blockIdx.x; u < 8 * NCHUNK; u += gridDim.x) {
        const int c = u % NCHUNK, bh = u / NCHUNK, h = bh & 3, b = bh >> 2; const size_t r0 = (size_t)b * NTOK + c * 64;
        if (BR == 1) { for (int i = tid; i < 2048; i += 512) LR[i] = MISC[(r0 + (i >> 5)) * 64 + MISC_LR + (i & 31)]; __syncthreads(); }
        if (tid < 2 * DK) {
            const int dir = tid / DK, d = tid % DK; GlChan<BR> G; G.init(p, l, dir, h, d);
            float s = 0.f;
#pragma unroll 1
            for (int grp = 0; grp < 8; ++grp) { float val[8];
#pragma unroll
                for (int e = 0; e < 8; ++e) { const int w = grp * 8 + e, t = dir == 0 ? 63 - w : w; float g, k; G.gk(Z + (r0 + t) * ZLD, LR + t * 32 + dir * 16, g, k); val[e] = k * __expf(s); s += g; }
                float m[8];
#pragma unroll
                for (int e = 0; e < 8; ++e) m[e] = dir == 0 ? val[7 - e] : val[e];
                const int t0 = dir == 0 ? 56 - grp * 8 : grp * 8;
                *(LAS u32x4*)(KT + (dir * DK + d) * 72 + t0) = (u32x4){pack2(m[0], m[1]), pack2(m[2], m[3]), pack2(m[4], m[5]), pack2(m[6], m[7])}; }
            DEC[((size_t)((dir * 2 + b) * 4 + h) * NCHUNK + c) * 128 + d] = __expf(s);
        } else if (tid < 2 * DK + 128) { const int v = tid - 2 * DK;
#pragma unroll 1
            for (int grp = 0; grp < 8; ++grp) { unsigned short x[8];
#pragma unroll
                for (int e = 0; e < 8; ++e) x[e] = Z[(r0 + grp * 8 + e) * ZLD + VOFF + h * 128 + v];
                *(LAS u32x4*)(VT + v * 72 + grp * 8) = (u32x4){x[0] | ((unsigned)x[1] << 16), x[2] | ((unsigned)x[3] << 16), x[4] | ((unsigned)x[5] << 16), x[6] | ((unsigned)x[7] << 16)}; }
        }
        __syncthreads();
        { const int dir = wid >> 2; const size_t sbase = ((size_t)((dir * 2 + b) * 4 + h) * NCHUNK + c) * 128 * DK;
#pragma unroll
          for (int di = 0; di < DK / 64; ++di) { const int dt = (wid & 3) * (DK / 64) + di;
            const bf16x8 x0 = *(const LAS bf16x8*)(KT + (dir * DK + 16 * dt + fr) * 72 + 8 * fq), x1 = *(const LAS bf16x8*)(KT + (dir * DK + 16 * dt + fr) * 72 + 8 * fq + 32);
#pragma unroll
            for (int vt = 0; vt < 8; ++vt) { const bf16x8 y0 = *(const LAS bf16x8*)(VT + (16 * vt + fr) * 72 + 8 * fq), y1 = *(const LAS bf16x8*)(VT + (16 * vt + fr) * 72 + 8 * fq + 32);
                f32x4 acc = (f32x4){0.f, 0.f, 0.f, 0.f}; acc = mfma16(x0, y0, acc); acc = mfma16(x1, y1, acc);
                *(uint2*)(ST + sbase + (size_t)(16 * vt + fr) * DK + 16 * dt + 4 * fq) = make_uint2(pack2(acc[0], acc[1]), pack2(acc[2], acc[3])); } } }
        __syncthreads();
    }
}
template <int BR> __device__ __forceinline__ void phase_gl_carry(const PP& p) {
    constexpr int DK = BR == 1 ? 64 : 128, D8 = DK / 8, TOTAL = 16 * 128 * D8;
    const int g = blockIdx.x * 512 + otid(p.swid);
    bf16_t* ST = (bf16_t*)(p.ws + WS_BIG + BIG_ST); const float* DEC = (const float*)(p.ws + WS_SMALL + SM_DEC);
    const float* BE = (const float*)(p.ws + WS_SMALL + SM_MLBE); const float* MLOC = (const float*)(p.ws + WS_SMALL + SM_MLML); float* MIN_ = (float*)(p.ws + WS_SMALL + SM_MLMIN); float* DN = (float*)(p.ws + WS_SMALL + SM_MLDN);
    if (g < TOTAL) {
        const int d8 = g % D8, v = (g / D8) % 128, chain = g / (D8 * 128), dir = chain >> 3;
        float S[8]; float m = 0.f;
#pragma unroll
        for (int e = 0; e < 8; ++e) S[e] = 0.f;
        for (int ci0 = 0; ci0 < NCHUNK; ci0 += 4) { uint4 ds[4]; f32x4 da[4], db[4]; size_t off[4];
#pragma unroll
            for (int k = 0; k < 4; ++k) { const int c = chain_chunk(dir, ci0 + k); off[k] = (((size_t)chain * NCHUNK + c) * 128 + v) * DK + d8 * 8; ds[k] = *(const uint4*)(ST + off[k]);
                if (BR == 3) { da[k][0] = BE[chain * NCHUNK + c]; da[k][1] = MLOC[chain * NCHUNK + c]; }
                else { da[k] = *(const f32x4*)(DEC + ((size_t)chain * NCHUNK + c) * 128 + d8 * 8); db[k] = *(const f32x4*)(DEC + ((size_t)chain * NCHUNK + c) * 128 + d8 * 8 + 4); } }
#pragma unroll
            for (int k = 0; k < 4; ++k) {
                *(uint4*)(ST + off[k]) = make_uint4(pack2(S[0], S[1]), pack2(S[2], S[3]), pack2(S[4], S[5]), pack2(S[6], S[7]));
                const unsigned wds[4] = {ds[k].x, ds[k].y, ds[k].z, ds[k].w};
                float al[8], be[8];
                if (BR == 3) { const float mn = fmaxf(da[k][0] + m, da[k][1]), a = __expf(da[k][0] + m - mn), bb = __expf(da[k][1] - mn); m = mn;
#pragma unroll
                    for (int e = 0; e < 8; ++e) { al[e] = a; be[e] = bb; } }
                else {
#pragma unroll
                    for (int e = 0; e < 4; ++e) { al[e] = da[k][e]; al[4 + e] = db[k][e]; be[e] = 1.f; be[4 + e] = 1.f; } }
#pragma unroll
                for (int e = 0; e < 4; ++e) { S[2 * e] = al[2 * e] * S[2 * e] + be[2 * e] * bf2f((bf16_t)(wds[e] & 0xffff)); S[2 * e + 1] = al[2 * e + 1] * S[2 * e + 1] + be[2 * e + 1] * bf2f((bf16_t)(wds[e] >> 16)); } } }
    } else if (BR == 3 && g < TOTAL + 16 * 128) {
        const int q = g - TOTAL, d = q & 127, chain = q >> 7, dir = chain >> 3; float n = 0.f, m = 0.f;
        for (int ci = 0; ci < NCHUNK; ++ci) { const int c = chain_chunk(dir, ci); const float be = BE[chain * NCHUNK + c], ml = MLOC[chain * NCHUNK + c]; const size_t o = ((size_t)chain * NCHUNK + c) * 128 + d;
            const float dn = DN[o]; DN[o] = n; if (d == 0) MIN_[chain * NCHUNK + c] = m;
            const float mn = fmaxf(be + m, ml); n = __expf(be + m - mn) * n + __expf(ml - mn) * dn; m = mn; }
    }
}
template <int BR> __device__ __forceinline__ void phase_gl_out(const PP& p, int l, LAS unsigned char* L) {
    constexpr int DK = BR == 1 ? 64 : 128, PQ = DK + 8;
    const int tid = otid(p.swid), lane = tid & 63, wid = p.swid, fr = lane & 15, fq = lane >> 4;
    LAS bf16_t* QP = (LAS bf16_t*)L;
    LAS bf16_t* KP = QP + 2 * 64 * PQ;
    LAS bf16_t* QT = KP + 2 * 64 * PQ;
    LAS bf16_t* VT = QT + 2 * 64 * PQ;
    LAS bf16_t* PS = VT + 128 * 72;
    LAS float* RED = (LAS float*)(PS + 2 * 64 * 72);
    LAS float* LR = RED + 512;
    const bf16_t* Z = (const bf16_t*)(p.ws + WS_BIG + BIG_Z); const float* MISC = (const float*)(p.ws + WS_MISC);
    const bf16_t* ST = (const bf16_t*)(p.ws + WS_BIG + BIG_ST); bf16_t* YS = (bf16_t*)(p.ws + WS_BIG + BIG_YS) + (size_t)BR * TT * 512;
    const float* gain = (BR == 1 ? p.in[I_GLANG] : p.in[I_HGNG]) + l * 128;
    constexpr int VOFF = BR == 1 ? GV : HI, QOFF = BR == 1 ? GQ : HQ, GOFF = BR == 1 ? GG : HGT;
    for (int u = blockIdx.x; u < 8 * NCHUNK; u += gridDim.x) {
        const int c = u % NCHUNK, bh = u / NCHUNK, h = bh & 3, b = bh >> 2; const size_t r0 = (size_t)b * NTOK + c * 64;
        if (BR == 1) { for (int i = tid; i < 2048; i += 512) LR[i] = MISC[(r0 + (i >> 5)) * 64 + MISC_LR + (i & 31)]; __syncthreads(); }
        if (tid < 2 * DK) {
            const int dir = tid / DK, d = tid % DK; GlChan<BR> G; G.init(p, l, dir, h, d);
            float beta = 0.f;
#pragma unroll 4
            for (int w = 0; w < 32; ++w) { const int t = dir == 0 ? w : 63 - w; float g, k; G.gk(Z + (r0 + t) * ZLD, LR + t * 32 + dir * 16, g, k); beta += g; }
            const float ebeta = __expf(beta); float bs = 0.f;
#pragma unroll 4
            for (int w = 0; w < 64; ++w) { const int t = dir == 0 ? w : 63 - w; float g, k; G.gk(Z + (r0 + t) * ZLD, LR + t * 32 + dir * 16, g, k); bs += g;
                const float e1 = __expf(bs - beta); const float qraw = bf2f(Z[(r0 + t) * ZLD + QOFF + h * DK + d]);
                const float q = BR == 1 ? qraw * 0.125f : siluf(qraw) * 0.08838834764831845f;
                QP[(dir * 64 + t) * PQ + d] = f2bf(q * e1); QT[(dir * 64 + t) * PQ + d] = f2bf(q * e1 * ebeta); KP[(dir * 64 + t) * PQ + d] = f2bf(k / e1); }
        } else if (tid < 2 * DK + 128) { const int v = tid - 2 * DK;
#pragma unroll 1
            for (int grp = 0; grp < 8; ++grp) { unsigned short x[8];
#pragma unroll
                for (int e = 0; e < 8; ++e) x[e] = Z[(r0 + grp * 8 + e) * ZLD + VOFF + h * 128 + v];
                *(LAS u32x4*)(VT + v * 72 + grp * 8) = (u32x4){x[0] | ((unsigned)x[1] << 16), x[2] | ((unsigned)x[3] << 16), x[4] | ((unsigned)x[5] << 16), x[6] | ((unsigned)x[7] << 16)}; }
        }
        __syncthreads();
        {
            const int dir = wid >> 2, it = wid & 3;
#pragma unroll
            for (int jt = 0; jt < 4; ++jt) {
                f32x4 acc = (f32x4){0.f, 0.f, 0.f, 0.f};
#pragma unroll
                for (int kk = 0; kk < DK / 32; ++kk) acc = mfma16(*(const LAS bf16x8*)(KP + (dir * 64 + 16 * jt + fr) * PQ + 8 * fq + 32 * kk), *(const LAS bf16x8*)(QP + (dir * 64 + 16 * it + fr) * PQ + 8 * fq + 32 * kk), acc);
#pragma unroll
                for (int jj = 0; jj < 4; ++jj) { const int jg = 16 * jt + 4 * fq + jj, ig = 16 * it + fr; const bool keep = dir == 0 ? (jg <= ig) : (jg >= ig); acc[jj] = keep ? acc[jj] : 0.f; }
                *(LAS u32x2*)(PS + (dir * 64 + 16 * it + fr) * 72 + 16 * jt + 4 * fq) = (u32x2){pack2(acc[0], acc[1]), pack2(acc[2], acc[3])}; }
        }
        __syncthreads();
        {
            f32x4 acc[4];
#pragma unroll
            for (int it = 0; it < 4; ++it) acc[it] = (f32x4){0.f, 0.f, 0.f, 0.f};
            const bf16x8 xv0 = *(const LAS bf16x8*)(VT + (16 * wid + fr) * 72 + 8 * fq), xv1 = *(const LAS bf16x8*)(VT + (16 * wid + fr) * 72 + 8 * fq + 32);
#pragma unroll
            for (int dir = 0; dir < 2; ++dir) {
                const bf16_t* sp = ST + (((size_t)((dir * 2 + b) * 4 + h) * NCHUNK + c) * 128 + 16 * wid + fr) * DK + 8 * fq;
                bf16x8 xs[DK / 32];
#pragma unroll
                for (int kk = 0; kk < DK / 32; ++kk) xs[kk] = *(const bf16x8*)(sp + 32 * kk);
#pragma unroll
                for (int it = 0; it < 4; ++it) {
                    acc[it] = mfma16(xv0, *(const LAS bf16x8*)(PS + (dir * 64 + 16 * it + fr) * 72 + 8 * fq), acc[it]);
                    acc[it] = mfma16(xv1, *(const LAS bf16x8*)(PS + (dir * 64 + 16 * it + fr) * 72 + 8 * fq + 32), acc[it]);
#pragma unroll
                    for (int kk = 0; kk < DK / 32; ++kk) acc[it] = mfma16(xs[kk], *(const LAS bf16x8*)(QT + (dir * 64 + 16 * it + fr) * PQ + 8 * fq + 32 * kk), acc[it]); } }
#pragma unroll
            for (int it = 0; it < 4; ++it) { float ss = acc[it][0] * acc[it][0] + acc[it][1] * acc[it][1] + acc[it][2] * acc[it][2] + acc[it][3] * acc[it][3];
                ss += __shfl_xor(ss, 16); ss += __shfl_xor(ss, 32); if (fq == 0) RED[wid * 64 + 16 * it + fr] = ss; }
            __syncthreads();
            const f32x4 gn = *(const f32x4*)(gain + 16 * wid + 4 * fq);
#pragma unroll
            for (int it = 0; it < 4; ++it) { float tot = 0.f;
#pragma unroll
                for (int w2 = 0; w2 < 8; ++w2) tot += RED[w2 * 64 + 16 * it + fr];
                const float rs = rsqrtf(tot * (1.f / 128.f) + EPS); const size_t row = r0 + 16 * it + fr;
                const uint2 gt = *(const uint2*)(Z + row * ZLD + GOFF + h * 128 + 16 * wid + 4 * fq);
                const float y0 = acc[it][0] * rs * gn[0] * siluf(bf2f((bf16_t)(gt.x & 0xffff))), y1 = acc[it][1] * rs * gn[1] * siluf(bf2f((bf16_t)(gt.x >> 16)));
                const float y2 = acc[it][2] * rs * gn[2] * siluf(bf2f((bf16_t)(gt.y & 0xffff))), y3 = acc[it][3] * rs * gn[3] * siluf(bf2f((bf16_t)(gt.y >> 16)));
                *(uint2*)(YS + row * 512 + h * 128 + 16 * wid + 4 * fq) = make_uint2(pack2(y0, y1), pack2(y2, y3)); }
        }
        __syncthreads();
    }
}

__device__ __forceinline__ float wave_incl_scan_add(float x, int lane) {
#pragma unroll
    for (int o = 1; o < 64; o <<= 1) { const float y = __shfl_up(x, o); x = lane >= o ? x + y : x; }
    return x;
}
__device__ __forceinline__ float wave_incl_scan_max(float x, int lane) {
#pragma unroll
    for (int o = 1; o < 64; o <<= 1) { const float y = __shfl_up(x, o); x = lane >= o ? fmaxf(x, y) : x; }
    return x;
}
__device__ __forceinline__ float wave_max(float v) {
#pragma unroll
    for (int o = 32; o > 0; o >>= 1) v = fmaxf(v, __shfl_xor(v, o));
    return v;
}
__device__ __forceinline__ void phase_ml_local(const PP& p, int l, LAS unsigned char* L) {
    const int tid = otid(p.swid), lane = tid & 63, wid = p.swid, fr = lane & 15, fq = lane >> 4;
    LAS bf16_t* KT = (LAS bf16_t*)L;
    LAS bf16_t* VT = KT + 2 * 128 * 72;
    LAS float* WE = (LAS float*)(VT + 128 * 72);
    const bf16_t* Z = (const bf16_t*)(p.ws + WS_BIG + BIG_Z); const float* MISC = (const float*)(p.ws + WS_MISC);
    bf16_t* ST = (bf16_t*)(p.ws + WS_BIG + BIG_ST);
    float* BE = (float*)(p.ws + WS_SMALL + SM_MLBE); float* MLOC = (float*)(p.ws + WS_SMALL + SM_MLML); float* DN = (float*)(p.ws + WS_SMALL + SM_MLDN);
    for (int u = blockIdx.x; u < 8 * NCHUNK; u += gridDim.x) {
        const int c = u % NCHUNK, bh = u / NCHUNK, h = bh & 3, b = bh >> 2, p0 = c * 64; const size_t rb = (size_t)b * NTOK, r0 = rb + p0;
        const int lo = p0 < CTXL ? 0 : CTXL, hi = p0 < CTXL ? CTXL : NTOK;
        if (wid < 2) {
            const int dir = wid, t = dir == 0 ? lane : 63 - lane; const size_t r = r0 + t; const int chain = (dir * 2 + b) * 4 + h;
            const float ii = MISC[r * 64 + MISC_IF + dir * 8 + h] + p.in[I_MLGB][(l * 2 + dir) * 8 + h];
            const float lf = logsig(MISC[r * 64 + MISC_IF + dir * 8 + 4 + h] + p.in[I_MLGB][(l * 2 + dir) * 8 + 4 + h]);
            const float bc = wave_incl_scan_add(lf, lane), bend = __shfl(bc, 63), mloc = bend + wave_max(ii - bc);
            WE[dir * 64 + t] = __expf(bend - bc + ii - mloc);
            if (lane == 0) { BE[chain * NCHUNK + c] = bend; MLOC[chain * NCHUNK + c] = mloc; }
        }
        __syncthreads();
        if (tid < 256) {
            const int dir = tid >> 7, d = tid & 127, ch = h * 128 + d;
            float cw[4];
#pragma unroll
            for (int q = 0; q < 4; ++q) cw[q] = p.in[I_MLCW][(l * 4 + q) * 1024 + 512 + ch];
            const float cb = p.in[I_MLCB][l * 1024 + 512 + ch];
            float w0 = (p0 - 2 >= lo) ? bf2f(Z[(rb + p0 - 2) * ZLD + MK + ch]) : 0.f, w1 = (p0 - 1 >= lo) ? bf2f(Z[(rb + p0 - 1) * ZLD + MK + ch]) : 0.f, w2 = bf2f(Z[(rb + p0) * ZLD + MK + ch]);
            float dn = 0.f;
#pragma unroll 1
            for (int grp = 0; grp < 8; ++grp) { float val[8];
#pragma unroll
                for (int e = 0; e < 8; ++e) { const int t = grp * 8 + e; const float w3 = (p0 + t + 1 < hi) ? bf2f(Z[(rb + p0 + t + 1) * ZLD + MK + ch]) : 0.f;
                    const float k = siluf(cb + cw[0] * w0 + cw[1] * w1 + cw[2] * w2 + cw[3] * w3); w0 = w1; w1 = w2; w2 = w3;
                    val[e] = k * WE[dir * 64 + t]; dn += val[e]; }
                *(LAS u32x4*)(KT + (dir * 128 + d) * 72 + grp * 8) = (u32x4){pack2(val[0], val[1]), pack2(val[2], val[3]), pack2(val[4], val[5]), pack2(val[6], val[7])}; }
            DN[((size_t)((dir * 2 + b) * 4 + h) * NCHUNK + c) * 128 + d] = dn;
        } else if (tid < 384) { const int v = tid - 256;
#pragma unroll 1
            for (int grp = 0; grp < 8; ++grp) { unsigned short x[8];
#pragma unroll
                for (int e = 0; e < 8; ++e) x[e] = Z[(r0 + grp * 8 + e) * ZLD + MV + h * 128 + v];
                *(LAS u32x4*)(VT + v * 72 + grp * 8) = (u32x4){x[0] | ((unsigned)x[1] << 16), x[2] | ((unsigned)x[3] << 16), x[4] | ((unsigned)x[5] << 16), x[6] | ((unsigned)x[7] << 16)}; }
        }
        __syncthreads();
        { const int dir = wid >> 2; const size_t sbase = ((size_t)((dir * 2 + b) * 4 + h) * NCHUNK + c) * 128 * 128;
#pragma unroll
          for (int di = 0; di < 2; ++di) { const int dt = (wid & 3) * 2 + di;
            const bf16x8 x0 = *(const LAS bf16x8*)(KT + (dir * 128 + 16 * dt + fr) * 72 + 8 * fq), x1 = *(const LAS bf16x8*)(KT + (dir * 128 + 16 * dt + fr) * 72 + 8 * fq + 32);
#pragma unroll
            for (int vt = 0; vt < 8; ++vt) { const bf16x8 y0 = *(const LAS bf16x8*)(VT + (16 * vt + fr) * 72 + 8 * fq), y1 = *(const LAS bf16x8*)(VT + (16 * vt + fr) * 72 + 8 * fq + 32);
                f32x4 acc = (f32x4){0.f, 0.f, 0.f, 0.f}; acc = mfma16(x0, y0, acc); acc = mfma16(x1, y1, acc);
                *(uint2*)(ST + sbase + (size_t)(16 * vt + fr) * 128 + 16 * dt + 4 * fq) = make_uint2(pack2(acc[0], acc[1]), pack2(acc[2], acc[3])); } } }
        __syncthreads();
    }
}
__device__ __forceinline__ void phase_ml_out(const PP& p, int l, LAS unsigned char* L) {
    constexpr int PQ = 136;
    const int tid = otid(p.swid), lane = tid & 63, wid = p.swid, fr = lane & 15, fq = lane >> 4;
    LAS bf16_t* QL = (LAS bf16_t*)L;
    LAS bf16_t* KL = QL + 64 * PQ;
    LAS bf16_t* VT = KL + 64 * PQ;
    LAS bf16_t* PS = VT + 128 * 72;
    LAS float* SC = (LAS float*)(PS + 2 * 64 * 72);
    LAS float* NV = SC + 2 * 576;
    LAS float* RED = NV + 256;
    const bf16_t* Z = (const bf16_t*)(p.ws + WS_BIG + BIG_Z); const float* MISC = (const float*)(p.ws + WS_MISC);
    const bf16_t* ST = (const bf16_t*)(p.ws + WS_BIG + BIG_ST); bf16_t* YS = (bf16_t*)(p.ws + WS_BIG + BIG_YS) + (size_t)3 * TT * 512;
    const float* MIN_ = (const float*)(p.ws + WS_SMALL + SM_MLMIN); const float* DN = (const float*)(p.ws + WS_SMALL + SM_MLDN);
    const float* gain = p.in[I_MLNG] + l * 128;
    for (int u = blockIdx.x; u < 8 * NCHUNK; u += gridDim.x) {
        const int c = u % NCHUNK, bh = u / NCHUNK, h = bh & 3, b = bh >> 2, p0 = c * 64; const size_t rb = (size_t)b * NTOK, r0 = rb + p0;
        const int lo = p0 < CTXL ? 0 : CTXL, hi = p0 < CTXL ? CTXL : NTOK;
        if (wid < 2) {
            const int dir = wid, t = dir == 0 ? lane : 63 - lane; const size_t r = r0 + t; const int chain = (dir * 2 + b) * 4 + h;
            const float ii = MISC[r * 64 + MISC_IF + dir * 8 + h] + p.in[I_MLGB][(l * 2 + dir) * 8 + h];
            const float lf = logsig(MISC[r * 64 + MISC_IF + dir * 8 + 4 + h] + p.in[I_MLGB][(l * 2 + dir) * 8 + 4 + h]);
            const float bc = wave_incl_scan_add(lf, lane), a = ii - bc, arun = wave_incl_scan_max(a, lane), mprev = MIN_[chain * NCHUNK + c];
            const float m = bc + fmaxf(mprev, arun);
            LAS float* S = SC + dir * 576;
            S[t] = bc - m; S[64 + t] = a; S[128 + t] = __expf(bc + mprev - m); S[192 + t] = __expf(-m);
        } else if (wid < 6) {
            const int q2 = tid - 128, which = q2 >> 7, d = q2 & 127, ch = h * 128 + d, zc = (which ? MK : MQ) + ch;
            float cw[4];
#pragma unroll
            for (int q = 0; q < 4; ++q) cw[q] = p.in[I_MLCW][(l * 4 + q) * 1024 + which * 512 + ch];
            const float cb = p.in[I_MLCB][l * 1024 + which * 512 + ch], scl = which ? 1.f : 0.08838834764831845f;
            LAS bf16_t* dst = (which ? KL : QL) + d;
            float w0 = (p0 - 2 >= lo) ? bf2f(Z[(rb + p0 - 2) * ZLD + zc]) : 0.f, w1 = (p0 - 1 >= lo) ? bf2f(Z[(rb + p0 - 1) * ZLD + zc]) : 0.f, w2 = bf2f(Z[(rb + p0) * ZLD + zc]);
#pragma unroll 8
            for (int t = 0; t < 64; ++t) { const float w3 = (p0 + t + 1 < hi) ? bf2f(Z[(rb + p0 + t + 1) * ZLD + zc]) : 0.f;
                dst[t * PQ] = f2bf(siluf(cb + cw[0] * w0 + cw[1] * w1 + cw[2] * w2 + cw[3] * w3) * scl); w0 = w1; w1 = w2; w2 = w3; }
        } else {
            const int v = tid - 384;
#pragma unroll 1
            for (int grp = 0; grp < 8; ++grp) { unsigned short x[8];
#pragma unroll
                for (int e = 0; e < 8; ++e) x[e] = Z[(r0 + grp * 8 + e) * ZLD + MV + h * 128 + v];
                *(LAS u32x4*)(VT + v * 72 + grp * 8) = (u32x4){x[0] | ((unsigned)x[1] << 16), x[2] | ((unsigned)x[3] << 16), x[4] | ((unsigned)x[5] << 16), x[6] | ((unsigned)x[7] << 16)}; }
#pragma unroll
            for (int dir = 0; dir < 2; ++dir) NV[dir * 128 + v] = DN[((size_t)((dir * 2 + b) * 4 + h) * NCHUNK + c) * 128 + v];
        }
        __syncthreads();
        {
            const int dir = tid >> 8, i = (tid >> 2) & 63, part = tid & 3; float sacc = 0.f;
#pragma unroll 8
            for (int d = part * 32; d < part * 32 + 32; ++d) sacc += bf2f(QL[i * PQ + d]) * NV[dir * 128 + d];
            sacc += __shfl_xor(sacc, 1); sacc += __shfl_xor(sacc, 2);
            if (part == 0) SC[dir * 576 + 256 + i] = sacc;
        }
        {
            const int it = wid & 3;
#pragma unroll
            for (int jh = 0; jh < 2; ++jh) { const int jt = (wid >> 2) * 2 + jh;
                f32x4 acc = (f32x4){0.f, 0.f, 0.f, 0.f};
#pragma unroll
                for (int kk = 0; kk < 4; ++kk) acc = mfma16(*(const LAS bf16x8*)(KL + (16 * jt + fr) * PQ + 8 * fq + 32 * kk), *(const LAS bf16x8*)(QL + (16 * it + fr) * PQ + 8 * fq + 32 * kk), acc);
                const int ig = 16 * it + fr;
#pragma unroll
                for (int dir = 0; dir < 2; ++dir) { const LAS float* S = SC + dir * 576; const float ui = S[ig]; float sv[4];
#pragma unroll
                    for (int jj = 0; jj < 4; ++jj) { const int jg = 16 * jt + 4 * fq + jj; const bool keep = dir == 0 ? (jg <= ig) : (jg >= ig);
                        const float wgt = __expf(fminf(ui + S[64 + jg], 0.f)); sv[jj] = keep ? acc[jj] * wgt : 0.f; }
                    *(LAS u32x2*)(PS + (dir * 64 + ig) * 72 + 16 * jt + 4 * fq) = (u32x2){pack2(sv[0], sv[1]), pack2(sv[2], sv[3])};
                    float rsum = sv[0] + sv[1] + sv[2] + sv[3]; rsum += __shfl_xor(rsum, 16); rsum += __shfl_xor(rsum, 32);
                    if (fq == 0) SC[dir * 576 + 320 + jt * 64 + ig] = rsum; } }
        }
        __syncthreads();
        {
            f32x4 o[4];
#pragma unroll
            for (int it = 0; it < 4; ++it) o[it] = (f32x4){0.f, 0.f, 0.f, 0.f};
            const bf16x8 xv0 = *(const LAS bf16x8*)(VT + (16 * wid + fr) * 72 + 8 * fq), xv1 = *(const LAS bf16x8*)(VT + (16 * wid + fr) * 72 + 8 * fq + 32);
#pragma unroll
            for (int dir = 0; dir < 2; ++dir) {
                const bf16_t* sp = ST + (((size_t)((dir * 2 + b) * 4 + h) * NCHUNK + c) * 128 + 16 * wid + fr) * 128 + 8 * fq;
                bf16x8 xs[4];
#pragma unroll
                for (int kk = 0; kk < 4; ++kk) xs[kk] = *(const bf16x8*)(sp + 32 * kk);
                const LAS float* S = SC + dir * 576;
#pragma unroll
                for (int it = 0; it < 4; ++it) { const int ig = 16 * it + fr;
                    f32x4 ap = (f32x4){0.f, 0.f, 0.f, 0.f}, ac = (f32x4){0.f, 0.f, 0.f, 0.f};
                    ap = mfma16(xv0, *(const LAS bf16x8*)(PS + (dir * 64 + ig) * 72 + 8 * fq), ap);
                    ap = mfma16(xv1, *(const LAS bf16x8*)(PS + (dir * 64 + ig) * 72 + 8 * fq + 32), ap);
#pragma unroll
                    for (int kk = 0; kk < 4; ++kk) ac = mfma16(xs[kk], *(const LAS bf16x8*)(QL + ig * PQ + 8 * fq + 32 * kk), ac);
                    const float wi = S[128 + ig], den = S[320 + ig] + S[384 + ig] + S[448 + ig] + S[512 + ig] + wi * S[256 + ig];
                    const float inv = 1.f / fmaxf(fabsf(den), S[192 + ig]);
#pragma unroll
                    for (int jj = 0; jj < 4; ++jj) o[it][jj] += (ap[jj] + wi * ac[jj]) * inv; } }
#pragma unroll
            for (int it = 0; it < 4; ++it) { float ss = o[it][0] * o[it][0] + o[it][1] * o[it][1] + o[it][2] * o[it][2] + o[it][3] * o[it][3];
                ss += __shfl_xor(ss, 16); ss += __shfl_xor(ss, 32); if (fq == 0) RED[wid * 64 + 16 * it + fr] = ss; }
            __syncthreads();
            const f32x4 gn = *(const f32x4*)(gain + 16 * wid + 4 * fq);
#pragma unroll
            for (int it = 0; it < 4; ++it) { float tot = 0.f;
#pragma unroll
                for (int w2 = 0; w2 < 8; ++w2) tot += RED[w2 * 64 + 16 * it + fr];
                const float rs = rsqrtf(tot * (1.f / 128.f) + EPS); const size_t row = r0 + 16 * it + fr;
                const uint2 gt = *(const uint2*)(Z + row * ZLD + MO + h * 128 + 16 * wid + 4 * fq);
                const float y0 = o[it][0] * rs * gn[0] * sigm(bf2f((bf16_t)(gt.x & 0xffff))), y1 = o[it][1] * rs * gn[1] * sigm(bf2f((bf16_t)(gt.x >> 16)));
                const float y2 = o[it][2] * rs * gn[2] * sigm(bf2f((bf16_t)(gt.y & 0xffff))), y3 = o[it][3] * rs * gn[3] * sigm(bf2f((bf16_t)(gt.y >> 16)));
                *(uint2*)(YS + row * 512 + h * 128 + 16 * wid + 4 * fq) = make_uint2(pack2(y0, y1), pack2(y2, y3)); }
        }
        __syncthreads();
    }
}

#ifndef CH_GLA
#define CH_GLA 1
#endif
#ifndef CH_HG
#define CH_HG 1
#endif
#ifndef CH_ML
#define CH_ML 1
#endif
#if CH_GLA
#define GLA_LOCAL(p, l) phase_gl_local<1>(p, l, L)
#define GLA_CARRY(p, l) phase_gl_carry<1>(p)
#define GLA_OUT(p, l) phase_gl_out<1>(p, l, L)
#else
#define GLA_LOCAL(p, l) phase_seq_gl<1>(p, l, (LAS float*)L)
#define GLA_CARRY(p, l)
#define GLA_OUT(p, l) phase_epi_norm<1>(p, l)
#endif
#if CH_HG
#define HG_LOCAL(p, l) phase_gl_local<2>(p, l, L)
#define HG_CARRY(p, l) phase_gl_carry<2>(p)
#define HG_OUT(p, l) phase_gl_out<2>(p, l, L)
#else
#define HG_LOCAL(p, l) phase_seq_gl<2>(p, l, (LAS float*)L)
#define HG_CARRY(p, l)
#define HG_OUT(p, l) phase_epi_norm<2>(p, l)
#endif
#if CH_ML
#define ML_LOCAL(p, l) phase_ml_local(p, l, L)
#define ML_CARRY(p, l) phase_gl_carry<3>(p)
#define ML_OUT(p, l) phase_ml_out(p, l, L)
#else
#define ML_LOCAL(p, l) phase_seq_ml(p, l, (LAS float*)L)
#define ML_CARRY(p, l)
#define ML_OUT(p, l) phase_epi_norm<3>(p, l)
#endif
constexpr int LDS_BYTES = 147456, NPH_LAYER = 22, NPH = 1 + 2 * NPH_LAYER;
__global__ void __launch_bounds__(512, 2) mega(P p_unused) {
    extern __shared__ __attribute__((aligned(16))) unsigned char lds[];
    LAS unsigned char* L = (LAS unsigned char*)lds;
    LAS int* tbl = (LAS int*)(L + 131072 + 1024);
    const int swid = __builtin_amdgcn_readfirstlane((int)(threadIdx.x >> 6));
    int lo, hi; unsigned* barw;
    { const PP p = load_args(swid); lo = p.ph_lo; hi = p.ph_hi; barw = (unsigned*)(p.ws + WS_CTL); }
    { const int t0 = (int)threadIdx.x; if (t0 < 4) ((LAS unsigned*)(L + LDS_BYTES - 16))[t0] = 0u; }
    __syncthreads();
    XcdBarrier bar; bar.bar = barw; bar.x = 0; bar.st = nullptr; bar.swid = swid;
    if (hi - lo > 1) bar = xcd_barrier_post(barw, (volatile LAS unsigned*)(L + LDS_BYTES - 16), swid);
#ifndef PHSEL
#define PHSEL(k) 1
#endif
#define IN(k) (PHSEL(k) && lo <= (k) && (k) < hi)
#define SEAM(k) do { if (IN((k) + 1)) xcd_barrier(bar); } while (0)
#define PHASE(k, ...) if (IN(k)) { const PP p = load_args(swid); unsigned char* ws = p.ws; unsigned char* wb = ws + WS_WB; unsigned char* big = ws + WS_BIG; (void)wb; (void)big; __VA_ARGS__ SEAM(k); }
    PHASE(0, phase_mods(p, (LAS float*)L);)
#define LAYER_BODY(l) { constexpr int pb = 1 + NPH_LAYER * (l); \
    PHASE(pb + 0, phase_convert(p, l, (LAS float*)L);) \
    PHASE(pb + 1, phase_norm1(p, l);) \
    PHASE(pb + 2, Gemm g{(const bf16_t*)(ws + WS_U), (const bf16_t*)(wb + WB_WIN), DM, DM, p.swid}; OrderPlain S; S.init(MT, 11, gridDim.x, blockIdx.x); S.skipctx = 0; \
        EpiZ E{(bf16_t*)(big + BIG_Z), (float*)(ws + WS_MISC), 10}; GEMM_RUN(EpiZ, OrderPlain, g, S, E);) \
    PHASE(pb + 3, phase_rg<false>(p, l, L); GLA_LOCAL(p, l);) \
    PHASE(pb + 4, phase_rg_carry(p); GLA_CARRY(p, l);) \
    PHASE(pb + 5, phase_rg<true>(p, l, L); GLA_OUT(p, l);) \
    PHASE(pb + 6, Gemm g{(const bf16_t*)(ws + WS_U), (const bf16_t*)(wb + WB_WIN) + (size_t)2816 * DM, DM, DM, p.swid}; OrderPlain S; S.init(MT, 10, gridDim.x, blockIdx.x); S.skipctx = 0; \
        EpiZ E{(bf16_t*)(big + BIG_Z), (float*)(ws + WS_MISC), -1}; GEMM_RUN(EpiZ, OrderPlain, g, S, E);) \
    PHASE(pb + 7, HG_LOCAL(p, l);) \
    PHASE(pb + 8, HG_CARRY(p, l);) \
    PHASE(pb + 9, HG_OUT(p, l);) \
    PHASE(pb + 10, Gemm g{(const bf16_t*)(ws + WS_U), (const bf16_t*)(wb + WB_WIN) + (size_t)5376 * DM, DM, DM, p.swid}; OrderPlain S; S.init(MT, 8, gridDim.x, blockIdx.x); S.skipctx = 0; \
        EpiZ E{(bf16_t*)(big + BIG_Z), (float*)(ws + WS_MISC), -1}; GEMM_RUN(EpiZ, OrderPlain, g, S, E);) \
    PHASE(pb + 11, ML_LOCAL(p, l);) \
    PHASE(pb + 12, ML_CARRY(p, l);) \
    PHASE(pb + 13, ML_OUT(p, l);) \
    PHASE(pb + 14, Gemm g{(const bf16_t*)(big + BIG_YS), (const bf16_t*)(wb + WB_WB), 512, 512, p.swid}; OrderBranch S; S.init((l) ? 64 : MT, 16, gridDim.x, blockIdx.x); S.skipctx = (l); \
        EpiBO E{(bf16_t*)(big + BIG_BO)}; GEMM_RUN(EpiBO, OrderBranch, g, S, E);) \
    PHASE(pb + 15, Gemm g{(const bf16_t*)(ws + WS_U), (const bf16_t*)(wb + WB_WM), DM, DM, p.swid}; OrderPlain S; S.init((l) ? 64 : MT, 16, gridDim.x, blockIdx.x); S.skipctx = (l); \
        EpiMerge E{(const bf16_t*)(big + BIG_BO), p.in[I_BMERGE] + (size_t)(l) * 4096, (bf16_t*)(big + BIG_MERGED)}; GEMM_RUN(EpiMerge, OrderPlain, g, S, E);) \
    PHASE(pb + 16, Gemm g{(const bf16_t*)(big + BIG_MERGED), (const bf16_t*)(wb + WB_WO), DM, DM, p.swid}; OrderPlain S; S.init((l) ? 64 : MT, 4, gridDim.x, blockIdx.x); S.skipctx = (l); \
        EpiOut E{(l) == 0 ? p.in[I_X] : p.out, (l) == 0 ? p.in[I_CTX] : (const float*)(ws + WS_HCTX), p.out, (float*)(ws + WS_HCTX), (const float*)(ws + WS_MOD) + (size_t)(l) * 3 * 6144}; \
        GEMM_RUN(EpiOut, OrderPlain, g, S, E);) \
    PHASE(pb + 17, phase_route(p, l);) \
    PHASE(pb + 18, phase_dispatch(p, l, tbl);) \
    PHASE(pb + 19, const int nblk = moe_tables(p, l, tbl); Gemm g{(const bf16_t*)(big + BIG_XS), (const bf16_t*)(wb + WB_W13), DM, DM, p.swid}; OrderMoe S; S.init(nblk, 4, gridDim.x, blockIdx.x); S.blk_e = tbl + 32; \
        EpiH E{(bf16_t*)(big + BIG_HS)}; GEMM_RUN(EpiH, OrderMoe, g, S, E);) \
    PHASE(pb + 20, const int nblk = moe_tables(p, l, tbl); Gemm g{(const bf16_t*)(big + BIG_HS), (const bf16_t*)(wb + WB_W2), 512, 512, p.swid}; OrderMoe S; S.init(nblk, 4, gridDim.x, blockIdx.x); S.blk_e = tbl + 32; \
        EpiY E{(bf16_t*)(big + BIG_YM)}; GEMM_RUN(EpiY, OrderMoe, g, S, E);) \
    PHASE(pb + 21, phase_combine(p, l);) }
    LAYER_BODY(0)
    LAYER_BODY(1)
#undef LAYER_BODY
#undef PHASE
#undef SEAM
#undef IN
}

#ifndef N_LAUNCHES
#define N_LAUNCHES 1
#endif
extern "C" void kernel_launch(void* const* d_in, const int* in_sizes, int n_in, void* d_out, int out_size, void* d_ws, size_t ws_size, hipStream_t stream) {
    static int grid = 0;
    if (grid == 0) {
        if (n_in != N_IN || out_size != NBATCH * SEQL * DM || ws_size < WS_END) { fprintf(stderr, "kernel_launch: unexpected shapes (n_in %d out %d ws %zu need %zu)\n", n_in, out_size, ws_size, (size_t)WS_END); grid = -1; return; }
        int dev = 0, cus = 0, per_cu = 0;
        if (hipGetDevice(&dev) != hipSuccess || hipDeviceGetAttribute(&cus, hipDeviceAttributeMultiprocessorCount, dev) != hipSuccess) { grid = -1; return; }
        if (hipFuncSetAttribute((const void*)mega, hipFuncAttributeMaxDynamicSharedMemorySize, LDS_BYTES) != hipSuccess) { grid = -1; return; }
        if (hipOccupancyMaxActiveBlocksPerMultiprocessor(&per_cu, (const void*)mega, 512, LDS_BYTES) != hipSuccess || per_cu < 1) { fprintf(stderr, "kernel_launch: occupancy query says %d\n", per_cu); }
        (void)hipGetLastError();
        grid = cus;
    }
    if (grid < 0) return;
    (void)hipMemsetAsync((char*)d_ws + WS_CTL, 0, 65536, stream);
    P p{};
    for (int i = 0; i < N_IN; ++i) p.in[i] = (const float*)d_in[i];
    p.out = (float*)d_out; p.ws = (unsigned char*)d_ws;
    if (N_LAUNCHES == 1) { p.ph_lo = 0; p.ph_hi = NPH; hipLaunchKernelGGL(mega, dim3(grid), dim3(512), LDS_BYTES, stream, p); }
    else for (int k = 0; k < NPH; ++k) { p.ph_lo = k; p.ph_hi = k + 1; hipLaunchKernelGGL(mega, dim3(grid), dim3(512), LDS_BYTES, stream, p); }
}
```

```cpp
#include <hip/hip_runtime.h>
#include <cstdio>
#include <cstdint>

#define LAS __attribute__((address_space(3)))
typedef unsigned short bf16_t;
typedef short bf16x8 __attribute__((ext_vector_type(8)));
typedef float f32x4 __attribute__((ext_vector_type(4)));
typedef unsigned u32x4 __attribute__((ext_vector_type(4)));
typedef unsigned u32x2 __attribute__((ext_vector_type(2)));

#define XB_TMO      128
#define XB_XCNT(j)  (256  + 64 * (j))
#define XB_XSUB(j)  (1280 + 64 * (j))
#define XB_XGEN(j)  (2304 + 64 * (j))
#define XB_TOP      3328
#define XB_TOPGEN   3392
#define XCD_BAR_WORDS 3456
#define XB_SPIN_CAP (1u << 18)

__device__ __forceinline__ unsigned xb_ld(unsigned* p)              { return __hip_atomic_load(p, __ATOMIC_RELAXED, __HIP_MEMORY_SCOPE_AGENT); }
__device__ __forceinline__ unsigned xb_add(unsigned* p, unsigned v) { return __hip_atomic_fetch_add(p, v, __ATOMIC_RELAXED, __HIP_MEMORY_SCOPE_AGENT); }
__device__ __forceinline__ unsigned xb_xcc_id() { return (unsigned)__builtin_amdgcn_s_getreg((3 << 11) | 20) & 0xFu; }
#define XB_SPIN(cond, bar) do { unsigned _sp = 0; while (cond) { __builtin_amdgcn_s_sleep(1); \
    if ((++_sp & 255u) == 0u) { if (xb_ld(&(bar)[XB_TMO])) break; if (_sp > XB_SPIN_CAP) { atomicAdd(&(bar)[XB_TMO], 1u); break; } } } } while (0)

struct XcdBarrier {
    unsigned* bar; unsigned x;
    int swid;
    volatile LAS unsigned* st;
};

__device__ __forceinline__ XcdBarrier xcd_barrier_post(unsigned* bar, volatile LAS unsigned* st, int swid) {
    XcdBarrier b; b.bar = bar; b.x = xb_xcc_id(); b.st = st; b.swid = swid;
    if (swid == 0 && __builtin_amdgcn_mbcnt_hi(~0u, __builtin_amdgcn_mbcnt_lo(~0u, 0u)) == 0u) (void)xb_add(&bar[XB_XCNT(b.x)], 1u);
    return b;
}
__device__ __forceinline__ void xcd_barrier_complete(unsigned* bar, unsigned x, unsigned& nloc, unsigned& nx) {
    const unsigned G = gridDim.x * gridDim.y * gridDim.z;
    unsigned sum, cnt, mine, sp = 0u;
    for (;;) {
        sum = 0u; cnt = 0u; mine = 0u;
#pragma unroll
        for (unsigned j = 0; j < 16; ++j) { const unsigned c = xb_ld(&bar[XB_XCNT(j)]); sum += c; cnt += (c > 0u) ? 1u : 0u; mine = (j == x) ? c : mine; }
        if (sum == G) break;
        __builtin_amdgcn_s_sleep(1);
        if ((++sp & 255u) == 0u) { if (xb_ld(&bar[XB_TMO])) break; if (sp > XB_SPIN_CAP) { atomicAdd(&bar[XB_TMO], 1u); break; } }
    }
    nloc = mine > 0u ? mine : 1u; nx = cnt > 0u ? cnt : 1u;
}

__device__ __forceinline__ void xcd_barrier(const XcdBarrier& b) {
    asm volatile("s_waitcnt vmcnt(0)" ::: "memory");
    __syncthreads();
    if (b.swid == 0 && __builtin_amdgcn_mbcnt_hi(~0u, __builtin_amdgcn_mbcnt_lo(~0u, 0u)) == 0u) {
        unsigned* bar = b.bar;
        __builtin_amdgcn_s_waitcnt(0);
        unsigned nloc = b.st[0], nx = b.st[1];
        if (nloc == 0u) { xcd_barrier_complete(bar, b.x, nloc, nx); b.st[0] = nloc; b.st[1] = nx; }
        const unsigned old = xb_add(&bar[XB_XSUB(b.x)], 1u);
        const unsigned gen = old / nloc;
        if (old + 1u == (gen + 1u) * nloc) {
            __builtin_amdgcn_fence(__ATOMIC_RELEASE, "agent");
            asm volatile("s_waitcnt vmcnt(0)" ::: "memory");
            const unsigned og = xb_add(&bar[XB_TOP], 1u);
            const unsigned tg = og / nx;
            if (og + 1u == (tg + 1u) * nx) xb_add(&bar[XB_TOPGEN], 1u);
            else XB_SPIN(xb_ld(&bar[XB_TOPGEN]) == tg, bar);
            __builtin_amdgcn_fence(__ATOMIC_ACQUIRE, "agent");
            xb_add(&bar[XB_XGEN(b.x)], 1u);
            asm volatile("s_waitcnt vmcnt(0)" ::: "memory");
        } else {
            XB_SPIN(xb_ld(&bar[XB_XGEN(b.x)]) == gen, bar);
            __builtin_amdgcn_fence(__ATOMIC_ACQUIRE, "agent");
            asm volatile("s_waitcnt vmcnt(0)" ::: "memory");
        }
    }
    __syncthreads();
}


constexpr int DM = 1024, NBATCH = 2, SEQL = 8192, CTXL = 256, NTOK = 8448, TT = 16896, NCHUNK = 132, MT = 66;
constexpr int ZLD = 2560;
constexpr float EPS = 1e-6f;
constexpr int RGX = 0, RGY = 512, GQ = 1024, GK = 1280, GV = 1536, GG = 2048;
constexpr int HQ = 0, HI = 512, HF = 1024, HGT = 2048;
constexpr int MQ = 0, MK = 512, MV = 1024, MO = 1536;
constexpr int MISC_LR = 0, MISC_IF = 32;
constexpr int NSLOT_MAX = 37888;

enum { I_X = 0, I_C, I_CTX, I_CCTX, I_ADAW, I_ADAB, I_NMIXG, I_NFFNG, I_WIN, I_RGCW, I_RGCB, I_RGGW, I_RGGB, I_RGLAM, I_GLAWLR, I_GLABLR, I_GLANG,
       I_HGLB, I_HGNG, I_MLCW, I_MLCB, I_MLGB, I_MLNG, I_WBR, I_WMERGE, I_BMERGE, I_WOUT, I_MWG, I_MBG, I_MWE, I_MBE, I_MW1, I_MW3, I_MW2, I_FNG, N_IN };

constexpr size_t WS_CTL = 0;
constexpr size_t WS_MOD = 65536;
constexpr size_t WS_HCTX = 262144;
constexpr size_t WS_ROUTE = WS_HCTX + 2097152;
constexpr size_t WS_MISC = WS_ROUTE + 1048576;
constexpr size_t WS_SMALL = WS_MISC + 4325376;
constexpr size_t WS_WB = WS_SMALL + 8388608;
constexpr size_t WB_WIN = 0, WB_WM = WB_WIN + 15204352, WB_WB = WB_WM + 8388608, WB_WO = WB_WB + 4194304, WB_W13 = WB_WO + 2097152,
                 WB_W2 = WB_W13 + 33554432, WB_GW = WB_W2 + 16777216, WB_END = WB_GW + 262144;
constexpr size_t WS_U = WS_WB + WB_END;
constexpr size_t WS_BIG = WS_U + 34603008;
constexpr size_t BIG_Z = 0, BIG_ST = 86507520, BIG_YS = BIG_ST + 69206016 + 65536, BIG_END = BIG_YS + 69206016;
constexpr size_t WS_END = WS_BIG + BIG_END;
constexpr size_t BIG_BO = 0;
constexpr size_t BIG_MERGED = BIG_YS;
constexpr size_t BIG_XS = 0;
constexpr size_t BIG_HS = 77594624;
constexpr size_t BIG_YM = BIG_HS + 38797312;
static_assert(BIG_YM + 77594624 <= BIG_END, "moe alias");
static_assert(138412032 <= BIG_YS, "BO alias");
constexpr int CW_CNT = 4096;

struct P { const float* in[N_IN]; float* out; unsigned char* ws; int ph_lo, ph_hi; };
struct PP : P { int swid; };

__device__ __forceinline__ float bf2f(bf16_t b) { return __uint_as_float(((unsigned)b) << 16); }
__device__ __forceinline__ bf16_t f2bf(float f) { unsigned u = __float_as_uint(f); u += 0x7FFFu + ((u >> 16) & 1u); return (bf16_t)(u >> 16); }
__device__ __forceinline__ unsigned pack2(float lo, float hi) { return (unsigned)f2bf(lo) | ((unsigned)f2bf(hi) << 16); }
__device__ __forceinline__ float sigm(float x) { return 1.f / (1.f + __expf(-x)); }
__device__ __forceinline__ float siluf(float x) { return x * sigm(x); }
__device__ __forceinline__ float logsig(float x) { return fminf(x, 0.f) - log1pf(__expf(-fabsf(x))); }
__device__ __forceinline__ float softplusf(float x) { return fmaxf(x, 0.f) + log1pf(__expf(-fabsf(x))); }
__device__ __forceinline__ float gelu_tanh(float x) { const float y = 0.7978845608028654f * (x + 0.044715f * x * x * x); const float t = 1.f - 2.f / (__expf(2.f * y) + 1.f); return 0.5f * x * (1.f + t); }
__device__ __forceinline__ float wave_sum(float v) {
#pragma unroll
    for (int o = 32; o > 0; o >>= 1) v += __shfl_xor(v, o);
    return v;
}
__device__ __forceinline__ int lane_id() { return (int)__builtin_amdgcn_mbcnt_hi(~0u, __builtin_amdgcn_mbcnt_lo(~0u, 0u)); }
__device__ __forceinline__ int otid(int swid) { int t = swid * 64 + lane_id(); asm volatile("" : "+v"(t)); return t; }
__device__ __forceinline__ const float* hrow_c(const float* HL, const float* HC, int r) { const int b = r / NTOK, p = r - b * NTOK; return p < CTXL ? HC + ((size_t)b * CTXL + p) * DM : HL + ((size_t)b * SEQL + (p - CTXL)) * DM; }
__device__ __forceinline__ float* hrow_m(float* HL, float* HC, int r) { const int b = r / NTOK, p = r - b * NTOK; return p < CTXL ? HC + ((size_t)b * CTXL + p) * DM : HL + ((size_t)b * SEQL + (p - CTXL)) * DM; }
__device__ __forceinline__ int mod_idx(int r) { const int b = r / NTOK, p = r - b * NTOK; return p < CTXL ? 2 : b; }

typedef const __attribute__((address_space(4))) P* KP;
__device__ __forceinline__ PP load_args(int swid) { unsigned long long a = (unsigned long long)__builtin_amdgcn_kernarg_segment_ptr(); asm volatile("" : "+s"(a)); KP k = (KP)a; PP r; r.swid = swid;
#pragma unroll
    for (int i = 0; i < N_IN; ++i) r.in[i] = k->in[i];
    r.out = k->out; r.ws = k->ws; r.ph_lo = k->ph_lo; r.ph_hi = k->ph_hi; return r; }
struct Unit { int pm, pn; };
struct Gemm { const bf16_t* A; const bf16_t* Bt; int lda; int K; int swid; };

struct TileOrder {
    int nM, nN, G, c;
    __device__ __forceinline__ void a_ready(const Unit&) const {}
    __device__ __forceinline__ void done(const Unit&) const {}
    __device__ void init(int nM_, int nN_, int G_, int c_) { nM = nM_; nN = nN_; G = G_; c = c_; }
    __device__ __forceinline__ bool base(int i, Unit& u) const { const long L = (long)i * G + c; if (L >= (long)nM * nN) return false; u.pm = (int)(L / nN); u.pn = (int)(L % nN); return true; }
};
struct OrderPlain : TileOrder { int skipctx; __device__ __forceinline__ bool next(int i, Unit& u) const { if (!base(i, u)) return false; if (skipctx) u.pm = u.pm < 32 ? u.pm + 1 : u.pm + 2; return true; } };
struct OrderBranch : TileOrder { int skipctx; __device__ __forceinline__ bool next(int i, Unit& u) const { if (!base(i, u)) return false; int pm = u.pm; if (skipctx) pm = pm < 32 ? pm + 1 : pm + 2; u.pm = (u.pn >> 2) * MT + pm; return true; } };
struct OrderMoe : TileOrder { const LAS int* blk_e; __device__ __forceinline__ bool next(int i, Unit& u) const { if (!base(i, u)) return false; u.pn = blk_e[u.pm] * 4 + u.pn; return true; } };

template <class Epi, class Sched>
__device__ __forceinline__ void gemm_simple(const Gemm g, const Sched& S, const Epi& E) {
    const int tid = otid(g.swid), wid = tid >> 6, lane = tid & 63, wr = wid >> 2, wc = wid & 3, fr = lane & 15, fq = lane >> 4;
    Unit u;
    for (int it = 0; S.next(it, u); ++it) {
        f32x4 acc[2][2][4][2];
#pragma unroll
        for (int a = 0; a < 2; ++a)
#pragma unroll
            for (int b = 0; b < 2; ++b)
#pragma unroll
                for (int m = 0; m < 4; ++m)
#pragma unroll
                    for (int n = 0; n < 2; ++n) acc[a][b][m][n] = (f32x4){0.f, 0.f, 0.f, 0.f};
        const bf16_t* Ap = g.A + (size_t)(u.pm * 256 + wr * 64 + fr) * g.lda + fq * 8;
        const bf16_t* Bp = g.Bt + (size_t)(u.pn * 256 + wc * 32 + fr) * g.K + fq * 8;
        for (int k0 = 0; k0 < g.K; k0 += 32) {
            bf16x8 b[2][2];
#pragma unroll
            for (int bj = 0; bj < 2; ++bj)
#pragma unroll
                for (int n = 0; n < 2; ++n) b[bj][n] = *(const bf16x8*)(Bp + (size_t)(bj * 128 + n * 16) * g.K + k0);
#pragma unroll
            for (int ai = 0; ai < 2; ++ai) {
                bf16x8 a[4];
#pragma unroll
                for (int m = 0; m < 4; ++m) a[m] = *(const bf16x8*)(Ap + (size_t)(ai * 128 + m * 16) * g.lda + k0);
#pragma unroll
                for (int bj = 0; bj < 2; ++bj)
#pragma unroll
                    for (int m = 0; m < 4; ++m)
#pragma unroll
                        for (int n = 0; n < 2; ++n) acc[ai][bj][m][n] = __builtin_amdgcn_mfma_f32_16x16x32_bf16(b[bj][n], a[m], acc[ai][bj][m][n], 0, 0, 0);
                __builtin_amdgcn_sched_barrier(0);
            }
        }
        E(acc, u, wr, wc, fr, fq);
    }
}

#define PG8_LAS __attribute__((address_space(3)))
constexpr int BM = 256, BK = 64, HALF = 128, HTB = HALF * BK * 2  , STAGE_BYTES = 8 * HTB;
__host__ __device__ __forceinline__ int lds_byte(int r, int c) { const int st = (r >> 4) * 2 + (c >> 5), rr = r & 15, cc = c & 31, ob = rr * 64 + cc * 2; return st * 1024 + (ob ^ (((ob >> 9) & 1) << 5)); }
__host__ __device__ __forceinline__ void stage_rc(int b, int& R, int& C) { const int st = b / 1024, sb = b % 1024, swz = sb ^ (((sb >> 9) & 1) << 5); R = (st >> 1) * 16 + swz / 64; C = (st & 1) * 32 + (swz % 64) / 2; }
__host__ __device__ __forceinline__ int perm32(int rho) { const int n = rho >> 4, i = rho & 15; return 8 * (i >> 2) + 4 * n + (i & 3); }
template <class Epi, class Sched, bool STAMP = false>
__device__ __forceinline__ void gemm_phase(PG8_LAS unsigned char* lds, const Gemm g, const Sched& S, const Epi& E, unsigned long long* stamps = nullptr) {
    const int tid = otid(g.swid), wid = g.swid, lane = tid & 63, wr = wid >> 2, wc = wid & 3, fr = lane & 15, fq = lane >> 4;
    const int K = g.K, nt = K / BK;
    int ts_lo = 0, ts_hi = 0, nts = 0; const unsigned long long rt_entry = STAMP ? (unsigned long long)wall_clock64() : 0ull;
#define PG8_STAMP() do { if (STAMP && wid == 0 && nts < 64) { const unsigned long long _c = (unsigned long long)clock64(); \
        ts_lo = (lane == nts) ? (int)(unsigned)_c : ts_lo; ts_hi = (lane == nts) ? (int)(unsigned)(_c >> 32) : ts_hi; ++nts; } } while (0)
    PG8_STAMP();
    unsigned voffA[2], voffB[2];
#pragma unroll
    for (int i = 0; i < 2; ++i) { int R, C; stage_rc(tid * 16 + i * 8192, R, C); const int Rb = Epi::PERM ? ((R & ~31) + perm32(R & 31)) : R;
        voffA[i] = (unsigned)(R * K + C) * 2u; voffB[i] = (unsigned)(Rb * K + C) * 2u; }
    const size_t kstep = (size_t)(BK * 2);
    const size_t hstep = (size_t)HALF * K * 2;
    const size_t tstep = 2 * hstep;
    const unsigned ldsw = (unsigned)wid * 1024u;
    const int aoff = lds_byte(wr * 64 + fr, fq * 8), boff = lds_byte(wc * 32 + fr, fq * 8);
#define PG8_SA(b, h) (((b) * 2 + (h)) * HTB)
#define PG8_SB(b, h) ((4 + (b) * 2 + (h)) * HTB)
#define PG8_STAGE(bufoff, gbase, voff) do { _Pragma("unroll") for (int _i = 0; _i < 2; ++_i) \
        __builtin_amdgcn_global_load_lds((const unsigned*)((const char*)(gbase) + (voff)[_i]), (PG8_LAS unsigned*)(lds + (bufoff) + ldsw + _i * 8192), 16, 0, 0); } while (0)
#define PG8_LDA(dst, b, h) do { _Pragma("unroll") for (int m = 0; m < 4; ++m) _Pragma("unroll") for (int k = 0; k < 2; ++k) dst[m][k] = *(const PG8_LAS bf16x8*)(lds + PG8_SA(b, h) + aoff + m * 2048 + k * 1024); } while (0)
#define PG8_LDB(dst, b, h) do { _Pragma("unroll") for (int n = 0; n < 2; ++n) _Pragma("unroll") for (int k = 0; k < 2; ++k) dst[n][k] = *(const PG8_LAS bf16x8*)(lds + PG8_SB(b, h) + boff + n * 2048 + k * 1024); } while (0)
#define PG8_MMA(ai, bj, At, Bt) do { __builtin_amdgcn_s_setprio(1); _Pragma("unroll") for (int m = 0; m < 4; ++m) _Pragma("unroll") for (int n = 0; n < 2; ++n) _Pragma("unroll") for (int k = 0; k < 2; ++k) \
        acc[ai][bj][m][n] = __builtin_amdgcn_mfma_f32_16x16x32_bf16(Bt[n][k], At[m][k], acc[ai][bj][m][n], 0, 0, 0); __builtin_amdgcn_s_setprio(0); } while (0)
#define PG8_WAIT_V(n) asm volatile("s_waitcnt vmcnt(" #n ")" ::: "memory")
#define PG8_WAIT_L(n) asm volatile("s_waitcnt lgkmcnt(" #n ")" ::: "memory")
#define PG8_BAR __builtin_amdgcn_s_barrier()
#define PG8_SCHED __builtin_amdgcn_sched_barrier(0)
    Unit cur, nxt; int ui = 0;
    if (!S.next(0, cur)) return;
    f32x4 acc[2][2][4][2];
#pragma unroll
    for (int a = 0; a < 2; ++a)
#pragma unroll
        for (int b = 0; b < 2; ++b)
#pragma unroll
            for (int m = 0; m < 4; ++m)
#pragma unroll
                for (int n = 0; n < 2; ++n) acc[a][b][m][n] = (f32x4){0.f, 0.f, 0.f, 0.f};
    bf16x8 At[4][2], B0[2][2], B1[2][2];
    const char* cA = (const char*)g.A + (size_t)cur.pm * tstep; const char* cB = (const char*)g.Bt + (size_t)cur.pn * tstep;
    S.a_ready(cur);
    PG8_STAGE(PG8_SB(0, 0), cB, voffB); PG8_STAGE(PG8_SA(0, 0), cA, voffA); PG8_STAGE(PG8_SB(0, 1), cB + hstep, voffB); PG8_STAGE(PG8_SA(0, 1), cA + hstep, voffA);
    if (wr == 1) PG8_BAR;
    PG8_WAIT_V(4); PG8_BAR;
    PG8_STAGE(PG8_SB(1, 0), cB + kstep, voffB); PG8_STAGE(PG8_SA(1, 0), cA + kstep, voffA); PG8_STAGE(PG8_SB(1, 1), cB + hstep + kstep, voffB);
    PG8_WAIT_V(6); PG8_BAR;
    PG8_STAMP();
    for (;;) {
        const bool has_next = S.next(ui + 1, nxt);
        const char* nA = has_next ? (const char*)g.A + (size_t)nxt.pm * tstep : cA; const char* nB = has_next ? (const char*)g.Bt + (size_t)nxt.pn * tstep : cB;
        for (int t = 0; t < nt; t += 2) {
            const bool last = (t == nt - 2);
            const char* a1 = cA + (size_t)(t + 1) * kstep;
            const char* a2 = last ? nA : cA + (size_t)(t + 2) * kstep; const char* b2 = last ? nB : cB + (size_t)(t + 2) * kstep;
            const char* a3 = a2 + kstep; const char* b3 = b2 + kstep;
            if (last && has_next) S.a_ready(nxt);
            PG8_LDB(B0, 0, 0); PG8_SCHED; PG8_LDA(At, 0, 0); PG8_STAGE(PG8_SA(1, 1), a1 + hstep, voffA);
            PG8_WAIT_L(8); PG8_BAR; PG8_WAIT_L(0); PG8_MMA(0, 0, At, B0); PG8_BAR; PG8_SCHED;
            PG8_LDB(B1, 0, 1); PG8_STAGE(PG8_SB(0, 0), b2, voffB);
            PG8_BAR; PG8_WAIT_L(0); PG8_MMA(0, 1, At, B1); PG8_BAR;
            PG8_LDA(At, 0, 1); PG8_STAGE(PG8_SA(0, 0), a2, voffA);
            PG8_BAR; PG8_WAIT_L(0); PG8_MMA(1, 0, At, B0); PG8_BAR; PG8_SCHED;
            PG8_STAGE(PG8_SB(0, 1), b2 + hstep, voffB);
            PG8_WAIT_V(6); PG8_BAR; PG8_MMA(1, 1, At, B1); PG8_BAR;
            PG8_LDB(B0, 1, 0); PG8_SCHED; PG8_LDA(At, 1, 0); PG8_STAGE(PG8_SA(0, 1), a2 + hstep, voffA);
            PG8_WAIT_L(8); PG8_BAR; PG8_WAIT_L(0); PG8_MMA(0, 0, At, B0); PG8_BAR; PG8_SCHED;
            PG8_LDB(B1, 1, 1); PG8_STAGE(PG8_SB(1, 0), b3, voffB);
            PG8_BAR; PG8_WAIT_L(0); PG8_MMA(0, 1, At, B1); PG8_BAR;
            PG8_LDA(At, 1, 1); PG8_STAGE(PG8_SA(1, 0), a3, voffA);
            PG8_BAR; PG8_WAIT_L(0); PG8_MMA(1, 0, At, B0); PG8_BAR; PG8_SCHED;
            PG8_STAGE(PG8_SB(1, 1), b3 + hstep, voffB);
            PG8_WAIT_V(6); PG8_BAR; PG8_MMA(1, 1, At, B1); PG8_BAR;
        }
        PG8_STAMP();
        if constexpr (!Epi::AFTER_DRAIN) { E(acc, cur, wr, wc, fr, fq); S.done(cur); }
        PG8_STAMP();
        if (!has_next) break;
#pragma unroll
        for (int a = 0; a < 2; ++a)
#pragma unroll
            for (int b = 0; b < 2; ++b)
#pragma unroll
                for (int m = 0; m < 4; ++m)
#pragma unroll
                    for (int n = 0; n < 2; ++n) acc[a][b][m][n] = (f32x4){0.f, 0.f, 0.f, 0.f};
        cur = nxt; cA = nA; cB = nB; ++ui;
    }
    PG8_WAIT_V(0);
    if (wr == 0) PG8_BAR;
    PG8_BAR;
    if constexpr (Epi::AFTER_DRAIN) { E.fused(acc, cur, wr, wc, fr, fq, lds, wid, lane); S.done(cur); }
    PG8_STAMP();
    if (STAMP && wid == 0) { stamps[lane] = lane < nts ? (((unsigned long long)(unsigned)ts_hi << 32) | (unsigned)ts_lo) : 0ull;
        if (lane == 62) stamps[62] = rt_entry; if (lane == 63) stamps[63] = (unsigned long long)wall_clock64(); }
#undef PG8_STAMP
#undef PG8_SA
#undef PG8_SB
#undef PG8_STAGE
#undef PG8_LDA
#undef PG8_LDB
#undef PG8_MMA
#undef PG8_WAIT_V
#undef PG8_WAIT_L
#undef PG8_BAR
#undef PG8_SCHED
}

#ifdef USE_SIMPLE_GEMM
#define GEMM_RUN(EpiT, SchedT, g, S, E) gemm_simple<EpiT, SchedT>(g, S, E)
#else
#define GEMM_RUN(EpiT, SchedT, g, S, E) gemm_phase<EpiT, SchedT>(L, g, S, E)
#endif


struct EpiZ {
    static constexpr bool PERM = false, AFTER_DRAIN = false;
    bf16_t* Z; float* MISC; int misc_pn;
    __device__ __forceinline__ void operator()(const f32x4 (&acc)[2][2][4][2], const Unit& u, int wr, int wc, int fr, int fq) const {
        const int row0 = u.pm * 256 + wr * 64 + fr, col0 = u.pn * 256 + wc * 32 + 4 * fq;
#pragma unroll
        for (int ai = 0; ai < 2; ++ai)
#pragma unroll
            for (int m = 0; m < 4; ++m) { const int row = row0 + ai * 128 + m * 16;
#pragma unroll
                for (int bj = 0; bj < 2; ++bj)
#pragma unroll
                    for (int n = 0; n < 2; ++n) { const int col = col0 + bj * 128 + n * 16; const f32x4 v = acc[ai][bj][m][n];
                        if (u.pn == misc_pn) { const int cc = col - misc_pn * 256; if (cc < 64) *(f32x4*)(MISC + (size_t)row * 64 + cc) = v; }
                        else *(uint2*)(Z + (size_t)row * ZLD + col) = make_uint2(pack2(v[0], v[1]), pack2(v[2], v[3])); } }
    }
};
struct EpiBO {
    static constexpr bool PERM = false, AFTER_DRAIN = false;
    bf16_t* BO;
    __device__ __forceinline__ void operator()(const f32x4 (&acc)[2][2][4][2], const Unit& u, int wr, int wc, int fr, int fq) const {
        const int kb = u.pn >> 2, pm = u.pm - kb * MT, pn = u.pn & 3;
        const int row0 = pm * 256 + wr * 64 + fr, col0 = pn * 256 + wc * 32 + 4 * fq;
        bf16_t* base = BO + (size_t)kb * TT * DM;
#pragma unroll
        for (int ai = 0; ai < 2; ++ai)
#pragma unroll
            for (int m = 0; m < 4; ++m) { const int row = row0 + ai * 128 + m * 16;
#pragma unroll
                for (int bj = 0; bj < 2; ++bj)
#pragma unroll
                    for (int n = 0; n < 2; ++n) { const int col = col0 + bj * 128 + n * 16; const f32x4 v = acc[ai][bj][m][n];
                        *(uint2*)(base + (size_t)row * DM + col) = make_uint2(pack2(v[0], v[1]), pack2(v[2], v[3])); } }
    }
};
struct EpiMerge {
    static constexpr bool PERM = false, AFTER_DRAIN = false;
    const bf16_t* BO; const float* bm; bf16_t* MG;
    __device__ __forceinline__ void operator()(const f32x4 (&acc)[2][2][4][2], const Unit& u, int wr, int wc, int fr, int fq) const {
        const int row0 = u.pm * 256 + wr * 64 + fr, c0 = u.pn * 64 + wc * 16 + 4 * fq;
#pragma unroll
        for (int ai = 0; ai < 2; ++ai)
#pragma unroll
            for (int m = 0; m < 4; ++m) { const int row = row0 + ai * 128 + m * 16; f32x4 s = (f32x4){0.f, 0.f, 0.f, 0.f};
#pragma unroll
                for (int bj = 0; bj < 2; ++bj)
#pragma unroll
                    for (int n = 0; n < 2; ++n) { const int kb = 2 * bj + n; const f32x4 a = acc[ai][bj][m][n]; const f32x4 bb = *(const f32x4*)(bm + kb * DM + c0);
                        const uint2 bo = *(const uint2*)(BO + ((size_t)kb * TT + row) * DM + c0);
                        s[0] += sigm(a[0] + bb[0]) * bf2f((bf16_t)(bo.x & 0xffff)); s[1] += sigm(a[1] + bb[1]) * bf2f((bf16_t)(bo.x >> 16));
                        s[2] += sigm(a[2] + bb[2]) * bf2f((bf16_t)(bo.y & 0xffff)); s[3] += sigm(a[3] + bb[3]) * bf2f((bf16_t)(bo.y >> 16)); }
                *(uint2*)(MG + (size_t)row * DM + c0) = make_uint2(pack2(s[0], s[1]), pack2(s[2], s[3])); }
    }
};
struct EpiOut {
    static constexpr bool PERM = false, AFTER_DRAIN = false;
    const float* sL; const float* sC; float* dL; float* dC; const float* mod;
    __device__ __forceinline__ void operator()(const f32x4 (&acc)[2][2][4][2], const Unit& u, int wr, int wc, int fr, int fq) const {
        const int row0 = u.pm * 256 + wr * 64 + fr, col0 = u.pn * 256 + wc * 32 + 4 * fq;
        const int mv = mod_idx(u.pm * 256);
        const float* g1 = mod + mv * 6144 + 2 * DM;
#pragma unroll
        for (int ai = 0; ai < 2; ++ai)
#pragma unroll
            for (int m = 0; m < 4; ++m) { const int row = row0 + ai * 128 + m * 16; const float* src = hrow_c(sL, sC, row); float* dst = hrow_m(dL, dC, row);
#pragma unroll
                for (int bj = 0; bj < 2; ++bj)
#pragma unroll
                    for (int n = 0; n < 2; ++n) { const int col = col0 + bj * 128 + n * 16; const f32x4 v = acc[ai][bj][m][n];
                        const f32x4 h = *(const f32x4*)(src + col), gg = *(const f32x4*)(g1 + col);
                        *(f32x4*)(dst + col) = h + gg * v; } }
    }
};
struct EpiH {
    static constexpr bool PERM = false, AFTER_DRAIN = false;
    bf16_t* HS;
    __device__ __forceinline__ void operator()(const f32x4 (&acc)[2][2][4][2], const Unit& u, int wr, int wc, int fr, int fq) const {
        const int pn = u.pn & 3, row0 = u.pm * 256 + wr * 64 + fr, hc0 = pn * 128 + wc * 16 + 4 * fq;
#pragma unroll
        for (int ai = 0; ai < 2; ++ai)
#pragma unroll
            for (int m = 0; m < 4; ++m) { const int row = row0 + ai * 128 + m * 16;
#pragma unroll
                for (int bj = 0; bj < 2; ++bj) { const f32x4 a = acc[ai][bj][m][0], c = acc[ai][bj][m][1];
                    *(uint2*)(HS + (size_t)row * 512 + hc0 + bj * 64) = make_uint2(pack2(siluf(a[0]) * c[0], siluf(a[1]) * c[1]), pack2(siluf(a[2]) * c[2], siluf(a[3]) * c[3])); } }
    }
};
struct EpiY {
    static constexpr bool PERM = false, AFTER_DRAIN = false;
    bf16_t* YM;
    __device__ __forceinline__ void operator()(const f32x4 (&acc)[2][2][4][2], const Unit& u, int wr, int wc, int fr, int fq) const {
        const int pn = u.pn & 3, row0 = u.pm * 256 + wr * 64 + fr, col0 = pn * 256 + wc * 32 + 4 * fq;
#pragma unroll
        for (int ai = 0; ai < 2; ++ai)
#pragma unroll
            for (int m = 0; m < 4; ++m) { const int row = row0 + ai * 128 + m * 16;
#pragma unroll
                for (int bj = 0; bj < 2; ++bj)
#pragma unroll
                    for (int n = 0; n < 2; ++n) { const int col = col0 + bj * 128 + n * 16; const f32x4 v = acc[ai][bj][m][n];
                        *(uint2*)(YM + (size_t)row * DM + col) = make_uint2(pack2(v[0], v[1]), pack2(v[2], v[3])); } }
    }
};

__device__ __forceinline__ void phase_mods(const PP& p, LAS float* lds) {
    const int tid = otid(p.swid);
    float* MOD = (float*)(p.ws + WS_MOD);
    LAS float* sc = lds;
    LAS float* red = lds + 3072;
    for (int i = tid; i < 3072; i += 512) { const int v = i >> 10, k = i & 1023; const float x = v < 2 ? p.in[I_C][v * DM + k] : p.in[I_CCTX][k]; sc[i] = siluf(x); }
    __syncthreads();
    for (int u = blockIdx.x; u < 96; u += gridDim.x) {
        const int l = u / 48, cg = u % 48, col = cg * 128 + (tid & 127), kp = tid >> 7;
        const float* W = p.in[I_ADAW] + (size_t)l * DM * 6144 + col;
        float s0 = 0.f, s1 = 0.f, s2 = 0.f;
        for (int k = kp * 256; k < kp * 256 + 256; ++k) { const float w = W[(size_t)k * 6144]; s0 += sc[k] * w; s1 += sc[1024 + k] * w; s2 += sc[2048 + k] * w; }
        red[(kp * 3 + 0) * 128 + (tid & 127)] = s0; red[(kp * 3 + 1) * 128 + (tid & 127)] = s1; red[(kp * 3 + 2) * 128 + (tid & 127)] = s2;
        __syncthreads();
        if (tid < 384) { const int v = tid >> 7, cc = tid & 127; const float s = red[(0 * 3 + v) * 128 + cc] + red[(1 * 3 + v) * 128 + cc] + red[(2 * 3 + v) * 128 + cc] + red[(3 * 3 + v) * 128 + cc];
            MOD[((size_t)l * 3 + v) * 6144 + cg * 128 + cc] = s + p.in[I_ADAB][l * 6144 + cg * 128 + cc]; }
        __syncthreads();
    }
}

__device__ __forceinline__ const float* conv_src(const PP& p, int l, int mat, int sub, int n, int& ld) {
    switch (mat) {
    case 0: { ld = 7216; int c; if (n < 2592) c = n; else if (n < 2608) c = 7200 + (n - 2592); else if (n < 2816) return nullptr; else if (n < 5376) c = 2592 + (n - 2816); else c = 5152 + (n - 5376);
              return p.in[I_WIN] + (size_t)l * DM * 7216 + c; }
    case 1: { ld = 4096; const int pn = n >> 8, ct = n & 255, bj = ct >> 7, wc = (ct >> 5) & 3, nn = (ct >> 4) & 1, i = ct & 15; const int kb = 2 * bj + nn, c = 64 * pn + 16 * wc + i;
              return p.in[I_WMERGE] + (size_t)l * DM * 4096 + kb * DM + c; }
    case 2: { ld = 1024; return p.in[I_WBR] + ((size_t)l * 4 + sub) * 512 * DM + n; }
    case 3: { ld = 1024; return p.in[I_WOUT] + (size_t)l * DM * DM + n; }
    case 4: { ld = 512; const int g = n >> 5, nn = (n >> 4) & 1, i = n & 15, hc = 16 * g + i; return (nn ? p.in[I_MW3] : p.in[I_MW1]) + ((size_t)l * 16 + sub) * DM * 512 + hc; }
    case 5: { ld = 1024; return p.in[I_MW2] + ((size_t)l * 16 + sub) * 512 * DM + n; }
    default: { ld = 64; return p.in[I_RGGW] + ((size_t)l * 32 + sub) * 4096 + n; }
    }
}
__device__ __forceinline__ void conv_unit(int u, int& mat, int& sub, int& nt, int& kt, int& K, size_t& dstoff) {
    if (u < 1856) { mat = 0; sub = 0; nt = u >> 4; kt = u & 15; K = 1024; dstoff = WB_WIN; }
    else if (u < 2880) { const int v = u - 1856; mat = 1; sub = 0; nt = v >> 4; kt = v & 15; K = 1024; dstoff = WB_WM; }
    else if (u < 3392) { const int v = u - 2880; mat = 2; sub = v >> 7; nt = (v & 127) >> 3; kt = v & 7; K = 512; dstoff = WB_WB + (size_t)sub * 1024 * 512 * 2; }
    else if (u < 3648) { const int v = u - 3392; mat = 3; sub = 0; nt = v >> 4; kt = v & 15; K = 1024; dstoff = WB_WO; }
    else if (u < 7744) { const int v = u - 3648; mat = 4; sub = v >> 8; nt = (v & 255) >> 4; kt = v & 15; K = 1024; dstoff = WB_W13 + (size_t)sub * 1024 * 1024 * 2; }
    else if (u < 9792) { const int v = u - 7744; mat = 5; sub = v >> 7; nt = (v & 127) >> 3; kt = v & 7; K = 512; dstoff = WB_W2 + (size_t)sub * 1024 * 512 * 2; }
    else { mat = 6; sub = u - 9792; nt = 0; kt = 0; K = 64; dstoff = WB_GW + (size_t)sub * 4096 * 2; }
}
__device__ __forceinline__ void phase_convert(const PP& p, int l, LAS float* tile  ) {
    const int tid = otid(p.swid);
    unsigned char* wb = p.ws + WS_WB;
    for (int u0 = blockIdx.x * 4; u0 < 9824; u0 += gridDim.x * 4) {
        float val[4][8];
#pragma unroll
        for (int q = 0; q < 4; ++q) { int mat, sub, nt, kt, K; size_t dstoff; conv_unit(u0 + q, mat, sub, nt, kt, K, dstoff);
            int ld; const float* sp = conv_src(p, l, mat, sub, nt * 64 + (tid & 63), ld);
#pragma unroll
            for (int i = 0; i < 8; ++i) { const int kk = (tid >> 6) + 8 * i; val[q][i] = sp ? sp[(size_t)(kt * 64 + kk) * ld] : 0.f; } }
#pragma unroll
        for (int q = 0; q < 4; ++q)
#pragma unroll
            for (int i = 0; i < 8; ++i) tile[q * 4160 + ((tid >> 6) + 8 * i) * 65 + (tid & 63)] = val[q][i];
        __syncthreads();
#pragma unroll
        for (int q = 0; q < 4; ++q) { int mat, sub, nt, kt, K; size_t dstoff; conv_unit(u0 + q, mat, sub, nt, kt, K, dstoff);
            const int nn = tid >> 3, ks = (tid & 7) * 8; unsigned w[4];
#pragma unroll
            for (int j = 0; j < 4; ++j) w[j] = pack2(tile[q * 4160 + (ks + 2 * j) * 65 + nn], tile[q * 4160 + (ks + 2 * j + 1) * 65 + nn]);
            *(uint4*)((bf16_t*)(wb + dstoff) + (size_t)(nt * 64 + nn) * K + kt * 64 + ks) = make_uint4(w[0], w[1], w[2], w[3]); }
        __syncthreads();
    }
}

__device__ __forceinline__ void norm_row(const PP& p, int l, int which, const float* src, int mv, int lane, float (&u)[4][4]) {
    const float* MOD = (const float*)(p.ws + WS_MOD) + ((size_t)l * 3 + mv) * 6144;
    const float* gain = (which ? p.in[I_NFFNG] : p.in[I_NMIXG]) + l * DM;
    const float* sh = MOD + (which ? 3 : 0) * DM; const float* sc = MOD + (which ? 4 : 1) * DM;
    float ss = 0.f;
#pragma unroll
    for (int i = 0; i < 4; ++i) { const f32x4 v = *(const f32x4*)(src + 256 * i + 4 * lane); u[i][0] = v[0]; u[i][1] = v[1]; u[i][2] = v[2]; u[i][3] = v[3]; ss += v[0] * v[0] + v[1] * v[1] + v[2] * v[2] + v[3] * v[3]; }
    ss = wave_sum(ss);
    const float rs = rsqrtf(ss * (1.f / DM) + EPS);
#pragma unroll
    for (int i = 0; i < 4; ++i) { const int col = 256 * i + 4 * lane; const f32x4 g = *(const f32x4*)(gain + col), a = *(const f32x4*)(sc + col), b = *(const f32x4*)(sh + col);
#pragma unroll
        for (int j = 0; j < 4; ++j) u[i][j] = u[i][j] * rs * g[j] * (1.f + a[j]) + b[j]; }
}
__device__ __forceinline__ void phase_norm1(const PP& p, int l) {
    const int tid_ = otid(p.swid), lane = tid_ & 63, gw = blockIdx.x * 8 + (tid_ >> 6), nw = gridDim.x * 8;
    const float* sL = l == 0 ? p.in[I_X] : p.out; const float* sC = l == 0 ? p.in[I_CTX] : (const float*)(p.ws + WS_HCTX);
    bf16_t* U = (bf16_t*)(p.ws + WS_U);
    for (int r = gw; r < TT; r += nw) {
        float u[4][4]; norm_row(p, l, 0, hrow_c(sL, sC, r), mod_idx(r), lane, u);
#pragma unroll
        for (int i = 0; i < 4; ++i) *(uint2*)(U + (size_t)r * DM + 256 * i + 4 * lane) = make_uint2(pack2(u[i][0], u[i][1]), pack2(u[i][2], u[i][3]));
    }
}

__device__ __forceinline__ void phase_route(const PP& p, int l, LAS unsigned char* L) {
    const int tid_ = otid(p.swid), lane = tid_ & 63, wid = p.swid;
    LAS int* lcnt = (LAS int*)L;
    LAS int* rex = lcnt + 32;
    LAS int* rpos = rex + 132;
    if (tid_ < 32) lcnt[tid_] = 0;
    __syncthreads();
    const float* sL = p.out; const float* sC = (const float*)(p.ws + WS_HCTX);
    int* tok_e = (int*)(p.ws + WS_ROUTE); float* tok_w = (float*)(p.ws + WS_ROUTE + 262144); int* tok_pos = (int*)(p.ws + WS_ROUTE + 524288);
    unsigned* cnt = (unsigned*)(p.ws + WS_CTL) + CW_CNT + l * 16 * 32;
    const float* wg = p.in[I_MWG] + (size_t)l * DM * 4; const float* we = p.in[I_MWE] + (size_t)l * DM * 16;
    const int rbase = blockIdx.x * 66;
    const float* gain = p.in[I_NFFNG] + l * DM;
    for (int rp = wid; rp < 33; rp += 8) {
        const int rr0 = 2 * rp, r0 = rbase + rr0, r1 = r0 + 1;
        if (l == 1 && (r0 % NTOK) < CTXL) { if (lane == 0) { rex[2 * rr0] = -1; rex[2 * rr0 + 1] = -1; rex[2 * rr0 + 2] = -1; rex[2 * rr0 + 3] = -1; } continue; }
        const float* s0 = hrow_c(sL, sC, r0); const float* s1 = hrow_c(sL, sC, r1); const int mv = mod_idx(r0);
        const float* MOD = (const float*)(p.ws + WS_MOD) + ((size_t)l * 3 + mv) * 6144; const float* sh = MOD + 3 * DM; const float* sc = MOD + 4 * DM;
        f32x4 xa[4], xb[4]; float ssa = 0.f, ssb = 0.f;
#pragma unroll
        for (int i = 0; i < 4; ++i) { xa[i] = *(const f32x4*)(s0 + 256 * i + 4 * lane); xb[i] = *(const f32x4*)(s1 + 256 * i + 4 * lane); }
#pragma unroll
        for (int i = 0; i < 4; ++i) { ssa += xa[i][0] * xa[i][0] + xa[i][1] * xa[i][1] + xa[i][2] * xa[i][2] + xa[i][3] * xa[i][3]; ssb += xb[i][0] * xb[i][0] + xb[i][1] * xb[i][1] + xb[i][2] * xb[i][2] + xb[i][3] * xb[i][3]; }
        ssa = wave_sum(ssa); ssb = wave_sum(ssb);
        const float rsa = rsqrtf(ssa * (1.f / DM) + EPS), rsb = rsqrtf(ssb * (1.f / DM) + EPS);
        float acca[20], accb[20];
#pragma unroll
        for (int q = 0; q < 20; ++q) { acca[q] = 0.f; accb[q] = 0.f; }
#pragma unroll 1
        for (int i = 0; i < 4; ++i) { const int col0 = 256 * i + 4 * lane;
            const f32x4 g = *(const f32x4*)(gain + col0), a = *(const f32x4*)(sc + col0), bsh = *(const f32x4*)(sh + col0), va = *(const f32x4*)(s0 + col0), vb = *(const f32x4*)(s1 + col0);
            const float* wgp = wg + (size_t)col0 * 4; const float* wep = we + (size_t)col0 * 16;
#pragma unroll
            for (int j = 0; j < 4; ++j) { const float m1 = g[j] * (1.f + a[j]); const float ya = va[j] * rsa * m1 + bsh[j], yb = vb[j] * rsb * m1 + bsh[j];
                const f32x4 gq = *(const f32x4*)(wgp + j * 4);
#pragma unroll
                for (int q = 0; q < 4; ++q) { acca[q] += ya * gq[q]; accb[q] += yb * gq[q]; }
#pragma unroll
                for (int q = 0; q < 4; ++q) { const f32x4 e = *(const f32x4*)(wep + j * 16 + 4 * q);
#pragma unroll
                    for (int z2 = 0; z2 < 4; ++z2) { acca[4 + 4 * q + z2] += ya * e[z2]; accb[4 + 4 * q + z2] += yb * e[z2]; } } }
            asm volatile("" ::: "memory"); }
#pragma unroll
        for (int q = 0; q < 20; ++q) { acca[q] = wave_sum(acca[q]); accb[q] = wave_sum(accb[q]); }
        if (lane < 2) {
            const int rr = rr0 + lane, r = r0 + lane; float acc[20];
#pragma unroll
            for (int q = 0; q < 20; ++q) acc[q] = lane ? accb[q] : acca[q];
            float gl[4];
#pragma unroll
            for (int q = 0; q < 4; ++q) gl[q] = acc[q] + p.in[I_MBG][l * 4 + q];
            int grp = 0; float gm = gl[0];
#pragma unroll
            for (int q = 1; q < 4; ++q) if (gl[q] > gm) { gm = gl[q]; grp = q; }
            float se = 0.f;
#pragma unroll
            for (int q = 0; q < 4; ++q) se += __expf(gl[q] - gm);
            const float pg = 1.f / se;
            float el[4];
#pragma unroll
            for (int q = 0; q < 4; ++q) { float v = 0.f;
#pragma unroll
                for (int gg = 0; gg < 4; ++gg) v = (gg == grp) ? acc[4 + gg * 4 + q] : v;
                el[q] = v + p.in[I_MBE][l * 16 + grp * 4 + q]; }
            int i0 = 0; float m0 = el[0];
#pragma unroll
            for (int q = 1; q < 4; ++q) if (el[q] > m0) { m0 = el[q]; i0 = q; }
            int i1 = -1; float m1 = -3.4e38f;
#pragma unroll
            for (int q = 0; q < 4; ++q) if (q != i0 && el[q] > m1) { m1 = el[q]; i1 = q; }
            const float e1 = __expf(m1 - m0), w0 = pg / (1.f + e1), w1 = pg * e1 / (1.f + e1);
            const int ex0 = grp * 4 + i0, ex1 = grp * 4 + i1;
            rex[2 * rr] = ex0; rex[2 * rr + 1] = ex1; rpos[2 * rr] = __hip_atomic_fetch_add(&lcnt[ex0], 1, __ATOMIC_RELAXED, __HIP_MEMORY_SCOPE_WORKGROUP); rpos[2 * rr + 1] = __hip_atomic_fetch_add(&lcnt[ex1], 1, __ATOMIC_RELAXED, __HIP_MEMORY_SCOPE_WORKGROUP);
            tok_e[2 * r] = ex0; tok_e[2 * r + 1] = ex1; tok_w[2 * r] = w0; tok_w[2 * r + 1] = w1;
        }
    }
    __syncthreads();
    if (tid_ < 16) { const int c = lcnt[tid_]; lcnt[16 + tid_] = c ? (int)atomicAdd(&cnt[32 * tid_], (unsigned)c) : 0; }
    __syncthreads();
    for (int i = tid_; i < 132; i += 512) { const int r = rbase + (i >> 1); const int e = rex[i]; if (r < TT && e >= 0) tok_pos[2 * r + (i & 1)] = lcnt[16 + e] + rpos[i]; }
    __syncthreads();
}
__device__ __forceinline__ int moe_tables(const PP& p, int l, LAS int* tbl  ) {
    const unsigned* cnt = (const unsigned*)(p.ws + WS_CTL) + CW_CNT + l * 16 * 32;
    __syncthreads();
    if (otid(p.swid) == 0) { int s = 0;
        for (int e = 0; e < 16; ++e) { const int c = (int)__hip_atomic_load(cnt + 32 * e, __ATOMIC_RELAXED, __HIP_MEMORY_SCOPE_AGENT); const int nb = (c + 255) >> 8; tbl[e] = s * 256; for (int b = 0; b < nb; ++b) tbl[32 + s + b] = e; s += nb; }
        tbl[16] = s; }
    __syncthreads();
    return tbl[16];
}
__device__ __forceinline__ void phase_dispatch(const PP& p, int l, LAS int* tbl) {
    const int tid_ = otid(p.swid), lane = tid_ & 63, gw = blockIdx.x * 8 + (tid_ >> 6), nw = gridDim.x * 8;
    moe_tables(p, l, tbl);
    const float* sL = p.out; const float* sC = (const float*)(p.ws + WS_HCTX);
    const int* tok_e = (const int*)(p.ws + WS_ROUTE); const int* tok_pos = (const int*)(p.ws + WS_ROUTE + 524288); int* tok_slot = (int*)(p.ws + WS_ROUTE + 786432);
    bf16_t* XS = (bf16_t*)(p.ws + WS_BIG + BIG_XS);
    for (int r = gw; r < TT; r += nw) {
        if (l == 1 && (r % NTOK) < CTXL) continue;
        float u[4][4]; norm_row(p, l, 1, hrow_c(sL, sC, r), mod_idx(r), lane, u);
        const int s0 = tbl[tok_e[2 * r]] + tok_pos[2 * r], s1 = tbl[tok_e[2 * r + 1]] + tok_pos[2 * r + 1];
        if (lane == 0) { tok_slot[2 * r] = s0; tok_slot[2 * r + 1] = s1; }
#pragma unroll
        for (int i = 0; i < 4; ++i) { const uint2 v = make_uint2(pack2(u[i][0], u[i][1]), pack2(u[i][2], u[i][3]));
            *(uint2*)(XS + (size_t)s0 * DM + 256 * i + 4 * lane) = v; *(uint2*)(XS + (size_t)s1 * DM + 256 * i + 4 * lane) = v; }
    }
}
__device__ __forceinline__ void phase_combine(const PP& p, int l) {
    const int tid_ = otid(p.swid), lane = tid_ & 63, gw = blockIdx.x * 8 + (tid_ >> 6), nw = gridDim.x * 8;
    float* HL = p.out; float* HC = (float*)(p.ws + WS_HCTX);
    const float* tok_w = (const float*)(p.ws + WS_ROUTE + 262144); const int* tok_slot = (const int*)(p.ws + WS_ROUTE + 786432);
    const bf16_t* YM = (const bf16_t*)(p.ws + WS_BIG + BIG_YM);
    for (int r = gw; r < TT; r += nw) {
        if (l == 1 && (r % NTOK) < CTXL) continue;
        const float* g2 = (const float*)(p.ws + WS_MOD) + ((size_t)l * 3 + mod_idx(r)) * 6144 + 5 * DM;
        float* hp = hrow_m(HL, HC, r);
        const int s0 = tok_slot[2 * r], s1 = tok_slot[2 * r + 1]; const float w0 = tok_w[2 * r], w1 = tok_w[2 * r + 1];
        float x[4][4]; float ss = 0.f;
#pragma unroll
        for (int i = 0; i < 4; ++i) { const int col = 256 * i + 4 * lane; const f32x4 h = *(const f32x4*)(hp + col), g = *(const f32x4*)(g2 + col);
            const uint2 a = *(const uint2*)(YM + (size_t)s0 * DM + col), b = *(const uint2*)(YM + (size_t)s1 * DM + col);
            x[i][0] = h[0] + g[0] * (w0 * bf2f((bf16_t)(a.x & 0xffff)) + w1 * bf2f((bf16_t)(b.x & 0xffff)));
            x[i][1] = h[1] + g[1] * (w0 * bf2f((bf16_t)(a.x >> 16)) + w1 * bf2f((bf16_t)(b.x >> 16)));
            x[i][2] = h[2] + g[2] * (w0 * bf2f((bf16_t)(a.y & 0xffff)) + w1 * bf2f((bf16_t)(b.y & 0xffff)));
            x[i][3] = h[3] + g[3] * (w0 * bf2f((bf16_t)(a.y >> 16)) + w1 * bf2f((bf16_t)(b.y >> 16)));
            ss += x[i][0] * x[i][0] + x[i][1] * x[i][1] + x[i][2] * x[i][2] + x[i][3] * x[i][3]; }
        if (l == 1) {
            ss = wave_sum(ss); const float rs = rsqrtf(ss * (1.f / DM) + EPS);
#pragma unroll
            for (int i = 0; i < 4; ++i) { const int col = 256 * i + 4 * lane; const f32x4 g = *(const f32x4*)(p.in[I_FNG] + col);
                *(f32x4*)(hp + col) = (f32x4){x[i][0] * rs * g[0], x[i][1] * rs * g[1], x[i][2] * rs * g[2], x[i][3] * rs * g[3]}; }
        } else {
#pragma unroll
            for (int i = 0; i < 4; ++i) *(f32x4*)(hp + 256 * i + 4 * lane) = (f32x4){x[i][0], x[i][1], x[i][2], x[i][3]};
        }
    }
}

__device__ __forceinline__ int chain_chunk(int dir, int ci) { return dir == 0 ? ci : (ci < 4 ? 3 - ci : 135 - ci); }

__device__ __forceinline__ void phase_seq_rg(const PP& p, int l) {
    const int tid_ = otid(p.swid); if (tid_ >= 64 || blockIdx.x >= 32) return;
    const int u = blockIdx.x, lane = tid_, blk = u & 7, dir = (u >> 3) & 1, b = u >> 4, ch = blk * 64 + lane;
    const bf16_t* Z = (const bf16_t*)(p.ws + WS_BIG + BIG_Z);
    float* O = (float*)(p.ws + WS_BIG + BIG_ST) + (size_t)dir * TT * 512;
    float Wr[64], Wi[64];
    const float* gw = p.in[I_RGGW] + ((((size_t)l * 2 + dir) * 2) * 8 + blk) * 4096;
#pragma unroll
    for (int i = 0; i < 64; ++i) { Wr[i] = gw[i * 64 + lane]; Wi[i] = gw[8 * 4096 + i * 64 + lane]; }
    const float br = p.in[I_RGGB][((l * 2 + dir) * 2 + 0) * 512 + ch], bi = p.in[I_RGGB][((l * 2 + dir) * 2 + 1) * 512 + ch];
    const float sp = softplusf(-p.in[I_RGLAM][(l * 2 + dir) * 512 + ch]);
    float cw[4];
#pragma unroll
    for (int j = 0; j < 4; ++j) cw[j] = p.in[I_RGCW][(l * 4 + j) * 512 + ch];
    const float cb = p.in[I_RGCB][l * 512 + ch];
    float h = 0.f;
    for (int s = 0; s < NTOK; ++s) {
        int pp; if (dir == 0) pp = s; else pp = s < CTXL ? CTXL - 1 - s : NTOK - 1 - (s - CTXL);
        const int lo = pp < CTXL ? 0 : CTXL, hi = pp < CTXL ? CTXL : NTOK;
        float xb = cb;
#pragma unroll
        for (int j = 0; j < 4; ++j) { const int q = pp + j - 2; if (q >= lo && q < hi) xb += cw[j] * bf2f(Z[((size_t)b * NTOK + q) * ZLD + RGX + ch]); }
        float pr = br, pi = bi;
#pragma unroll
        for (int i = 0; i < 64; ++i) { const float xi = __uint_as_float(__builtin_amdgcn_readlane(__float_as_uint(xb), i)); pr += xi * Wr[i]; pi += xi * Wi[i]; }
        const float r = sigm(pr), ig = sigm(pi), la = -8.f * r * sp, a = __expf(la), bt = sqrtf(-expm1f(2.f * la)) * (ig * xb);
        h = a * h + bt;
        O[((size_t)b * NTOK + pp) * 512 + ch] = h;
    }
}
__device__ __forceinline__ void phase_epi_rg(const PP& p) {
    const int tid_ = otid(p.swid);
    const bf16_t* Z = (const bf16_t*)(p.ws + WS_BIG + BIG_Z); const float* OF = (const float*)(p.ws + WS_BIG + BIG_ST); const float* OB = OF + (size_t)TT * 512;
    bf16_t* YS = (bf16_t*)(p.ws + WS_BIG + BIG_YS);
    for (size_t i = (size_t)blockIdx.x * 512 + tid_; i < (size_t)TT * 512; i += (size_t)gridDim.x * 512) { const size_t r = i >> 9; const int ch = (int)(i & 511);
        YS[i] = f2bf(gelu_tanh(bf2f(Z[r * ZLD + RGY + ch])) * (OF[i] + OB[i])); }
}
template <int BR> __device__ __forceinline__ void phase_seq_gl(const PP& p, int l, LAS float* sm) {
    constexpr int DK = BR == 1 ? 64 : 128, DP = DK / 4;
    if (blockIdx.x >= 16) return;
    LAS float* LA = sm; LAS float* LK = sm + 64 * DK; LAS float* LQ = sm + 2 * 64 * DK; LAS float* LV = sm + 3 * 64 * DK;
    const int u = blockIdx.x, tid = otid(p.swid), dir = u & 1, h = (u >> 1) & 3, b = u >> 3, v = tid >> 2, part = tid & 3;
    const bf16_t* Z = (const bf16_t*)(p.ws + WS_BIG + BIG_Z); const float* MISC = (const float*)(p.ws + WS_MISC);
    float* O = (float*)(p.ws + WS_BIG + BIG_ST) + (size_t)dir * TT * 512;
    float S[DP];
#pragma unroll
    for (int i = 0; i < DP; ++i) S[i] = 0.f;
    for (int ci = 0; ci < NCHUNK; ++ci) {
        const int c = chain_chunk(dir, ci); const size_t r0 = (size_t)b * NTOK + c * 64;
        __syncthreads();
        for (int idx = tid; idx < 64 * DK; idx += 512) { const int t = idx / DK, d = idx % DK; const size_t r = r0 + t;
            float a, k, q;
            if (BR == 1) { float pre = p.in[I_GLABLR][(l * 2 + dir) * 256 + h * 64 + d];
                for (int rr = 0; rr < 16; ++rr) pre += MISC[r * 64 + MISC_LR + dir * 16 + rr] * p.in[I_GLAWLR][((size_t)(l * 2 + dir) * 16 + rr) * 256 + h * 64 + d];
                a = __expf(logsig(pre) * (1.f / 16.f)); k = bf2f(Z[r * ZLD + GK + h * 64 + d]); q = bf2f(Z[r * ZLD + GQ + h * 64 + d]) * 0.125f; }
            else { float lb = 0.f; if (l == 1) { const float l0 = p.in[I_HGLB][(0 * 2 + dir) * 512 + h * 128 + d], l1 = p.in[I_HGLB][(1 * 2 + dir) * 512 + h * 128 + d]; lb = 1.f / (1.f + __expf(l0 - l1)); }
                const float f = bf2f(Z[r * ZLD + HF + dir * 512 + h * 128 + d]); const float s = sigm(f);
                a = lb + (1.f - lb) * s; k = (1.f - lb) * sigm(-f); q = siluf(bf2f(Z[r * ZLD + HQ + h * 128 + d])) * 0.08838834764831845f; }
            LA[idx] = a; LK[idx] = k; LQ[idx] = q; }
        for (int idx = tid; idx < 64 * 128; idx += 512) { const int t = idx >> 7, vv = idx & 127; LV[idx] = bf2f(Z[(r0 + t) * ZLD + (BR == 1 ? GV : HI) + h * 128 + vv]); }
        __syncthreads();
        for (int j = 0; j < 64; ++j) { const int t = dir == 0 ? j : 63 - j; const float vv = LV[t * 128 + v]; float o = 0.f;
#pragma unroll
            for (int i = 0; i < DP; ++i) { const int d = part * DP + i; S[i] = LA[t * DK + d] * S[i] + LK[t * DK + d] * vv; o += S[i] * LQ[t * DK + d]; }
            o += __shfl_xor(o, 1); o += __shfl_xor(o, 2);
            if (part == 0) O[(r0 + t) * 512 + h * 128 + v] = o; }
    }
}
__device__ __forceinline__ void phase_seq_ml(const PP& p, int l, LAS float* sm) {
    if (blockIdx.x >= 16) return;
    LAS float* LK = sm; LAS float* LQ = sm + 8192; LAS float* LV = sm + 16384; LAS float* LI = sm + 24576; LAS float* LF = LI + 64;
    const int u = blockIdx.x, tid = otid(p.swid), dir = u & 1, h = (u >> 1) & 3, b = u >> 3, v = tid >> 2, part = tid & 3;
    const bf16_t* Z = (const bf16_t*)(p.ws + WS_BIG + BIG_Z); const float* MISC = (const float*)(p.ws + WS_MISC);
    float* O = (float*)(p.ws + WS_BIG + BIG_ST) + (size_t)dir * TT * 512;
    float C[32], N[32]; float m = 0.f;
#pragma unroll
    for (int i = 0; i < 32; ++i) { C[i] = 0.f; N[i] = 0.f; }
    for (int ci = 0; ci < NCHUNK; ++ci) {
        const int c = chain_chunk(dir, ci); const int p0 = c * 64; const size_t r0 = (size_t)b * NTOK + p0;
        const int lo = p0 < CTXL ? 0 : CTXL, hi = p0 < CTXL ? CTXL : NTOK;
        __syncthreads();
        for (int idx = tid; idx < 64 * 128; idx += 512) { const int t = idx >> 7, d = idx & 127, ch = h * 128 + d; const int pp = p0 + t;
            float q = p.in[I_MLCB][l * 1024 + ch], k = p.in[I_MLCB][l * 1024 + 512 + ch];
#pragma unroll
            for (int j = 0; j < 4; ++j) { const int qq = pp + j - 2; if (qq >= lo && qq < hi) { const size_t rr = (size_t)b * NTOK + qq;
                q += p.in[I_MLCW][(l * 4 + j) * 1024 + ch] * bf2f(Z[rr * ZLD + MQ + ch]); k += p.in[I_MLCW][(l * 4 + j) * 1024 + 512 + ch] * bf2f(Z[rr * ZLD + MK + ch]); } }
            LQ[idx] = siluf(q) * 0.08838834764831845f; LK[idx] = siluf(k); LV[idx] = bf2f(Z[(r0 + t) * ZLD + MV + ch]); }
        if (tid < 64) { const size_t r = r0 + tid; LI[tid] = MISC[r * 64 + MISC_IF + dir * 8 + h] + p.in[I_MLGB][(l * 2 + dir) * 8 + h];
            LF[tid] = logsig(MISC[r * 64 + MISC_IF + dir * 8 + 4 + h] + p.in[I_MLGB][(l * 2 + dir) * 8 + 4 + h]); }
        __syncthreads();
        for (int j = 0; j < 64; ++j) { const int t = dir == 0 ? j : 63 - j; const float it = LI[t], lf = LF[t];
            const float mn = fmaxf(lf + m, it), fd = __expf(lf + m - mn), iw = __expf(it - mn); m = mn;
            const float vv = LV[t * 128 + v]; float num = 0.f, den = 0.f;
#pragma unroll
            for (int i = 0; i < 32; ++i) { const int d = part * 32 + i; const float kd = LK[t * 128 + d], qd = LQ[t * 128 + d]; C[i] = fd * C[i] + iw * kd * vv; N[i] = fd * N[i] + iw * kd; num += C[i] * qd; den += N[i] * qd; }
            num += __shfl_xor(num, 1); num += __shfl_xor(num, 2); den += __shfl_xor(den, 1); den += __shfl_xor(den, 2);
            if (part == 0) O[(r0 + t) * 512 + h * 128 + v] = num / fmaxf(fabsf(den), __expf(-mn)); }
    }
}
template <int BR> __device__ __forceinline__ void phase_epi_norm(const PP& p, int l) {
    const int tid_ = otid(p.swid), lane = tid_ & 63; const bf16_t* Z = (const bf16_t*)(p.ws + WS_BIG + BIG_Z);
    const float* OF = (const float*)(p.ws + WS_BIG + BIG_ST); const float* OB = OF + (size_t)TT * 512;
    bf16_t* YS = (bf16_t*)(p.ws + WS_BIG + BIG_YS) + (size_t)BR * TT * 512;
    const float* gain = (BR == 1 ? p.in[I_GLANG] : BR == 2 ? p.in[I_HGNG] : p.in[I_MLNG]) + l * 128;
    const int goff = BR == 1 ? GG : BR == 2 ? HGT : MO;
    for (int w = blockIdx.x * 8 + (tid_ >> 6); w < TT * 4; w += gridDim.x * 8) { const size_t r = w >> 2; const int h = w & 3;
        const size_t i0 = r * 512 + h * 128 + lane, i1 = i0 + 64; const float o0 = OF[i0] + OB[i0], o1 = OF[i1] + OB[i1];
        const float ss = wave_sum(o0 * o0 + o1 * o1), rs = rsqrtf(ss * (1.f / 128.f) + EPS);
        const float g0 = bf2f(Z[r * ZLD + goff + h * 128 + lane]), g1 = bf2f(Z[r * ZLD + goff + h * 128 + lane + 64]);
        const float a0 = BR == 3 ? sigm(g0) : siluf(g0), a1 = BR == 3 ? sigm(g1) : siluf(g1);
        YS[i0] = f2bf(o0 * rs * gain[lane] * a0); YS[i1] = f2bf(o1 * rs * gain[lane + 64] * a1); }
}

constexpr size_t SM_RGA = 0, SM_RGB = 1081344, SM_RGH = 2162688, SM_DEC = 3244032, SM_MLBE = 4325376, SM_MLML = SM_MLBE + 8448, SM_MLMIN = SM_MLML + 8448, SM_MLDN = 4350720;
__device__ __forceinline__ unsigned pack2f(float lo, float hi) { return pack2(lo, hi); }
__device__ __forceinline__ f32x4 mfma16(bf16x8 x, bf16x8 y, f32x4 c) { const f32x4 d = __builtin_amdgcn_mfma_f32_16x16x32_bf16(x, y, c, 0, 0, 0); asm volatile("" :: "v"(x), "v"(y), "v"(d)); return d; }

template <bool OUT> __device__ __forceinline__ void phase_rg(const PP& p, int l, LAS unsigned char* L) {
    const int tid = otid(p.swid), lane = tid & 63, wid = p.swid, fr = lane & 15, fq = lane >> 4;
    LAS bf16_t* XB = (LAS bf16_t*)L;
    LAS float* XF = (LAS float*)(L + 9216);
    LAS float* PRE = (LAS float*)(L + 9216 + 16384);
    const bf16_t* Z = (const bf16_t*)(p.ws + WS_BIG + BIG_Z); const bf16_t* GWT = (const bf16_t*)(p.ws + WS_WB + WB_GW);
    float* RA = (float*)(p.ws + WS_SMALL + SM_RGA); float* RB = (float*)(p.ws + WS_SMALL + SM_RGB); const float* RH = (const float*)(p.ws + WS_SMALL + SM_RGH);
    bf16_t* YS = (bf16_t*)(p.ws + WS_BIG + BIG_YS);
    for (int u = blockIdx.x; u < 2112; u += gridDim.x) {
        const int blk = u & 7, c = (u >> 3) % NCHUNK, b = u / (8 * NCHUNK), p0 = c * 64;
        const size_t rb = (size_t)b * NTOK; const int lo = p0 < CTXL ? 0 : CTXL, hi = p0 < CTXL ? CTXL : NTOK;
        const int j = tid & 63, tg = tid >> 6, ch = blk * 64 + j;
        {
            float cw[4];
#pragma unroll
            for (int q = 0; q < 4; ++q) cw[q] = p.in[I_RGCW][(l * 4 + q) * 512 + ch];
            const float cb = p.in[I_RGCB][l * 512 + ch];
            float win[11];
#pragma unroll
            for (int k = 0; k < 11; ++k) { const int q = p0 + tg * 8 - 2 + k; win[k] = (q >= lo && q < hi) ? bf2f(Z[(rb + q) * ZLD + RGX + ch]) : 0.f; }
#pragma unroll
            for (int k = 0; k < 8; ++k) { const int t = tg * 8 + k; const float xb = cb + cw[0] * win[k] + cw[1] * win[k + 1] + cw[2] * win[k + 2] + cw[3] * win[k + 3];
                XF[t * 64 + j] = xb; XB[t * 72 + j] = f2bf(xb); }
        }
        __syncthreads();
        {
            const int set = wid >> 1; const bf16_t* W = GWT + ((size_t)set * 8 + blk) * 4096;
#pragma unroll
            for (int tti = 0; tti < 2; ++tti) { const int tt = (wid & 1) * 2 + tti;
                const bf16x8 y0 = *(const LAS bf16x8*)(XB + (16 * tt + fr) * 72 + 8 * fq), y1 = *(const LAS bf16x8*)(XB + (16 * tt + fr) * 72 + 8 * fq + 32);
#pragma unroll
                for (int jt = 0; jt < 4; ++jt) { const bf16x8 x0 = *(const bf16x8*)(W + (16 * jt + fr) * 64 + 8 * fq), x1 = *(const bf16x8*)(W + (16 * jt + fr) * 64 + 8 * fq + 32);
                    f32x4 acc = (f32x4){0.f, 0.f, 0.f, 0.f}; acc = mfma16(x0, y0, acc); acc = mfma16(x1, y1, acc);
                    *(LAS f32x4*)(PRE + (set * 64 + 16 * tt + fr) * 68 + 16 * jt + 4 * fq) = acc; } }
        }
        __syncthreads();
        {
#pragma unroll
            for (int dir = 0; dir < 2; ++dir) { const float br = p.in[I_RGGB][((l * 2 + dir) * 2 + 0) * 512 + ch], bi = p.in[I_RGGB][((l * 2 + dir) * 2 + 1) * 512 + ch];
                const float sp = softplusf(-p.in[I_RGLAM][(l * 2 + dir) * 512 + ch]);
#pragma unroll
                for (int k = 0; k < 8; ++k) { const int t = tg * 8 + k; LAS float* pa = PRE + ((dir * 2 + 0) * 64 + t) * 68 + j; LAS float* pb = PRE + ((dir * 2 + 1) * 64 + t) * 68 + j;
                    const float r = sigm(*pa + br), ig = sigm(*pb + bi), la = -8.f * r * sp;
                    const float a = __expf(la), x2 = 2.f * la;
                    const float ser = -x2 * (1.f + x2 * (0.5f + x2 * (0.16666667f + x2 * (0.041666668f + x2 * (0.008333334f + x2 * 0.0013888889f)))));
                    const float om = x2 > -0.5f ? ser : 1.f - a * a;
                    *pa = a; *pb = sqrtf(om) * (ig * XF[t * 64 + j]); } }
        }
        __syncthreads();
        if (tid < 128) {
            const int dir = tid >> 6; const size_t sidx = ((size_t)(dir * 2 + b) * NCHUNK + c) * 512 + ch;
            float h = OUT ? RH[sidx] : 0.f, P = 1.f;
#pragma unroll 8
            for (int s2 = 0; s2 < 64; ++s2) { const int t = dir ? 63 - s2 : s2; const float a = PRE[((dir * 2 + 0) * 64 + t) * 68 + j], bt = PRE[((dir * 2 + 1) * 64 + t) * 68 + j];
                h = a * h + bt; if (OUT) PRE[((dir * 2 + 1) * 64 + t) * 68 + j] = h; else P *= a; }
            if (!OUT) { RA[sidx] = P; RB[sidx] = h; }
        }
        if (OUT) { __syncthreads();
#pragma unroll
            for (int k = 0; k < 8; ++k) { const int t = tg * 8 + k; const size_t r = rb + p0 + t;
                YS[r * 512 + ch] = f2bf(gelu_tanh(bf2f(Z[r * ZLD + RGY + ch])) * (PRE[((0 * 2 + 1) * 64 + t) * 68 + j] + PRE[((1 * 2 + 1) * 64 + t) * 68 + j])); } }
        __syncthreads();
    }
}
__device__ __forceinline__ void phase_rg_carry(const PP& p) {
    const int g = blockIdx.x * 512 + otid(p.swid); if (g >= 2048) return;
    const int dir = g >> 10, b = (g >> 9) & 1, ch = g & 511;
    const float* RA = (const float*)(p.ws + WS_SMALL + SM_RGA); const float* RB = (const float*)(p.ws + WS_SMALL + SM_RGB); float* RH = (float*)(p.ws + WS_SMALL + SM_RGH);
    float h = 0.f;
    for (int ci0 = 0; ci0 < NCHUNK; ci0 += 6) { float a[6], bb[6]; size_t idx[6];
#pragma unroll
        for (int k = 0; k < 6; ++k) { idx[k] = ((size_t)(dir * 2 + b) * NCHUNK + chain_chunk(dir, ci0 + k)) * 512 + ch; a[k] = RA[idx[k]]; bb[k] = RB[idx[k]]; }
#pragma unroll
        for (int k = 0; k < 6; ++k) { RH[idx[k]] = h; h = a[k] * h + bb[k]; } }
}

template <int BR> struct GlChan {
    float w[16]; float bias; float lb; int dir, h, d, l;
    __device__ __forceinline__ void init(const PP& p, int l_, int dir_, int h_, int d_) { l = l_; dir = dir_; h = h_; d = d_;
        if (BR == 1) {
#pragma unroll
            for (int r = 0; r < 16; ++r) w[r] = p.in[I_GLAWLR][((size_t)(l * 2 + dir) * 16 + r) * 256 + h * 64 + d];
            bias = p.in[I_GLABLR][(l * 2 + dir) * 256 + h * 64 + d]; lb = 0.f;
        } else { lb = 0.f; if (l == 1) { const float l0 = p.in[I_HGLB][(0 * 2 + dir) * 512 + h * 128 + d], l1 = p.in[I_HGLB][(1 * 2 + dir) * 512 + h * 128 + d]; lb = 1.f / (1.f + __expf(l0 - l1)); } bias = 0.f; }
    }
    __device__ __forceinline__ void gk(const bf16_t* zrow, const LAS float* lr, float& g, float& k) const {
        if (BR == 1) { float pre = bias;
#pragma unroll
            for (int r4 = 0; r4 < 4; ++r4) { const f32x4 x = *(const LAS f32x4*)(lr + 4 * r4); pre += x[0] * w[4 * r4] + x[1] * w[4 * r4 + 1] + x[2] * w[4 * r4 + 2] + x[3] * w[4 * r4 + 3]; }
            g = logsig(pre) * (1.f / 16.f); k = bf2f(zrow[GK + h * 64 + d]);
        } else { const float f = bf2f(zrow[HF + dir * 512 + h * 128 + d]); const float e = __expf(-f), sg = 1.f / (1.f + e);
            g = __logf(lb + (1.f - lb) * sg); k = (1.f - lb) * (e * sg); }
    }
};
template <int BR> __device__ __forceinline__ void phase_gl_local(const PP& p, int l, LAS unsigned char* L) {
    constexpr int DK = BR == 1 ? 64 : 128, TS = 512 / DK, NT = 64 / TS, GP = DK + 1;
    const int tid = otid(p.swid), lane = tid & 63, wid = p.swid, fr = lane & 15, fq = lane >> 4;
    LAS float* Gl = (LAS float*)L;
    LAS bf16_t* KT = (LAS bf16_t*)(L + 33280);
    LAS bf16_t* VT = KT + 2 * DK * 72;
    LAS float* TOTL = (LAS float*)(VT + 128 * 72);
    LAS float* LR = TOTL + 128;
    const bf16_t* Z = (const bf16_t*)(p.ws + WS_BIG + BIG_Z); const float* MISC = (const float*)(p.ws + WS_MISC);
    bf16_t* ST = (bf16_t*)(p.ws + WS_BIG + BIG_ST); float* DEC = (float*)(p.ws + WS_SMALL + SM_DEC);
    constexpr int VOFF = BR == 1 ? GV : HI;
    const int d = tid % DK, tq = tid / DK;
    for (int u = blockIdx.x; u < 8 * NCHUNK; u += gridDim.x) {
        const int c = u % NCHUNK, bh = u / NCHUNK, h = bh & 3, b = bh >> 2; const size_t r0 = (size_t)b * NTOK + c * 64;
        if (BR == 1) { for (int i = tid; i < 2048; i += 512) LR[i] = MISC[(r0 + (i >> 5)) * 64 + MISC_LR + (i & 31)]; }
        { const int v = tid & 127;
#pragma unroll
          for (int gi = 0; gi < 2; ++gi) { const int grp = (tid >> 7) + 4 * gi; unsigned short x[8];
#pragma unroll
            for (int e = 0; e < 8; ++e) x[e] = Z[(r0 + grp * 8 + e) * ZLD + VOFF + h * 128 + v];
            *(LAS u32x4*)(VT + v * 72 + grp * 8) = (u32x4){x[0] | ((unsigned)x[1] << 16), x[2] | ((unsigned)x[3] << 16), x[4] | ((unsigned)x[5] << 16), x[6] | ((unsigned)x[7] << 16)}; } }
        if (BR == 1) __syncthreads();
#pragma unroll 1
        for (int dir = 0; dir < 2; ++dir) {
            GlChan<BR> G; G.init(p, l, dir, h, d);
            float kk[NT];
#pragma unroll
            for (int n = 0; n < NT; ++n) { const int t = tq + TS * n; float g; G.gk(Z + (r0 + t) * ZLD, LR + t * 32 + dir * 16, g, kk[n]); Gl[t * GP + d] = g; }
            __syncthreads();
            if (tid < DK) { float s2 = 0.f;
#pragma unroll 8
                for (int w = 0; w < 64; ++w) { const int t = dir ? 63 - w : w; s2 += Gl[t * GP + tid]; Gl[t * GP + tid] = s2; }
                TOTL[tid] = s2; DEC[((size_t)((dir * 2 + b) * 4 + h) * NCHUNK + c) * 128 + tid] = __expf(s2); }
            __syncthreads();
            { const float tot = TOTL[d];
#pragma unroll
              for (int n = 0; n < NT; ++n) { const int t = tq + TS * n; KT[(dir * DK + d) * 72 + t] = f2bf(kk[n] * __expf(tot - Gl[t * GP + d])); } }
            __syncthreads();
        }
        { const int dir = wid >> 2; const size_t sbase = ((size_t)((dir * 2 + b) * 4 + h) * NCHUNK + c) * 128 * DK;
#pragma unroll
          for (int di = 0; di < DK / 64; ++di) { const int dt = (wid & 3) * (DK / 64) + di;
            const bf16x8 x0 = *(const LAS bf16x8*)(KT + (dir * DK + 16 * dt + fr) * 72 + 8 * fq), x1 = *(const LAS bf16x8*)(KT + (dir * DK + 16 * dt + fr) * 72 + 8 * fq + 32);
#pragma unroll
            for (int vt = 0; vt < 8; ++vt) { const bf16x8 y0 = *(const LAS bf16x8*)(VT + (16 * vt + fr) * 72 + 8 * fq), y1 = *(const LAS bf16x8*)(VT + (16 * vt + fr) * 72 + 8 * fq + 32);
                f32x4 acc = (f32x4){0.f, 0.f, 0.f, 0.f}; acc = mfma16(x0, y0, acc); acc = mfma16(x1, y1, acc);
                *(uint2*)(ST + sbase + (size_t)(16 * vt + fr) * DK + 16 * dt + 4 * fq) = make_uint2(pack2(acc[0], acc[1]), pack2(acc[2], acc[3])); } } }
        __syncthreads();
    }
}
template <int BR> __device__ __forceinline__ void phase_gl_carry(const PP& p) {
    constexpr int DK = BR == 1 ? 64 : 128, D4 = DK / 4, TOTAL = 16 * 128 * D4, NB = 6;
    const int g = blockIdx.x * 512 + otid(p.swid);
    bf16_t* ST = (bf16_t*)(p.ws + WS_BIG + BIG_ST); const float* DEC = (const float*)(p.ws + WS_SMALL + SM_DEC);
    const float* BE = (const float*)(p.ws + WS_SMALL + SM_MLBE); const float* MLOC = (const float*)(p.ws + WS_SMALL + SM_MLML); float* MIN_ = (float*)(p.ws + WS_SMALL + SM_MLMIN); float* DN = (float*)(p.ws + WS_SMALL + SM_MLDN);
    if (g < TOTAL) {
        const int d4 = g % D4, v = (g / D4) % 128, chain = g / (D4 * 128), dir = chain >> 3;
        float S[4] = {0.f, 0.f, 0.f, 0.f}; float m = 0.f;
        for (int ci0 = 0; ci0 < NCHUNK; ci0 += NB) { uint2 ds[NB]; f32x4 da[NB]; size_t off[NB];
#pragma unroll
            for (int k = 0; k < NB; ++k) { const int c = chain_chunk(dir, ci0 + k); off[k] = (((size_t)chain * NCHUNK + c) * 128 + v) * DK + d4 * 4; ds[k] = *(const uint2*)(ST + off[k]);
                if (BR == 3) { da[k][0] = BE[chain * NCHUNK + c]; da[k][1] = MLOC[chain * NCHUNK + c]; da[k][2] = 0.f; da[k][3] = 0.f; }
                else da[k] = *(const f32x4*)(DEC + ((size_t)chain * NCHUNK + c) * 128 + d4 * 4); }
#pragma unroll
            for (int k = 0; k < NB; ++k) {
                *(uint2*)(ST + off[k]) = make_uint2(pack2(S[0], S[1]), pack2(S[2], S[3]));
                float al[4], be[4];
                if (BR == 3) { const float mn = fmaxf(da[k][0] + m, da[k][1]), a = __expf(da[k][0] + m - mn), bb = __expf(da[k][1] - mn); m = mn;
#pragma unroll
                    for (int e = 0; e < 4; ++e) { al[e] = a; be[e] = bb; } }
                else {
#pragma unroll
                    for (int e = 0; e < 4; ++e) { al[e] = da[k][e]; be[e] = 1.f; } }
                S[0] = al[0] * S[0] + be[0] * bf2f((bf16_t)(ds[k].x & 0xffff)); S[1] = al[1] * S[1] + be[1] * bf2f((bf16_t)(ds[k].x >> 16));
                S[2] = al[2] * S[2] + be[2] * bf2f((bf16_t)(ds[k].y & 0xffff)); S[3] = al[3] * S[3] + be[3] * bf2f((bf16_t)(ds[k].y >> 16)); } }
    } else if (BR == 3 && g < TOTAL + 16 * 128) {
        const int q = g - TOTAL, d = q & 127, chain = q >> 7, dir = chain >> 3; float n = 0.f, m = 0.f;
        for (int ci0 = 0; ci0 < NCHUNK; ci0 += NB) { float be[NB], ml[NB], dn[NB]; size_t o[NB];
#pragma unroll
            for (int k = 0; k < NB; ++k) { const int c = chain_chunk(dir, ci0 + k); be[k] = BE[chain * NCHUNK + c]; ml[k] = MLOC[chain * NCHUNK + c]; o[k] = ((size_t)chain * NCHUNK + c) * 128 + d; dn[k] = DN[o[k]]; }
#pragma unroll
            for (int k = 0; k < NB; ++k) { DN[o[k]] = n; if (d == 0) MIN_[chain * NCHUNK + chain_chunk(dir, ci0 + k)] = m;
                const float mn = fmaxf(be[k] + m, ml[k]); n = __expf(be[k] + m - mn) * n + __expf(ml[k] - mn) * dn[k]; m = mn; } }
    }
}
template <int BR> __device__ __forceinline__ void phase_gl_out(const PP& p, int l, LAS unsigned char* L) {
    constexpr int DK = BR == 1 ? 64 : 128, PQ = DK + 8, TS = 512 / DK, NT = 64 / TS, GP = DK + 1;
    const int tid = otid(p.swid), lane = tid & 63, wid = p.swid, fr = lane & 15, fq = lane >> 4;
    LAS float* Gl = (LAS float*)L;
    LAS bf16_t* QP = (LAS bf16_t*)(L + 33280);
    LAS bf16_t* KP = QP + 64 * PQ;
    LAS bf16_t* QT = KP + 64 * PQ;
    LAS bf16_t* VT = QT + 64 * PQ;
    LAS bf16_t* PS = VT + 128 * 72;
    LAS float* EB = (LAS float*)(PS + 64 * 72);
    LAS float* RED = EB + 256;
    LAS float* LR = RED + 512;
    const bf16_t* Z = (const bf16_t*)(p.ws + WS_BIG + BIG_Z); const float* MISC = (const float*)(p.ws + WS_MISC);
    const bf16_t* ST = (const bf16_t*)(p.ws + WS_BIG + BIG_ST); bf16_t* YS = (bf16_t*)(p.ws + WS_BIG + BIG_YS) + (size_t)BR * TT * 512;
    const float* gain = (BR == 1 ? p.in[I_GLANG] : p.in[I_HGNG]) + l * 128;
    constexpr int VOFF = BR == 1 ? GV : HI, QOFF = BR == 1 ? GQ : HQ, GOFF = BR == 1 ? GG : HGT;
    const int d = tid % DK, tq = tid / DK;
    for (int u = blockIdx.x; u < 8 * NCHUNK; u += gridDim.x) {
        const int c = u % NCHUNK, bh = u / NCHUNK, h = bh & 3, b = bh >> 2; const size_t r0 = (size_t)b * NTOK + c * 64;
        if (BR == 1) { for (int i = tid; i < 2048; i += 512) LR[i] = MISC[(r0 + (i >> 5)) * 64 + MISC_LR + (i & 31)]; }
        { const int v = tid & 127;
#pragma unroll
          for (int gi = 0; gi < 2; ++gi) { const int grp = (tid >> 7) + 4 * gi; unsigned short x[8];
#pragma unroll
            for (int e = 0; e < 8; ++e) x[e] = Z[(r0 + grp * 8 + e) * ZLD + VOFF + h * 128 + v];
            *(LAS u32x4*)(VT + v * 72 + grp * 8) = (u32x4){x[0] | ((unsigned)x[1] << 16), x[2] | ((unsigned)x[3] << 16), x[4] | ((unsigned)x[5] << 16), x[6] | ((unsigned)x[7] << 16)}; } }
        uint2 gtv[4];
#pragma unroll
        for (int it = 0; it < 4; ++it) gtv[it] = *(const uint2*)(Z + (r0 + 16 * it + fr) * ZLD + GOFF + h * 128 + 16 * wid + 4 * fq);
        float qv[NT];
#pragma unroll
        for (int n = 0; n < NT; ++n) { const float qraw = bf2f(Z[(r0 + tq + TS * n) * ZLD + QOFF + h * DK + d]); qv[n] = BR == 1 ? qraw * 0.125f : siluf(qraw) * 0.08838834764831845f; }
        if (BR == 1) __syncthreads();
        f32x4 acc[4];
#pragma unroll
        for (int it = 0; it < 4; ++it) acc[it] = (f32x4){0.f, 0.f, 0.f, 0.f};
#pragma unroll 1
        for (int dir = 0; dir < 2; ++dir) {
            GlChan<BR> G; G.init(p, l, dir, h, d);
            bf16x8 xs[DK / 32];
            { const bf16_t* sp = ST + (((size_t)((dir * 2 + b) * 4 + h) * NCHUNK + c) * 128 + 16 * wid + fr) * DK + 8 * fq;
#pragma unroll
              for (int kq = 0; kq < DK / 32; ++kq) xs[kq] = *(const bf16x8*)(sp + 32 * kq); }
            float kk[NT];
#pragma unroll
            for (int n = 0; n < NT; ++n) { const int t = tq + TS * n; float g; G.gk(Z + (r0 + t) * ZLD, LR + t * 32 + dir * 16, g, kk[n]); Gl[t * GP + d] = g; }
            __syncthreads();
            if (tid < DK) { float s2 = 0.f, beta = 0.f;
#pragma unroll 8
                for (int w = 0; w < 64; ++w) { const int t = dir ? 63 - w : w; s2 += Gl[t * GP + tid]; Gl[t * GP + tid] = s2; beta = w == 31 ? s2 : beta; }
                EB[tid] = beta; EB[DK + tid] = __expf(beta); }
            __syncthreads();
            { const float beta = EB[d], ebeta = EB[DK + d];
#pragma unroll
              for (int n = 0; n < NT; ++n) { const int t = tq + TS * n; const float e1 = __expf(Gl[t * GP + d] - beta), qe = qv[n] * e1;
                  QP[t * PQ + d] = f2bf(qe); QT[t * PQ + d] = f2bf(qe * ebeta); KP[t * PQ + d] = f2bf(kk[n] / e1); } }
            __syncthreads();
            {
                const int it = wid & 3;
#pragma unroll
                for (int jh = 0; jh < 2; ++jh) { const int jt = (wid >> 2) * 2 + jh;
                    f32x4 sa = (f32x4){0.f, 0.f, 0.f, 0.f};
#pragma unroll
                    for (int kq = 0; kq < DK / 32; ++kq) sa = mfma16(*(const LAS bf16x8*)(KP + (16 * jt + fr) * PQ + 8 * fq + 32 * kq), *(const LAS bf16x8*)(QP + (16 * it + fr) * PQ + 8 * fq + 32 * kq), sa);
#pragma unroll
                    for (int jj = 0; jj < 4; ++jj) { const int jg = 16 * jt + 4 * fq + jj, ig = 16 * it + fr; const bool keep = dir == 0 ? (jg <= ig) : (jg >= ig); sa[jj] = keep ? sa[jj] : 0.f; }
                    *(LAS u32x2*)(PS + (16 * it + fr) * 72 + 16 * jt + 4 * fq) = (u32x2){pack2(sa[0], sa[1]), pack2(sa[2], sa[3])}; }
            }
            __syncthreads();
            {
                const bf16x8 xv0 = *(const LAS bf16x8*)(VT + (16 * wid + fr) * 72 + 8 * fq), xv1 = *(const LAS bf16x8*)(VT + (16 * wid + fr) * 72 + 8 * fq + 32);
#pragma unroll
                for (int it = 0; it < 4; ++it) {
                    acc[it] = mfma16(xv0, *(const LAS bf16x8*)(PS + (16 * it + fr) * 72 + 8 * fq), acc[it]);
                    acc[it] = mfma16(xv1, *(const LAS bf16x8*)(PS + (16 * it + fr) * 72 + 8 * fq + 32), acc[it]);
#pragma unroll
                    for (int kq = 0; kq < DK / 32; ++kq) acc[it] = mfma16(xs[kq], *(const LAS bf16x8*)(QT + (16 * it + fr) * PQ + 8 * fq + 32 * kq), acc[it]); }
            }
        }
#pragma unroll
        for (int it = 0; it < 4; ++it) { float ss = acc[it][0] * acc[it][0] + acc[it][1] * acc[it][1] + acc[it][2] * acc[it][2] + acc[it][3] * acc[it][3];
            ss += __shfl_xor(ss, 16); ss += __shfl_xor(ss, 32); if (fq == 0) RED[wid * 64 + 16 * it + fr] = ss; }
        __syncthreads();
        const f32x4 gn = *(const f32x4*)(gain + 16 * wid + 4 * fq);
#pragma unroll
        for (int it = 0; it < 4; ++it) { float tot = 0.f;
#pragma unroll
            for (int w2 = 0; w2 < 8; ++w2) tot += RED[w2 * 64 + 16 * it + fr];
            const float rs = rsqrtf(tot * (1.f / 128.f) + EPS); const size_t row = r0 + 16 * it + fr;
            const uint2 gt = gtv[it];
            const float y0 = acc[it][0] * rs * gn[0] * siluf(bf2f((bf16_t)(gt.x & 0xffff))), y1 = acc[it][1] * rs * gn[1] * siluf(bf2f((bf16_t)(gt.x >> 16)));
            const float y2 = acc[it][2] * rs * gn[2] * siluf(bf2f((bf16_t)(gt.y & 0xffff))), y3 = acc[it][3] * rs * gn[3] * siluf(bf2f((bf16_t)(gt.y >> 16)));
            *(uint2*)(YS + row * 512 + h * 128 + 16 * wid + 4 * fq) = make_uint2(pack2(y0, y1), pack2(y2, y3)); }
        __syncthreads();
    }
}

__device__ __forceinline__ float wave_incl_scan_add(float x, int lane) {
#pragma unroll
    for (int o = 1; o < 64; o <<= 1) { const float y = __shfl_up(x, o); x = lane >= o ? x + y : x; }
    return x;
}
__device__ __forceinline__ float wave_incl_scan_max(float x, int lane) {
#pragma unroll
    for (int o = 1; o < 64; o <<= 1) { const float y = __shfl_up(x, o); x = lane >= o ? fmaxf(x, y) : x; }
    return x;
}
__device__ __forceinline__ float wave_max(float v) {
#pragma unroll
    for (int o = 32; o > 0; o >>= 1) v = fmaxf(v, __shfl_xor(v, o));
    return v;
}
__device__ __forceinline__ void phase_ml_local(const PP& p, int l, LAS unsigned char* L) {
    const int tid = otid(p.swid), lane = tid & 63, wid = p.swid, fr = lane & 15, fq = lane >> 4;
    LAS bf16_t* KT = (LAS bf16_t*)L;
    LAS bf16_t* VT = KT + 2 * 128 * 72;
    LAS float* WE = (LAS float*)(VT + 128 * 72);
    LAS float* DNP = WE + 128;
    const bf16_t* Z = (const bf16_t*)(p.ws + WS_BIG + BIG_Z); const float* MISC = (const float*)(p.ws + WS_MISC);
    bf16_t* ST = (bf16_t*)(p.ws + WS_BIG + BIG_ST);
    float* BE = (float*)(p.ws + WS_SMALL + SM_MLBE); float* MLOC = (float*)(p.ws + WS_SMALL + SM_MLML); float* DN = (float*)(p.ws + WS_SMALL + SM_MLDN);
    for (int u = blockIdx.x; u < 8 * NCHUNK; u += gridDim.x) {
        const int c = u % NCHUNK, bh = u / NCHUNK, h = bh & 3, b = bh >> 2, p0 = c * 64; const size_t rb = (size_t)b * NTOK, r0 = rb + p0;
        const int lo = p0 < CTXL ? 0 : CTXL, hi = p0 < CTXL ? CTXL : NTOK;
        const int d = tid & 127, sg = tid >> 7, ch = h * 128 + d;
        float kv[16];
        {
            float cw[4];
#pragma unroll
            for (int q = 0; q < 4; ++q) cw[q] = p.in[I_MLCW][(l * 4 + q) * 1024 + 512 + ch];
            const float cb = p.in[I_MLCB][l * 1024 + 512 + ch];
            float win[19];
#pragma unroll
            for (int k = 0; k < 19; ++k) { const int q = p0 + sg * 16 - 2 + k; win[k] = (q >= lo && q < hi) ? bf2f(Z[(rb + q) * ZLD + MK + ch]) : 0.f; }
#pragma unroll
            for (int n = 0; n < 16; ++n) kv[n] = siluf(cb + cw[0] * win[n] + cw[1] * win[n + 1] + cw[2] * win[n + 2] + cw[3] * win[n + 3]);
        }
        { const int v = tid & 127;
#pragma unroll
          for (int gi = 0; gi < 2; ++gi) { const int grp = (tid >> 7) + 4 * gi; unsigned short x[8];
#pragma unroll
            for (int e = 0; e < 8; ++e) x[e] = Z[(r0 + grp * 8 + e) * ZLD + MV + h * 128 + v];
            *(LAS u32x4*)(VT + v * 72 + grp * 8) = (u32x4){x[0] | ((unsigned)x[1] << 16), x[2] | ((unsigned)x[3] << 16), x[4] | ((unsigned)x[5] << 16), x[6] | ((unsigned)x[7] << 16)}; } }
        if (wid < 2) {
            const int dir = wid, t = dir == 0 ? lane : 63 - lane; const size_t r = r0 + t; const int chain = (dir * 2 + b) * 4 + h;
            const float ii = MISC[r * 64 + MISC_IF + dir * 8 + h] + p.in[I_MLGB][(l * 2 + dir) * 8 + h];
            const float lf = logsig(MISC[r * 64 + MISC_IF + dir * 8 + 4 + h] + p.in[I_MLGB][(l * 2 + dir) * 8 + 4 + h]);
            const float bc = wave_incl_scan_add(lf, lane), bend = __shfl(bc, 63), mloc = bend + wave_max(ii - bc);
            WE[dir * 64 + t] = __expf(bend - bc + ii - mloc);
            if (lane == 0) { BE[chain * NCHUNK + c] = bend; MLOC[chain * NCHUNK + c] = mloc; }
        }
        __syncthreads();
#pragma unroll
        for (int dir = 0; dir < 2; ++dir) { float val[16], dn = 0.f;
#pragma unroll
            for (int n = 0; n < 16; ++n) { val[n] = kv[n] * WE[dir * 64 + sg * 16 + n]; dn += val[n]; }
            *(LAS u32x4*)(KT + (dir * 128 + d) * 72 + sg * 16) = (u32x4){pack2(val[0], val[1]), pack2(val[2], val[3]), pack2(val[4], val[5]), pack2(val[6], val[7])};
            *(LAS u32x4*)(KT + (dir * 128 + d) * 72 + sg * 16 + 8) = (u32x4){pack2(val[8], val[9]), pack2(val[10], val[11]), pack2(val[12], val[13]), pack2(val[14], val[15])};
            DNP[(sg * 2 + dir) * 128 + d] = dn; }
        __syncthreads();
        if (tid < 256) { const int dir = tid >> 7; DN[((size_t)((dir * 2 + b) * 4 + h) * NCHUNK + c) * 128 + d] = DNP[(0 * 2 + dir) * 128 + d] + DNP[(1 * 2 + dir) * 128 + d] + DNP[(2 * 2 + dir) * 128 + d] + DNP[(3 * 2 + dir) * 128 + d]; }
        { const int dir = wid >> 2; const size_t sbase = ((size_t)((dir * 2 + b) * 4 + h) * NCHUNK + c) * 128 * 128;
#pragma unroll
          for (int di = 0; di < 2; ++di) { const int dt = (wid & 3) * 2 + di;
            const bf16x8 x0 = *(const LAS bf16x8*)(KT + (dir * 128 + 16 * dt + fr) * 72 + 8 * fq), x1 = *(const LAS bf16x8*)(KT + (dir * 128 + 16 * dt + fr) * 72 + 8 * fq + 32);
#pragma unroll
            for (int vt = 0; vt < 8; ++vt) { const bf16x8 y0 = *(const LAS bf16x8*)(VT + (16 * vt + fr) * 72 + 8 * fq), y1 = *(const LAS bf16x8*)(VT + (16 * vt + fr) * 72 + 8 * fq + 32);
                f32x4 acc = (f32x4){0.f, 0.f, 0.f, 0.f}; acc = mfma16(x0, y0, acc); acc = mfma16(x1, y1, acc);
                *(uint2*)(ST + sbase + (size_t)(16 * vt + fr) * 128 + 16 * dt + 4 * fq) = make_uint2(pack2(acc[0], acc[1]), pack2(acc[2], acc[3])); } } }
        __syncthreads();
    }
}
__device__ __forceinline__ void phase_ml_out(const PP& p, int l, LAS unsigned char* L) {
    constexpr int PQ = 136;
    const int tid = otid(p.swid), lane = tid & 63, wid = p.swid, fr = lane & 15, fq = lane >> 4;
    LAS bf16_t* QL = (LAS bf16_t*)L;
    LAS bf16_t* KL = QL + 64 * PQ;
    LAS bf16_t* VT = KL + 64 * PQ;
    LAS bf16_t* PS = VT + 128 * 72;
    LAS float* SC = (LAS float*)(PS + 2 * 64 * 72);
    LAS float* NV = SC + 2 * 576;
    LAS float* RED = NV + 256;
    const bf16_t* Z = (const bf16_t*)(p.ws + WS_BIG + BIG_Z); const float* MISC = (const float*)(p.ws + WS_MISC);
    const bf16_t* ST = (const bf16_t*)(p.ws + WS_BIG + BIG_ST); bf16_t* YS = (bf16_t*)(p.ws + WS_BIG + BIG_YS) + (size_t)3 * TT * 512;
    const float* MIN_ = (const float*)(p.ws + WS_SMALL + SM_MLMIN); const float* DN = (const float*)(p.ws + WS_SMALL + SM_MLDN);
    const float* gain = p.in[I_MLNG] + l * 128;
    for (int u = blockIdx.x; u < 8 * NCHUNK; u += gridDim.x) {
        const int c = u % NCHUNK, bh = u / NCHUNK, h = bh & 3, b = bh >> 2, p0 = c * 64; const size_t rb = (size_t)b * NTOK, r0 = rb + p0;
        const int lo = p0 < CTXL ? 0 : CTXL, hi = p0 < CTXL ? CTXL : NTOK;
        const int d = tid & 127, sg = tid >> 7, ch = h * 128 + d;
        uint2 gtv[4];
#pragma unroll
        for (int it = 0; it < 4; ++it) gtv[it] = *(const uint2*)(Z + (r0 + 16 * it + fr) * ZLD + MO + h * 128 + 16 * wid + 4 * fq);
#pragma unroll
        for (int which = 0; which < 2; ++which) {
            const int zc = (which ? MK : MQ) + ch;
            float cw[4];
#pragma unroll
            for (int q = 0; q < 4; ++q) cw[q] = p.in[I_MLCW][(l * 4 + q) * 1024 + which * 512 + ch];
            const float cb = p.in[I_MLCB][l * 1024 + which * 512 + ch], scl = which ? 1.f : 0.08838834764831845f;
            float win[19];
#pragma unroll
            for (int k = 0; k < 19; ++k) { const int q = p0 + sg * 16 - 2 + k; win[k] = (q >= lo && q < hi) ? bf2f(Z[(rb + q) * ZLD + zc]) : 0.f; }
            LAS bf16_t* dst = (which ? KL : QL) + (sg * 16) * PQ + d;
#pragma unroll
            for (int n = 0; n < 16; ++n) dst[n * PQ] = f2bf(siluf(cb + cw[0] * win[n] + cw[1] * win[n + 1] + cw[2] * win[n + 2] + cw[3] * win[n + 3]) * scl);
        }
        { const int v = tid & 127;
#pragma unroll
          for (int gi = 0; gi < 2; ++gi) { const int grp = (tid >> 7) + 4 * gi; unsigned short x[8];
#pragma unroll
            for (int e = 0; e < 8; ++e) x[e] = Z[(r0 + grp * 8 + e) * ZLD + MV + h * 128 + v];
            *(LAS u32x4*)(VT + v * 72 + grp * 8) = (u32x4){x[0] | ((unsigned)x[1] << 16), x[2] | ((unsigned)x[3] << 16), x[4] | ((unsigned)x[5] << 16), x[6] | ((unsigned)x[7] << 16)}; } }
        if (tid < 256) NV[tid] = DN[((size_t)(((tid >> 7) * 2 + b) * 4 + h) * NCHUNK + c) * 128 + (tid & 127)];
        if (wid < 2) {
            const int dir = wid, t = dir == 0 ? lane : 63 - lane; const size_t r = r0 + t; const int chain = (dir * 2 + b) * 4 + h;
            const float ii = MISC[r * 64 + MISC_IF + dir * 8 + h] + p.in[I_MLGB][(l * 2 + dir) * 8 + h];
            const float lf = logsig(MISC[r * 64 + MISC_IF + dir * 8 + 4 + h] + p.in[I_MLGB][(l * 2 + dir) * 8 + 4 + h]);
            const float bc = wave_incl_scan_add(lf, lane), a = ii - bc, arun = wave_incl_scan_max(a, lane), mprev = MIN_[chain * NCHUNK + c];
            const float m = bc + fmaxf(mprev, arun);
            LAS float* S = SC + dir * 576;
            S[t] = bc - m; S[64 + t] = a; S[128 + t] = __expf(bc + mprev - m); S[192 + t] = __expf(-m);
        }
        __syncthreads();
        {
            const int dir = tid >> 8, i = (tid >> 2) & 63, part = tid & 3; float sacc = 0.f;
#pragma unroll 8
            for (int d = part * 32; d < part * 32 + 32; ++d) sacc += bf2f(QL[i * PQ + d]) * NV[dir * 128 + d];
            sacc += __shfl_xor(sacc, 1); sacc += __shfl_xor(sacc, 2);
            if (part == 0) SC[dir * 576 + 256 + i] = sacc;
        }
        {
            const int it = wid & 3;
#pragma unroll
            for (int jh = 0; jh < 2; ++jh) { const int jt = (wid >> 2) * 2 + jh;
                f32x4 acc = (f32x4){0.f, 0.f, 0.f, 0.f};
#pragma unroll
                for (int kk = 0; kk < 4; ++kk) acc = mfma16(*(const LAS bf16x8*)(KL + (16 * jt + fr) * PQ + 8 * fq + 32 * kk), *(const LAS bf16x8*)(QL + (16 * it + fr) * PQ + 8 * fq + 32 * kk), acc);
                const int ig = 16 * it + fr;
#pragma unroll
                for (int dir = 0; dir < 2; ++dir) { const LAS float* S = SC + dir * 576; const float ui = S[ig]; float sv[4];
#pragma unroll
                    for (int jj = 0; jj < 4; ++jj) { const int jg = 16 * jt + 4 * fq + jj; const bool keep = dir == 0 ? (jg <= ig) : (jg >= ig);
                        const float wgt = __expf(fminf(ui + S[64 + jg], 0.f)); sv[jj] = keep ? acc[jj] * wgt : 0.f; }
                    *(LAS u32x2*)(PS + (dir * 64 + ig) * 72 + 16 * jt + 4 * fq) = (u32x2){pack2(sv[0], sv[1]), pack2(sv[2], sv[3])};
                    float rsum = sv[0] + sv[1] + sv[2] + sv[3]; rsum += __shfl_xor(rsum, 16); rsum += __shfl_xor(rsum, 32);
                    if (fq == 0) SC[dir * 576 + 320 + jt * 64 + ig] = rsum; } }
        }
        __syncthreads();
        {
            f32x4 o[4];
#pragma unroll
            for (int it = 0; it < 4; ++it) o[it] = (f32x4){0.f, 0.f, 0.f, 0.f};
            const bf16x8 xv0 = *(const LAS bf16x8*)(VT + (16 * wid + fr) * 72 + 8 * fq), xv1 = *(const LAS bf16x8*)(VT + (16 * wid + fr) * 72 + 8 * fq + 32);
#pragma unroll
            for (int dir = 0; dir < 2; ++dir) {
                const bf16_t* sp = ST + (((size_t)((dir * 2 + b) * 4 + h) * NCHUNK + c) * 128 + 16 * wid + fr) * 128 + 8 * fq;
                bf16x8 xs[4];
#pragma unroll
                for (int kk = 0; kk < 4; ++kk) xs[kk] = *(const bf16x8*)(sp + 32 * kk);
                const LAS float* S = SC + dir * 576;
#pragma unroll
                for (int it = 0; it < 4; ++it) { const int ig = 16 * it + fr;
                    f32x4 ap = (f32x4){0.f, 0.f, 0.f, 0.f}, ac = (f32x4){0.f, 0.f, 0.f, 0.f};
                    ap = mfma16(xv0, *(const LAS bf16x8*)(PS + (dir * 64 + ig) * 72 + 8 * fq), ap);
                    ap = mfma16(xv1, *(const LAS bf16x8*)(PS + (dir * 64 + ig) * 72 + 8 * fq + 32), ap);
#pragma unroll
                    for (int kk = 0; kk < 4; ++kk) ac = mfma16(xs[kk], *(const LAS bf16x8*)(QL + ig * PQ + 8 * fq + 32 * kk), ac);
                    const float wi = S[128 + ig], den = S[320 + ig] + S[384 + ig] + S[448 + ig] + S[512 + ig] + wi * S[256 + ig];
                    const float inv = 1.f / fmaxf(fabsf(den), S[192 + ig]);
#pragma unroll
                    for (int jj = 0; jj < 4; ++jj) o[it][jj] += (ap[jj] + wi * ac[jj]) * inv; } }
#pragma unroll
            for (int it = 0; it < 4; ++it) { float ss = o[it][0] * o[it][0] + o[it][1] * o[it][1] + o[it][2] * o[it][2] + o[it][3] * o[it][3];
                ss += __shfl_xor(ss, 16); ss += __shfl_xor(ss, 32); if (fq == 0) RED[wid * 64 + 16 * it + fr] = ss; }
            __syncthreads();
            const f32x4 gn = *(const f32x4*)(gain + 16 * wid + 4 * fq);
#pragma unroll
            for (int it = 0; it < 4; ++it) { float tot = 0.f;
#pragma unroll
                for (int w2 = 0; w2 < 8; ++w2) tot += RED[w2 * 64 + 16 * it + fr];
                const float rs = rsqrtf(tot * (1.f / 128.f) + EPS); const size_t row = r0 + 16 * it + fr;
                const uint2 gt = gtv[it];
                const float y0 = o[it][0] * rs * gn[0] * sigm(bf2f((bf16_t)(gt.x & 0xffff))), y1 = o[it][1] * rs * gn[1] * sigm(bf2f((bf16_t)(gt.x >> 16)));
                const float y2 = o[it][2] * rs * gn[2] * sigm(bf2f((bf16_t)(gt.y & 0xffff))), y3 = o[it][3] * rs * gn[3] * sigm(bf2f((bf16_t)(gt.y >> 16)));
                *(uint2*)(YS + row * 512 + h * 128 + 16 * wid + 4 * fq) = make_uint2(pack2(y0, y1), pack2(y2, y3)); }
        }
        __syncthreads();
    }
}

#ifndef CH_GLA
#define CH_GLA 1
#endif
#ifndef CH_HG
#define CH_HG 1
#endif
#ifndef CH_ML
#define CH_ML 1
#endif
#if CH_GLA
#define GLA_LOCAL(p, l) phase_gl_local<1>(p, l, L)
#define GLA_CARRY(p, l) phase_gl_carry<1>(p)
#define GLA_OUT(p, l) phase_gl_out<1>(p, l, L)
#else
#define GLA_LOCAL(p, l) phase_seq_gl<1>(p, l, (LAS float*)L)
#define GLA_CARRY(p, l)
#define GLA_OUT(p, l) phase_epi_norm<1>(p, l)
#endif
#if CH_HG
#define HG_LOCAL(p, l) phase_gl_local<2>(p, l, L)
#define HG_CARRY(p, l) phase_gl_carry<2>(p)
#define HG_OUT(p, l) phase_gl_out<2>(p, l, L)
#else
#define HG_LOCAL(p, l) phase_seq_gl<2>(p, l, (LAS float*)L)
#define HG_CARRY(p, l)
#define HG_OUT(p, l) phase_epi_norm<2>(p, l)
#endif
#if CH_ML
#define ML_LOCAL(p, l) phase_ml_local(p, l, L)
#define ML_CARRY(p, l) phase_gl_carry<3>(p)
#define ML_OUT(p, l) phase_ml_out(p, l, L)
#else
#define ML_LOCAL(p, l) phase_seq_ml(p, l, (LAS float*)L)
#define ML_CARRY(p, l)
#define ML_OUT(p, l) phase_epi_norm<3>(p, l)
#endif
constexpr int LDS_BYTES = 147456, NPH_LAYER = 22, NPH = 1 + 2 * NPH_LAYER;
__global__ void __launch_bounds__(512, 2) mega(P p_unused) {
    extern __shared__ __attribute__((aligned(16))) unsigned char lds[];
    LAS unsigned char* L = (LAS unsigned char*)lds;
    LAS int* tbl = (LAS int*)(L + 131072 + 1024);
    const int swid = __builtin_amdgcn_readfirstlane((int)(threadIdx.x >> 6));
    int lo, hi; unsigned* barw;
    { const PP p = load_args(swid); lo = p.ph_lo; hi = p.ph_hi; barw = (unsigned*)(p.ws + WS_CTL); }
    { const int t0 = (int)threadIdx.x; if (t0 < 4) ((LAS unsigned*)(L + LDS_BYTES - 16))[t0] = 0u; }
    __syncthreads();
    XcdBarrier bar; bar.bar = barw; bar.x = 0; bar.st = nullptr; bar.swid = swid;
    if (hi - lo > 1) bar = xcd_barrier_post(barw, (volatile LAS unsigned*)(L + LDS_BYTES - 16), swid);
#ifndef PHSEL
#define PHSEL(k) 1
#endif
#define IN(k) (PHSEL(k) && lo <= (k) && (k) < hi)
#define SEAM(k) do { if (IN((k) + 1)) xcd_barrier(bar); } while (0)
#define PHASE(k, ...) if (IN(k)) { const PP p = load_args(swid); unsigned char* ws = p.ws; unsigned char* wb = ws + WS_WB; unsigned char* big = ws + WS_BIG; (void)wb; (void)big; __VA_ARGS__ SEAM(k); }
    PHASE(0, phase_mods(p, (LAS float*)L);)
#define LAYER_BODY(l) { constexpr int pb = 1 + NPH_LAYER * (l); \
    PHASE(pb + 0, phase_convert(p, l, (LAS float*)L);) \
    PHASE(pb + 1, phase_norm1(p, l);) \
    PHASE(pb + 2, Gemm g{(const bf16_t*)(ws + WS_U), (const bf16_t*)(wb + WB_WIN), DM, DM, p.swid}; OrderPlain S; S.init(MT, 11, gridDim.x, blockIdx.x); S.skipctx = 0; \
        EpiZ E{(bf16_t*)(big + BIG_Z), (float*)(ws + WS_MISC), 10}; GEMM_RUN(EpiZ, OrderPlain, g, S, E);) \
    PHASE(pb + 3, phase_rg<false>(p, l, L); GLA_LOCAL(p, l);) \
    PHASE(pb + 4, phase_rg_carry(p); GLA_CARRY(p, l);) \
    PHASE(pb + 5, phase_rg<true>(p, l, L); GLA_OUT(p, l);) \
    PHASE(pb + 6, Gemm g{(const bf16_t*)(ws + WS_U), (const bf16_t*)(wb + WB_WIN) + (size_t)2816 * DM, DM, DM, p.swid}; OrderPlain S; S.init(MT, 10, gridDim.x, blockIdx.x); S.skipctx = 0; \
        EpiZ E{(bf16_t*)(big + BIG_Z), (float*)(ws + WS_MISC), -1}; GEMM_RUN(EpiZ, OrderPlain, g, S, E);) \
    PHASE(pb + 7, HG_LOCAL(p, l);) \
    PHASE(pb + 8, HG_CARRY(p, l);) \
    PHASE(pb + 9, HG_OUT(p, l);) \
    PHASE(pb + 10, Gemm g{(const bf16_t*)(ws + WS_U), (const bf16_t*)(wb + WB_WIN) + (size_t)5376 * DM, DM, DM, p.swid}; OrderPlain S; S.init(MT, 8, gridDim.x, blockIdx.x); S.skipctx = 0; \
        EpiZ E{(bf16_t*)(big + BIG_Z), (float*)(ws + WS_MISC), -1}; GEMM_RUN(EpiZ, OrderPlain, g, S, E);) \
    PHASE(pb + 11, ML_LOCAL(p, l);) \
    PHASE(pb + 12, ML_CARRY(p, l);) \
    PHASE(pb + 13, ML_OUT(p, l);) \
    PHASE(pb + 14, Gemm g{(const bf16_t*)(big + BIG_YS), (const bf16_t*)(wb + WB_WB), 512, 512, p.swid}; OrderBranch S; S.init((l) ? 64 : MT, 16, gridDim.x, blockIdx.x); S.skipctx = (l); \
        EpiBO E{(bf16_t*)(big + BIG_BO)}; GEMM_RUN(EpiBO, OrderBranch, g, S, E);) \
    PHASE(pb + 15, Gemm g{(const bf16_t*)(ws + WS_U), (const bf16_t*)(wb + WB_WM), DM, DM, p.swid}; OrderPlain S; S.init((l) ? 64 : MT, 16, gridDim.x, blockIdx.x); S.skipctx = (l); \
        EpiMerge E{(const bf16_t*)(big + BIG_BO), p.in[I_BMERGE] + (size_t)(l) * 4096, (bf16_t*)(big + BIG_MERGED)}; GEMM_RUN(EpiMerge, OrderPlain, g, S, E);) \
    PHASE(pb + 16, Gemm g{(const bf16_t*)(big + BIG_MERGED), (const bf16_t*)(wb + WB_WO), DM, DM, p.swid}; OrderPlain S; S.init((l) ? 64 : MT, 4, gridDim.x, blockIdx.x); S.skipctx = (l); \
        EpiOut E{(l) == 0 ? p.in[I_X] : p.out, (l) == 0 ? p.in[I_CTX] : (const float*)(ws + WS_HCTX), p.out, (float*)(ws + WS_HCTX), (const float*)(ws + WS_MOD) + (size_t)(l) * 3 * 6144}; \
        GEMM_RUN(EpiOut, OrderPlain, g, S, E);) \
    PHASE(pb + 17, phase_route(p, l, L);) \
    PHASE(pb + 18, phase_dispatch(p, l, tbl);) \
    PHASE(pb + 19, const int nblk = moe_tables(p, l, tbl); Gemm g{(const bf16_t*)(big + BIG_XS), (const bf16_t*)(wb + WB_W13), DM, DM, p.swid}; OrderMoe S; S.init(nblk, 4, gridDim.x, blockIdx.x); S.blk_e = tbl + 32; \
        EpiH E{(bf16_t*)(big + BIG_HS)}; GEMM_RUN(EpiH, OrderMoe, g, S, E);) \
    PHASE(pb + 20, const int nblk = moe_tables(p, l, tbl); Gemm g{(const bf16_t*)(big + BIG_HS), (const bf16_t*)(wb + WB_W2), 512, 512, p.swid}; OrderMoe S; S.init(nblk, 4, gridDim.x, blockIdx.x); S.blk_e = tbl + 32; \
        EpiY E{(bf16_t*)(big + BIG_YM)}; GEMM_RUN(EpiY, OrderMoe, g, S, E);) \
    PHASE(pb + 21, phase_combine(p, l);) }
    LAYER_BODY(0)
    LAYER_BODY(1)
#undef LAYER_BODY
#undef PHASE
#undef SEAM
#undef IN
}

#ifndef N_LAUNCHES
#define N_LAUNCHES 1
#endif
extern "C" void kernel_launch(void* const* d_in, const int* in_sizes, int n_in, void* d_out, int out_size, void* d_ws, size_t ws_size, hipStream_t stream) {
    static int grid = 0;
    if (grid == 0) {
        if (n_in != N_IN || out_size != NBATCH * SEQL * DM || ws_size < WS_END) { fprintf(stderr, "kernel_launch: unexpected shapes (n_in %d out %d ws %zu need %zu)\n", n_in, out_size, ws_size, (size_t)WS_END); grid = -1; return; }
        int dev = 0, cus = 0, per_cu = 0;
        if (hipGetDevice(&dev) != hipSuccess || hipDeviceGetAttribute(&cus, hipDeviceAttributeMultiprocessorCount, dev) != hipSuccess) { grid = -1; return; }
        if (hipFuncSetAttribute((const void*)mega, hipFuncAttributeMaxDynamicSharedMemorySize, LDS_BYTES) != hipSuccess) { grid = -1; return; }
        if (hipOccupancyMaxActiveBlocksPerMultiprocessor(&per_cu, (const void*)mega, 512, LDS_BYTES) != hipSuccess || per_cu < 1) { fprintf(stderr, "kernel_launch: occupancy query says %d\n", per_cu); }
        (void)hipGetLastError();
        grid = cus;
    }
    if (grid < 0) return;
    (void)hipMemsetAsync((char*)d_ws + WS_CTL, 0, 65536, stream);
    P p{};
    for (int i = 0; i < N_IN; ++i) p.in[i] = (const float*)d_in[i];
    p.out = (float*)d_out; p.ws = (unsigned char*)d_ws;
    if (N_LAUNCHES == 1) { p.ph_lo = 0; p.ph_hi = NPH; hipLaunchKernelGGL(mega, dim3(grid), dim3(512), LDS_BYTES, stream, p); }
    else for (int k = 0; k < NPH; ++k) { p.ph_lo = k; p.ph_hi = k + 1; hipLaunchKernelGGL(mega, dim3(grid), dim3(512), LDS_BYTES, stream, p); }
}
```

```cpp
#include <hip/hip_runtime.h>
#include <cstdio>
#include <cstdint>

#define LAS __attribute__((address_space(3)))
typedef unsigned short bf16_t;
typedef short bf16x8 __attribute__((ext_vector_type(8)));
typedef float f32x4 __attribute__((ext_vector_type(4)));
typedef unsigned u32x4 __attribute__((ext_vector_type(4)));
typedef unsigned u32x2 __attribute__((ext_vector_type(2)));

#define XB_TMO      128
#define XB_XCNT(j)  (256  + 64 * (j))
#define XB_XSUB(j)  (1280 + 64 * (j))
#define XB_XGEN(j)  (2304 + 64 * (j))
#define XB_TOP      3328
#define XB_TOPGEN   3392
#define XCD_BAR_WORDS 3456
#define XB_SPIN_CAP (1u << 18)

__device__ __forceinline__ unsigned xb_ld(unsigned* p)              { return __hip_atomic_load(p, __ATOMIC_RELAXED, __HIP_MEMORY_SCOPE_AGENT); }
__device__ __forceinline__ unsigned xb_add(unsigned* p, unsigned v) { return __hip_atomic_fetch_add(p, v, __ATOMIC_RELAXED, __HIP_MEMORY_SCOPE_AGENT); }
__device__ __forceinline__ unsigned xb_xcc_id() { return (unsigned)__builtin_amdgcn_s_getreg((3 << 11) | 20) & 0xFu; }
#define XB_SPIN(cond, bar) do { unsigned _sp = 0; while (cond) { __builtin_amdgcn_s_sleep(1); \
    if ((++_sp & 255u) == 0u) { if (xb_ld(&(bar)[XB_TMO])) break; if (_sp > XB_SPIN_CAP) { atomicAdd(&(bar)[XB_TMO], 1u); break; } } } } while (0)

struct XcdBarrier {
    unsigned* bar; unsigned x;
    int swid;
    volatile LAS unsigned* st;
};

__device__ __forceinline__ XcdBarrier xcd_barrier_post(unsigned* bar, volatile LAS unsigned* st, int swid) {
    XcdBarrier b; b.bar = bar; b.x = xb_xcc_id(); b.st = st; b.swid = swid;
    if (swid == 0 && __builtin_amdgcn_mbcnt_hi(~0u, __builtin_amdgcn_mbcnt_lo(~0u, 0u)) == 0u) (void)xb_add(&bar[XB_XCNT(b.x)], 1u);
    return b;
}
__device__ __forceinline__ void xcd_barrier_complete(unsigned* bar, unsigned x, unsigned& nloc, unsigned& nx) {
    const unsigned G = gridDim.x * gridDim.y * gridDim.z;
    unsigned sum, cnt, mine, sp = 0u;
    for (;;) {
        sum = 0u; cnt = 0u; mine = 0u;
#pragma unroll
        for (unsigned j = 0; j < 16; ++j) { const unsigned c = xb_ld(&bar[XB_XCNT(j)]); sum += c; cnt += (c > 0u) ? 1u : 0u; mine = (j == x) ? c : mine; }
        if (sum == G) break;
        __builtin_amdgcn_s_sleep(1);
        if ((++sp & 255u) == 0u) { if (xb_ld(&bar[XB_TMO])) break; if (sp > XB_SPIN_CAP) { atomicAdd(&bar[XB_TMO], 1u); break; } }
    }
    nloc = mine > 0u ? mine : 1u; nx = cnt > 0u ? cnt : 1u;
}

__device__ __forceinline__ void xcd_barrier(const XcdBarrier& b) {
    asm volatile("s_waitcnt vmcnt(0)" ::: "memory");
    __syncthreads();
    if (b.swid == 0 && __builtin_amdgcn_mbcnt_hi(~0u, __builtin_amdgcn_mbcnt_lo(~0u, 0u)) == 0u) {
        unsigned* bar = b.bar;
        __builtin_amdgcn_s_waitcnt(0);
        unsigned nloc = b.st[0], nx = b.st[1];
        if (nloc == 0u) { xcd_barrier_complete(bar, b.x, nloc, nx); b.st[0] = nloc; b.st[1] = nx; }
        const unsigned old = xb_add(&bar[XB_XSUB(b.x)], 1u);
        const unsigned gen = old / nloc;
        if (old + 1u == (gen + 1u) * nloc) {
            __builtin_amdgcn_fence(__ATOMIC_RELEASE, "agent");
            asm volatile("s_waitcnt vmcnt(0)" ::: "memory");
            const unsigned og = xb_add(&bar[XB_TOP], 1u);
            const unsigned tg = og / nx;
            if (og + 1u == (tg + 1u) * nx) xb_add(&bar[XB_TOPGEN], 1u);
            else XB_SPIN(xb_ld(&bar[XB_TOPGEN]) == tg, bar);
            __builtin_amdgcn_fence(__ATOMIC_ACQUIRE, "agent");
            xb_add(&bar[XB_XGEN(b.x)], 1u);
            asm volatile("s_waitcnt vmcnt(0)" ::: "memory");
        } else {
            XB_SPIN(xb_ld(&bar[XB_XGEN(b.x)]) == gen, bar);
            __builtin_amdgcn_fence(__ATOMIC_ACQUIRE, "agent");
            asm volatile("s_waitcnt vmcnt(0)" ::: "memory");
        }
    }
    __syncthreads();
}


constexpr int DM = 1024, NBATCH = 2, SEQL = 8192, CTXL = 256, NTOK = 8448, TT = 16896, NCHUNK = 132, MT = 66;
constexpr int ZLD = 2560;
constexpr float EPS = 1e-6f;
constexpr int RGX = 0, RGY = 512, GQ = 1024, GK = 1280, GV = 1536, GG = 2048;
constexpr int HQ = 0, HI = 512, HF = 1024, HGT = 2048;
constexpr int MQ = 0, MK = 512, MV = 1024, MO = 1536;
constexpr int MISC_LR = 0, MISC_IF = 32;
constexpr int NSLOT_MAX = 37888;

enum { I_X = 0, I_C, I_CTX, I_CCTX, I_ADAW, I_ADAB, I_NMIXG, I_NFFNG, I_WIN, I_RGCW, I_RGCB, I_RGGW, I_RGGB, I_RGLAM, I_GLAWLR, I_GLABLR, I_GLANG,
       I_HGLB, I_HGNG, I_MLCW, I_MLCB, I_MLGB, I_MLNG, I_WBR, I_WMERGE, I_BMERGE, I_WOUT, I_MWG, I_MBG, I_MWE, I_MBE, I_MW1, I_MW3, I_MW2, I_FNG, N_IN };

constexpr size_t WS_CTL = 0;
constexpr size_t WS_MOD = 65536;
constexpr size_t WS_HCTX = 262144;
constexpr size_t WS_ROUTE = WS_HCTX + 2097152;
constexpr size_t WS_MISC = WS_ROUTE + 1048576;
constexpr size_t WS_SMALL = WS_MISC + 4325376;
constexpr size_t WS_WB = WS_SMALL + 8388608;
constexpr size_t WB_WIN = 0, WB_WM = WB_WIN + 15204352, WB_WB = WB_WM + 8388608, WB_WO = WB_WB + 4194304, WB_W13 = WB_WO + 2097152,
                 WB_W2 = WB_W13 + 33554432, WB_GW = WB_W2 + 16777216, WB_END = WB_GW + 262144;
constexpr size_t WS_U = WS_WB + WB_END;
constexpr size_t WS_BIG = WS_U + 34603008;
constexpr size_t BIG_Z = 0, BIG_ST = 86507520, BIG_YS = BIG_ST + 69206016 + 65536, BIG_END = BIG_YS + 69206016;
constexpr size_t WS_WB2 = WS_BIG + BIG_END;
constexpr size_t WS_END = WS_WB2 + 33554432 + 16777216;
constexpr size_t BIG_BO = 0;
constexpr size_t BIG_MERGED = BIG_YS;
constexpr size_t BIG_XS = 0;
constexpr size_t BIG_HS = 77594624;
constexpr size_t BIG_YM = BIG_HS + 38797312;
static_assert(BIG_YM + 77594624 <= BIG_END, "moe alias");
static_assert(138412032 <= BIG_YS, "BO alias");
constexpr int CW_CNT = 4096;

struct P { const float* in[N_IN]; float* out; unsigned char* ws; int ph_lo, ph_hi; };
struct PP : P { int swid; };

__device__ __forceinline__ float bf2f(bf16_t b) { return __uint_as_float(((unsigned)b) << 16); }
typedef float f32x2_t __attribute__((ext_vector_type(2)));
typedef __bf16 bf16x2_t __attribute__((ext_vector_type(2)));
__device__ __forceinline__ unsigned pack2(float lo, float hi) { const f32x2_t v = {lo, hi}; const bf16x2_t b = __builtin_convertvector(v, bf16x2_t); return __builtin_bit_cast(unsigned, b); }
__device__ __forceinline__ bf16_t f2bf(float f) { return (bf16_t)(pack2(f, 0.f) & 0xffffu); }
__device__ __forceinline__ float frcp(float x) { return __builtin_amdgcn_rcpf(x); }
__device__ __forceinline__ float sigm(float x) { return frcp(1.f + __expf(-x)); }
__device__ __forceinline__ float siluf(float x) { return x * sigm(x); }
__device__ __forceinline__ float logsig(float x) { return fminf(x, 0.f) - __logf(1.f + __expf(-fabsf(x))); }
__device__ __forceinline__ float softplusf(float x) { return fmaxf(x, 0.f) + __logf(1.f + __expf(-fabsf(x))); }
__device__ __forceinline__ float gelu_tanh(float x) { const float y = 0.7978845608028654f * (x + 0.044715f * x * x * x); const float t = 1.f - 2.f * frcp(__expf(2.f * y) + 1.f); return 0.5f * x * (1.f + t); }
__device__ __forceinline__ float wave_sum(float v) {
#pragma unroll
    for (int o = 32; o > 0; o >>= 1) v += __shfl_xor(v, o);
    return v;
}
__device__ __forceinline__ int lane_id() { return (int)__builtin_amdgcn_mbcnt_hi(~0u, __builtin_amdgcn_mbcnt_lo(~0u, 0u)); }
__device__ __forceinline__ int otid(int swid) { int t = swid * 64 + lane_id(); asm volatile("" : "+v"(t)); return t; }
__device__ __forceinline__ const float* hrow_c(const float* HL, const float* HC, int r) { const int b = r / NTOK, p = r - b * NTOK; return p < CTXL ? HC + ((size_t)b * CTXL + p) * DM : HL + ((size_t)b * SEQL + (p - CTXL)) * DM; }
__device__ __forceinline__ float* hrow_m(float* HL, float* HC, int r) { const int b = r / NTOK, p = r - b * NTOK; return p < CTXL ? HC + ((size_t)b * CTXL + p) * DM : HL + ((size_t)b * SEQL + (p - CTXL)) * DM; }
__device__ __forceinline__ int mod_idx(int r) { const int b = r / NTOK, p = r - b * NTOK; return p < CTXL ? 2 : b; }

typedef const __attribute__((address_space(4))) P* KP;
__device__ __forceinline__ PP load_args(int swid) { unsigned long long a = (unsigned long long)__builtin_amdgcn_kernarg_segment_ptr(); asm volatile("" : "+s"(a)); KP k = (KP)a; PP r; r.swid = swid;
#pragma unroll
    for (int i = 0; i < N_IN; ++i) r.in[i] = k->in[i];
    r.out = k->out; r.ws = k->ws; r.ph_lo = k->ph_lo; r.ph_hi = k->ph_hi; return r; }
struct Unit { int pm, pn; };
struct Gemm { const bf16_t* A; const bf16_t* Bt; int lda; int K; int swid; };

struct TileOrder {
    int nM, nN, G, c;
    __device__ __forceinline__ void a_ready(const Unit&) const {}
    __device__ __forceinline__ void done(const Unit&) const {}
    __device__ void init(int nM_, int nN_, int G_, int c_) { nM = nM_; nN = nN_; G = G_; c = c_; }
    __device__ __forceinline__ bool base(int i, Unit& u) const { const long L = (long)i * G + c; if (L >= (long)nM * nN) return false; u.pm = (int)(L / nN); u.pn = (int)(L % nN); return true; }
};
struct OrderPlain : TileOrder { int skipctx; __device__ __forceinline__ bool next(int i, Unit& u) const { if (!base(i, u)) return false; if (skipctx) u.pm = u.pm < 32 ? u.pm + 1 : u.pm + 2; return true; } };
struct OrderBranch : TileOrder { int skipctx; __device__ __forceinline__ bool next(int i, Unit& u) const { if (!base(i, u)) return false; int pm = u.pm; if (skipctx) pm = pm < 32 ? pm + 1 : pm + 2; u.pm = (u.pn >> 2) * MT + pm; return true; } };
struct OrderMoe : TileOrder { const LAS int* blk_e; __device__ __forceinline__ bool next(int i, Unit& u) const { if (!base(i, u)) return false; u.pn = blk_e[u.pm] * 4 + u.pn; return true; } };

template <class Epi, class Sched>
__device__ __forceinline__ void gemm_simple(const Gemm g, const Sched& S, const Epi& E) {
    const int tid = otid(g.swid), wid = tid >> 6, lane = tid & 63, wr = wid >> 2, wc = wid & 3, fr = lane & 15, fq = lane >> 4;
    Unit u;
    for (int it = 0; S.next(it, u); ++it) {
        f32x4 acc[2][2][4][2];
#pragma unroll
        for (int a = 0; a < 2; ++a)
#pragma unroll
            for (int b = 0; b < 2; ++b)
#pragma unroll
                for (int m = 0; m < 4; ++m)
#pragma unroll
                    for (int n = 0; n < 2; ++n) acc[a][b][m][n] = (f32x4){0.f, 0.f, 0.f, 0.f};
        const bf16_t* Ap = g.A + (size_t)(u.pm * 256 + wr * 64 + fr) * g.lda + fq * 8;
        const bf16_t* Bp = g.Bt + (size_t)(u.pn * 256 + wc * 32 + fr) * g.K + fq * 8;
        for (int k0 = 0; k0 < g.K; k0 += 32) {
            bf16x8 b[2][2];
#pragma unroll
            for (int bj = 0; bj < 2; ++bj)
#pragma unroll
                for (int n = 0; n < 2; ++n) b[bj][n] = *(const bf16x8*)(Bp + (size_t)(bj * 128 + n * 16) * g.K + k0);
#pragma unroll
            for (int ai = 0; ai < 2; ++ai) {
                bf16x8 a[4];
#pragma unroll
                for (int m = 0; m < 4; ++m) a[m] = *(const bf16x8*)(Ap + (size_t)(ai * 128 + m * 16) * g.lda + k0);
#pragma unroll
                for (int bj = 0; bj < 2; ++bj)
#pragma unroll
                    for (int m = 0; m < 4; ++m)
#pragma unroll
                        for (int n = 0; n < 2; ++n) acc[ai][bj][m][n] = __builtin_amdgcn_mfma_f32_16x16x32_bf16(b[bj][n], a[m], acc[ai][bj][m][n], 0, 0, 0);
                __builtin_amdgcn_sched_barrier(0);
            }
        }
        E(acc, u, wr, wc, fr, fq);
    }
}

#define PG8_LAS __attribute__((address_space(3)))
constexpr int BM = 256, BK = 64, HALF = 128, HTB = HALF * BK * 2  , STAGE_BYTES = 8 * HTB;
__host__ __device__ __forceinline__ int lds_byte(int r, int c) { const int st = (r >> 4) * 2 + (c >> 5), rr = r & 15, cc = c & 31, ob = rr * 64 + cc * 2; return st * 1024 + (ob ^ (((ob >> 9) & 1) << 5)); }
__host__ __device__ __forceinline__ void stage_rc(int b, int& R, int& C) { const int st = b / 1024, sb = b % 1024, swz = sb ^ (((sb >> 9) & 1) << 5); R = (st >> 1) * 16 + swz / 64; C = (st & 1) * 32 + (swz % 64) / 2; }
__host__ __device__ __forceinline__ int perm32(int rho) { const int n = rho >> 4, i = rho & 15; return 8 * (i >> 2) + 4 * n + (i & 3); }
template <class Epi, class Sched, bool STAMP = false>
__device__ __forceinline__ void gemm_phase(PG8_LAS unsigned char* lds, const Gemm g, const Sched& S, const Epi& E, unsigned long long* stamps = nullptr) {
    const int tid = otid(g.swid), wid = g.swid, lane = tid & 63, wr = wid >> 2, wc = wid & 3, fr = lane & 15, fq = lane >> 4;
    const int K = g.K, nt = K / BK;
    int ts_lo = 0, ts_hi = 0, nts = 0; const unsigned long long rt_entry = STAMP ? (unsigned long long)wall_clock64() : 0ull;
#define PG8_STAMP() do { if (STAMP && wid == 0 && nts < 64) { const unsigned long long _c = (unsigned long long)clock64(); \
        ts_lo = (lane == nts) ? (int)(unsigned)_c : ts_lo; ts_hi = (lane == nts) ? (int)(unsigned)(_c >> 32) : ts_hi; ++nts; } } while (0)
    PG8_STAMP();
    unsigned voffA[2], voffB[2];
#pragma unroll
    for (int i = 0; i < 2; ++i) { int R, C; stage_rc(tid * 16 + i * 8192, R, C); const int Rb = Epi::PERM ? ((R & ~31) + perm32(R & 31)) : R;
        voffA[i] = (unsigned)(R * K + C) * 2u; voffB[i] = (unsigned)(Rb * K + C) * 2u; }
    const size_t kstep = (size_t)(BK * 2);
    const size_t hstep = (size_t)HALF * K * 2;
    const size_t tstep = 2 * hstep;
    const unsigned ldsw = (unsigned)wid * 1024u;
    const int aoff = lds_byte(wr * 64 + fr, fq * 8), boff = lds_byte(wc * 32 + fr, fq * 8);
#define PG8_SA(b, h) (((b) * 2 + (h)) * HTB)
#define PG8_SB(b, h) ((4 + (b) * 2 + (h)) * HTB)
#define PG8_STAGE(bufoff, gbase, voff) do { _Pragma("unroll") for (int _i = 0; _i < 2; ++_i) \
        __builtin_amdgcn_global_load_lds((const unsigned*)((const char*)(gbase) + (voff)[_i]), (PG8_LAS unsigned*)(lds + (bufoff) + ldsw + _i * 8192), 16, 0, 0); } while (0)
#define PG8_LDA(dst, b, h) do { _Pragma("unroll") for (int m = 0; m < 4; ++m) _Pragma("unroll") for (int k = 0; k < 2; ++k) dst[m][k] = *(const PG8_LAS bf16x8*)(lds + PG8_SA(b, h) + aoff + m * 2048 + k * 1024); } while (0)
#define PG8_LDB(dst, b, h) do { _Pragma("unroll") for (int n = 0; n < 2; ++n) _Pragma("unroll") for (int k = 0; k < 2; ++k) dst[n][k] = *(const PG8_LAS bf16x8*)(lds + PG8_SB(b, h) + boff + n * 2048 + k * 1024); } while (0)
#define PG8_MMA(ai, bj, At, Bt) do { __builtin_amdgcn_s_setprio(1); _Pragma("unroll") for (int m = 0; m < 4; ++m) _Pragma("unroll") for (int n = 0; n < 2; ++n) _Pragma("unroll") for (int k = 0; k < 2; ++k) \
        acc[ai][bj][m][n] = __builtin_amdgcn_mfma_f32_16x16x32_bf16(Bt[n][k], At[m][k], acc[ai][bj][m][n], 0, 0, 0); __builtin_amdgcn_s_setprio(0); } while (0)
#define PG8_WAIT_V(n) asm volatile("s_waitcnt vmcnt(" #n ")" ::: "memory")
#define PG8_WAIT_L(n) asm volatile("s_waitcnt lgkmcnt(" #n ")" ::: "memory")
#define PG8_BAR __builtin_amdgcn_s_barrier()
#define PG8_SCHED __builtin_amdgcn_sched_barrier(0)
    Unit cur, nxt; int ui = 0;
    if (!S.next(0, cur)) return;
    f32x4 acc[2][2][4][2];
#pragma unroll
    for (int a = 0; a < 2; ++a)
#pragma unroll
        for (int b = 0; b < 2; ++b)
#pragma unroll
            for (int m = 0; m < 4; ++m)
#pragma unroll
                for (int n = 0; n < 2; ++n) acc[a][b][m][n] = (f32x4){0.f, 0.f, 0.f, 0.f};
    bf16x8 At[4][2], B0[2][2], B1[2][2];
    const char* cA = (const char*)g.A + (size_t)cur.pm * tstep; const char* cB = (const char*)g.Bt + (size_t)cur.pn * tstep;
    S.a_ready(cur);
    PG8_STAGE(PG8_SB(0, 0), cB, voffB); PG8_STAGE(PG8_SA(0, 0), cA, voffA); PG8_STAGE(PG8_SB(0, 1), cB + hstep, voffB); PG8_STAGE(PG8_SA(0, 1), cA + hstep, voffA);
    if (wr == 1) PG8_BAR;
    PG8_WAIT_V(4); PG8_BAR;
    PG8_STAGE(PG8_SB(1, 0), cB + kstep, voffB); PG8_STAGE(PG8_SA(1, 0), cA + kstep, voffA); PG8_STAGE(PG8_SB(1, 1), cB + hstep + kstep, voffB);
    PG8_WAIT_V(6); PG8_BAR;
    PG8_STAMP();
    for (;;) {
        const bool has_next = S.next(ui + 1, nxt);
        const char* nA = has_next ? (const char*)g.A + (size_t)nxt.pm * tstep : cA; const char* nB = has_next ? (const char*)g.Bt + (size_t)nxt.pn * tstep : cB;
        for (int t = 0; t < nt; t += 2) {
            const bool last = (t == nt - 2);
            const char* a1 = cA + (size_t)(t + 1) * kstep;
            const char* a2 = last ? nA : cA + (size_t)(t + 2) * kstep; const char* b2 = last ? nB : cB + (size_t)(t + 2) * kstep;
            const char* a3 = a2 + kstep; const char* b3 = b2 + kstep;
            if (last && has_next) S.a_ready(nxt);
            PG8_LDB(B0, 0, 0); PG8_SCHED; PG8_LDA(At, 0, 0); PG8_STAGE(PG8_SA(1, 1), a1 + hstep, voffA);
            PG8_WAIT_L(8); PG8_BAR; PG8_WAIT_L(0); PG8_MMA(0, 0, At, B0); PG8_BAR; PG8_SCHED;
            PG8_LDB(B1, 0, 1); PG8_STAGE(PG8_SB(0, 0), b2, voffB);
            PG8_BAR; PG8_WAIT_L(0); PG8_MMA(0, 1, At, B1); PG8_BAR;
            PG8_LDA(At, 0, 1); PG8_STAGE(PG8_SA(0, 0), a2, voffA);
            PG8_BAR; PG8_WAIT_L(0); PG8_MMA(1, 0, At, B0); PG8_BAR; PG8_SCHED;
            PG8_STAGE(PG8_SB(0, 1), b2 + hstep, voffB);
            PG8_WAIT_V(6); PG8_BAR; PG8_MMA(1, 1, At, B1); PG8_BAR;
            PG8_LDB(B0, 1, 0); PG8_SCHED; PG8_LDA(At, 1, 0); PG8_STAGE(PG8_SA(0, 1), a2 + hstep, voffA);
            PG8_WAIT_L(8); PG8_BAR; PG8_WAIT_L(0); PG8_MMA(0, 0, At, B0); PG8_BAR; PG8_SCHED;
            PG8_LDB(B1, 1, 1); PG8_STAGE(PG8_SB(1, 0), b3, voffB);
            PG8_BAR; PG8_WAIT_L(0); PG8_MMA(0, 1, At, B1); PG8_BAR;
            PG8_LDA(At, 1, 1); PG8_STAGE(PG8_SA(1, 0), a3, voffA);
            PG8_BAR; PG8_WAIT_L(0); PG8_MMA(1, 0, At, B0); PG8_BAR; PG8_SCHED;
            PG8_STAGE(PG8_SB(1, 1), b3 + hstep, voffB);
            PG8_WAIT_V(6); PG8_BAR; PG8_MMA(1, 1, At, B1); PG8_BAR;
        }
        PG8_STAMP();
        if constexpr (!Epi::AFTER_DRAIN) { E(acc, cur, wr, wc, fr, fq); S.done(cur); }
        PG8_STAMP();
        if (!has_next) break;
#pragma unroll
        for (int a = 0; a < 2; ++a)
#pragma unroll
            for (int b = 0; b < 2; ++b)
#pragma unroll
                for (int m = 0; m < 4; ++m)
#pragma unroll
                    for (int n = 0; n < 2; ++n) acc[a][b][m][n] = (f32x4){0.f, 0.f, 0.f, 0.f};
        cur = nxt; cA = nA; cB = nB; ++ui;
    }
    PG8_WAIT_V(0);
    if (wr == 0) PG8_BAR;
    PG8_BAR;
    if constexpr (Epi::AFTER_DRAIN) { E.fused(acc, cur, wr, wc, fr, fq, lds, wid, lane); S.done(cur); }
    PG8_STAMP();
    if (STAMP && wid == 0) { stamps[lane] = lane < nts ? (((unsigned long long)(unsigned)ts_hi << 32) | (unsigned)ts_lo) : 0ull;
        if (lane == 62) stamps[62] = rt_entry; if (lane == 63) stamps[63] = (unsigned long long)wall_clock64(); }
#undef PG8_STAMP
#undef PG8_SA
#undef PG8_SB
#undef PG8_STAGE
#undef PG8_LDA
#undef PG8_LDB
#undef PG8_MMA
#undef PG8_WAIT_V
#undef PG8_WAIT_L
#undef PG8_BAR
#undef PG8_SCHED
}

#ifdef USE_SIMPLE_GEMM
#define GEMM_RUN(EpiT, SchedT, g, S, E) gemm_simple<EpiT, SchedT>(g, S, E)
#else
#define GEMM_RUN(EpiT, SchedT, g, S, E) gemm_phase<EpiT, SchedT>(L, g, S, E)
#endif


struct EpiZ {
    static constexpr bool PERM = false, AFTER_DRAIN = false;
    bf16_t* Z; float* MISC; int misc_pn;
    __device__ __forceinline__ void operator()(const f32x4 (&acc)[2][2][4][2], const Unit& u, int wr, int wc, int fr, int fq) const {
        const int row0 = u.pm * 256 + wr * 64 + fr, col0 = u.pn * 256 + wc * 32 + 4 * fq;
#pragma unroll
        for (int ai = 0; ai < 2; ++ai)
#pragma unroll
            for (int m = 0; m < 4; ++m) { const int row = row0 + ai * 128 + m * 16;
#pragma unroll
                for (int bj = 0; bj < 2; ++bj)
#pragma unroll
                    for (int n = 0; n < 2; ++n) { const int col = col0 + bj * 128 + n * 16; const f32x4 v = acc[ai][bj][m][n];
                        if (u.pn == misc_pn) { const int cc = col - misc_pn * 256; if (cc < 64) *(f32x4*)(MISC + (size_t)row * 64 + cc) = v; }
                        else *(uint2*)(Z + (size_t)row * ZLD + col) = make_uint2(pack2(v[0], v[1]), pack2(v[2], v[3])); } }
    }
};
struct EpiBO {
    static constexpr bool PERM = false, AFTER_DRAIN = false;
    bf16_t* BO;
    __device__ __forceinline__ void operator()(const f32x4 (&acc)[2][2][4][2], const Unit& u, int wr, int wc, int fr, int fq) const {
        const int kb = u.pn >> 2, pm = u.pm - kb * MT, pn = u.pn & 3;
        const int row0 = pm * 256 + wr * 64 + fr, col0 = pn * 256 + wc * 32 + 4 * fq;
        bf16_t* base = BO + (size_t)kb * TT * DM;
#pragma unroll
        for (int ai = 0; ai < 2; ++ai)
#pragma unroll
            for (int m = 0; m < 4; ++m) { const int row = row0 + ai * 128 + m * 16;
#pragma unroll
                for (int bj = 0; bj < 2; ++bj)
#pragma unroll
                    for (int n = 0; n < 2; ++n) { const int col = col0 + bj * 128 + n * 16; const f32x4 v = acc[ai][bj][m][n];
                        *(uint2*)(base + (size_t)row * DM + col) = make_uint2(pack2(v[0], v[1]), pack2(v[2], v[3])); } }
    }
};
struct EpiMerge {
    static constexpr bool PERM = false, AFTER_DRAIN = false;
    const bf16_t* BO; const float* bm; bf16_t* MG;
    __device__ __forceinline__ void operator()(const f32x4 (&acc)[2][2][4][2], const Unit& u, int wr, int wc, int fr, int fq) const {
        const int row0 = u.pm * 256 + wr * 64 + fr, c0 = u.pn * 64 + wc * 16 + 4 * fq;
#pragma unroll
        for (int ai = 0; ai < 2; ++ai)
#pragma unroll
            for (int m = 0; m < 4; ++m) { const int row = row0 + ai * 128 + m * 16; f32x4 s = (f32x4){0.f, 0.f, 0.f, 0.f};
#pragma unroll
                for (int bj = 0; bj < 2; ++bj)
#pragma unroll
                    for (int n = 0; n < 2; ++n) { const int kb = 2 * bj + n; const f32x4 a = acc[ai][bj][m][n]; const f32x4 bb = *(const f32x4*)(bm + kb * DM + c0);
                        const uint2 bo = *(const uint2*)(BO + ((size_t)kb * TT + row) * DM + c0);
                        s[0] += sigm(a[0] + bb[0]) * bf2f((bf16_t)(bo.x & 0xffff)); s[1] += sigm(a[1] + bb[1]) * bf2f((bf16_t)(bo.x >> 16));
                        s[2] += sigm(a[2] + bb[2]) * bf2f((bf16_t)(bo.y & 0xffff)); s[3] += sigm(a[3] + bb[3]) * bf2f((bf16_t)(bo.y >> 16)); }
                *(uint2*)(MG + (size_t)row * DM + c0) = make_uint2(pack2(s[0], s[1]), pack2(s[2], s[3])); }
    }
};
struct EpiOut {
    static constexpr bool PERM = false, AFTER_DRAIN = false;
    const float* sL; const float* sC; float* dL; float* dC; const float* mod;
    __device__ __forceinline__ void operator()(const f32x4 (&acc)[2][2][4][2], const Unit& u, int wr, int wc, int fr, int fq) const {
        const int row0 = u.pm * 256 + wr * 64 + fr, col0 = u.pn * 256 + wc * 32 + 4 * fq;
        const int mv = mod_idx(u.pm * 256);
        const float* g1 = mod + mv * 6144 + 2 * DM;
#pragma unroll
        for (int ai = 0; ai < 2; ++ai)
#pragma unroll
            for (int m = 0; m < 4; ++m) { const int row = row0 + ai * 128 + m * 16; const float* src = hrow_c(sL, sC, row); float* dst = hrow_m(dL, dC, row);
#pragma unroll
                for (int bj = 0; bj < 2; ++bj)
#pragma unroll
                    for (int n = 0; n < 2; ++n) { const int col = col0 + bj * 128 + n * 16; const f32x4 v = acc[ai][bj][m][n];
                        const f32x4 h = *(const f32x4*)(src + col), gg = *(const f32x4*)(g1 + col);
                        *(f32x4*)(dst + col) = h + gg * v; } }
    }
};
struct EpiH {
    static constexpr bool PERM = false, AFTER_DRAIN = false;
    bf16_t* HS;
    __device__ __forceinline__ void operator()(const f32x4 (&acc)[2][2][4][2], const Unit& u, int wr, int wc, int fr, int fq) const {
        const int pn = u.pn & 3, row0 = u.pm * 256 + wr * 64 + fr, hc0 = pn * 128 + wc * 16 + 4 * fq;
#pragma unroll
        for (int ai = 0; ai < 2; ++ai)
#pragma unroll
            for (int m = 0; m < 4; ++m) { const int row = row0 + ai * 128 + m * 16;
#pragma unroll
                for (int bj = 0; bj < 2; ++bj) { const f32x4 a = acc[ai][bj][m][0], c = acc[ai][bj][m][1];
                    *(uint2*)(HS + (size_t)row * 512 + hc0 + bj * 64) = make_uint2(pack2(siluf(a[0]) * c[0], siluf(a[1]) * c[1]), pack2(siluf(a[2]) * c[2], siluf(a[3]) * c[3])); } }
    }
};
struct EpiY {
    static constexpr bool PERM = false, AFTER_DRAIN = false;
    bf16_t* YM;
    __device__ __forceinline__ void operator()(const f32x4 (&acc)[2][2][4][2], const Unit& u, int wr, int wc, int fr, int fq) const {
        const int pn = u.pn & 3, row0 = u.pm * 256 + wr * 64 + fr, col0 = pn * 256 + wc * 32 + 4 * fq;
#pragma unroll
        for (int ai = 0; ai < 2; ++ai)
#pragma unroll
            for (int m = 0; m < 4; ++m) { const int row = row0 + ai * 128 + m * 16;
#pragma unroll
                for (int bj = 0; bj < 2; ++bj)
#pragma unroll
                    for (int n = 0; n < 2; ++n) { const int col = col0 + bj * 128 + n * 16; const f32x4 v = acc[ai][bj][m][n];
                        *(uint2*)(YM + (size_t)row * DM + col) = make_uint2(pack2(v[0], v[1]), pack2(v[2], v[3])); } }
    }
};

__device__ __forceinline__ void phase_mods(const PP& p, LAS float* lds) {
    const int tid = otid(p.swid);
    float* MOD = (float*)(p.ws + WS_MOD);
    LAS float* sc = lds;
    LAS float* red = lds + 3072;
    for (int i = tid; i < 3072; i += 512) { const int v = i >> 10, k = i & 1023; const float x = v < 2 ? p.in[I_C][v * DM + k] : p.in[I_CCTX][k]; sc[i] = siluf(x); }
    __syncthreads();
    for (int u = blockIdx.x; u < 96; u += gridDim.x) {
        const int l = u / 48, cg = u % 48, col = cg * 128 + (tid & 127), kp = tid >> 7;
        const float* W = p.in[I_ADAW] + (size_t)l * DM * 6144 + col;
        float s0 = 0.f, s1 = 0.f, s2 = 0.f;
        for (int k = kp * 256; k < kp * 256 + 256; ++k) { const float w = W[(size_t)k * 6144]; s0 += sc[k] * w; s1 += sc[1024 + k] * w; s2 += sc[2048 + k] * w; }
        red[(kp * 3 + 0) * 128 + (tid & 127)] = s0; red[(kp * 3 + 1) * 128 + (tid & 127)] = s1; red[(kp * 3 + 2) * 128 + (tid & 127)] = s2;
        __syncthreads();
        if (tid < 384) { const int v = tid >> 7, cc = tid & 127; const float s = red[(0 * 3 + v) * 128 + cc] + red[(1 * 3 + v) * 128 + cc] + red[(2 * 3 + v) * 128 + cc] + red[(3 * 3 + v) * 128 + cc];
            MOD[((size_t)l * 3 + v) * 6144 + cg * 128 + cc] = s + p.in[I_ADAB][l * 6144 + cg * 128 + cc]; }
        __syncthreads();
    }
}

__device__ __forceinline__ const float* conv_src(const PP& p, int l, int mat, int sub, int n, int& ld) {
    switch (mat) {
    case 0: { ld = 7216; int c; if (n < 2592) c = n; else if (n < 2608) c = 7200 + (n - 2592); else if (n < 2816) return nullptr; else if (n < 5376) c = 2592 + (n - 2816); else c = 5152 + (n - 5376);
              return p.in[I_WIN] + (size_t)l * DM * 7216 + c; }
    case 1: { ld = 4096; const int pn = n >> 8, ct = n & 255, bj = ct >> 7, wc = (ct >> 5) & 3, nn = (ct >> 4) & 1, i = ct & 15; const int kb = 2 * bj + nn, c = 64 * pn + 16 * wc + i;
              return p.in[I_WMERGE] + (size_t)l * DM * 4096 + kb * DM + c; }
    case 2: { ld = 1024; return p.in[I_WBR] + ((size_t)l * 4 + sub) * 512 * DM + n; }
    case 3: { ld = 1024; return p.in[I_WOUT] + (size_t)l * DM * DM + n; }
    case 4: { ld = 512; const int g = n >> 5, nn = (n >> 4) & 1, i = n & 15, hc = 16 * g + i; return (nn ? p.in[I_MW3] : p.in[I_MW1]) + ((size_t)l * 16 + sub) * DM * 512 + hc; }
    case 5: { ld = 1024; return p.in[I_MW2] + ((size_t)l * 16 + sub) * 512 * DM + n; }
    default: { ld = 64; return p.in[I_RGGW] + ((size_t)l * 32 + sub) * 4096 + n; }
    }
}
__device__ __forceinline__ void conv_unit(int u, int& mat, int& sub, int& nt, int& kt, int& K, size_t& dstoff) {
    if (u < 1856) { mat = 0; sub = 0; nt = u >> 4; kt = u & 15; K = 1024; dstoff = WB_WIN; }
    else if (u < 2880) { const int v = u - 1856; mat = 1; sub = 0; nt = v >> 4; kt = v & 15; K = 1024; dstoff = WB_WM; }
    else if (u < 3392) { const int v = u - 2880; mat = 2; sub = v >> 7; nt = (v & 127) >> 3; kt = v & 7; K = 512; dstoff = WB_WB + (size_t)sub * 1024 * 512 * 2; }
    else if (u < 3648) { const int v = u - 3392; mat = 3; sub = 0; nt = v >> 4; kt = v & 15; K = 1024; dstoff = WB_WO; }
    else if (u < 7744) { const int v = u - 3648; mat = 4; sub = v >> 8; nt = (v & 255) >> 4; kt = v & 15; K = 1024; dstoff = WB_W13 + (size_t)sub * 1024 * 1024 * 2; }
    else if (u < 9792) { const int v = u - 7744; mat = 5; sub = v >> 7; nt = (v & 127) >> 3; kt = v & 7; K = 512; dstoff = WB_W2 + (size_t)sub * 1024 * 512 * 2; }
    else { mat = 6; sub = u - 9792; nt = 0; kt = 0; K = 64; dstoff = WB_GW + (size_t)sub * 4096 * 2; }
}
__device__ __forceinline__ void phase_convert(const PP& p, int l, LAS float* tile  , int u_lo, int u_hi, int wg_lo) {
    const int tid = otid(p.swid);
    unsigned char* wb = p.ws + WS_WB;
    if ((int)blockIdx.x < wg_lo) return;
    for (int u0 = u_lo + ((int)blockIdx.x - wg_lo) * 4; u0 < u_hi; u0 += ((int)gridDim.x - wg_lo) * 4) {
        float val[4][8];
#pragma unroll
        for (int q = 0; q < 4; ++q) { int mat, sub, nt, kt, K; size_t dstoff; conv_unit(u0 + q, mat, sub, nt, kt, K, dstoff);
            int ld; const float* sp = conv_src(p, l, mat, sub, nt * 64 + (tid & 63), ld);
#pragma unroll
            for (int i = 0; i < 8; ++i) { const int kk = (tid >> 6) + 8 * i; val[q][i] = sp ? sp[(size_t)(kt * 64 + kk) * ld] : 0.f; } }
#pragma unroll
        for (int q = 0; q < 4; ++q)
#pragma unroll
            for (int i = 0; i < 8; ++i) tile[q * 4160 + ((tid >> 6) + 8 * i) * 65 + (tid & 63)] = val[q][i];
        __syncthreads();
#pragma unroll
        for (int q = 0; q < 4; ++q) { int mat, sub, nt, kt, K; size_t dstoff; conv_unit(u0 + q, mat, sub, nt, kt, K, dstoff);
            const int nn = tid >> 3, ks = (tid & 7) * 8; unsigned w[4];
#pragma unroll
            for (int j = 0; j < 4; ++j) w[j] = pack2(tile[q * 4160 + (ks + 2 * j) * 65 + nn], tile[q * 4160 + (ks + 2 * j + 1) * 65 + nn]);
            unsigned char* dbase = (l == 1 && (mat == 4 || mat == 5)) ? p.ws + WS_WB2 + (dstoff - WB_W13) : wb + dstoff;
            *(uint4*)((bf16_t*)dbase + (size_t)(nt * 64 + nn) * K + kt * 64 + ks) = make_uint4(w[0], w[1], w[2], w[3]); }
        __syncthreads();
    }
}

__device__ __forceinline__ void norm_row(const PP& p, int l, int which, const float* src, int mv, int lane, float (&u)[4][4]) {
    const float* MOD = (const float*)(p.ws + WS_MOD) + ((size_t)l * 3 + mv) * 6144;
    const float* gain = (which ? p.in[I_NFFNG] : p.in[I_NMIXG]) + l * DM;
    const float* sh = MOD + (which ? 3 : 0) * DM; const float* sc = MOD + (which ? 4 : 1) * DM;
    float ss = 0.f;
#pragma unroll
    for (int i = 0; i < 4; ++i) { const f32x4 v = *(const f32x4*)(src + 256 * i + 4 * lane); u[i][0] = v[0]; u[i][1] = v[1]; u[i][2] = v[2]; u[i][3] = v[3]; ss += v[0] * v[0] + v[1] * v[1] + v[2] * v[2] + v[3] * v[3]; }
    ss = wave_sum(ss);
    const float rs = rsqrtf(ss * (1.f / DM) + EPS);
#pragma unroll
    for (int i = 0; i < 4; ++i) { const int col = 256 * i + 4 * lane; const f32x4 g = *(const f32x4*)(gain + col), a = *(const f32x4*)(sc + col), b = *(const f32x4*)(sh + col);
#pragma unroll
        for (int j = 0; j < 4; ++j) u[i][j] = u[i][j] * rs * g[j] * (1.f + a[j]) + b[j]; }
}
__device__ __forceinline__ void phase_norm1(const PP& p, int l) {
    const int tid_ = otid(p.swid), lane = tid_ & 63, gw = blockIdx.x * 8 + (tid_ >> 6), nw = gridDim.x * 8;
    const float* sL = l == 0 ? p.in[I_X] : p.out; const float* sC = l == 0 ? p.in[I_CTX] : (const float*)(p.ws + WS_HCTX);
    bf16_t* U = (bf16_t*)(p.ws + WS_U);
    for (int r = gw; r < TT; r += nw) {
        float u[4][4]; norm_row(p, l, 0, hrow_c(sL, sC, r), mod_idx(r), lane, u);
#pragma unroll
        for (int i = 0; i < 4; ++i) *(uint2*)(U + (size_t)r * DM + 256 * i + 4 * lane) = make_uint2(pack2(u[i][0], u[i][1]), pack2(u[i][2], u[i][3]));
    }
}

__device__ __forceinline__ void phase_route(const PP& p, int l, LAS unsigned char* L) {
    const int tid_ = otid(p.swid), lane = tid_ & 63, wid = p.swid;
    LAS int* lcnt = (LAS int*)L;
    LAS int* rex = lcnt + 32;
    LAS int* rpos = rex + 132;
    if (tid_ < 32) lcnt[tid_] = 0;
    __syncthreads();
    const float* sL = p.out; const float* sC = (const float*)(p.ws + WS_HCTX);
    int* tok_e = (int*)(p.ws + WS_ROUTE); float* tok_w = (float*)(p.ws + WS_ROUTE + 262144); int* tok_pos = (int*)(p.ws + WS_ROUTE + 524288);
    unsigned* cnt = (unsigned*)(p.ws + WS_CTL) + CW_CNT + l * 16 * 32;
    const float* wg = p.in[I_MWG] + (size_t)l * DM * 4; const float* we = p.in[I_MWE] + (size_t)l * DM * 16;
    const int rbase = blockIdx.x * 66;
    const float* gain = p.in[I_NFFNG] + l * DM;
    for (int rp = wid; rp < 33; rp += 8) {
        const int rr0 = 2 * rp, r0 = rbase + rr0, r1 = r0 + 1;
        if (l == 1 && (r0 % NTOK) < CTXL) { if (lane == 0) { rex[2 * rr0] = -1; rex[2 * rr0 + 1] = -1; rex[2 * rr0 + 2] = -1; rex[2 * rr0 + 3] = -1; } continue; }
        const float* s0 = hrow_c(sL, sC, r0); const float* s1 = hrow_c(sL, sC, r1); const int mv = mod_idx(r0);
        const float* MOD = (const float*)(p.ws + WS_MOD) + ((size_t)l * 3 + mv) * 6144; const float* sh = MOD + 3 * DM; const float* sc = MOD + 4 * DM;
        f32x4 xa[4], xb[4]; float ssa = 0.f, ssb = 0.f;
#pragma unroll
        for (int i = 0; i < 4; ++i) { xa[i] = *(const f32x4*)(s0 + 256 * i + 4 * lane); xb[i] = *(const f32x4*)(s1 + 256 * i + 4 * lane); }
#pragma unroll
        for (int i = 0; i < 4; ++i) { ssa += xa[i][0] * xa[i][0] + xa[i][1] * xa[i][1] + xa[i][2] * xa[i][2] + xa[i][3] * xa[i][3]; ssb += xb[i][0] * xb[i][0] + xb[i][1] * xb[i][1] + xb[i][2] * xb[i][2] + xb[i][3] * xb[i][3]; }
        ssa = wave_sum(ssa); ssb = wave_sum(ssb);
        const float rsa = rsqrtf(ssa * (1.f / DM) + EPS), rsb = rsqrtf(ssb * (1.f / DM) + EPS);
        float acca[20], accb[20];
#pragma unroll
        for (int q = 0; q < 20; ++q) { acca[q] = 0.f; accb[q] = 0.f; }
#pragma unroll 1
        for (int i = 0; i < 4; ++i) { const int col0 = 256 * i + 4 * lane;
            const f32x4 g = *(const f32x4*)(gain + col0), a = *(const f32x4*)(sc + col0), bsh = *(const f32x4*)(sh + col0), va = *(const f32x4*)(s0 + col0), vb = *(const f32x4*)(s1 + col0);
            const float* wgp = wg + (size_t)col0 * 4; const float* wep = we + (size_t)col0 * 16;
#pragma unroll
            for (int j = 0; j < 4; ++j) { const float m1 = g[j] * (1.f + a[j]); const float ya = va[j] * rsa * m1 + bsh[j], yb = vb[j] * rsb * m1 + bsh[j];
                const f32x4 gq = *(const f32x4*)(wgp + j * 4);
#pragma unroll
                for (int q = 0; q < 4; ++q) { acca[q] += ya * gq[q]; accb[q] += yb * gq[q]; }
#pragma unroll
                for (int q = 0; q < 4; ++q) { const f32x4 e = *(const f32x4*)(wep + j * 16 + 4 * q);
#pragma unroll
                    for (int z2 = 0; z2 < 4; ++z2) { acca[4 + 4 * q + z2] += ya * e[z2]; accb[4 + 4 * q + z2] += yb * e[z2]; } } }
            asm volatile("" ::: "memory"); }
#pragma unroll
        for (int q = 0; q < 20; ++q) { acca[q] = wave_sum(acca[q]); accb[q] = wave_sum(accb[q]); }
        if (lane < 2) {
            const int rr = rr0 + lane, r = r0 + lane; float acc[20];
#pragma unroll
            for (int q = 0; q < 20; ++q) acc[q] = lane ? accb[q] : acca[q];
            float gl[4];
#pragma unroll
            for (int q = 0; q < 4; ++q) gl[q] = acc[q] + p.in[I_MBG][l * 4 + q];
            int grp = 0; float gm = gl[0];
#pragma unroll
            for (int q = 1; q < 4; ++q) if (gl[q] > gm) { gm = gl[q]; grp = q; }
            float se = 0.f;
#pragma unroll
            for (int q = 0; q < 4; ++q) se += __expf(gl[q] - gm);
            const float pg = 1.f / se;
            float el[4];
#pragma unroll
            for (int q = 0; q < 4; ++q) { float v = 0.f;
#pragma unroll
                for (int gg = 0; gg < 4; ++gg) v = (gg == grp) ? acc[4 + gg * 4 + q] : v;
                el[q] = v + p.in[I_MBE][l * 16 + grp * 4 + q]; }
            int i0 = 0; float m0 = el[0];
#pragma unroll
            for (int q = 1; q < 4; ++q) if (el[q] > m0) { m0 = el[q]; i0 = q; }
            int i1 = -1; float m1 = -3.4e38f;
#pragma unroll
            for (int q = 0; q < 4; ++q) if (q != i0 && el[q] > m1) { m1 = el[q]; i1 = q; }
            const float e1 = __expf(m1 - m0), w0 = pg / (1.f + e1), w1 = pg * e1 / (1.f + e1);
            const int ex0 = grp * 4 + i0, ex1 = grp * 4 + i1;
            rex[2 * rr] = ex0; rex[2 * rr + 1] = ex1; rpos[2 * rr] = __hip_atomic_fetch_add(&lcnt[ex0], 1, __ATOMIC_RELAXED, __HIP_MEMORY_SCOPE_WORKGROUP); rpos[2 * rr + 1] = __hip_atomic_fetch_add(&lcnt[ex1], 1, __ATOMIC_RELAXED, __HIP_MEMORY_SCOPE_WORKGROUP);
            tok_e[2 * r] = ex0; tok_e[2 * r + 1] = ex1; tok_w[2 * r] = w0; tok_w[2 * r + 1] = w1;
        }
    }
    __syncthreads();
    if (tid_ < 16) { const int c = lcnt[tid_]; lcnt[16 + tid_] = c ? (int)atomicAdd(&cnt[32 * tid_], (unsigned)c) : 0; }
    __syncthreads();
    for (int i = tid_; i < 132; i += 512) { const int r = rbase + (i >> 1); const int e = rex[i]; if (r < TT && e >= 0) tok_pos[2 * r + (i & 1)] = lcnt[16 + e] + rpos[i]; }
    __syncthreads();
}
__device__ __forceinline__ int moe_tables(const PP& p, int l, LAS int* tbl  ) {
    const unsigned* cnt = (const unsigned*)(p.ws + WS_CTL) + CW_CNT + l * 16 * 32;
    __syncthreads();
    if (otid(p.swid) == 0) { int s = 0;
        for (int e = 0; e < 16; ++e) { const int c = (int)__hip_atomic_load(cnt + 32 * e, __ATOMIC_RELAXED, __HIP_MEMORY_SCOPE_AGENT); const int nb = (c + 255) >> 8; tbl[e] = s * 256; for (int b = 0; b < nb; ++b) tbl[32 + s + b] = e; s += nb; }
        tbl[16] = s; }
    __syncthreads();
    return tbl[16];
}
__device__ __forceinline__ void phase_dispatch(const PP& p, int l, LAS int* tbl) {
    const int tid_ = otid(p.swid), lane = tid_ & 63, gw = blockIdx.x * 8 + (tid_ >> 6), nw = gridDim.x * 8;
    moe_tables(p, l, tbl);
    const float* sL = p.out; const float* sC = (const float*)(p.ws + WS_HCTX);
    const int* tok_e = (const int*)(p.ws + WS_ROUTE); const int* tok_pos = (const int*)(p.ws + WS_ROUTE + 524288); int* tok_slot = (int*)(p.ws + WS_ROUTE + 786432);
    bf16_t* XS = (bf16_t*)(p.ws + WS_BIG + BIG_XS);
    for (int r = gw; r < TT; r += nw) {
        if (l == 1 && (r % NTOK) < CTXL) continue;
        float u[4][4]; norm_row(p, l, 1, hrow_c(sL, sC, r), mod_idx(r), lane, u);
        const int s0 = tbl[tok_e[2 * r]] + tok_pos[2 * r], s1 = tbl[tok_e[2 * r + 1]] + tok_pos[2 * r + 1];
        if (lane == 0) { tok_slot[2 * r] = s0; tok_slot[2 * r + 1] = s1; }
#pragma unroll
        for (int i = 0; i < 4; ++i) { const uint2 v = make_uint2(pack2(u[i][0], u[i][1]), pack2(u[i][2], u[i][3]));
            *(uint2*)(XS + (size_t)s0 * DM + 256 * i + 4 * lane) = v; *(uint2*)(XS + (size_t)s1 * DM + 256 * i + 4 * lane) = v; }
    }
}
__device__ __forceinline__ void phase_combine(const PP& p, int l) {
    const int tid_ = otid(p.swid), lane = tid_ & 63, gw = blockIdx.x * 8 + (tid_ >> 6), nw = gridDim.x * 8;
    float* HL = p.out; float* HC = (float*)(p.ws + WS_HCTX);
    const float* tok_w = (const float*)(p.ws + WS_ROUTE + 262144); const int* tok_slot = (const int*)(p.ws + WS_ROUTE + 786432);
    const bf16_t* YM = (const bf16_t*)(p.ws + WS_BIG + BIG_YM);
    for (int r = gw; r < TT; r += nw) {
        if (l == 1 && (r % NTOK) < CTXL) continue;
        const float* g2 = (const float*)(p.ws + WS_MOD) + ((size_t)l * 3 + mod_idx(r)) * 6144 + 5 * DM;
        float* hp = hrow_m(HL, HC, r);
        const int s0 = tok_slot[2 * r], s1 = tok_slot[2 * r + 1]; const float w0 = tok_w[2 * r], w1 = tok_w[2 * r + 1];
        float x[4][4]; float ss = 0.f;
#pragma unroll
        for (int i = 0; i < 4; ++i) { const int col = 256 * i + 4 * lane; const f32x4 h = *(const f32x4*)(hp + col), g = *(const f32x4*)(g2 + col);
            const uint2 a = *(const uint2*)(YM + (size_t)s0 * DM + col), b = *(const uint2*)(YM + (size_t)s1 * DM + col);
            x[i][0] = h[0] + g[0] * (w0 * bf2f((bf16_t)(a.x & 0xffff)) + w1 * bf2f((bf16_t)(b.x & 0xffff)));
            x[i][1] = h[1] + g[1] * (w0 * bf2f((bf16_t)(a.x >> 16)) + w1 * bf2f((bf16_t)(b.x >> 16)));
            x[i][2] = h[2] + g[2] * (w0 * bf2f((bf16_t)(a.y & 0xffff)) + w1 * bf2f((bf16_t)(b.y & 0xffff)));
            x[i][3] = h[3] + g[3] * (w0 * bf2f((bf16_t)(a.y >> 16)) + w1 * bf2f((bf16_t)(b.y >> 16)));
            ss += x[i][0] * x[i][0] + x[i][1] * x[i][1] + x[i][2] * x[i][2] + x[i][3] * x[i][3]; }
        if (l == 1) {
            ss = wave_sum(ss); const float rs = rsqrtf(ss * (1.f / DM) + EPS);
#pragma unroll
            for (int i = 0; i < 4; ++i) { const int col = 256 * i + 4 * lane; const f32x4 g = *(const f32x4*)(p.in[I_FNG] + col);
                *(f32x4*)(hp + col) = (f32x4){x[i][0] * rs * g[0], x[i][1] * rs * g[1], x[i][2] * rs * g[2], x[i][3] * rs * g[3]}; }
        } else {
#pragma unroll
            for (int i = 0; i < 4; ++i) *(f32x4*)(hp + 256 * i + 4 * lane) = (f32x4){x[i][0], x[i][1], x[i][2], x[i][3]};
            ss = wave_sum(ss); const float rs = rsqrtf(ss * (1.f / DM) + EPS);
            const float* MOD1 = (const float*)(p.ws + WS_MOD) + ((size_t)1 * 3 + mod_idx(r)) * 6144; bf16_t* U = (bf16_t*)(p.ws + WS_U);
#pragma unroll
            for (int i = 0; i < 4; ++i) { const int col = 256 * i + 4 * lane; const f32x4 g = *(const f32x4*)(p.in[I_NMIXG] + DM + col), a = *(const f32x4*)(MOD1 + DM + col), bsh = *(const f32x4*)(MOD1 + col);
                float y[4];
#pragma unroll
                for (int j2 = 0; j2 < 4; ++j2) y[j2] = x[i][j2] * rs * g[j2] * (1.f + a[j2]) + bsh[j2];
                *(uint2*)(U + (size_t)r * DM + col) = make_uint2(pack2(y[0], y[1]), pack2(y[2], y[3])); }
        }
    }
}

__device__ __forceinline__ int chain_chunk(int dir, int ci) { return dir == 0 ? ci : (ci < 4 ? 3 - ci : 135 - ci); }

__device__ __forceinline__ void phase_seq_rg(const PP& p, int l) {
    const int tid_ = otid(p.swid); if (tid_ >= 64 || blockIdx.x >= 32) return;
    const int u = blockIdx.x, lane = tid_, blk = u & 7, dir = (u >> 3) & 1, b = u >> 4, ch = blk * 64 + lane;
    const bf16_t* Z = (const bf16_t*)(p.ws + WS_BIG + BIG_Z);
    float* O = (float*)(p.ws + WS_BIG + BIG_ST) + (size_t)dir * TT * 512;
    float Wr[64], Wi[64];
    const float* gw = p.in[I_RGGW] + ((((size_t)l * 2 + dir) * 2) * 8 + blk) * 4096;
#pragma unroll
    for (int i = 0; i < 64; ++i) { Wr[i] = gw[i * 64 + lane]; Wi[i] = gw[8 * 4096 + i * 64 + lane]; }
    const float br = p.in[I_RGGB][((l * 2 + dir) * 2 + 0) * 512 + ch], bi = p.in[I_RGGB][((l * 2 + dir) * 2 + 1) * 512 + ch];
    const float sp = softplusf(-p.in[I_RGLAM][(l * 2 + dir) * 512 + ch]);
    float cw[4];
#pragma unroll
    for (int j = 0; j < 4; ++j) cw[j] = p.in[I_RGCW][(l * 4 + j) * 512 + ch];
    const float cb = p.in[I_RGCB][l * 512 + ch];
    float h = 0.f;
    for (int s = 0; s < NTOK; ++s) {
        int pp; if (dir == 0) pp = s; else pp = s < CTXL ? CTXL - 1 - s : NTOK - 1 - (s - CTXL);
        const int lo = pp < CTXL ? 0 : CTXL, hi = pp < CTXL ? CTXL : NTOK;
        float xb = cb;
#pragma unroll
        for (int j = 0; j < 4; ++j) { const int q = pp + j - 2; if (q >= lo && q < hi) xb += cw[j] * bf2f(Z[((size_t)b * NTOK + q) * ZLD + RGX + ch]); }
        float pr = br, pi = bi;
#pragma unroll
        for (int i = 0; i < 64; ++i) { const float xi = __uint_as_float(__builtin_amdgcn_readlane(__float_as_uint(xb), i)); pr += xi * Wr[i]; pi += xi * Wi[i]; }
        const float r = sigm(pr), ig = sigm(pi), la = -8.f * r * sp, a = __expf(la), bt = sqrtf(-expm1f(2.f * la)) * (ig * xb);
        h = a * h + bt;
        O[((size_t)b * NTOK + pp) * 512 + ch] = h;
    }
}
__device__ __forceinline__ void phase_epi_rg(const PP& p) {
    const int tid_ = otid(p.swid);
    const bf16_t* Z = (const bf16_t*)(p.ws + WS_BIG + BIG_Z); const float* OF = (const float*)(p.ws + WS_BIG + BIG_ST); const float* OB = OF + (size_t)TT * 512;
    bf16_t* YS = (bf16_t*)(p.ws + WS_BIG + BIG_YS);
    for (size_t i = (size_t)blockIdx.x * 512 + tid_; i < (size_t)TT * 512; i += (size_t)gridDim.x * 512) { const size_t r = i >> 9; const int ch = (int)(i & 511);
        YS[i] = f2bf(gelu_tanh(bf2f(Z[r * ZLD + RGY + ch])) * (OF[i] + OB[i])); }
}
template <int BR> __device__ __forceinline__ void phase_seq_gl(const PP& p, int l, LAS float* sm) {
    constexpr int DK = BR == 1 ? 64 : 128, DP = DK / 4;
    if (blockIdx.x >= 16) return;
    LAS float* LA = sm; LAS float* LK = sm + 64 * DK; LAS float* LQ = sm + 2 * 64 * DK; LAS float* LV = sm + 3 * 64 * DK;
    const int u = blockIdx.x, tid = otid(p.swid), dir = u & 1, h = (u >> 1) & 3, b = u >> 3, v = tid >> 2, part = tid & 3;
    const bf16_t* Z = (const bf16_t*)(p.ws + WS_BIG + BIG_Z); const float* MISC = (const float*)(p.ws + WS_MISC);
    float* O = (float*)(p.ws + WS_BIG + BIG_ST) + (size_t)dir * TT * 512;
    float S[DP];
#pragma unroll
    for (int i = 0; i < DP; ++i) S[i] = 0.f;
    for (int ci = 0; ci < NCHUNK; ++ci) {
        const int c = chain_chunk(dir, ci); const size_t r0 = (size_t)b * NTOK + c * 64;
        __syncthreads();
        for (int idx = tid; idx < 64 * DK; idx += 512) { const int t = idx / DK, d = idx % DK; const size_t r = r0 + t;
            float a, k, q;
            if (BR == 1) { float pre = p.in[I_GLABLR][(l * 2 + dir) * 256 + h * 64 + d];
                for (int rr = 0; rr < 16; ++rr) pre += MISC[r * 64 + MISC_LR + dir * 16 + rr] * p.in[I_GLAWLR][((size_t)(l * 2 + dir) * 16 + rr) * 256 + h * 64 + d];
                a = __expf(logsig(pre) * (1.f / 16.f)); k = bf2f(Z[r * ZLD + GK + h * 64 + d]); q = bf2f(Z[r * ZLD + GQ + h * 64 + d]) * 0.125f; }
            else { float lb = 0.f; if (l == 1) { const float l0 = p.in[I_HGLB][(0 * 2 + dir) * 512 + h * 128 + d], l1 = p.in[I_HGLB][(1 * 2 + dir) * 512 + h * 128 + d]; lb = 1.f / (1.f + __expf(l0 - l1)); }
                const float f = bf2f(Z[r * ZLD + HF + dir * 512 + h * 128 + d]); const float s = sigm(f);
                a = lb + (1.f - lb) * s; k = (1.f - lb) * sigm(-f); q = siluf(bf2f(Z[r * ZLD + HQ + h * 128 + d])) * 0.08838834764831845f; }
            LA[idx] = a; LK[idx] = k; LQ[idx] = q; }
        for (int idx = tid; idx < 64 * 128; idx += 512) { const int t = idx >> 7, vv = idx & 127; LV[idx] = bf2f(Z[(r0 + t) * ZLD + (BR == 1 ? GV : HI) + h * 128 + vv]); }
        __syncthreads();
        for (int j = 0; j < 64; ++j) { const int t = dir == 0 ? j : 63 - j; const float vv = LV[t * 128 + v]; float o = 0.f;
#pragma unroll
            for (int i = 0; i < DP; ++i) { const int d = part * DP + i; S[i] = LA[t * DK + d] * S[i] + LK[t * DK + d] * vv; o += S[i] * LQ[t * DK + d]; }
            o += __shfl_xor(o, 1); o += __shfl_xor(o, 2);
            if (part == 0) O[(r0 + t) * 512 + h * 128 + v] = o; }
    }
}
__device__ __forceinline__ void phase_seq_ml(const PP& p, int l, LAS float* sm) {
    if (blockIdx.x >= 16) return;
    LAS float* LK = sm; LAS float* LQ = sm + 8192; LAS float* LV = sm + 16384; LAS float* LI = sm + 24576; LAS float* LF = LI + 64;
    const int u = blockIdx.x, tid = otid(p.swid), dir = u & 1, h = (u >> 1) & 3, b = u >> 3, v = tid >> 2, part = tid & 3;
    const bf16_t* Z = (const bf16_t*)(p.ws + WS_BIG + BIG_Z); const float* MISC = (const float*)(p.ws + WS_MISC);
    float* O = (float*)(p.ws + WS_BIG + BIG_ST) + (size_t)dir * TT * 512;
    float C[32], N[32]; float m = 0.f;
#pragma unroll
    for (int i = 0; i < 32; ++i) { C[i] = 0.f; N[i] = 0.f; }
    for (int ci = 0; ci < NCHUNK; ++ci) {
        const int c = chain_chunk(dir, ci); const int p0 = c * 64; const size_t r0 = (size_t)b * NTOK + p0;
        const int lo = p0 < CTXL ? 0 : CTXL, hi = p0 < CTXL ? CTXL : NTOK;
        __syncthreads();
        for (int idx = tid; idx < 64 * 128; idx += 512) { const int t = idx >> 7, d = idx & 127, ch = h * 128 + d; const int pp = p0 + t;
            float q = p.in[I_MLCB][l * 1024 + ch], k = p.in[I_MLCB][l * 1024 + 512 + ch];
#pragma unroll
            for (int j = 0; j < 4; ++j) { const int qq = pp + j - 2; if (qq >= lo && qq < hi) { const size_t rr = (size_t)b * NTOK + qq;
                q += p.in[I_MLCW][(l * 4 + j) * 1024 + ch] * bf2f(Z[rr * ZLD + MQ + ch]); k += p.in[I_MLCW][(l * 4 + j) * 1024 + 512 + ch] * bf2f(Z[rr * ZLD + MK + ch]); } }
            LQ[idx] = siluf(q) * 0.08838834764831845f; LK[idx] = siluf(k); LV[idx] = bf2f(Z[(r0 + t) * ZLD + MV + ch]); }
        if (tid < 64) { const size_t r = r0 + tid; LI[tid] = MISC[r * 64 + MISC_IF + dir * 8 + h] + p.in[I_MLGB][(l * 2 + dir) * 8 + h];
            LF[tid] = logsig(MISC[r * 64 + MISC_IF + dir * 8 + 4 + h] + p.in[I_MLGB][(l * 2 + dir) * 8 + 4 + h]); }
        __syncthreads();
        for (int j = 0; j < 64; ++j) { const int t = dir == 0 ? j : 63 - j; const float it = LI[t], lf = LF[t];
            const float mn = fmaxf(lf + m, it), fd = __expf(lf + m - mn), iw = __expf(it - mn); m = mn;
            const float vv = LV[t * 128 + v]; float num = 0.f, den = 0.f;
#pragma unroll
            for (int i = 0; i < 32; ++i) { const int d = part * 32 + i; const float kd = LK[t * 128 + d], qd = LQ[t * 128 + d]; C[i] = fd * C[i] + iw * kd * vv; N[i] = fd * N[i] + iw * kd; num += C[i] * qd; den += N[i] * qd; }
            num += __shfl_xor(num, 1); num += __shfl_xor(num, 2); den += __shfl_xor(den, 1); den += __shfl_xor(den, 2);
            if (part == 0) O[(r0 + t) * 512 + h * 128 + v] = num / fmaxf(fabsf(den), __expf(-mn)); }
    }
}
template <int BR> __device__ __forceinline__ void phase_epi_norm(const PP& p, int l) {
    const int tid_ = otid(p.swid), lane = tid_ & 63; const bf16_t* Z = (const bf16_t*)(p.ws + WS_BIG + BIG_Z);
    const float* OF = (const float*)(p.ws + WS_BIG + BIG_ST); const float* OB = OF + (size_t)TT * 512;
    bf16_t* YS = (bf16_t*)(p.ws + WS_BIG + BIG_YS) + (size_t)BR * TT * 512;
    const float* gain = (BR == 1 ? p.in[I_GLANG] : BR == 2 ? p.in[I_HGNG] : p.in[I_MLNG]) + l * 128;
    const int goff = BR == 1 ? GG : BR == 2 ? HGT : MO;
    for (int w = blockIdx.x * 8 + (tid_ >> 6); w < TT * 4; w += gridDim.x * 8) { const size_t r = w >> 2; const int h = w & 3;
        const size_t i0 = r * 512 + h * 128 + lane, i1 = i0 + 64; const float o0 = OF[i0] + OB[i0], o1 = OF[i1] + OB[i1];
        const float ss = wave_sum(o0 * o0 + o1 * o1), rs = rsqrtf(ss * (1.f / 128.f) + EPS);
        const float g0 = bf2f(Z[r * ZLD + goff + h * 128 + lane]), g1 = bf2f(Z[r * ZLD + goff + h * 128 + lane + 64]);
        const float a0 = BR == 3 ? sigm(g0) : siluf(g0), a1 = BR == 3 ? sigm(g1) : siluf(g1);
        YS[i0] = f2bf(o0 * rs * gain[lane] * a0); YS[i1] = f2bf(o1 * rs * gain[lane + 64] * a1); }
}

constexpr size_t SM_RGA = 0, SM_RGB = 1081344, SM_RGH = 2162688, SM_DEC = 3244032, SM_MLBE = 4325376, SM_MLML = SM_MLBE + 8448, SM_MLMIN = SM_MLML + 8448, SM_MLDN = 4350720;
__device__ __forceinline__ unsigned pack2f(float lo, float hi) { return pack2(lo, hi); }
__device__ __forceinline__ f32x4 mfma16(bf16x8 x, bf16x8 y, f32x4 c) { const f32x4 d = __builtin_amdgcn_mfma_f32_16x16x32_bf16(x, y, c, 0, 0, 0); asm volatile("" :: "v"(x), "v"(y), "v"(d)); return d; }

template <bool OUT> __device__ __forceinline__ void phase_rg(const PP& p, int l, LAS unsigned char* L) {
    const int tid = otid(p.swid), lane = tid & 63, wid = p.swid, fr = lane & 15, fq = lane >> 4;
    LAS bf16_t* XB = (LAS bf16_t*)L;
    LAS float* XF = (LAS float*)(L + 9216);
    LAS float* PRE = (LAS float*)(L + 9216 + 16384);
    const bf16_t* Z = (const bf16_t*)(p.ws + WS_BIG + BIG_Z); const bf16_t* GWT = (const bf16_t*)(p.ws + WS_WB + WB_GW);
    float* RA = (float*)(p.ws + WS_SMALL + SM_RGA); float* RB = (float*)(p.ws + WS_SMALL + SM_RGB); const float* RH = (const float*)(p.ws + WS_SMALL + SM_RGH);
    bf16_t* YS = (bf16_t*)(p.ws + WS_BIG + BIG_YS);
    const int blk = blockIdx.x & 7, nstr = gridDim.x >> 3, j = tid & 63, tg = tid >> 6, ch = blk * 64 + j;
    float cw[4];
#pragma unroll
    for (int q = 0; q < 4; ++q) cw[q] = p.in[I_RGCW][(l * 4 + q) * 512 + ch];
    const float cb = p.in[I_RGCB][l * 512 + ch];
    float gbr[2], gbi[2], gsp[2];
#pragma unroll
    for (int dir = 0; dir < 2; ++dir) { gbr[dir] = p.in[I_RGGB][((l * 2 + dir) * 2 + 0) * 512 + ch]; gbi[dir] = p.in[I_RGGB][((l * 2 + dir) * 2 + 1) * 512 + ch]; gsp[dir] = softplusf(-p.in[I_RGLAM][(l * 2 + dir) * 512 + ch]); }
    bf16x8 wx[4][2];
    { const int set = wid >> 1; const bf16_t* W = GWT + ((size_t)set * 8 + blk) * 4096;
#pragma unroll
      for (int jt = 0; jt < 4; ++jt) { wx[jt][0] = *(const bf16x8*)(W + (16 * jt + fr) * 64 + 8 * fq); wx[jt][1] = *(const bf16x8*)(W + (16 * jt + fr) * 64 + 8 * fq + 32); } }
    unsigned short win[11], yv[8]; float hin = 0.f;
    auto fetch = [&](int bc, unsigned short (&w_)[11], unsigned short (&y_)[8], float& h_) {
        const int c = bc % NCHUNK, b = bc / NCHUNK, p0 = c * 64; const size_t rb = (size_t)b * NTOK; const int lo = p0 < CTXL ? 0 : CTXL, hi = p0 < CTXL ? CTXL : NTOK;
#pragma unroll
        for (int k = 0; k < 11; ++k) { const int q = p0 + tg * 8 - 2 + k; w_[k] = (q >= lo && q < hi) ? Z[(rb + q) * ZLD + RGX + ch] : (unsigned short)0; }
        if (OUT) {
#pragma unroll
            for (int k = 0; k < 8; ++k) y_[k] = Z[(rb + p0 + tg * 8 + k) * ZLD + RGY + ch];
            if (tid < 128) h_ = RH[((size_t)((tid >> 6) * 2 + b) * NCHUNK + c) * 512 + ch]; }
    };
    int bc = blockIdx.x >> 3;
    if (bc < 2 * NCHUNK) fetch(bc, win, yv, hin);
    for (; bc < 2 * NCHUNK; bc += nstr) {
        const int c = bc % NCHUNK, b = bc / NCHUNK, p0 = c * 64; const size_t rb = (size_t)b * NTOK;
        float wf[11]; unsigned short ycur[8]; const float hcur = hin;
#pragma unroll
        for (int k = 0; k < 11; ++k) wf[k] = bf2f(win[k]);
#pragma unroll
        for (int k = 0; k < 8; ++k) ycur[k] = yv[k];
        if (bc + nstr < 2 * NCHUNK) fetch(bc + nstr, win, yv, hin);
#pragma unroll
        for (int k = 0; k < 8; ++k) { const int t = tg * 8 + k; const float xb = cb + cw[0] * wf[k] + cw[1] * wf[k + 1] + cw[2] * wf[k + 2] + cw[3] * wf[k + 3];
            XF[t * 64 + j] = xb; XB[t * 72 + j] = f2bf(xb); }
        __syncthreads();
        {
            const int set = wid >> 1;
#pragma unroll
            for (int tti = 0; tti < 2; ++tti) { const int tt = (wid & 1) * 2 + tti;
                const bf16x8 y0 = *(const LAS bf16x8*)(XB + (16 * tt + fr) * 72 + 8 * fq), y1 = *(const LAS bf16x8*)(XB + (16 * tt + fr) * 72 + 8 * fq + 32);
#pragma unroll
                for (int jt = 0; jt < 4; ++jt) { f32x4 acc = (f32x4){0.f, 0.f, 0.f, 0.f}; acc = mfma16(wx[jt][0], y0, acc); acc = mfma16(wx[jt][1], y1, acc);
                    *(LAS f32x4*)(PRE + (set * 64 + 16 * tt + fr) * 68 + 16 * jt + 4 * fq) = acc; } }
        }
        __syncthreads();
#pragma unroll
        for (int dir = 0; dir < 2; ++dir) {
#pragma unroll
            for (int k = 0; k < 8; ++k) { const int t = tg * 8 + k; LAS float* pa = PRE + ((dir * 2 + 0) * 64 + t) * 68 + j; LAS float* pb = PRE + ((dir * 2 + 1) * 64 + t) * 68 + j;
                const float r = sigm(*pa + gbr[dir]), ig = sigm(*pb + gbi[dir]), la = -8.f * r * gsp[dir];
                const float a = __expf(la), x2 = 2.f * la;
                const float ser = -x2 * (1.f + x2 * (0.5f + x2 * (0.16666667f + x2 * (0.041666668f + x2 * (0.008333334f + x2 * 0.0013888889f)))));
                const float om = x2 > -0.5f ? ser : 1.f - a * a;
                *pa = a; *pb = __builtin_amdgcn_sqrtf(om) * (ig * XF[t * 64 + j]); } }
        __syncthreads();
        if (tid < 128) {
            const int dir = tid >> 6; const size_t sidx = ((size_t)(dir * 2 + b) * NCHUNK + c) * 512 + ch;
            float h = OUT ? hcur : 0.f, P = 1.f;
#pragma unroll 8
            for (int s2 = 0; s2 < 64; ++s2) { const int t = dir ? 63 - s2 : s2; const float a = PRE[((dir * 2 + 0) * 64 + t) * 68 + j], bt = PRE[((dir * 2 + 1) * 64 + t) * 68 + j];
                h = a * h + bt; if (OUT) PRE[((dir * 2 + 1) * 64 + t) * 68 + j] = h; else P *= a; }
            if (!OUT) { RA[sidx] = P; RB[sidx] = h; }
        }
        if (OUT) { __syncthreads();
#pragma unroll
            for (int k = 0; k < 8; ++k) { const int t = tg * 8 + k; const size_t r = rb + p0 + t;
                YS[r * 512 + ch] = f2bf(gelu_tanh(bf2f(ycur[k])) * (PRE[((0 * 2 + 1) * 64 + t) * 68 + j] + PRE[((1 * 2 + 1) * 64 + t) * 68 + j])); } }
        __syncthreads();
    }
}
__device__ __forceinline__ void phase_rg_carry(const PP& p) {
    const int g = blockIdx.x * 512 + otid(p.swid); if (g >= 2048) return;
    const int dir = g >> 10, b = (g >> 9) & 1, ch = g & 511;
    const float* RA = (const float*)(p.ws + WS_SMALL + SM_RGA); const float* RB = (const float*)(p.ws + WS_SMALL + SM_RGB); float* RH = (float*)(p.ws + WS_SMALL + SM_RGH);
    float h = 0.f;
    for (int ci0 = 0; ci0 < NCHUNK; ci0 += 6) { float a[6], bb[6]; size_t idx[6];
#pragma unroll
        for (int k = 0; k < 6; ++k) { idx[k] = ((size_t)(dir * 2 + b) * NCHUNK + chain_chunk(dir, ci0 + k)) * 512 + ch; a[k] = RA[idx[k]]; bb[k] = RB[idx[k]]; }
#pragma unroll
        for (int k = 0; k < 6; ++k) { RH[idx[k]] = h; h = a[k] * h + bb[k]; } }
}

template <int BR> struct GlChan {
    float w[16]; float bias; float lb; int dir, h, d, l;
    __device__ __forceinline__ void init(const PP& p, int l_, int dir_, int h_, int d_) { l = l_; dir = dir_; h = h_; d = d_;
        if (BR == 1) {
#pragma unroll
            for (int r = 0; r < 16; ++r) w[r] = p.in[I_GLAWLR][((size_t)(l * 2 + dir) * 16 + r) * 256 + h * 64 + d];
            bias = p.in[I_GLABLR][(l * 2 + dir) * 256 + h * 64 + d]; lb = 0.f;
        } else { lb = 0.f; if (l == 1) { const float l0 = p.in[I_HGLB][(0 * 2 + dir) * 512 + h * 128 + d], l1 = p.in[I_HGLB][(1 * 2 + dir) * 512 + h * 128 + d]; lb = 1.f / (1.f + __expf(l0 - l1)); } bias = 0.f; }
    }
    __device__ __forceinline__ void gk(const bf16_t* zrow, const LAS float* lr, float& g, float& k) const {
        if (BR == 1) { float pre = bias;
#pragma unroll
            for (int r4 = 0; r4 < 4; ++r4) { const f32x4 x = *(const LAS f32x4*)(lr + 4 * r4); pre += x[0] * w[4 * r4] + x[1] * w[4 * r4 + 1] + x[2] * w[4 * r4 + 2] + x[3] * w[4 * r4 + 3]; }
            g = logsig(pre) * (1.f / 16.f); k = bf2f(zrow[GK + h * 64 + d]);
        } else { const float f = bf2f(zrow[HF + dir * 512 + h * 128 + d]); const float e = __expf(-f), sg = frcp(1.f + e);
            g = __logf(lb + (1.f - lb) * sg); k = (1.f - lb) * (e * sg); }
    }
};
template <int BR> __device__ __forceinline__ void phase_gl_local(const PP& p, int l, LAS unsigned char* L) {
    constexpr int DK = BR == 1 ? 64 : 128, NSEG = 512 / DK, NT = 64 / NSEG;
    const int tid = otid(p.swid), lane = tid & 63, wid = p.swid, fr = lane & 15, fq = lane >> 4;
    LAS bf16_t* KT = (LAS bf16_t*)L;
    LAS bf16_t* VT = KT + 2 * DK * 72;
    LAS float* SEG = (LAS float*)(VT + 128 * 72);
    LAS float* LR = SEG + 1024;
    const bf16_t* Z = (const bf16_t*)(p.ws + WS_BIG + BIG_Z); const float* MISC = (const float*)(p.ws + WS_MISC);
    bf16_t* ST = (bf16_t*)(p.ws + WS_BIG + BIG_ST); float* DEC = (float*)(p.ws + WS_SMALL + SM_DEC);
    constexpr int VOFF = BR == 1 ? GV : HI;
    const int d = tid % DK, sg = tid / DK;
    for (int u = blockIdx.x; u < 8 * NCHUNK; u += gridDim.x) {
        const int c = u % NCHUNK, bh = u / NCHUNK, h = bh & 3, b = bh >> 2; const size_t r0 = (size_t)b * NTOK + c * 64;
        if (BR == 1) { for (int i = tid; i < 2048; i += 512) LR[i] = MISC[(r0 + (i >> 5)) * 64 + MISC_LR + (i & 31)]; }
        { const int v = tid & 127;
#pragma unroll
          for (int gi = 0; gi < 2; ++gi) { const int grp = (tid >> 7) + 4 * gi; unsigned short x[8];
#pragma unroll
            for (int e = 0; e < 8; ++e) x[e] = Z[(r0 + grp * 8 + e) * ZLD + VOFF + h * 128 + v];
            *(LAS u32x4*)(VT + v * 72 + grp * 8) = (u32x4){x[0] | ((unsigned)x[1] << 16), x[2] | ((unsigned)x[3] << 16), x[4] | ((unsigned)x[5] << 16), x[6] | ((unsigned)x[7] << 16)}; } }
        if (BR == 1) __syncthreads();
        float cs[2][NT], kk[2][NT];
#pragma unroll
        for (int dir = 0; dir < 2; ++dir) { GlChan<BR> G; G.init(p, l, dir, h, d); float run = 0.f;
#pragma unroll
            for (int q = 0; q < NT; ++q) { const int n = dir ? NT - 1 - q : q, t = sg * NT + n; float g; G.gk(Z + (r0 + t) * ZLD, LR + t * 32 + dir * 16, g, kk[dir][n]); run += g; cs[dir][n] = run; }
            SEG[(dir * NSEG + sg) * DK + d] = run; }
        __syncthreads();
#pragma unroll
        for (int dir = 0; dir < 2; ++dir) { float before = 0.f, tot = 0.f;
#pragma unroll
            for (int s2 = 0; s2 < NSEG; ++s2) { const float x = SEG[(dir * NSEG + s2) * DK + d]; tot += x; const bool earlier = dir ? (s2 > sg) : (s2 < sg); before += earlier ? x : 0.f; }
            float val[NT];
#pragma unroll
            for (int n = 0; n < NT; ++n) val[n] = kk[dir][n] * __expf(tot - (before + cs[dir][n]));
#pragma unroll
            for (int n8 = 0; n8 < NT / 8; ++n8)
                *(LAS u32x4*)(KT + (dir * DK + d) * 72 + sg * NT + 8 * n8) = (u32x4){pack2(val[8 * n8], val[8 * n8 + 1]), pack2(val[8 * n8 + 2], val[8 * n8 + 3]), pack2(val[8 * n8 + 4], val[8 * n8 + 5]), pack2(val[8 * n8 + 6], val[8 * n8 + 7])};
            if (sg == 0) DEC[((size_t)((dir * 2 + b) * 4 + h) * NCHUNK + c) * 128 + d] = __expf(tot); }
        __syncthreads();
        { const int dir = wid >> 2; const size_t sbase = ((size_t)((dir * 2 + b) * 4 + h) * NCHUNK + c) * 128 * DK;
#pragma unroll
          for (int di = 0; di < DK / 64; ++di) { const int dt = (wid & 3) * (DK / 64) + di;
            const bf16x8 x0 = *(const LAS bf16x8*)(KT + (dir * DK + 16 * dt + fr) * 72 + 8 * fq), x1 = *(const LAS bf16x8*)(KT + (dir * DK + 16 * dt + fr) * 72 + 8 * fq + 32);
#pragma unroll
            for (int vt = 0; vt < 8; ++vt) { const bf16x8 y0 = *(const LAS bf16x8*)(VT + (16 * vt + fr) * 72 + 8 * fq), y1 = *(const LAS bf16x8*)(VT + (16 * vt + fr) * 72 + 8 * fq + 32);
                f32x4 acc = (f32x4){0.f, 0.f, 0.f, 0.f}; acc = mfma16(x0, y0, acc); acc = mfma16(x1, y1, acc);
                *(uint2*)(ST + sbase + (size_t)(16 * vt + fr) * DK + 16 * dt + 4 * fq) = make_uint2(pack2(acc[0], acc[1]), pack2(acc[2], acc[3])); } } }
        __syncthreads();
    }
}
template <int BR> __device__ __forceinline__ void phase_gl_carry(const PP& p) {
    constexpr int DK = BR == 1 ? 64 : 128, D4 = DK / 4, TOTAL = 16 * 128 * D4, NB = 6;
    const int g = blockIdx.x * 512 + otid(p.swid);
    bf16_t* ST = (bf16_t*)(p.ws + WS_BIG + BIG_ST); const float* DEC = (const float*)(p.ws + WS_SMALL + SM_DEC);
    const float* BE = (const float*)(p.ws + WS_SMALL + SM_MLBE); const float* MLOC = (const float*)(p.ws + WS_SMALL + SM_MLML); float* MIN_ = (float*)(p.ws + WS_SMALL + SM_MLMIN); float* DN = (float*)(p.ws + WS_SMALL + SM_MLDN);
    if (g < TOTAL) {
        const int d4 = g % D4, v = (g / D4) % 128, chain = g / (D4 * 128), dir = chain >> 3;
        float S[4] = {0.f, 0.f, 0.f, 0.f}; float m = 0.f;
        for (int ci0 = 0; ci0 < NCHUNK; ci0 += NB) { uint2 ds[NB]; f32x4 da[NB]; size_t off[NB];
#pragma unroll
            for (int k = 0; k < NB; ++k) { const int c = chain_chunk(dir, ci0 + k); off[k] = (((size_t)chain * NCHUNK + c) * 128 + v) * DK + d4 * 4; ds[k] = *(const uint2*)(ST + off[k]);
                if (BR == 3) { da[k][0] = BE[chain * NCHUNK + c]; da[k][1] = MLOC[chain * NCHUNK + c]; da[k][2] = 0.f; da[k][3] = 0.f; }
                else da[k] = *(const f32x4*)(DEC + ((size_t)chain * NCHUNK + c) * 128 + d4 * 4); }
#pragma unroll
            for (int k = 0; k < NB; ++k) {
                *(uint2*)(ST + off[k]) = make_uint2(pack2(S[0], S[1]), pack2(S[2], S[3]));
                float al[4], be[4];
                if (BR == 3) { const float mn = fmaxf(da[k][0] + m, da[k][1]), a = __expf(da[k][0] + m - mn), bb = __expf(da[k][1] - mn); m = mn;
#pragma unroll
                    for (int e = 0; e < 4; ++e) { al[e] = a; be[e] = bb; } }
                else {
#pragma unroll
                    for (int e = 0; e < 4; ++e) { al[e] = da[k][e]; be[e] = 1.f; } }
                S[0] = al[0] * S[0] + be[0] * bf2f((bf16_t)(ds[k].x & 0xffff)); S[1] = al[1] * S[1] + be[1] * bf2f((bf16_t)(ds[k].x >> 16));
                S[2] = al[2] * S[2] + be[2] * bf2f((bf16_t)(ds[k].y & 0xffff)); S[3] = al[3] * S[3] + be[3] * bf2f((bf16_t)(ds[k].y >> 16)); } }
    } else if (BR == 3 && g < TOTAL + 16 * 128) {
        const int q = g - TOTAL, d = q & 127, chain = q >> 7, dir = chain >> 3; float n = 0.f, m = 0.f;
        for (int ci0 = 0; ci0 < NCHUNK; ci0 += NB) { float be[NB], ml[NB], dn[NB]; size_t o[NB];
#pragma unroll
            for (int k = 0; k < NB; ++k) { const int c = chain_chunk(dir, ci0 + k); be[k] = BE[chain * NCHUNK + c]; ml[k] = MLOC[chain * NCHUNK + c]; o[k] = ((size_t)chain * NCHUNK + c) * 128 + d; dn[k] = DN[o[k]]; }
#pragma unroll
            for (int k = 0; k < NB; ++k) { DN[o[k]] = n; if (d == 0) MIN_[chain * NCHUNK + chain_chunk(dir, ci0 + k)] = m;
                const float mn = fmaxf(be[k] + m, ml[k]); n = __expf(be[k] + m - mn) * n + __expf(ml[k] - mn) * dn[k]; m = mn; } }
    }
}
template <int BR> __device__ __forceinline__ void phase_gl_out(const PP& p, int l, LAS unsigned char* L) {
    constexpr int DK = BR == 1 ? 64 : 128, PQ = DK + 8, NSEG = 512 / DK, NT = 64 / NSEG;
    const int tid = otid(p.swid), lane = tid & 63, wid = p.swid, fr = lane & 15, fq = lane >> 4;
    LAS bf16_t* QP = (LAS bf16_t*)L;
    LAS bf16_t* KP = QP + 2 * 64 * PQ;
    LAS bf16_t* QT = KP + 2 * 64 * PQ;
    LAS bf16_t* VT = QT + 2 * 64 * PQ;
    LAS bf16_t* PS = VT + 128 * 72;
    LAS float* SEG = (LAS float*)(PS + 2 * 64 * 72);
    LAS float* RED = SEG;
    LAS float* LR = SEG + 1024;
    const bf16_t* Z = (const bf16_t*)(p.ws + WS_BIG + BIG_Z); const float* MISC = (const float*)(p.ws + WS_MISC);
    const bf16_t* ST = (const bf16_t*)(p.ws + WS_BIG + BIG_ST); bf16_t* YS = (bf16_t*)(p.ws + WS_BIG + BIG_YS) + (size_t)BR * TT * 512;
    const float* gain = (BR == 1 ? p.in[I_GLANG] : p.in[I_HGNG]) + l * 128;
    constexpr int VOFF = BR == 1 ? GV : HI, QOFF = BR == 1 ? GQ : HQ, GOFF = BR == 1 ? GG : HGT;
    const int d = tid % DK, sg = tid / DK;
    for (int u = blockIdx.x; u < 8 * NCHUNK; u += gridDim.x) {
        const int c = u % NCHUNK, bh = u / NCHUNK, h = bh & 3, b = bh >> 2; const size_t r0 = (size_t)b * NTOK + c * 64;
        if (BR == 1) { for (int i = tid; i < 2048; i += 512) LR[i] = MISC[(r0 + (i >> 5)) * 64 + MISC_LR + (i & 31)]; }
        uint2 gtv[4];
#pragma unroll
        for (int it = 0; it < 4; ++it) gtv[it] = *(const uint2*)(Z + (r0 + 16 * it + fr) * ZLD + GOFF + h * 128 + 16 * wid + 4 * fq);
        { const int v = tid & 127;
#pragma unroll
          for (int gi = 0; gi < 2; ++gi) { const int grp = (tid >> 7) + 4 * gi; unsigned short x[8];
#pragma unroll
            for (int e = 0; e < 8; ++e) x[e] = Z[(r0 + grp * 8 + e) * ZLD + VOFF + h * 128 + v];
            *(LAS u32x4*)(VT + v * 72 + grp * 8) = (u32x4){x[0] | ((unsigned)x[1] << 16), x[2] | ((unsigned)x[3] << 16), x[4] | ((unsigned)x[5] << 16), x[6] | ((unsigned)x[7] << 16)}; } }
        float qv[NT];
#pragma unroll
        for (int n = 0; n < NT; ++n) { const float qraw = bf2f(Z[(r0 + sg * NT + n) * ZLD + QOFF + h * DK + d]); qv[n] = BR == 1 ? qraw * 0.125f : siluf(qraw) * 0.08838834764831845f; }
        if (BR == 1) __syncthreads();
        float cs[2][NT], kk[2][NT];
#pragma unroll
        for (int dir = 0; dir < 2; ++dir) { GlChan<BR> G; G.init(p, l, dir, h, d); float run = 0.f;
#pragma unroll
            for (int q = 0; q < NT; ++q) { const int n = dir ? NT - 1 - q : q, t = sg * NT + n; float g; G.gk(Z + (r0 + t) * ZLD, LR + t * 32 + dir * 16, g, kk[dir][n]); run += g; cs[dir][n] = run; }
            SEG[(dir * NSEG + sg) * DK + d] = run; }
        __syncthreads();
#pragma unroll
        for (int dir = 0; dir < 2; ++dir) { float before = 0.f, beta = 0.f;
#pragma unroll
            for (int s2 = 0; s2 < NSEG; ++s2) { const float x = SEG[(dir * NSEG + s2) * DK + d]; const int rank = dir ? NSEG - 1 - s2 : s2; const int myrank = dir ? NSEG - 1 - sg : sg;
                before += rank < myrank ? x : 0.f; beta += rank < NSEG / 2 ? x : 0.f; }
            const float ebeta = __expf(beta);
#pragma unroll
            for (int n = 0; n < NT; ++n) { const int t = sg * NT + n; const float e1 = __expf(before + cs[dir][n] - beta), qe = qv[n] * e1;
                QP[(dir * 64 + t) * PQ + d] = f2bf(qe); QT[(dir * 64 + t) * PQ + d] = f2bf(qe * ebeta); KP[(dir * 64 + t) * PQ + d] = f2bf(kk[dir][n] * frcp(e1)); } }
        bf16x8 xs[2][DK / 32];
#pragma unroll
        for (int dir = 0; dir < 2; ++dir) { const bf16_t* sp = ST + (((size_t)((dir * 2 + b) * 4 + h) * NCHUNK + c) * 128 + 16 * wid + fr) * DK + 8 * fq;
#pragma unroll
            for (int kq = 0; kq < DK / 32; ++kq) xs[dir][kq] = *(const bf16x8*)(sp + 32 * kq); }
        __syncthreads();
        {
            const int dir = wid >> 2, it = wid & 3;
#pragma unroll
            for (int jt = 0; jt < 4; ++jt) {
                f32x4 sa = (f32x4){0.f, 0.f, 0.f, 0.f};
#pragma unroll
                for (int kq = 0; kq < DK / 32; ++kq) sa = mfma16(*(const LAS bf16x8*)(KP + (dir * 64 + 16 * jt + fr) * PQ + 8 * fq + 32 * kq), *(const LAS bf16x8*)(QP + (dir * 64 + 16 * it + fr) * PQ + 8 * fq + 32 * kq), sa);
#pragma unroll
                for (int jj = 0; jj < 4; ++jj) { const int jg = 16 * jt + 4 * fq + jj, ig = 16 * it + fr; const bool keep = dir == 0 ? (jg <= ig) : (jg >= ig); sa[jj] = keep ? sa[jj] : 0.f; }
                *(LAS u32x2*)(PS + (dir * 64 + 16 * it + fr) * 72 + 16 * jt + 4 * fq) = (u32x2){pack2(sa[0], sa[1]), pack2(sa[2], sa[3])}; }
        }
        __syncthreads();
        f32x4 acc[4];
        {
#pragma unroll
            for (int it = 0; it < 4; ++it) acc[it] = (f32x4){0.f, 0.f, 0.f, 0.f};
            const bf16x8 xv0 = *(const LAS bf16x8*)(VT + (16 * wid + fr) * 72 + 8 * fq), xv1 = *(const LAS bf16x8*)(VT + (16 * wid + fr) * 72 + 8 * fq + 32);
#pragma unroll
            for (int dir = 0; dir < 2; ++dir)
#pragma unroll
                for (int it = 0; it < 4; ++it) {
                    acc[it] = mfma16(xv0, *(const LAS bf16x8*)(PS + (dir * 64 + 16 * it + fr) * 72 + 8 * fq), acc[it]);
                    acc[it] = mfma16(xv1, *(const LAS bf16x8*)(PS + (dir * 64 + 16 * it + fr) * 72 + 8 * fq + 32), acc[it]);
#pragma unroll
                    for (int kq = 0; kq < DK / 32; ++kq) acc[it] = mfma16(xs[dir][kq], *(const LAS bf16x8*)(QT + (dir * 64 + 16 * it + fr) * PQ + 8 * fq + 32 * kq), acc[it]); }
        }
#pragma unroll
        for (int it = 0; it < 4; ++it) { float ss = acc[it][0] * acc[it][0] + acc[it][1] * acc[it][1] + acc[it][2] * acc[it][2] + acc[it][3] * acc[it][3];
            ss += __shfl_xor(ss, 16); ss += __shfl_xor(ss, 32); if (fq == 0) RED[wid * 64 + 16 * it + fr] = ss; }
        __syncthreads();
        const f32x4 gn = *(const f32x4*)(gain + 16 * wid + 4 * fq);
#pragma unroll
        for (int it = 0; it < 4; ++it) { float tot = 0.f;
#pragma unroll
            for (int w2 = 0; w2 < 8; ++w2) tot += RED[w2 * 64 + 16 * it + fr];
            const float rs = rsqrtf(tot * (1.f / 128.f) + EPS); const size_t row = r0 + 16 * it + fr;
            const uint2 gt = gtv[it];
            const float y0 = acc[it][0] * rs * gn[0] * siluf(bf2f((bf16_t)(gt.x & 0xffff))), y1 = acc[it][1] * rs * gn[1] * siluf(bf2f((bf16_t)(gt.x >> 16)));
            const float y2 = acc[it][2] * rs * gn[2] * siluf(bf2f((bf16_t)(gt.y & 0xffff))), y3 = acc[it][3] * rs * gn[3] * siluf(bf2f((bf16_t)(gt.y >> 16)));
            *(uint2*)(YS + row * 512 + h * 128 + 16 * wid + 4 * fq) = make_uint2(pack2(y0, y1), pack2(y2, y3)); }
        __syncthreads();
    }
}

__device__ __forceinline__ float wave_incl_scan_add(float x, int lane) {
#pragma unroll
    for (int o = 1; o < 64; o <<= 1) { const float y = __shfl_up(x, o); x = lane >= o ? x + y : x; }
    return x;
}
__device__ __forceinline__ float wave_incl_scan_max(float x, int lane) {
#pragma unroll
    for (int o = 1; o < 64; o <<= 1) { const float y = __shfl_up(x, o); x = lane >= o ? fmaxf(x, y) : x; }
    return x;
}
__device__ __forceinline__ float wave_max(float v) {
#pragma unroll
    for (int o = 32; o > 0; o >>= 1) v = fmaxf(v, __shfl_xor(v, o));
    return v;
}
__device__ __forceinline__ void phase_ml_local(const PP& p, int l, LAS unsigned char* L) {
    const int tid = otid(p.swid), lane = tid & 63, wid = p.swid, fr = lane & 15, fq = lane >> 4;
    LAS bf16_t* KT = (LAS bf16_t*)L;
    LAS bf16_t* VT = KT + 2 * 128 * 72;
    LAS float* WE = (LAS float*)(VT + 128 * 72);
    LAS float* DNP = WE + 128;
    const bf16_t* Z = (const bf16_t*)(p.ws + WS_BIG + BIG_Z); const float* MISC = (const float*)(p.ws + WS_MISC);
    bf16_t* ST = (bf16_t*)(p.ws + WS_BIG + BIG_ST);
    float* BE = (float*)(p.ws + WS_SMALL + SM_MLBE); float* MLOC = (float*)(p.ws + WS_SMALL + SM_MLML); float* DN = (float*)(p.ws + WS_SMALL + SM_MLDN);
    for (int u = blockIdx.x; u < 8 * NCHUNK; u += gridDim.x) {
        const int c = u % NCHUNK, bh = u / NCHUNK, h = bh & 3, b = bh >> 2, p0 = c * 64; const size_t rb = (size_t)b * NTOK, r0 = rb + p0;
        const int lo = p0 < CTXL ? 0 : CTXL, hi = p0 < CTXL ? CTXL : NTOK;
        const int d = tid & 127, sg = tid >> 7, ch = h * 128 + d;
        float kv[16];
        {
            float cw[4];
#pragma unroll
            for (int q = 0; q < 4; ++q) cw[q] = p.in[I_MLCW][(l * 4 + q) * 1024 + 512 + ch];
            const float cb = p.in[I_MLCB][l * 1024 + 512 + ch];
            float win[19];
#pragma unroll
            for (int k = 0; k < 19; ++k) { const int q = p0 + sg * 16 - 2 + k; win[k] = (q >= lo && q < hi) ? bf2f(Z[(rb + q) * ZLD + MK + ch]) : 0.f; }
#pragma unroll
            for (int n = 0; n < 16; ++n) kv[n] = siluf(cb + cw[0] * win[n] + cw[1] * win[n + 1] + cw[2] * win[n + 2] + cw[3] * win[n + 3]);
        }
        { const int v = tid & 127;
#pragma unroll
          for (int gi = 0; gi < 2; ++gi) { const int grp = (tid >> 7) + 4 * gi; unsigned short x[8];
#pragma unroll
            for (int e = 0; e < 8; ++e) x[e] = Z[(r0 + grp * 8 + e) * ZLD + MV + h * 128 + v];
            *(LAS u32x4*)(VT + v * 72 + grp * 8) = (u32x4){x[0] | ((unsigned)x[1] << 16), x[2] | ((unsigned)x[3] << 16), x[4] | ((unsigned)x[5] << 16), x[6] | ((unsigned)x[7] << 16)}; } }
        if (wid < 2) {
            const int dir = wid, t = dir == 0 ? lane : 63 - lane; const size_t r = r0 + t; const int chain = (dir * 2 + b) * 4 + h;
            const float ii = MISC[r * 64 + MISC_IF + dir * 8 + h] + p.in[I_MLGB][(l * 2 + dir) * 8 + h];
            const float lf = logsig(MISC[r * 64 + MISC_IF + dir * 8 + 4 + h] + p.in[I_MLGB][(l * 2 + dir) * 8 + 4 + h]);
            const float bc = wave_incl_scan_add(lf, lane), bend = __shfl(bc, 63), mloc = bend + wave_max(ii - bc);
            WE[dir * 64 + t] = __expf(bend - bc + ii - mloc);
            if (lane == 0) { BE[chain * NCHUNK + c] = bend; MLOC[chain * NCHUNK + c] = mloc; }
        }
        __syncthreads();
#pragma unroll
        for (int dir = 0; dir < 2; ++dir) { float val[16], dn = 0.f;
#pragma unroll
            for (int n = 0; n < 16; ++n) { val[n] = kv[n] * WE[dir * 64 + sg * 16 + n]; dn += val[n]; }
            *(LAS u32x4*)(KT + (dir * 128 + d) * 72 + sg * 16) = (u32x4){pack2(val[0], val[1]), pack2(val[2], val[3]), pack2(val[4], val[5]), pack2(val[6], val[7])};
            *(LAS u32x4*)(KT + (dir * 128 + d) * 72 + sg * 16 + 8) = (u32x4){pack2(val[8], val[9]), pack2(val[10], val[11]), pack2(val[12], val[13]), pack2(val[14], val[15])};
            DNP[(sg * 2 + dir) * 128 + d] = dn; }
        __syncthreads();
        if (tid < 256) { const int dir = tid >> 7; DN[((size_t)((dir * 2 + b) * 4 + h) * NCHUNK + c) * 128 + d] = DNP[(0 * 2 + dir) * 128 + d] + DNP[(1 * 2 + dir) * 128 + d] + DNP[(2 * 2 + dir) * 128 + d] + DNP[(3 * 2 + dir) * 128 + d]; }
        { const int dir = wid >> 2; const size_t sbase = ((size_t)((dir * 2 + b) * 4 + h) * NCHUNK + c) * 128 * 128;
#pragma unroll
          for (int di = 0; di < 2; ++di) { const int dt = (wid & 3) * 2 + di;
            const bf16x8 x0 = *(const LAS bf16x8*)(KT + (dir * 128 + 16 * dt + fr) * 72 + 8 * fq), x1 = *(const LAS bf16x8*)(KT + (dir * 128 + 16 * dt + fr) * 72 + 8 * fq + 32);
#pragma unroll
            for (int vt = 0; vt < 8; ++vt) { const bf16x8 y0 = *(const LAS bf16x8*)(VT + (16 * vt + fr) * 72 + 8 * fq), y1 = *(const LAS bf16x8*)(VT + (16 * vt + fr) * 72 + 8 * fq + 32);
                f32x4 acc = (f32x4){0.f, 0.f, 0.f, 0.f}; acc = mfma16(x0, y0, acc); acc = mfma16(x1, y1, acc);
                *(uint2*)(ST + sbase + (size_t)(16 * vt + fr) * 128 + 16 * dt + 4 * fq) = make_uint2(pack2(acc[0], acc[1]), pack2(acc[2], acc[3])); } } }
        __syncthreads();
    }
}
__device__ __forceinline__ void phase_ml_out(const PP& p, int l, LAS unsigned char* L) {
    constexpr int PQ = 136;
    const int tid = otid(p.swid), lane = tid & 63, wid = p.swid, fr = lane & 15, fq = lane >> 4;
    LAS bf16_t* QL = (LAS bf16_t*)L;
    LAS bf16_t* KL = QL + 64 * PQ;
    LAS bf16_t* VT = KL + 64 * PQ;
    LAS bf16_t* PS = VT + 128 * 72;
    LAS float* SC = (LAS float*)(PS + 2 * 64 * 72);
    LAS float* NV = SC + 2 * 576;
    LAS float* RED = NV + 256;
    const bf16_t* Z = (const bf16_t*)(p.ws + WS_BIG + BIG_Z); const float* MISC = (const float*)(p.ws + WS_MISC);
    const bf16_t* ST = (const bf16_t*)(p.ws + WS_BIG + BIG_ST); bf16_t* YS = (bf16_t*)(p.ws + WS_BIG + BIG_YS) + (size_t)3 * TT * 512;
    const float* MIN_ = (const float*)(p.ws + WS_SMALL + SM_MLMIN); const float* DN = (const float*)(p.ws + WS_SMALL + SM_MLDN);
    const float* gain = p.in[I_MLNG] + l * 128;
    for (int u = blockIdx.x; u < 8 * NCHUNK; u += gridDim.x) {
        const int c = u % NCHUNK, bh = u / NCHUNK, h = bh & 3, b = bh >> 2, p0 = c * 64; const size_t rb = (size_t)b * NTOK, r0 = rb + p0;
        const int lo = p0 < CTXL ? 0 : CTXL, hi = p0 < CTXL ? CTXL : NTOK;
        const int d = tid & 127, sg = tid >> 7, ch = h * 128 + d;
        uint2 gtv[4];
#pragma unroll
        for (int it = 0; it < 4; ++it) gtv[it] = *(const uint2*)(Z + (r0 + 16 * it + fr) * ZLD + MO + h * 128 + 16 * wid + 4 * fq);
#pragma unroll
        for (int which = 0; which < 2; ++which) {
            const int zc = (which ? MK : MQ) + ch;
            float cw[4];
#pragma unroll
            for (int q = 0; q < 4; ++q) cw[q] = p.in[I_MLCW][(l * 4 + q) * 1024 + which * 512 + ch];
            const float cb = p.in[I_MLCB][l * 1024 + which * 512 + ch], scl = which ? 1.f : 0.08838834764831845f;
            float win[19];
#pragma unroll
            for (int k = 0; k < 19; ++k) { const int q = p0 + sg * 16 - 2 + k; win[k] = (q >= lo && q < hi) ? bf2f(Z[(rb + q) * ZLD + zc]) : 0.f; }
            LAS bf16_t* dst = (which ? KL : QL) + (sg * 16) * PQ + d;
#pragma unroll
            for (int n = 0; n < 16; ++n) dst[n * PQ] = f2bf(siluf(cb + cw[0] * win[n] + cw[1] * win[n + 1] + cw[2] * win[n + 2] + cw[3] * win[n + 3]) * scl);
        }
        { const int v = tid & 127;
#pragma unroll
          for (int gi = 0; gi < 2; ++gi) { const int grp = (tid >> 7) + 4 * gi; unsigned short x[8];
#pragma unroll
            for (int e = 0; e < 8; ++e) x[e] = Z[(r0 + grp * 8 + e) * ZLD + MV + h * 128 + v];
            *(LAS u32x4*)(VT + v * 72 + grp * 8) = (u32x4){x[0] | ((unsigned)x[1] << 16), x[2] | ((unsigned)x[3] << 16), x[4] | ((unsigned)x[5] << 16), x[6] | ((unsigned)x[7] << 16)}; } }
        if (tid < 256) NV[tid] = DN[((size_t)(((tid >> 7) * 2 + b) * 4 + h) * NCHUNK + c) * 128 + (tid & 127)];
        if (wid < 2) {
            const int dir = wid, t = dir == 0 ? lane : 63 - lane; const size_t r = r0 + t; const int chain = (dir * 2 + b) * 4 + h;
            const float ii = MISC[r * 64 + MISC_IF + dir * 8 + h] + p.in[I_MLGB][(l * 2 + dir) * 8 + h];
            const float lf = logsig(MISC[r * 64 + MISC_IF + dir * 8 + 4 + h] + p.in[I_MLGB][(l * 2 + dir) * 8 + 4 + h]);
            const float bc = wave_incl_scan_add(lf, lane), a = ii - bc, arun = wave_incl_scan_max(a, lane), mprev = MIN_[chain * NCHUNK + c];
            const float m = bc + fmaxf(mprev, arun);
            LAS float* S = SC + dir * 576;
            S[t] = bc - m; S[64 + t] = a; S[128 + t] = __expf(bc + mprev - m); S[192 + t] = __expf(-m);
        }
        __syncthreads();
        {
            const int dir = tid >> 8, i = (tid >> 2) & 63, part = tid & 3; float sacc = 0.f;
#pragma unroll 8
            for (int d = part * 32; d < part * 32 + 32; ++d) sacc += bf2f(QL[i * PQ + d]) * NV[dir * 128 + d];
            sacc += __shfl_xor(sacc, 1); sacc += __shfl_xor(sacc, 2);
            if (part == 0) SC[dir * 576 + 256 + i] = sacc;
        }
        {
            const int it = wid & 3;
#pragma unroll
            for (int jh = 0; jh < 2; ++jh) { const int jt = (wid >> 2) * 2 + jh;
                f32x4 acc = (f32x4){0.f, 0.f, 0.f, 0.f};
#pragma unroll
                for (int kk = 0; kk < 4; ++kk) acc = mfma16(*(const LAS bf16x8*)(KL + (16 * jt + fr) * PQ + 8 * fq + 32 * kk), *(const LAS bf16x8*)(QL + (16 * it + fr) * PQ + 8 * fq + 32 * kk), acc);
                const int ig = 16 * it + fr;
#pragma unroll
                for (int dir = 0; dir < 2; ++dir) { const LAS float* S = SC + dir * 576; const float ui = S[ig]; float sv[4];
#pragma unroll
                    for (int jj = 0; jj < 4; ++jj) { const int jg = 16 * jt + 4 * fq + jj; const bool keep = dir == 0 ? (jg <= ig) : (jg >= ig);
                        const float wgt = __expf(fminf(ui + S[64 + jg], 0.f)); sv[jj] = keep ? acc[jj] * wgt : 0.f; }
                    *(LAS u32x2*)(PS + (dir * 64 + ig) * 72 + 16 * jt + 4 * fq) = (u32x2){pack2(sv[0], sv[1]), pack2(sv[2], sv[3])};
                    float rsum = sv[0] + sv[1] + sv[2] + sv[3]; rsum += __shfl_xor(rsum, 16); rsum += __shfl_xor(rsum, 32);
                    if (fq == 0) SC[dir * 576 + 320 + jt * 64 + ig] = rsum; } }
        }
        __syncthreads();
        {
            f32x4 o[4];
#pragma unroll
            for (int it = 0; it < 4; ++it) o[it] = (f32x4){0.f, 0.f, 0.f, 0.f};
            const bf16x8 xv0 = *(const LAS bf16x8*)(VT + (16 * wid + fr) * 72 + 8 * fq), xv1 = *(const LAS bf16x8*)(VT + (16 * wid + fr) * 72 + 8 * fq + 32);
#pragma unroll
            for (int dir = 0; dir < 2; ++dir) {
                const bf16_t* sp = ST + (((size_t)((dir * 2 + b) * 4 + h) * NCHUNK + c) * 128 + 16 * wid + fr) * 128 + 8 * fq;
                bf16x8 xs[4];
#pragma unroll
                for (int kk = 0; kk < 4; ++kk) xs[kk] = *(const bf16x8*)(sp + 32 * kk);
                const LAS float* S = SC + dir * 576;
#pragma unroll
                for (int it = 0; it < 4; ++it) { const int ig = 16 * it + fr;
                    f32x4 ap = (f32x4){0.f, 0.f, 0.f, 0.f}, ac = (f32x4){0.f, 0.f, 0.f, 0.f};
                    ap = mfma16(xv0, *(const LAS bf16x8*)(PS + (dir * 64 + ig) * 72 + 8 * fq), ap);
                    ap = mfma16(xv1, *(const LAS bf16x8*)(PS + (dir * 64 + ig) * 72 + 8 * fq + 32), ap);
#pragma unroll
                    for (int kk = 0; kk < 4; ++kk) ac = mfma16(xs[kk], *(const LAS bf16x8*)(QL + ig * PQ + 8 * fq + 32 * kk), ac);
                    const float wi = S[128 + ig], den = S[320 + ig] + S[384 + ig] + S[448 + ig] + S[512 + ig] + wi * S[256 + ig];
                    const float inv = frcp(fmaxf(fabsf(den), S[192 + ig]));
#pragma unroll
                    for (int jj = 0; jj < 4; ++jj) o[it][jj] += (ap[jj] + wi * ac[jj]) * inv; } }
#pragma unroll
            for (int it = 0; it < 4; ++it) { float ss = o[it][0] * o[it][0] + o[it][1] * o[it][1] + o[it][2] * o[it][2] + o[it][3] * o[it][3];
                ss += __shfl_xor(ss, 16); ss += __shfl_xor(ss, 32); if (fq == 0) RED[wid * 64 + 16 * it + fr] = ss; }
            __syncthreads();
            const f32x4 gn = *(const f32x4*)(gain + 16 * wid + 4 * fq);
#pragma unroll
            for (int it = 0; it < 4; ++it) { float tot = 0.f;
#pragma unroll
                for (int w2 = 0; w2 < 8; ++w2) tot += RED[w2 * 64 + 16 * it + fr];
                const float rs = rsqrtf(tot * (1.f / 128.f) + EPS); const size_t row = r0 + 16 * it + fr;
                const uint2 gt = gtv[it];
                const float y0 = o[it][0] * rs * gn[0] * sigm(bf2f((bf16_t)(gt.x & 0xffff))), y1 = o[it][1] * rs * gn[1] * sigm(bf2f((bf16_t)(gt.x >> 16)));
                const float y2 = o[it][2] * rs * gn[2] * sigm(bf2f((bf16_t)(gt.y & 0xffff))), y3 = o[it][3] * rs * gn[3] * sigm(bf2f((bf16_t)(gt.y >> 16)));
                *(uint2*)(YS + row * 512 + h * 128 + 16 * wid + 4 * fq) = make_uint2(pack2(y0, y1), pack2(y2, y3)); }
        }
        __syncthreads();
    }
}

#ifndef CH_GLA
#define CH_GLA 1
#endif
#ifndef CH_HG
#define CH_HG 1
#endif
#ifndef CH_ML
#define CH_ML 1
#endif
#if CH_GLA
#define GLA_LOCAL(p, l) phase_gl_local<1>(p, l, L)
#define GLA_CARRY(p, l) phase_gl_carry<1>(p)
#define GLA_OUT(p, l) phase_gl_out<1>(p, l, L)
#else
#define GLA_LOCAL(p, l) phase_seq_gl<1>(p, l, (LAS float*)L)
#define GLA_CARRY(p, l)
#define GLA_OUT(p, l) phase_epi_norm<1>(p, l)
#endif
#if CH_HG
#define HG_LOCAL(p, l) phase_gl_local<2>(p, l, L)
#define HG_CARRY(p, l) phase_gl_carry<2>(p)
#define HG_OUT(p, l) phase_gl_out<2>(p, l, L)
#else
#define HG_LOCAL(p, l) phase_seq_gl<2>(p, l, (LAS float*)L)
#define HG_CARRY(p, l)
#define HG_OUT(p, l) phase_epi_norm<2>(p, l)
#endif
#if CH_ML
#define ML_LOCAL(p, l) phase_ml_local(p, l, L)
#define ML_CARRY(p, l) phase_gl_carry<3>(p)
#define ML_OUT(p, l) phase_ml_out(p, l, L)
#else
#define ML_LOCAL(p, l) phase_seq_ml(p, l, (LAS float*)L)
#define ML_CARRY(p, l)
#define ML_OUT(p, l) phase_epi_norm<3>(p, l)
#endif
constexpr int LDS_BYTES = 147456, NPH_LAYER = 22, NPH = 1 + 2 * NPH_LAYER;
__global__ void __launch_bounds__(512, 2) mega(P p_unused) {
    extern __shared__ __attribute__((aligned(16))) unsigned char lds[];
    LAS unsigned char* L = (LAS unsigned char*)lds;
    LAS int* tbl = (LAS int*)(L + 131072 + 1024);
    const int swid = __builtin_amdgcn_readfirstlane((int)(threadIdx.x >> 6));
    int lo, hi; unsigned* barw;
    { const PP p = load_args(swid); lo = p.ph_lo; hi = p.ph_hi; barw = (unsigned*)(p.ws + WS_CTL); }
    { const int t0 = (int)threadIdx.x; if (t0 < 4) ((LAS unsigned*)(L + LDS_BYTES - 16))[t0] = 0u; }
    __syncthreads();
    XcdBarrier bar; bar.bar = barw; bar.x = 0; bar.st = nullptr; bar.swid = swid;
    if (hi - lo > 1) bar = xcd_barrier_post(barw, (volatile LAS unsigned*)(L + LDS_BYTES - 16), swid);
#ifndef PHSEL
#define PHSEL(k) 1
#endif
#define IN(k) (PHSEL(k) && lo <= (k) && (k) < hi)
#define SEAM(k) do { if (IN((k) + 1)) xcd_barrier(bar); } while (0)
#define PHASE(k, ...) if (IN(k)) { const PP p = load_args(swid); unsigned char* ws = p.ws; unsigned char* wb = ws + WS_WB; unsigned char* big = ws + WS_BIG; (void)wb; (void)big; __VA_ARGS__ SEAM(k); }
    PHASE(0, phase_mods(p, (LAS float*)L); phase_convert(p, 0, (LAS float*)L, 0, 9824, 0);)
#define LAYER_BODY(l) { constexpr int pb = 1 + NPH_LAYER * (l); \
    if ((l) == 1) { PHASE(pb + 0, phase_convert(p, 1, (LAS float*)L, 0, 3648, 0); phase_convert(p, 1, (LAS float*)L, 9792, 9824, 0);) } \
    if ((l) == 0) { PHASE(pb + 1, phase_norm1(p, l);) } \
    PHASE(pb + 2, Gemm g{(const bf16_t*)(ws + WS_U), (const bf16_t*)(wb + WB_WIN), DM, DM, p.swid}; OrderPlain S; S.init(MT, 11, gridDim.x, blockIdx.x); S.skipctx = 0; \
        EpiZ E{(bf16_t*)(big + BIG_Z), (float*)(ws + WS_MISC), 10}; GEMM_RUN(EpiZ, OrderPlain, g, S, E);) \
    PHASE(pb + 3, phase_rg<false>(p, l, L); GLA_LOCAL(p, l);) \
    PHASE(pb + 4, phase_rg_carry(p); GLA_CARRY(p, l); if ((l) == 0) phase_convert(p, 1, (LAS float*)L, 3648, 5696, 136);) \
    PHASE(pb + 5, phase_rg<true>(p, l, L); GLA_OUT(p, l);) \
    PHASE(pb + 6, Gemm g{(const bf16_t*)(ws + WS_U), (const bf16_t*)(wb + WB_WIN) + (size_t)2816 * DM, DM, DM, p.swid}; OrderPlain S; S.init(MT, 10, gridDim.x, blockIdx.x); S.skipctx = 0; \
        EpiZ E{(bf16_t*)(big + BIG_Z), (float*)(ws + WS_MISC), -1}; GEMM_RUN(EpiZ, OrderPlain, g, S, E);) \
    PHASE(pb + 7, HG_LOCAL(p, l);) \
    PHASE(pb + 8, HG_CARRY(p, l); if ((l) == 0) phase_convert(p, 1, (LAS float*)L, 5696, 7744, 136);) \
    PHASE(pb + 9, HG_OUT(p, l);) \
    PHASE(pb + 10, Gemm g{(const bf16_t*)(ws + WS_U), (const bf16_t*)(wb + WB_WIN) + (size_t)5376 * DM, DM, DM, p.swid}; OrderPlain S; S.init(MT, 8, gridDim.x, blockIdx.x); S.skipctx = 0; \
        EpiZ E{(bf16_t*)(big + BIG_Z), (float*)(ws + WS_MISC), -1}; GEMM_RUN(EpiZ, OrderPlain, g, S, E);) \
    PHASE(pb + 11, ML_LOCAL(p, l);) \
    PHASE(pb + 12, ML_CARRY(p, l); if ((l) == 0) phase_convert(p, 1, (LAS float*)L, 7744, 9792, 136);) \
    PHASE(pb + 13, ML_OUT(p, l);) \
    PHASE(pb + 14, Gemm g{(const bf16_t*)(big + BIG_YS), (const bf16_t*)(wb + WB_WB), 512, 512, p.swid}; OrderBranch S; S.init((l) ? 64 : MT, 16, gridDim.x, blockIdx.x); S.skipctx = (l); \
        EpiBO E{(bf16_t*)(big + BIG_BO)}; GEMM_RUN(EpiBO, OrderBranch, g, S, E);) \
    PHASE(pb + 15, Gemm g{(const bf16_t*)(ws + WS_U), (const bf16_t*)(wb + WB_WM), DM, DM, p.swid}; OrderPlain S; S.init((l) ? 64 : MT, 16, gridDim.x, blockIdx.x); S.skipctx = (l); \
        EpiMerge E{(const bf16_t*)(big + BIG_BO), p.in[I_BMERGE] + (size_t)(l) * 4096, (bf16_t*)(big + BIG_MERGED)}; GEMM_RUN(EpiMerge, OrderPlain, g, S, E);) \
    PHASE(pb + 16, Gemm g{(const bf16_t*)(big + BIG_MERGED), (const bf16_t*)(wb + WB_WO), DM, DM, p.swid}; OrderPlain S; S.init((l) ? 64 : MT, 4, gridDim.x, blockIdx.x); S.skipctx = (l); \
        EpiOut E{(l) == 0 ? p.in[I_X] : p.out, (l) == 0 ? p.in[I_CTX] : (const float*)(ws + WS_HCTX), p.out, (float*)(ws + WS_HCTX), (const float*)(ws + WS_MOD) + (size_t)(l) * 3 * 6144}; \
        GEMM_RUN(EpiOut, OrderPlain, g, S, E);) \
    PHASE(pb + 17, phase_route(p, l, L);) \
    PHASE(pb + 18, phase_dispatch(p, l, tbl);) \
    PHASE(pb + 19, const int nblk = moe_tables(p, l, tbl); Gemm g{(const bf16_t*)(big + BIG_XS), (l) ? (const bf16_t*)(ws + WS_WB2) : (const bf16_t*)(wb + WB_W13), DM, DM, p.swid}; OrderMoe S; S.init(nblk, 4, gridDim.x, blockIdx.x); S.blk_e = tbl + 32; \
        EpiH E{(bf16_t*)(big + BIG_HS)}; GEMM_RUN(EpiH, OrderMoe, g, S, E);) \
    PHASE(pb + 20, const int nblk = moe_tables(p, l, tbl); Gemm g{(const bf16_t*)(big + BIG_HS), (l) ? (const bf16_t*)(ws + WS_WB2 + 33554432) : (const bf16_t*)(wb + WB_W2), 512, 512, p.swid}; OrderMoe S; S.init(nblk, 4, gridDim.x, blockIdx.x); S.blk_e = tbl + 32; \
        EpiY E{(bf16_t*)(big + BIG_YM)}; GEMM_RUN(EpiY, OrderMoe, g, S, E);) \
    PHASE(pb + 21, phase_combine(p, l);) }
    LAYER_BODY(0)
    LAYER_BODY(1)
#undef LAYER_BODY
#undef PHASE
#undef SEAM
#undef IN
}

#ifndef N_LAUNCHES
#define N_LAUNCHES 1
#endif
extern "C" void kernel_launch(void* const* d_in, const int* in_sizes, int n_in, void* d_out, int out_size, void* d_ws, size_t ws_size, hipStream_t stream) {
    static int grid = 0;
    if (grid == 0) {
        if (n_in != N_IN || out_size != NBATCH * SEQL * DM || ws_size < WS_END) { fprintf(stderr, "kernel_launch: unexpected shapes (n_in %d out %d ws %zu need %zu)\n", n_in, out_size, ws_size, (size_t)WS_END); grid = -1; return; }
        int dev = 0, cus = 0, per_cu = 0;
        if (hipGetDevice(&dev) != hipSuccess || hipDeviceGetAttribute(&cus, hipDeviceAttributeMultiprocessorCount, dev) != hipSuccess) { grid = -1; return; }
        if (hipFuncSetAttribute((const void*)mega, hipFuncAttributeMaxDynamicSharedMemorySize, LDS_BYTES) != hipSuccess) { grid = -1; return; }
        if (hipOccupancyMaxActiveBlocksPerMultiprocessor(&per_cu, (const void*)mega, 512, LDS_BYTES) != hipSuccess || per_cu < 1) { fprintf(stderr, "kernel_launch: occupancy query says %d\n", per_cu); }
        (void)hipGetLastError();
        grid = cus;
    }
    if (grid < 0) return;
    (void)hipMemsetAsync((char*)d_ws + WS_CTL, 0, 65536, stream);
    P p{};
    for (int i = 0; i < N_IN; ++i) p.in[i] = (const float*)d_in[i];
    p.out = (float*)d_out; p.ws = (unsigned char*)d_ws;
    if (N_LAUNCHES == 1) { p.ph_lo = 0; p.ph_hi = NPH; hipLaunchKernelGGL(mega, dim3(grid), dim3(512), LDS_BYTES, stream, p); }
    else for (int k = 0; k < NPH; ++k) { p.ph_lo = k; p.ph_hi = k + 1; hipLaunchKernelGGL(mega, dim3(grid), dim3(512), LDS_BYTES, stream, p); }
}
```

```cpp
#include <hip/hip_runtime.h>
#include <cstdio>
#include <cstdint>

#define LAS __attribute__((address_space(3)))
typedef unsigned short bf16_t;
typedef short bf16x8 __attribute__((ext_vector_type(8)));
typedef float f32x4 __attribute__((ext_vector_type(4)));
typedef unsigned u32x4 __attribute__((ext_vector_type(4)));
typedef unsigned u32x2 __attribute__((ext_vector_type(2)));

#define XB_TMO      128
#define XB_XCNT(j)  (256  + 64 * (j))
#define XB_XSUB(j)  (1280 + 64 * (j))
#define XB_XGEN(j)  (2304 + 64 * (j))
#define XB_TOP      3328
#define XB_TOPGEN   3392
#define XCD_BAR_WORDS 3456
#define XB_SPIN_CAP (1u << 18)

__device__ __forceinline__ unsigned xb_ld(unsigned* p)              { return __hip_atomic_load(p, __ATOMIC_RELAXED, __HIP_MEMORY_SCOPE_AGENT); }
__device__ __forceinline__ unsigned xb_add(unsigned* p, unsigned v) { return __hip_atomic_fetch_add(p, v, __ATOMIC_RELAXED, __HIP_MEMORY_SCOPE_AGENT); }
__device__ __forceinline__ unsigned xb_xcc_id() { return (unsigned)__builtin_amdgcn_s_getreg((3 << 11) | 20) & 0xFu; }
#define XB_SPIN(cond, bar) do { unsigned _sp = 0; while (cond) { __builtin_amdgcn_s_sleep(1); \
    if ((++_sp & 255u) == 0u) { if (xb_ld(&(bar)[XB_TMO])) break; if (_sp > XB_SPIN_CAP) { atomicAdd(&(bar)[XB_TMO], 1u); break; } } } } while (0)

struct XcdBarrier {
    unsigned* bar; unsigned x;
    int swid;
    volatile LAS unsigned* st;
};

__device__ __forceinline__ XcdBarrier xcd_barrier_post(unsigned* bar, volatile LAS unsigned* st, int swid) {
    XcdBarrier b; b.bar = bar; b.x = xb_xcc_id(); b.st = st; b.swid = swid;
    if (swid == 0 && __builtin_amdgcn_mbcnt_hi(~0u, __builtin_amdgcn_mbcnt_lo(~0u, 0u)) == 0u) (void)xb_add(&bar[XB_XCNT(b.x)], 1u);
    return b;
}
__device__ __forceinline__ void xcd_barrier_complete(unsigned* bar, unsigned x, unsigned& nloc, unsigned& nx) {
    const unsigned G = gridDim.x * gridDim.y * gridDim.z;
    unsigned sum, cnt, mine, sp = 0u;
    for (;;) {
        sum = 0u; cnt = 0u; mine = 0u;
#pragma unroll
        for (unsigned j = 0; j < 16; ++j) { const unsigned c = xb_ld(&bar[XB_XCNT(j)]); sum += c; cnt += (c > 0u) ? 1u : 0u; mine = (j == x) ? c : mine; }
        if (sum == G) break;
        __builtin_amdgcn_s_sleep(1);
        if ((++sp & 255u) == 0u) { if (xb_ld(&bar[XB_TMO])) break; if (sp > XB_SPIN_CAP) { atomicAdd(&bar[XB_TMO], 1u); break; } }
    }
    nloc = mine > 0u ? mine : 1u; nx = cnt > 0u ? cnt : 1u;
}

__device__ __forceinline__ void xcd_barrier(const XcdBarrier& b) {
    asm volatile("s_waitcnt vmcnt(0)" ::: "memory");
    __syncthreads();
    if (b.swid == 0 && __builtin_amdgcn_mbcnt_hi(~0u, __builtin_amdgcn_mbcnt_lo(~0u, 0u)) == 0u) {
        unsigned* bar = b.bar;
        __builtin_amdgcn_s_waitcnt(0);
        unsigned nloc = b.st[0], nx = b.st[1];
        if (nloc == 0u) { xcd_barrier_complete(bar, b.x, nloc, nx); b.st[0] = nloc; b.st[1] = nx; }
        const unsigned old = xb_add(&bar[XB_XSUB(b.x)], 1u);
        const unsigned gen = old / nloc;
        if (old + 1u == (gen + 1u) * nloc) {
            __builtin_amdgcn_fence(__ATOMIC_RELEASE, "agent");
            asm volatile("s_waitcnt vmcnt(0)" ::: "memory");
            const unsigned og = xb_add(&bar[XB_TOP], 1u);
            const unsigned tg = og / nx;
            if (og + 1u == (tg + 1u) * nx) xb_add(&bar[XB_TOPGEN], 1u);
            else XB_SPIN(xb_ld(&bar[XB_TOPGEN]) == tg, bar);
            __builtin_amdgcn_fence(__ATOMIC_ACQUIRE, "agent");
            xb_add(&bar[XB_XGEN(b.x)], 1u);
            asm volatile("s_waitcnt vmcnt(0)" ::: "memory");
        } else {
            XB_SPIN(xb_ld(&bar[XB_XGEN(b.x)]) == gen, bar);
            __builtin_amdgcn_fence(__ATOMIC_ACQUIRE, "agent");
            asm volatile("s_waitcnt vmcnt(0)" ::: "memory");
        }
    }
    __syncthreads();
}


constexpr int DM = 1024, NBATCH = 2, SEQL = 8192, CTXL = 256, NTOK = 8448, TT = 16896, NCHUNK = 132, MT = 66;
constexpr int ZLD = 2560;
constexpr float EPS = 1e-6f;
constexpr int RGX = 0, RGY = 512, GQ = 1024, GK = 1280, GV = 1536, GG = 2048;
constexpr int HQ = 0, HI = 512, HF = 1024, HGT = 2048;
constexpr int MQ = 0, MK = 512, MV = 1024, MO = 1536;
constexpr int MISC_LR = 0, MISC_IF = 32;
constexpr int NSLOT_MAX = 37888;

enum { I_X = 0, I_C, I_CTX, I_CCTX, I_ADAW, I_ADAB, I_NMIXG, I_NFFNG, I_WIN, I_RGCW, I_RGCB, I_RGGW, I_RGGB, I_RGLAM, I_GLAWLR, I_GLABLR, I_GLANG,
       I_HGLB, I_HGNG, I_MLCW, I_MLCB, I_MLGB, I_MLNG, I_WBR, I_WMERGE, I_BMERGE, I_WOUT, I_MWG, I_MBG, I_MWE, I_MBE, I_MW1, I_MW3, I_MW2, I_FNG, N_IN };

constexpr size_t WS_CTL = 0;
constexpr size_t WS_MOD = 65536;
constexpr size_t WS_HCTX = 262144;
constexpr size_t WS_ROUTE = WS_HCTX + 2097152;
constexpr size_t WS_MISC = WS_ROUTE + 1048576;
constexpr size_t WS_SMALL = WS_MISC + 4325376;
constexpr size_t WS_WB = WS_SMALL + 8388608;
constexpr size_t WB_WIN = 0, WB_WM = WB_WIN + 15204352, WB_WB = WB_WM + 8388608, WB_WO = WB_WB + 4194304, WB_W13 = WB_WO + 2097152,
                 WB_W2 = WB_W13 + 33554432, WB_GW = WB_W2 + 16777216, WB_END = WB_GW + 262144;
constexpr size_t WS_U = WS_WB + WB_END;
constexpr size_t WS_BIG = WS_U + 34603008;
constexpr size_t BIG_Z = 0, BIG_ST = 86507520, BIG_YS = BIG_ST + 69206016 + 65536, BIG_END = BIG_YS + 69206016;
constexpr size_t WS_WB2 = WS_BIG + BIG_END;
constexpr size_t WS_END = WS_WB2 + 33554432 + 16777216;
constexpr size_t BIG_BO = 0;
constexpr size_t BIG_MERGED = BIG_YS;
constexpr size_t BIG_XS = 0;
constexpr size_t BIG_HS = 77594624;
constexpr size_t BIG_YM = BIG_HS + 38797312;
static_assert(BIG_YM + 77594624 <= BIG_END, "moe alias");
static_assert(138412032 <= BIG_YS, "BO alias");
constexpr int CW_CNT = 4096;

struct P { const float* in[N_IN]; float* out; unsigned char* ws; int ph_lo, ph_hi; };
struct PP : P { int swid; };

__device__ __forceinline__ float bf2f(bf16_t b) { return __uint_as_float(((unsigned)b) << 16); }
typedef float f32x2_t __attribute__((ext_vector_type(2)));
typedef __bf16 bf16x2_t __attribute__((ext_vector_type(2)));
__device__ __forceinline__ unsigned pack2(float lo, float hi) { const f32x2_t v = {lo, hi}; const bf16x2_t b = __builtin_convertvector(v, bf16x2_t); return __builtin_bit_cast(unsigned, b); }
__device__ __forceinline__ bf16_t f2bf(float f) { return (bf16_t)(pack2(f, 0.f) & 0xffffu); }
__device__ __forceinline__ float frcp(float x) { return __builtin_amdgcn_rcpf(x); }
__device__ __forceinline__ float sigm(float x) { return frcp(1.f + __expf(-x)); }
__device__ __forceinline__ float siluf(float x) { return x * sigm(x); }
__device__ __forceinline__ float logsig(float x) { return fminf(x, 0.f) - __logf(1.f + __expf(-fabsf(x))); }
__device__ __forceinline__ float softplusf(float x) { return fmaxf(x, 0.f) + __logf(1.f + __expf(-fabsf(x))); }
__device__ __forceinline__ float gelu_tanh(float x) { const float y = 0.7978845608028654f * (x + 0.044715f * x * x * x); const float t = 1.f - 2.f * frcp(__expf(2.f * y) + 1.f); return 0.5f * x * (1.f + t); }
__device__ __forceinline__ float wave_sum(float v) {
#pragma unroll
    for (int o = 32; o > 0; o >>= 1) v += __shfl_xor(v, o);
    return v;
}
__device__ __forceinline__ int lane_id() { return (int)__builtin_amdgcn_mbcnt_hi(~0u, __builtin_amdgcn_mbcnt_lo(~0u, 0u)); }
__device__ __forceinline__ int otid(int swid) { int t = swid * 64 + lane_id(); asm volatile("" : "+v"(t)); return t; }
__device__ __forceinline__ const float* hrow_c(const float* HL, const float* HC, int r) { const int b = r / NTOK, p = r - b * NTOK; return p < CTXL ? HC + ((size_t)b * CTXL + p) * DM : HL + ((size_t)b * SEQL + (p - CTXL)) * DM; }
__device__ __forceinline__ float* hrow_m(float* HL, float* HC, int r) { const int b = r / NTOK, p = r - b * NTOK; return p < CTXL ? HC + ((size_t)b * CTXL + p) * DM : HL + ((size_t)b * SEQL + (p - CTXL)) * DM; }
__device__ __forceinline__ int mod_idx(int r) { const int b = r / NTOK, p = r - b * NTOK; return p < CTXL ? 2 : b; }

typedef const __attribute__((address_space(4))) P* KP;
__device__ __forceinline__ PP load_args(int swid) { unsigned long long a = (unsigned long long)__builtin_amdgcn_kernarg_segment_ptr(); asm volatile("" : "+s"(a)); KP k = (KP)a; PP r; r.swid = swid;
#pragma unroll
    for (int i = 0; i < N_IN; ++i) r.in[i] = k->in[i];
    r.out = k->out; r.ws = k->ws; r.ph_lo = k->ph_lo; r.ph_hi = k->ph_hi; return r; }
struct Unit { int pm, pn; };
struct Gemm { const bf16_t* A; const bf16_t* Bt; int lda; int K; int swid; };

struct TileOrder {
    int nM, nN, G, c;
    __device__ __forceinline__ void a_ready(const Unit&) const {}
    __device__ __forceinline__ void done(const Unit&) const {}
    __device__ void init(int nM_, int nN_, int G_, int c_) { nM = nM_; nN = nN_; G = G_; c = c_; }
    __device__ __forceinline__ bool base(int i, Unit& u) const { const long L = (long)i * G + c; const int nwg = nM * nN; if (L >= (long)nwg) return false;
        int wgid = (int)L; { const int q = nwg / 8, r = nwg % 8, xcd = wgid % 8, off = wgid / 8; wgid = (xcd < r ? xcd * (q + 1) : r * (q + 1) + (xcd - r) * q) + off; }
        const int nig = 8 * nN, gid = wgid / nig, fm = gid * 8, gsz = (nM - fm) < 8 ? (nM - fm) : 8;
        u.pm = fm + ((wgid % nig) % gsz); u.pn = (wgid % nig) / gsz; return true; }
};
struct OrderPlain : TileOrder { int skipctx; __device__ __forceinline__ bool next(int i, Unit& u) const { if (!base(i, u)) return false; if (skipctx) u.pm = u.pm < 32 ? u.pm + 1 : u.pm + 2; return true; } };
struct OrderBranch : TileOrder { int skipctx; __device__ __forceinline__ bool next(int i, Unit& u) const { if (!base(i, u)) return false; int pm = u.pm; if (skipctx) pm = pm < 32 ? pm + 1 : pm + 2; u.pm = (u.pn >> 2) * MT + pm; return true; } };
struct OrderMoe : TileOrder { const LAS int* blk_e; __device__ __forceinline__ bool next(int i, Unit& u) const { if (!base(i, u)) return false; u.pn = blk_e[u.pm] * 4 + u.pn; return true; } };

template <class Epi, class Sched>
__device__ __forceinline__ void gemm_simple(const Gemm g, const Sched& S, const Epi& E) {
    const int tid = otid(g.swid), wid = tid >> 6, lane = tid & 63, wr = wid >> 2, wc = wid & 3, fr = lane & 15, fq = lane >> 4;
    Unit u;
    for (int it = 0; S.next(it, u); ++it) {
        f32x4 acc[2][2][4][2];
#pragma unroll
        for (int a = 0; a < 2; ++a)
#pragma unroll
            for (int b = 0; b < 2; ++b)
#pragma unroll
                for (int m = 0; m < 4; ++m)
#pragma unroll
                    for (int n = 0; n < 2; ++n) acc[a][b][m][n] = (f32x4){0.f, 0.f, 0.f, 0.f};
        const bf16_t* Ap = g.A + (size_t)(u.pm * 256 + wr * 64 + fr) * g.lda + fq * 8;
        const bf16_t* Bp = g.Bt + (size_t)(u.pn * 256 + wc * 32 + fr) * g.K + fq * 8;
        for (int k0 = 0; k0 < g.K; k0 += 32) {
            bf16x8 b[2][2];
#pragma unroll
            for (int bj = 0; bj < 2; ++bj)
#pragma unroll
                for (int n = 0; n < 2; ++n) b[bj][n] = *(const bf16x8*)(Bp + (size_t)(bj * 128 + n * 16) * g.K + k0);
#pragma unroll
            for (int ai = 0; ai < 2; ++ai) {
                bf16x8 a[4];
#pragma unroll
                for (int m = 0; m < 4; ++m) a[m] = *(const bf16x8*)(Ap + (size_t)(ai * 128 + m * 16) * g.lda + k0);
#pragma unroll
                for (int bj = 0; bj < 2; ++bj)
#pragma unroll
                    for (int m = 0; m < 4; ++m)
#pragma unroll
                        for (int n = 0; n < 2; ++n) acc[ai][bj][m][n] = __builtin_amdgcn_mfma_f32_16x16x32_bf16(b[bj][n], a[m], acc[ai][bj][m][n], 0, 0, 0);
                __builtin_amdgcn_sched_barrier(0);
            }
        }
        E(acc, u, wr, wc, fr, fq);
    }
}

#define PG8_LAS __attribute__((address_space(3)))
constexpr int BM = 256, BK = 64, HALF = 128, HTB = HALF * BK * 2  , STAGE_BYTES = 8 * HTB;
__host__ __device__ __forceinline__ int lds_byte(int r, int c) { const int st = (r >> 4) * 2 + (c >> 5), rr = r & 15, cc = c & 31, ob = rr * 64 + cc * 2; return st * 1024 + (ob ^ (((ob >> 9) & 1) << 5)); }
__host__ __device__ __forceinline__ void stage_rc(int b, int& R, int& C) { const int st = b / 1024, sb = b % 1024, swz = sb ^ (((sb >> 9) & 1) << 5); R = (st >> 1) * 16 + swz / 64; C = (st & 1) * 32 + (swz % 64) / 2; }
__host__ __device__ __forceinline__ int perm32(int rho) { const int n = rho >> 4, i = rho & 15; return 8 * (i >> 2) + 4 * n + (i & 3); }
template <class Epi, class Sched, bool STAMP = false>
__device__ __forceinline__ void gemm_phase(PG8_LAS unsigned char* lds, const Gemm g, const Sched& S, const Epi& E, unsigned long long* stamps = nullptr) {
    const int tid = otid(g.swid), wid = g.swid, lane = tid & 63, wr = wid >> 2, wc = wid & 3, fr = lane & 15, fq = lane >> 4;
    const int K = g.K, nt = K / BK;
    int ts_lo = 0, ts_hi = 0, nts = 0; const unsigned long long rt_entry = STAMP ? (unsigned long long)wall_clock64() : 0ull;
#define PG8_STAMP() do { if (STAMP && wid == 0 && nts < 64) { const unsigned long long _c = (unsigned long long)clock64(); \
        ts_lo = (lane == nts) ? (int)(unsigned)_c : ts_lo; ts_hi = (lane == nts) ? (int)(unsigned)(_c >> 32) : ts_hi; ++nts; } } while (0)
    PG8_STAMP();
    unsigned voffA[2], voffB[2];
#pragma unroll
    for (int i = 0; i < 2; ++i) { int R, C; stage_rc(tid * 16 + i * 8192, R, C); const int Rb = Epi::PERM ? ((R & ~31) + perm32(R & 31)) : R;
        voffA[i] = (unsigned)(R * K + C) * 2u; voffB[i] = (unsigned)(Rb * K + C) * 2u; }
    const size_t kstep = (size_t)(BK * 2);
    const size_t hstep = (size_t)HALF * K * 2;
    const size_t tstep = 2 * hstep;
    const unsigned ldsw = (unsigned)wid * 1024u;
    const int aoff = lds_byte(wr * 64 + fr, fq * 8), boff = lds_byte(wc * 32 + fr, fq * 8);
#define PG8_SA(b, h) (((b) * 2 + (h)) * HTB)
#define PG8_SB(b, h) ((4 + (b) * 2 + (h)) * HTB)
#define PG8_STAGE(bufoff, gbase, voff) do { _Pragma("unroll") for (int _i = 0; _i < 2; ++_i) \
        __builtin_amdgcn_global_load_lds((const unsigned*)((const char*)(gbase) + (voff)[_i]), (PG8_LAS unsigned*)(lds + (bufoff) + ldsw + _i * 8192), 16, 0, 0); } while (0)
#define PG8_LDA(dst, b, h) do { _Pragma("unroll") for (int m = 0; m < 4; ++m) _Pragma("unroll") for (int k = 0; k < 2; ++k) dst[m][k] = *(const PG8_LAS bf16x8*)(lds + PG8_SA(b, h) + aoff + m * 2048 + k * 1024); } while (0)
#define PG8_LDB(dst, b, h) do { _Pragma("unroll") for (int n = 0; n < 2; ++n) _Pragma("unroll") for (int k = 0; k < 2; ++k) dst[n][k] = *(const PG8_LAS bf16x8*)(lds + PG8_SB(b, h) + boff + n * 2048 + k * 1024); } while (0)
#define PG8_MMA(ai, bj, At, Bt) do { __builtin_amdgcn_s_setprio(1); _Pragma("unroll") for (int m = 0; m < 4; ++m) _Pragma("unroll") for (int n = 0; n < 2; ++n) _Pragma("unroll") for (int k = 0; k < 2; ++k) \
        acc[ai][bj][m][n] = __builtin_amdgcn_mfma_f32_16x16x32_bf16(Bt[n][k], At[m][k], acc[ai][bj][m][n], 0, 0, 0); __builtin_amdgcn_s_setprio(0); } while (0)
#define PG8_WAIT_V(n) asm volatile("s_waitcnt vmcnt(" #n ")" ::: "memory")
#define PG8_WAIT_L(n) asm volatile("s_waitcnt lgkmcnt(" #n ")" ::: "memory")
#define PG8_BAR __builtin_amdgcn_s_barrier()
#define PG8_SCHED __builtin_amdgcn_sched_barrier(0)
    Unit cur, nxt; int ui = 0;
    if (!S.next(0, cur)) return;
    f32x4 acc[2][2][4][2];
#pragma unroll
    for (int a = 0; a < 2; ++a)
#pragma unroll
        for (int b = 0; b < 2; ++b)
#pragma unroll
            for (int m = 0; m < 4; ++m)
#pragma unroll
                for (int n = 0; n < 2; ++n) acc[a][b][m][n] = (f32x4){0.f, 0.f, 0.f, 0.f};
    bf16x8 At[4][2], B0[2][2], B1[2][2];
    const char* cA = (const char*)g.A + (size_t)cur.pm * tstep; const char* cB = (const char*)g.Bt + (size_t)cur.pn * tstep;
    S.a_ready(cur);
    PG8_STAGE(PG8_SB(0, 0), cB, voffB); PG8_STAGE(PG8_SA(0, 0), cA, voffA); PG8_STAGE(PG8_SB(0, 1), cB + hstep, voffB); PG8_STAGE(PG8_SA(0, 1), cA + hstep, voffA);
    if (wr == 1) PG8_BAR;
    PG8_WAIT_V(4); PG8_BAR;
    PG8_STAGE(PG8_SB(1, 0), cB + kstep, voffB); PG8_STAGE(PG8_SA(1, 0), cA + kstep, voffA); PG8_STAGE(PG8_SB(1, 1), cB + hstep + kstep, voffB);
    PG8_WAIT_V(6); PG8_BAR;
    PG8_STAMP();
    for (;;) {
        const bool has_next = S.next(ui + 1, nxt);
        const char* nA = has_next ? (const char*)g.A + (size_t)nxt.pm * tstep : cA; const char* nB = has_next ? (const char*)g.Bt + (size_t)nxt.pn * tstep : cB;
        for (int t = 0; t < nt; t += 2) {
            const bool last = (t == nt - 2);
            const char* a1 = cA + (size_t)(t + 1) * kstep;
            const char* a2 = last ? nA : cA + (size_t)(t + 2) * kstep; const char* b2 = last ? nB : cB + (size_t)(t + 2) * kstep;
            const char* a3 = a2 + kstep; const char* b3 = b2 + kstep;
            if (last && has_next) S.a_ready(nxt);
            PG8_LDB(B0, 0, 0); PG8_SCHED; PG8_LDA(At, 0, 0); PG8_STAGE(PG8_SA(1, 1), a1 + hstep, voffA);
            PG8_WAIT_L(8); PG8_BAR; PG8_WAIT_L(0); PG8_MMA(0, 0, At, B0); PG8_BAR; PG8_SCHED;
            PG8_LDB(B1, 0, 1); PG8_STAGE(PG8_SB(0, 0), b2, voffB);
            PG8_BAR; PG8_WAIT_L(0); PG8_MMA(0, 1, At, B1); PG8_BAR;
            PG8_LDA(At, 0, 1); PG8_STAGE(PG8_SA(0, 0), a2, voffA);
            PG8_BAR; PG8_WAIT_L(0); PG8_MMA(1, 0, At, B0); PG8_BAR; PG8_SCHED;
            PG8_STAGE(PG8_SB(0, 1), b2 + hstep, voffB);
            PG8_WAIT_V(6); PG8_BAR; PG8_MMA(1, 1, At, B1); PG8_BAR;
            PG8_LDB(B0, 1, 0); PG8_SCHED; PG8_LDA(At, 1, 0); PG8_STAGE(PG8_SA(0, 1), a2 + hstep, voffA);
            PG8_WAIT_L(8); PG8_BAR; PG8_WAIT_L(0); PG8_MMA(0, 0, At, B0); PG8_BAR; PG8_SCHED;
            PG8_LDB(B1, 1, 1); PG8_STAGE(PG8_SB(1, 0), b3, voffB);
            PG8_BAR; PG8_WAIT_L(0); PG8_MMA(0, 1, At, B1); PG8_BAR;
            PG8_LDA(At, 1, 1); PG8_STAGE(PG8_SA(1, 0), a3, voffA);
            PG8_BAR; PG8_WAIT_L(0); PG8_MMA(1, 0, At, B0); PG8_BAR; PG8_SCHED;
            PG8_STAGE(PG8_SB(1, 1), b3 + hstep, voffB);
            PG8_WAIT_V(6); PG8_BAR; PG8_MMA(1, 1, At, B1); PG8_BAR;
        }
        PG8_STAMP();
        if constexpr (!Epi::AFTER_DRAIN) { E(acc, cur, wr, wc, fr, fq); S.done(cur); }
        PG8_STAMP();
        if (!has_next) break;
#pragma unroll
        for (int a = 0; a < 2; ++a)
#pragma unroll
            for (int b = 0; b < 2; ++b)
#pragma unroll
                for (int m = 0; m < 4; ++m)
#pragma unroll
                    for (int n = 0; n < 2; ++n) acc[a][b][m][n] = (f32x4){0.f, 0.f, 0.f, 0.f};
        cur = nxt; cA = nA; cB = nB; ++ui;
    }
    PG8_WAIT_V(0);
    if (wr == 0) PG8_BAR;
    PG8_BAR;
    if constexpr (Epi::AFTER_DRAIN) { E.fused(acc, cur, wr, wc, fr, fq, lds, wid, lane); S.done(cur); }
    PG8_STAMP();
    if (STAMP && wid == 0) { stamps[lane] = lane < nts ? (((unsigned long long)(unsigned)ts_hi << 32) | (unsigned)ts_lo) : 0ull;
        if (lane == 62) stamps[62] = rt_entry; if (lane == 63) stamps[63] = (unsigned long long)wall_clock64(); }
#undef PG8_STAMP
#undef PG8_SA
#undef PG8_SB
#undef PG8_STAGE
#undef PG8_LDA
#undef PG8_LDB
#undef PG8_MMA
#undef PG8_WAIT_V
#undef PG8_WAIT_L
#undef PG8_BAR
#undef PG8_SCHED
}

#ifdef USE_SIMPLE_GEMM
#define GEMM_RUN(EpiT, SchedT, g, S, E) gemm_simple<EpiT, SchedT>(g, S, E)
#else
#define GEMM_RUN(EpiT, SchedT, g, S, E) gemm_phase<EpiT, SchedT>(L, g, S, E)
#endif


struct EpiZ {
    static constexpr bool PERM = true, AFTER_DRAIN = false;
    bf16_t* Z; float* MISC; int misc_pn;
    __device__ __forceinline__ void operator()(const f32x4 (&acc)[2][2][4][2], const Unit& u, int wr, int wc, int fr, int fq) const {
        const int row0 = u.pm * 256 + wr * 64 + fr, col0 = u.pn * 256 + wc * 32 + 8 * fq;
        if (u.pn == misc_pn) {
            if (wc < 2) {
#pragma unroll
                for (int ai = 0; ai < 2; ++ai)
#pragma unroll
                    for (int m = 0; m < 4; ++m) { const int row = row0 + ai * 128 + m * 16; float* mp = MISC + (size_t)row * 64 + wc * 32 + 8 * fq;
                        *(f32x4*)mp = acc[ai][0][m][0]; *(f32x4*)(mp + 4) = acc[ai][0][m][1]; } }
        } else {
#pragma unroll
            for (int ai = 0; ai < 2; ++ai)
#pragma unroll
                for (int m = 0; m < 4; ++m) { const int row = row0 + ai * 128 + m * 16;
#pragma unroll
                    for (int bj = 0; bj < 2; ++bj) { const f32x4 v0 = acc[ai][bj][m][0], v1 = acc[ai][bj][m][1];
                        *(uint4*)(Z + (size_t)row * ZLD + col0 + bj * 128) = make_uint4(pack2(v0[0], v0[1]), pack2(v0[2], v0[3]), pack2(v1[0], v1[1]), pack2(v1[2], v1[3])); } }
        }
    }
};
struct EpiBO {
    static constexpr bool PERM = true, AFTER_DRAIN = false;
    bf16_t* BO;
    __device__ __forceinline__ void operator()(const f32x4 (&acc)[2][2][4][2], const Unit& u, int wr, int wc, int fr, int fq) const {
        const int kb = u.pn >> 2, pm = u.pm - kb * MT, pn = u.pn & 3;
        const int row0 = pm * 256 + wr * 64 + fr, col0 = pn * 256 + wc * 32 + 8 * fq;
        bf16_t* base = BO + (size_t)kb * TT * DM;
#pragma unroll
        for (int ai = 0; ai < 2; ++ai)
#pragma unroll
            for (int m = 0; m < 4; ++m) { const int row = row0 + ai * 128 + m * 16;
#pragma unroll
                for (int bj = 0; bj < 2; ++bj) { const f32x4 v0 = acc[ai][bj][m][0], v1 = acc[ai][bj][m][1];
                    *(uint4*)(base + (size_t)row * DM + col0 + bj * 128) = make_uint4(pack2(v0[0], v0[1]), pack2(v0[2], v0[3]), pack2(v1[0], v1[1]), pack2(v1[2], v1[3])); } }
    }
};
struct EpiMerge {
    static constexpr bool PERM = false, AFTER_DRAIN = false;
    const bf16_t* __restrict__ BO; const float* __restrict__ bm; bf16_t* __restrict__ MG;
    __device__ __forceinline__ void operator()(const f32x4 (&acc)[2][2][4][2], const Unit& u, int wr, int wc, int fr, int fq) const {
        const int row0 = u.pm * 256 + wr * 64 + fr, c0 = u.pn * 64 + wc * 16 + 4 * fq;
        f32x4 bb[4];
#pragma unroll
        for (int kb = 0; kb < 4; ++kb) bb[kb] = *(const f32x4*)(bm + kb * DM + c0);
#pragma unroll
        for (int ai = 0; ai < 2; ++ai) {
            uint2 bo[4][4];
#pragma unroll
            for (int m = 0; m < 4; ++m)
#pragma unroll
                for (int kb = 0; kb < 4; ++kb) bo[m][kb] = *(const uint2*)(BO + ((size_t)kb * TT + row0 + ai * 128 + m * 16) * DM + c0);
#pragma unroll
            for (int m = 0; m < 4; ++m) { const int row = row0 + ai * 128 + m * 16; f32x4 s = (f32x4){0.f, 0.f, 0.f, 0.f};
#pragma unroll
                for (int bj = 0; bj < 2; ++bj)
#pragma unroll
                    for (int n = 0; n < 2; ++n) { const int kb = 2 * bj + n; const f32x4 a = acc[ai][bj][m][n]; const uint2 bv = bo[m][kb];
                        s[0] += sigm(a[0] + bb[kb][0]) * bf2f((bf16_t)(bv.x & 0xffff)); s[1] += sigm(a[1] + bb[kb][1]) * bf2f((bf16_t)(bv.x >> 16));
                        s[2] += sigm(a[2] + bb[kb][2]) * bf2f((bf16_t)(bv.y & 0xffff)); s[3] += sigm(a[3] + bb[kb][3]) * bf2f((bf16_t)(bv.y >> 16)); }
                *(uint2*)(MG + (size_t)row * DM + c0) = make_uint2(pack2(s[0], s[1]), pack2(s[2], s[3])); } }
    }
};
struct EpiOut {
    static constexpr bool PERM = false, AFTER_DRAIN = false;
    const float* sL; const float* sC; float* dL; float* dC; const float* mod;
    __device__ __forceinline__ void operator()(const f32x4 (&acc)[2][2][4][2], const Unit& u, int wr, int wc, int fr, int fq) const {
        const int row0 = u.pm * 256 + wr * 64 + fr, col0 = u.pn * 256 + wc * 32 + 4 * fq;
        const int mv = mod_idx(u.pm * 256);
        const float* g1 = mod + mv * 6144 + 2 * DM;
        f32x4 gg[2][2];
#pragma unroll
        for (int bj = 0; bj < 2; ++bj)
#pragma unroll
            for (int n = 0; n < 2; ++n) gg[bj][n] = *(const f32x4*)(g1 + col0 + bj * 128 + n * 16);
#pragma unroll
        for (int ai = 0; ai < 2; ++ai) {
            f32x4 hv[4][2][2];
#pragma unroll
            for (int m = 0; m < 4; ++m) { const float* src = hrow_c(sL, sC, row0 + ai * 128 + m * 16);
#pragma unroll
                for (int bj = 0; bj < 2; ++bj)
#pragma unroll
                    for (int n = 0; n < 2; ++n) hv[m][bj][n] = *(const f32x4*)(src + col0 + bj * 128 + n * 16); }
#pragma unroll
            for (int m = 0; m < 4; ++m) { float* dst = hrow_m(dL, dC, row0 + ai * 128 + m * 16);
#pragma unroll
                for (int bj = 0; bj < 2; ++bj)
#pragma unroll
                    for (int n = 0; n < 2; ++n) *(f32x4*)(dst + col0 + bj * 128 + n * 16) = hv[m][bj][n] + gg[bj][n] * acc[ai][bj][m][n]; } }
    }
};
struct EpiH {
    static constexpr bool PERM = false, AFTER_DRAIN = false;
    bf16_t* HS;
    __device__ __forceinline__ void operator()(const f32x4 (&acc)[2][2][4][2], const Unit& u, int wr, int wc, int fr, int fq) const {
        const int pn = u.pn & 3, row0 = u.pm * 256 + wr * 64 + fr, hc0 = pn * 128 + wc * 16 + 4 * fq;
#pragma unroll
        for (int ai = 0; ai < 2; ++ai)
#pragma unroll
            for (int m = 0; m < 4; ++m) { const int row = row0 + ai * 128 + m * 16;
#pragma unroll
                for (int bj = 0; bj < 2; ++bj) { const f32x4 a = acc[ai][bj][m][0], c = acc[ai][bj][m][1];
                    *(uint2*)(HS + (size_t)row * 512 + hc0 + bj * 64) = make_uint2(pack2(siluf(a[0]) * c[0], siluf(a[1]) * c[1]), pack2(siluf(a[2]) * c[2], siluf(a[3]) * c[3])); } }
    }
};
struct EpiY {
    static constexpr bool PERM = true, AFTER_DRAIN = false;
    bf16_t* YM;
    __device__ __forceinline__ void operator()(const f32x4 (&acc)[2][2][4][2], const Unit& u, int wr, int wc, int fr, int fq) const {
        const int pn = u.pn & 3, row0 = u.pm * 256 + wr * 64 + fr, col0 = pn * 256 + wc * 32 + 8 * fq;
#pragma unroll
        for (int ai = 0; ai < 2; ++ai)
#pragma unroll
            for (int m = 0; m < 4; ++m) { const int row = row0 + ai * 128 + m * 16;
#pragma unroll
                for (int bj = 0; bj < 2; ++bj) { const f32x4 v0 = acc[ai][bj][m][0], v1 = acc[ai][bj][m][1];
                    *(uint4*)(YM + (size_t)row * DM + col0 + bj * 128) = make_uint4(pack2(v0[0], v0[1]), pack2(v0[2], v0[3]), pack2(v1[0], v1[1]), pack2(v1[2], v1[3])); } }
    }
};

__device__ __forceinline__ void phase_mods(const PP& p, LAS float* lds) {
    const int tid = otid(p.swid);
    float* MOD = (float*)(p.ws + WS_MOD);
    LAS float* sc = lds;
    LAS float* red = lds + 3072;
    for (int i = tid; i < 3072; i += 512) { const int v = i >> 10, k = i & 1023; const float x = v < 2 ? p.in[I_C][v * DM + k] : p.in[I_CCTX][k]; sc[i] = siluf(x); }
    __syncthreads();
    for (int u = blockIdx.x; u < 96; u += gridDim.x) {
        const int l = u / 48, cg = u % 48, col = cg * 128 + (tid & 127), kp = tid >> 7;
        const float* W = p.in[I_ADAW] + (size_t)l * DM * 6144 + col;
        float s0 = 0.f, s1 = 0.f, s2 = 0.f;
        for (int k = kp * 256; k < kp * 256 + 256; ++k) { const float w = W[(size_t)k * 6144]; s0 += sc[k] * w; s1 += sc[1024 + k] * w; s2 += sc[2048 + k] * w; }
        red[(kp * 3 + 0) * 128 + (tid & 127)] = s0; red[(kp * 3 + 1) * 128 + (tid & 127)] = s1; red[(kp * 3 + 2) * 128 + (tid & 127)] = s2;
        __syncthreads();
        if (tid < 384) { const int v = tid >> 7, cc = tid & 127; const float s = red[(0 * 3 + v) * 128 + cc] + red[(1 * 3 + v) * 128 + cc] + red[(2 * 3 + v) * 128 + cc] + red[(3 * 3 + v) * 128 + cc];
            MOD[((size_t)l * 3 + v) * 6144 + cg * 128 + cc] = s + p.in[I_ADAB][l * 6144 + cg * 128 + cc]; }
        __syncthreads();
    }
}

__device__ __forceinline__ const float* conv_src(const PP& p, int l, int mat, int sub, int n, int& ld) {
    switch (mat) {
    case 0: { ld = 7216; int c; if (n < 2592) c = n; else if (n < 2608) c = 7200 + (n - 2592); else if (n < 2816) return nullptr; else if (n < 5376) c = 2592 + (n - 2816); else c = 5152 + (n - 5376);
              return p.in[I_WIN] + (size_t)l * DM * 7216 + c; }
    case 1: { ld = 4096; const int pn = n >> 8, ct = n & 255, bj = ct >> 7, wc = (ct >> 5) & 3, nn = (ct >> 4) & 1, i = ct & 15; const int kb = 2 * bj + nn, c = 64 * pn + 16 * wc + i;
              return p.in[I_WMERGE] + (size_t)l * DM * 4096 + kb * DM + c; }
    case 2: { ld = 1024; return p.in[I_WBR] + ((size_t)l * 4 + sub) * 512 * DM + n; }
    case 3: { ld = 1024; return p.in[I_WOUT] + (size_t)l * DM * DM + n; }
    case 4: { ld = 512; const int g = n >> 5, nn = (n >> 4) & 1, i = n & 15, hc = 16 * g + i; return (nn ? p.in[I_MW3] : p.in[I_MW1]) + ((size_t)l * 16 + sub) * DM * 512 + hc; }
    case 5: { ld = 1024; return p.in[I_MW2] + ((size_t)l * 16 + sub) * 512 * DM + n; }
    default: { ld = 64; return p.in[I_RGGW] + ((size_t)l * 32 + sub) * 4096 + n; }
    }
}
__device__ __forceinline__ void conv_unit(int u, int& mat, int& sub, int& nt, int& kt, int& K, size_t& dstoff) {
    if (u < 1856) { mat = 0; sub = 0; nt = u >> 4; kt = u & 15; K = 1024; dstoff = WB_WIN; }
    else if (u < 2880) { const int v = u - 1856; mat = 1; sub = 0; nt = v >> 4; kt = v & 15; K = 1024; dstoff = WB_WM; }
    else if (u < 3392) { const int v = u - 2880; mat = 2; sub = v >> 7; nt = (v & 127) >> 3; kt = v & 7; K = 512; dstoff = WB_WB + (size_t)sub * 1024 * 512 * 2; }
    else if (u < 3648) { const int v = u - 3392; mat = 3; sub = 0; nt = v >> 4; kt = v & 15; K = 1024; dstoff = WB_WO; }
    else if (u < 7744) { const int v = u - 3648; mat = 4; sub = v >> 8; nt = (v & 255) >> 4; kt = v & 15; K = 1024; dstoff = WB_W13 + (size_t)sub * 1024 * 1024 * 2; }
    else if (u < 9792) { const int v = u - 7744; mat = 5; sub = v >> 7; nt = (v & 127) >> 3; kt = v & 7; K = 512; dstoff = WB_W2 + (size_t)sub * 1024 * 512 * 2; }
    else { mat = 6; sub = u - 9792; nt = 0; kt = 0; K = 64; dstoff = WB_GW + (size_t)sub * 4096 * 2; }
}
__device__ __forceinline__ void phase_convert(const PP& p, int l, LAS float* tile  , int u_lo, int u_hi, int wg_lo) {
    const int tid = otid(p.swid);
    unsigned char* wb = p.ws + WS_WB;
    if ((int)blockIdx.x < wg_lo) return;
    for (int u0 = u_lo + ((int)blockIdx.x - wg_lo) * 4; u0 < u_hi; u0 += ((int)gridDim.x - wg_lo) * 4) {
        float val[4][8];
#pragma unroll
        for (int q = 0; q < 4; ++q) { int mat, sub, nt, kt, K; size_t dstoff; conv_unit(u0 + q, mat, sub, nt, kt, K, dstoff);
            int ld; const float* sp = conv_src(p, l, mat, sub, nt * 64 + (tid & 63), ld);
#pragma unroll
            for (int i = 0; i < 8; ++i) { const int kk = (tid >> 6) + 8 * i; val[q][i] = sp ? sp[(size_t)(kt * 64 + kk) * ld] : 0.f; } }
#pragma unroll
        for (int q = 0; q < 4; ++q)
#pragma unroll
            for (int i = 0; i < 8; ++i) tile[q * 4160 + ((tid >> 6) + 8 * i) * 65 + (tid & 63)] = val[q][i];
        __syncthreads();
#pragma unroll
        for (int q = 0; q < 4; ++q) { int mat, sub, nt, kt, K; size_t dstoff; conv_unit(u0 + q, mat, sub, nt, kt, K, dstoff);
            const int nn = tid >> 3, ks = (tid & 7) * 8; unsigned w[4];
#pragma unroll
            for (int j = 0; j < 4; ++j) w[j] = pack2(tile[q * 4160 + (ks + 2 * j) * 65 + nn], tile[q * 4160 + (ks + 2 * j + 1) * 65 + nn]);
            unsigned char* dbase = (l == 1 && (mat == 4 || mat == 5)) ? p.ws + WS_WB2 + (dstoff - WB_W13) : wb + dstoff;
            *(uint4*)((bf16_t*)dbase + (size_t)(nt * 64 + nn) * K + kt * 64 + ks) = make_uint4(w[0], w[1], w[2], w[3]); }
        __syncthreads();
    }
}

__device__ __forceinline__ void norm_row(const PP& p, int l, int which, const float* src, int mv, int lane, float (&u)[4][4]) {
    const float* MOD = (const float*)(p.ws + WS_MOD) + ((size_t)l * 3 + mv) * 6144;
    const float* gain = (which ? p.in[I_NFFNG] : p.in[I_NMIXG]) + l * DM;
    const float* sh = MOD + (which ? 3 : 0) * DM; const float* sc = MOD + (which ? 4 : 1) * DM;
    float ss = 0.f;
#pragma unroll
    for (int i = 0; i < 4; ++i) { const f32x4 v = *(const f32x4*)(src + 256 * i + 4 * lane); u[i][0] = v[0]; u[i][1] = v[1]; u[i][2] = v[2]; u[i][3] = v[3]; ss += v[0] * v[0] + v[1] * v[1] + v[2] * v[2] + v[3] * v[3]; }
    ss = wave_sum(ss);
    const float rs = rsqrtf(ss * (1.f / DM) + EPS);
#pragma unroll
    for (int i = 0; i < 4; ++i) { const int col = 256 * i + 4 * lane; const f32x4 g = *(const f32x4*)(gain + col), a = *(const f32x4*)(sc + col), b = *(const f32x4*)(sh + col);
#pragma unroll
        for (int j = 0; j < 4; ++j) u[i][j] = u[i][j] * rs * g[j] * (1.f + a[j]) + b[j]; }
}
__device__ __forceinline__ void phase_norm1(const PP& p, int l) {
    const int tid_ = otid(p.swid), lane = tid_ & 63, gw = blockIdx.x * 8 + (tid_ >> 6), nw = gridDim.x * 8;
    const float* sL = l == 0 ? p.in[I_X] : p.out; const float* sC = l == 0 ? p.in[I_CTX] : (const float*)(p.ws + WS_HCTX);
    bf16_t* U = (bf16_t*)(p.ws + WS_U);
    for (int r = gw; r < TT; r += nw) {
        float u[4][4]; norm_row(p, l, 0, hrow_c(sL, sC, r), mod_idx(r), lane, u);
#pragma unroll
        for (int i = 0; i < 4; ++i) *(uint2*)(U + (size_t)r * DM + 256 * i + 4 * lane) = make_uint2(pack2(u[i][0], u[i][1]), pack2(u[i][2], u[i][3]));
    }
}

__device__ __forceinline__ void phase_route(const PP& p, int l, LAS unsigned char* L) {
    const int tid_ = otid(p.swid), lane = tid_ & 63, wid = p.swid;
    LAS int* lcnt = (LAS int*)L;
    LAS int* rex = lcnt + 32;
    LAS int* rpos = rex + 132;
    if (tid_ < 32) lcnt[tid_] = 0;
    __syncthreads();
    const float* sL = p.out; const float* sC = (const float*)(p.ws + WS_HCTX);
    int* tok_e = (int*)(p.ws + WS_ROUTE); float* tok_w = (float*)(p.ws + WS_ROUTE + 262144); int* tok_pos = (int*)(p.ws + WS_ROUTE + 524288);
    unsigned* cnt = (unsigned*)(p.ws + WS_CTL) + CW_CNT + l * 16 * 32;
    const float* wg = p.in[I_MWG] + (size_t)l * DM * 4; const float* we = p.in[I_MWE] + (size_t)l * DM * 16;
    const int rbase = blockIdx.x * 66;
    const float* gain = p.in[I_NFFNG] + l * DM;
    for (int rp = wid; rp < 33; rp += 8) {
        const int rr0 = 2 * rp, r0 = rbase + rr0, r1 = r0 + 1;
        if (l == 1 && (r0 % NTOK) < CTXL) { if (lane == 0) { rex[2 * rr0] = -1; rex[2 * rr0 + 1] = -1; rex[2 * rr0 + 2] = -1; rex[2 * rr0 + 3] = -1; } continue; }
        const float* s0 = hrow_c(sL, sC, r0); const float* s1 = hrow_c(sL, sC, r1); const int mv = mod_idx(r0);
        const float* MOD = (const float*)(p.ws + WS_MOD) + ((size_t)l * 3 + mv) * 6144; const float* sh = MOD + 3 * DM; const float* sc = MOD + 4 * DM;
        f32x4 xa[4], xb[4]; float ssa = 0.f, ssb = 0.f;
#pragma unroll
        for (int i = 0; i < 4; ++i) { xa[i] = *(const f32x4*)(s0 + 256 * i + 4 * lane); xb[i] = *(const f32x4*)(s1 + 256 * i + 4 * lane); }
#pragma unroll
        for (int i = 0; i < 4; ++i) { ssa += xa[i][0] * xa[i][0] + xa[i][1] * xa[i][1] + xa[i][2] * xa[i][2] + xa[i][3] * xa[i][3]; ssb += xb[i][0] * xb[i][0] + xb[i][1] * xb[i][1] + xb[i][2] * xb[i][2] + xb[i][3] * xb[i][3]; }
        ssa = wave_sum(ssa); ssb = wave_sum(ssb);
        const float rsa = rsqrtf(ssa * (1.f / DM) + EPS), rsb = rsqrtf(ssb * (1.f / DM) + EPS);
        float acca[20], accb[20];
#pragma unroll
        for (int q = 0; q < 20; ++q) { acca[q] = 0.f; accb[q] = 0.f; }
#pragma unroll 1
        for (int i = 0; i < 4; ++i) { const int col0 = 256 * i + 4 * lane;
            const f32x4 g = *(const f32x4*)(gain + col0), a = *(const f32x4*)(sc + col0), bsh = *(const f32x4*)(sh + col0), va = *(const f32x4*)(s0 + col0), vb = *(const f32x4*)(s1 + col0);
            const float* wgp = wg + (size_t)col0 * 4; const float* wep = we + (size_t)col0 * 16;
#pragma unroll
            for (int j = 0; j < 4; ++j) { const float m1 = g[j] * (1.f + a[j]); const float ya = va[j] * rsa * m1 + bsh[j], yb = vb[j] * rsb * m1 + bsh[j];
                const f32x4 gq = *(const f32x4*)(wgp + j * 4);
#pragma unroll
                for (int q = 0; q < 4; ++q) { acca[q] += ya * gq[q]; accb[q] += yb * gq[q]; }
#pragma unroll
                for (int q = 0; q < 4; ++q) { const f32x4 e = *(const f32x4*)(wep + j * 16 + 4 * q);
#pragma unroll
                    for (int z2 = 0; z2 < 4; ++z2) { acca[4 + 4 * q + z2] += ya * e[z2]; accb[4 + 4 * q + z2] += yb * e[z2]; } } }
            asm volatile("" ::: "memory"); }
#pragma unroll
        for (int q = 0; q < 20; ++q) { acca[q] = wave_sum(acca[q]); accb[q] = wave_sum(accb[q]); }
        if (lane < 2) {
            const int rr = rr0 + lane, r = r0 + lane; float acc[20];
#pragma unroll
            for (int q = 0; q < 20; ++q) acc[q] = lane ? accb[q] : acca[q];
            float gl[4];
#pragma unroll
            for (int q = 0; q < 4; ++q) gl[q] = acc[q] + p.in[I_MBG][l * 4 + q];
            int grp = 0; float gm = gl[0];
#pragma unroll
            for (int q = 1; q < 4; ++q) if (gl[q] > gm) { gm = gl[q]; grp = q; }
            float se = 0.f;
#pragma unroll
            for (int q = 0; q < 4; ++q) se += __expf(gl[q] - gm);
            const float pg = 1.f / se;
            float el[4];
#pragma unroll
            for (int q = 0; q < 4; ++q) { float v = 0.f;
#pragma unroll
                for (int gg = 0; gg < 4; ++gg) v = (gg == grp) ? acc[4 + gg * 4 + q] : v;
                el[q] = v + p.in[I_MBE][l * 16 + grp * 4 + q]; }
            int i0 = 0; float m0 = el[0];
#pragma unroll
            for (int q = 1; q < 4; ++q) if (el[q] > m0) { m0 = el[q]; i0 = q; }
            int i1 = -1; float m1 = -3.4e38f;
#pragma unroll
            for (int q = 0; q < 4; ++q) if (q != i0 && el[q] > m1) { m1 = el[q]; i1 = q; }
            const float e1 = __expf(m1 - m0), w0 = pg / (1.f + e1), w1 = pg * e1 / (1.f + e1);
            const int ex0 = grp * 4 + i0, ex1 = grp * 4 + i1;
            rex[2 * rr] = ex0; rex[2 * rr + 1] = ex1; rpos[2 * rr] = __hip_atomic_fetch_add(&lcnt[ex0], 1, __ATOMIC_RELAXED, __HIP_MEMORY_SCOPE_WORKGROUP); rpos[2 * rr + 1] = __hip_atomic_fetch_add(&lcnt[ex1], 1, __ATOMIC_RELAXED, __HIP_MEMORY_SCOPE_WORKGROUP);
            tok_e[2 * r] = ex0; tok_e[2 * r + 1] = ex1; tok_w[2 * r] = w0; tok_w[2 * r + 1] = w1;
        }
    }
    __syncthreads();
    if (tid_ < 16) { const int c = lcnt[tid_]; lcnt[16 + tid_] = c ? (int)atomicAdd(&cnt[32 * tid_], (unsigned)c) : 0; }
    __syncthreads();
    for (int i = tid_; i < 132; i += 512) { const int r = rbase + (i >> 1); const int e = rex[i]; if (r < TT && e >= 0) tok_pos[2 * r + (i & 1)] = lcnt[16 + e] + rpos[i]; }
    __syncthreads();
}
__device__ __forceinline__ int moe_tables(const PP& p, int l, LAS int* tbl  ) {
    const unsigned* cnt = (const unsigned*)(p.ws + WS_CTL) + CW_CNT + l * 16 * 32;
    __syncthreads();
    if (otid(p.swid) == 0) { int s = 0;
        for (int e = 0; e < 16; ++e) { const int c = (int)__hip_atomic_load(cnt + 32 * e, __ATOMIC_RELAXED, __HIP_MEMORY_SCOPE_AGENT); const int nb = (c + 255) >> 8; tbl[e] = s * 256; for (int b = 0; b < nb; ++b) tbl[32 + s + b] = e; s += nb; }
        tbl[16] = s; }
    __syncthreads();
    return tbl[16];
}
__device__ __forceinline__ void phase_dispatch(const PP& p, int l, LAS int* tbl) {
    const int tid_ = otid(p.swid), lane = tid_ & 63, gw = blockIdx.x * 8 + (tid_ >> 6), nw = gridDim.x * 8;
    moe_tables(p, l, tbl);
    const float* sL = p.out; const float* sC = (const float*)(p.ws + WS_HCTX);
    const int* tok_e = (const int*)(p.ws + WS_ROUTE); const int* tok_pos = (const int*)(p.ws + WS_ROUTE + 524288); int* tok_slot = (int*)(p.ws + WS_ROUTE + 786432);
    bf16_t* XS = (bf16_t*)(p.ws + WS_BIG + BIG_XS);
    for (int r = gw; r < TT; r += nw) {
        if (l == 1 && (r % NTOK) < CTXL) continue;
        float u[4][4]; norm_row(p, l, 1, hrow_c(sL, sC, r), mod_idx(r), lane, u);
        const int s0 = tbl[tok_e[2 * r]] + tok_pos[2 * r], s1 = tbl[tok_e[2 * r + 1]] + tok_pos[2 * r + 1];
        if (lane == 0) { tok_slot[2 * r] = s0; tok_slot[2 * r + 1] = s1; }
#pragma unroll
        for (int i = 0; i < 4; ++i) { const uint2 v = make_uint2(pack2(u[i][0], u[i][1]), pack2(u[i][2], u[i][3]));
            *(uint2*)(XS + (size_t)s0 * DM + 256 * i + 4 * lane) = v; *(uint2*)(XS + (size_t)s1 * DM + 256 * i + 4 * lane) = v; }
    }
}
__device__ __forceinline__ void phase_combine(const PP& p, int l) {
    const int tid_ = otid(p.swid), lane = tid_ & 63, gw = blockIdx.x * 8 + (tid_ >> 6), nw = gridDim.x * 8;
    float* HL = p.out; float* HC = (float*)(p.ws + WS_HCTX);
    const float* tok_w = (const float*)(p.ws + WS_ROUTE + 262144); const int* tok_slot = (const int*)(p.ws + WS_ROUTE + 786432);
    const bf16_t* YM = (const bf16_t*)(p.ws + WS_BIG + BIG_YM);
    for (int r = gw; r < TT; r += nw) {
        if (l == 1 && (r % NTOK) < CTXL) continue;
        const float* g2 = (const float*)(p.ws + WS_MOD) + ((size_t)l * 3 + mod_idx(r)) * 6144 + 5 * DM;
        float* hp = hrow_m(HL, HC, r);
        const int s0 = tok_slot[2 * r], s1 = tok_slot[2 * r + 1]; const float w0 = tok_w[2 * r], w1 = tok_w[2 * r + 1];
        float x[4][4]; float ss = 0.f;
#pragma unroll
        for (int i = 0; i < 4; ++i) { const int col = 256 * i + 4 * lane; const f32x4 h = *(const f32x4*)(hp + col), g = *(const f32x4*)(g2 + col);
            const uint2 a = *(const uint2*)(YM + (size_t)s0 * DM + col), b = *(const uint2*)(YM + (size_t)s1 * DM + col);
            x[i][0] = h[0] + g[0] * (w0 * bf2f((bf16_t)(a.x & 0xffff)) + w1 * bf2f((bf16_t)(b.x & 0xffff)));
            x[i][1] = h[1] + g[1] * (w0 * bf2f((bf16_t)(a.x >> 16)) + w1 * bf2f((bf16_t)(b.x >> 16)));
            x[i][2] = h[2] + g[2] * (w0 * bf2f((bf16_t)(a.y & 0xffff)) + w1 * bf2f((bf16_t)(b.y & 0xffff)));
            x[i][3] = h[3] + g[3] * (w0 * bf2f((bf16_t)(a.y >> 16)) + w1 * bf2f((bf16_t)(b.y >> 16)));
            ss += x[i][0] * x[i][0] + x[i][1] * x[i][1] + x[i][2] * x[i][2] + x[i][3] * x[i][3]; }
        if (l == 1) {
            ss = wave_sum(ss); const float rs = rsqrtf(ss * (1.f / DM) + EPS);
#pragma unroll
            for (int i = 0; i < 4; ++i) { const int col = 256 * i + 4 * lane; const f32x4 g = *(const f32x4*)(p.in[I_FNG] + col);
                *(f32x4*)(hp + col) = (f32x4){x[i][0] * rs * g[0], x[i][1] * rs * g[1], x[i][2] * rs * g[2], x[i][3] * rs * g[3]}; }
        } else {
#pragma unroll
            for (int i = 0; i < 4; ++i) *(f32x4*)(hp + 256 * i + 4 * lane) = (f32x4){x[i][0], x[i][1], x[i][2], x[i][3]};
            ss = wave_sum(ss); const float rs = rsqrtf(ss * (1.f / DM) + EPS);
            const float* MOD1 = (const float*)(p.ws + WS_MOD) + ((size_t)1 * 3 + mod_idx(r)) * 6144; bf16_t* U = (bf16_t*)(p.ws + WS_U);
#pragma unroll
            for (int i = 0; i < 4; ++i) { const int col = 256 * i + 4 * lane; const f32x4 g = *(const f32x4*)(p.in[I_NMIXG] + DM + col), a = *(const f32x4*)(MOD1 + DM + col), bsh = *(const f32x4*)(MOD1 + col);
                float y[4];
#pragma unroll
                for (int j2 = 0; j2 < 4; ++j2) y[j2] = x[i][j2] * rs * g[j2] * (1.f + a[j2]) + bsh[j2];
                *(uint2*)(U + (size_t)r * DM + col) = make_uint2(pack2(y[0], y[1]), pack2(y[2], y[3])); }
        }
    }
}

__device__ __forceinline__ int chain_chunk(int dir, int ci) { return dir == 0 ? ci : (ci < 4 ? 3 - ci : 135 - ci); }

__device__ __forceinline__ void phase_seq_rg(const PP& p, int l) {
    const int tid_ = otid(p.swid); if (tid_ >= 64 || blockIdx.x >= 32) return;
    const int u = blockIdx.x, lane = tid_, blk = u & 7, dir = (u >> 3) & 1, b = u >> 4, ch = blk * 64 + lane;
    const bf16_t* Z = (const bf16_t*)(p.ws + WS_BIG + BIG_Z);
    float* O = (float*)(p.ws + WS_BIG + BIG_ST) + (size_t)dir * TT * 512;
    float Wr[64], Wi[64];
    const float* gw = p.in[I_RGGW] + ((((size_t)l * 2 + dir) * 2) * 8 + blk) * 4096;
#pragma unroll
    for (int i = 0; i < 64; ++i) { Wr[i] = gw[i * 64 + lane]; Wi[i] = gw[8 * 4096 + i * 64 + lane]; }
    const float br = p.in[I_RGGB][((l * 2 + dir) * 2 + 0) * 512 + ch], bi = p.in[I_RGGB][((l * 2 + dir) * 2 + 1) * 512 + ch];
    const float sp = softplusf(-p.in[I_RGLAM][(l * 2 + dir) * 512 + ch]);
    float cw[4];
#pragma unroll
    for (int j = 0; j < 4; ++j) cw[j] = p.in[I_RGCW][(l * 4 + j) * 512 + ch];
    const float cb = p.in[I_RGCB][l * 512 + ch];
    float h = 0.f;
    for (int s = 0; s < NTOK; ++s) {
        int pp; if (dir == 0) pp = s; else pp = s < CTXL ? CTXL - 1 - s : NTOK - 1 - (s - CTXL);
        const int lo = pp < CTXL ? 0 : CTXL, hi = pp < CTXL ? CTXL : NTOK;
        float xb = cb;
#pragma unroll
        for (int j = 0; j < 4; ++j) { const int q = pp + j - 2; if (q >= lo && q < hi) xb += cw[j] * bf2f(Z[((size_t)b * NTOK + q) * ZLD + RGX + ch]); }
        float pr = br, pi = bi;
#pragma unroll
        for (int i = 0; i < 64; ++i) { const float xi = __uint_as_float(__builtin_amdgcn_readlane(__float_as_uint(xb), i)); pr += xi * Wr[i]; pi += xi * Wi[i]; }
        const float r = sigm(pr), ig = sigm(pi), la = -8.f * r * sp, a = __expf(la), bt = sqrtf(-expm1f(2.f * la)) * (ig * xb);
        h = a * h + bt;
        O[((size_t)b * NTOK + pp) * 512 + ch] = h;
    }
}
__device__ __forceinline__ void phase_epi_rg(const PP& p) {
    const int tid_ = otid(p.swid);
    const bf16_t* Z = (const bf16_t*)(p.ws + WS_BIG + BIG_Z); const float* OF = (const float*)(p.ws + WS_BIG + BIG_ST); const float* OB = OF + (size_t)TT * 512;
    bf16_t* YS = (bf16_t*)(p.ws + WS_BIG + BIG_YS);
    for (size_t i = (size_t)blockIdx.x * 512 + tid_; i < (size_t)TT * 512; i += (size_t)gridDim.x * 512) { const size_t r = i >> 9; const int ch = (int)(i & 511);
        YS[i] = f2bf(gelu_tanh(bf2f(Z[r * ZLD + RGY + ch])) * (OF[i] + OB[i])); }
}
template <int BR> __device__ __forceinline__ void phase_seq_gl(const PP& p, int l, LAS float* sm) {
    constexpr int DK = BR == 1 ? 64 : 128, DP = DK / 4;
    if (blockIdx.x >= 16) return;
    LAS float* LA = sm; LAS float* LK = sm + 64 * DK; LAS float* LQ = sm + 2 * 64 * DK; LAS float* LV = sm + 3 * 64 * DK;
    const int u = blockIdx.x, tid = otid(p.swid), dir = u & 1, h = (u >> 1) & 3, b = u >> 3, v = tid >> 2, part = tid & 3;
    const bf16_t* Z = (const bf16_t*)(p.ws + WS_BIG + BIG_Z); const float* MISC = (const float*)(p.ws + WS_MISC);
    float* O = (float*)(p.ws + WS_BIG + BIG_ST) + (size_t)dir * TT * 512;
    float S[DP];
#pragma unroll
    for (int i = 0; i < DP; ++i) S[i] = 0.f;
    for (int ci = 0; ci < NCHUNK; ++ci) {
        const int c = chain_chunk(dir, ci); const size_t r0 = (size_t)b * NTOK + c * 64;
        __syncthreads();
        for (int idx = tid; idx < 64 * DK; idx += 512) { const int t = idx / DK, d = idx % DK; const size_t r = r0 + t;
            float a, k, q;
            if (BR == 1) { float pre = p.in[I_GLABLR][(l * 2 + dir) * 256 + h * 64 + d];
                for (int rr = 0; rr < 16; ++rr) pre += MISC[r * 64 + MISC_LR + dir * 16 + rr] * p.in[I_GLAWLR][((size_t)(l * 2 + dir) * 16 + rr) * 256 + h * 64 + d];
                a = __expf(logsig(pre) * (1.f / 16.f)); k = bf2f(Z[r * ZLD + GK + h * 64 + d]); q = bf2f(Z[r * ZLD + GQ + h * 64 + d]) * 0.125f; }
            else { float lb = 0.f; if (l == 1) { const float l0 = p.in[I_HGLB][(0 * 2 + dir) * 512 + h * 128 + d], l1 = p.in[I_HGLB][(1 * 2 + dir) * 512 + h * 128 + d]; lb = 1.f / (1.f + __expf(l0 - l1)); }
                const float f = bf2f(Z[r * ZLD + HF + dir * 512 + h * 128 + d]); const float s = sigm(f);
                a = lb + (1.f - lb) * s; k = (1.f - lb) * sigm(-f); q = siluf(bf2f(Z[r * ZLD + HQ + h * 128 + d])) * 0.08838834764831845f; }
            LA[idx] = a; LK[idx] = k; LQ[idx] = q; }
        for (int idx = tid; idx < 64 * 128; idx += 512) { const int t = idx >> 7, vv = idx & 127; LV[idx] = bf2f(Z[(r0 + t) * ZLD + (BR == 1 ? GV : HI) + h * 128 + vv]); }
        __syncthreads();
        for (int j = 0; j < 64; ++j) { const int t = dir == 0 ? j : 63 - j; const float vv = LV[t * 128 + v]; float o = 0.f;
#pragma unroll
            for (int i = 0; i < DP; ++i) { const int d = part * DP + i; S[i] = LA[t * DK + d] * S[i] + LK[t * DK + d] * vv; o += S[i] * LQ[t * DK + d]; }
            o += __shfl_xor(o, 1); o += __shfl_xor(o, 2);
            if (part == 0) O[(r0 + t) * 512 + h * 128 + v] = o; }
    }
}
__device__ __forceinline__ void phase_seq_ml(const PP& p, int l, LAS float* sm) {
    if (blockIdx.x >= 16) return;
    LAS float* LK = sm; LAS float* LQ = sm + 8192; LAS float* LV = sm + 16384; LAS float* LI = sm + 24576; LAS float* LF = LI + 64;
    const int u = blockIdx.x, tid = otid(p.swid), dir = u & 1, h = (u >> 1) & 3, b = u >> 3, v = tid >> 2, part = tid & 3;
    const bf16_t* Z = (const bf16_t*)(p.ws + WS_BIG + BIG_Z); const float* MISC = (const float*)(p.ws + WS_MISC);
    float* O = (float*)(p.ws + WS_BIG + BIG_ST) + (size_t)dir * TT * 512;
    float C[32], N[32]; float m = 0.f;
#pragma unroll
    for (int i = 0; i < 32; ++i) { C[i] = 0.f; N[i] = 0.f; }
    for (int ci = 0; ci < NCHUNK; ++ci) {
        const int c = chain_chunk(dir, ci); const int p0 = c * 64; const size_t r0 = (size_t)b * NTOK + p0;
        const int lo = p0 < CTXL ? 0 : CTXL, hi = p0 < CTXL ? CTXL : NTOK;
        __syncthreads();
        for (int idx = tid; idx < 64 * 128; idx += 512) { const int t = idx >> 7, d = idx & 127, ch = h * 128 + d; const int pp = p0 + t;
            float q = p.in[I_MLCB][l * 1024 + ch], k = p.in[I_MLCB][l * 1024 + 512 + ch];
#pragma unroll
            for (int j = 0; j < 4; ++j) { const int qq = pp + j - 2; if (qq >= lo && qq < hi) { const size_t rr = (size_t)b * NTOK + qq;
                q += p.in[I_MLCW][(l * 4 + j) * 1024 + ch] * bf2f(Z[rr * ZLD + MQ + ch]); k += p.in[I_MLCW][(l * 4 + j) * 1024 + 512 + ch] * bf2f(Z[rr * ZLD + MK + ch]); } }
            LQ[idx] = siluf(q) * 0.08838834764831845f; LK[idx] = siluf(k); LV[idx] = bf2f(Z[(r0 + t) * ZLD + MV + ch]); }
        if (tid < 64) { const size_t r = r0 + tid; LI[tid] = MISC[r * 64 + MISC_IF + dir * 8 + h] + p.in[I_MLGB][(l * 2 + dir) * 8 + h];
            LF[tid] = logsig(MISC[r * 64 + MISC_IF + dir * 8 + 4 + h] + p.in[I_MLGB][(l * 2 + dir) * 8 + 4 + h]); }
        __syncthreads();
        for (int j = 0; j < 64; ++j) { const int t = dir == 0 ? j : 63 - j; const float it = LI[t], lf = LF[t];
            const float mn = fmaxf(lf + m, it), fd = __expf(lf + m - mn), iw = __expf(it - mn); m = mn;
            const float vv = LV[t * 128 + v]; float num = 0.f, den = 0.f;
#pragma unroll
            for (int i = 0; i < 32; ++i) { const int d = part * 32 + i; const float kd = LK[t * 128 + d], qd = LQ[t * 128 + d]; C[i] = fd * C[i] + iw * kd * vv; N[i] = fd * N[i] + iw * kd; num += C[i] * qd; den += N[i] * qd; }
            num += __shfl_xor(num, 1); num += __shfl_xor(num, 2); den += __shfl_xor(den, 1); den += __shfl_xor(den, 2);
            if (part == 0) O[(r0 + t) * 512 + h * 128 + v] = num / fmaxf(fabsf(den), __expf(-mn)); }
    }
}
template <int BR> __device__ __forceinline__ void phase_epi_norm(const PP& p, int l) {
    const int tid_ = otid(p.swid), lane = tid_ & 63; const bf16_t* Z = (const bf16_t*)(p.ws + WS_BIG + BIG_Z);
    const float* OF = (const float*)(p.ws + WS_BIG + BIG_ST); const float* OB = OF + (size_t)TT * 512;
    bf16_t* YS = (bf16_t*)(p.ws + WS_BIG + BIG_YS) + (size_t)BR * TT * 512;
    const float* gain = (BR == 1 ? p.in[I_GLANG] : BR == 2 ? p.in[I_HGNG] : p.in[I_MLNG]) + l * 128;
    const int goff = BR == 1 ? GG : BR == 2 ? HGT : MO;
    for (int w = blockIdx.x * 8 + (tid_ >> 6); w < TT * 4; w += gridDim.x * 8) { const size_t r = w >> 2; const int h = w & 3;
        const size_t i0 = r * 512 + h * 128 + lane, i1 = i0 + 64; const float o0 = OF[i0] + OB[i0], o1 = OF[i1] + OB[i1];
        const float ss = wave_sum(o0 * o0 + o1 * o1), rs = rsqrtf(ss * (1.f / 128.f) + EPS);
        const float g0 = bf2f(Z[r * ZLD + goff + h * 128 + lane]), g1 = bf2f(Z[r * ZLD + goff + h * 128 + lane + 64]);
        const float a0 = BR == 3 ? sigm(g0) : siluf(g0), a1 = BR == 3 ? sigm(g1) : siluf(g1);
        YS[i0] = f2bf(o0 * rs * gain[lane] * a0); YS[i1] = f2bf(o1 * rs * gain[lane + 64] * a1); }
}

constexpr size_t SM_RGA = 0, SM_RGB = 1081344, SM_RGH = 2162688, SM_DEC = 3244032, SM_MLBE = 4325376, SM_MLML = SM_MLBE + 8448, SM_MLMIN = SM_MLML + 8448, SM_MLDN = 4350720;
__device__ __forceinline__ unsigned pack2f(float lo, float hi) { return pack2(lo, hi); }
__device__ __forceinline__ f32x4 mfma16(bf16x8 x, bf16x8 y, f32x4 c) { const f32x4 d = __builtin_amdgcn_mfma_f32_16x16x32_bf16(x, y, c, 0, 0, 0); asm volatile("" :: "v"(x), "v"(y), "v"(d)); return d; }

__device__ __forceinline__ void settle(f32x4& a) { asm volatile("s_nop 11" : "+v"(a)); }
__device__ __forceinline__ void settle(f32x4& a, f32x4& b) { asm volatile("s_nop 11" : "+v"(a), "+v"(b)); }
__device__ __forceinline__ void settle(f32x4& a, f32x4& b, f32x4& c, f32x4& d) { asm volatile("s_nop 11" : "+v"(a), "+v"(b), "+v"(c), "+v"(d)); }
template <bool OUT> __device__ __forceinline__ void phase_rg(const PP& p, int l, LAS unsigned char* L) {
    const int tid = otid(p.swid), lane = tid & 63, wid = p.swid, fr = lane & 15, fq = lane >> 4;
    LAS bf16_t* XB = (LAS bf16_t*)L;
    LAS float* XF = (LAS float*)(L + 9216);
    LAS float* PRE = (LAS float*)(L + 9216 + 16384);
    const bf16_t* Z = (const bf16_t*)(p.ws + WS_BIG + BIG_Z); const bf16_t* GWT = (const bf16_t*)(p.ws + WS_WB + WB_GW);
    float* RA = (float*)(p.ws + WS_SMALL + SM_RGA); float* RB = (float*)(p.ws + WS_SMALL + SM_RGB); const float* RH = (const float*)(p.ws + WS_SMALL + SM_RGH);
    bf16_t* YS = (bf16_t*)(p.ws + WS_BIG + BIG_YS);
    const int blk = blockIdx.x & 7, nstr = gridDim.x >> 3, j = tid & 63, tg = tid >> 6, ch = blk * 64 + j;
    float cw[4];
#pragma unroll
    for (int q = 0; q < 4; ++q) cw[q] = p.in[I_RGCW][(l * 4 + q) * 512 + ch];
    const float cb = p.in[I_RGCB][l * 512 + ch];
    float gbr[2], gbi[2], gsp[2];
#pragma unroll
    for (int dir = 0; dir < 2; ++dir) { gbr[dir] = p.in[I_RGGB][((l * 2 + dir) * 2 + 0) * 512 + ch]; gbi[dir] = p.in[I_RGGB][((l * 2 + dir) * 2 + 1) * 512 + ch]; gsp[dir] = softplusf(-p.in[I_RGLAM][(l * 2 + dir) * 512 + ch]); }
    bf16x8 wx[4][2];
    { const int set = wid >> 1; const bf16_t* W = GWT + ((size_t)set * 8 + blk) * 4096;
#pragma unroll
      for (int jt = 0; jt < 4; ++jt) { wx[jt][0] = *(const bf16x8*)(W + (16 * jt + fr) * 64 + 8 * fq); wx[jt][1] = *(const bf16x8*)(W + (16 * jt + fr) * 64 + 8 * fq + 32); } }
    unsigned short win[11], yv[8]; float hin = 0.f;
    auto fetch = [&](int bc, unsigned short (&w_)[11], unsigned short (&y_)[8], float& h_) {
        const int c = bc % NCHUNK, b = bc / NCHUNK, p0 = c * 64; const size_t rb = (size_t)b * NTOK; const int lo = p0 < CTXL ? 0 : CTXL, hi = p0 < CTXL ? CTXL : NTOK;
#pragma unroll
        for (int k = 0; k < 11; ++k) { const int q = p0 + tg * 8 - 2 + k; w_[k] = (q >= lo && q < hi) ? Z[(rb + q) * ZLD + RGX + ch] : (unsigned short)0; }
        if (OUT) {
#pragma unroll
            for (int k = 0; k < 8; ++k) y_[k] = Z[(rb + p0 + tg * 8 + k) * ZLD + RGY + ch];
            if (tid < 128) h_ = RH[((size_t)((tid >> 6) * 2 + b) * NCHUNK + c) * 512 + ch]; }
    };
    int bc = blockIdx.x >> 3;
    if (bc < 2 * NCHUNK) fetch(bc, win, yv, hin);
    for (; bc < 2 * NCHUNK; bc += nstr) {
        const int c = bc % NCHUNK, b = bc / NCHUNK, p0 = c * 64; const size_t rb = (size_t)b * NTOK;
        float wf[11]; unsigned short ycur[8]; const float hcur = hin;
#pragma unroll
        for (int k = 0; k < 11; ++k) wf[k] = bf2f(win[k]);
#pragma unroll
        for (int k = 0; k < 8; ++k) ycur[k] = yv[k];
        if (bc + nstr < 2 * NCHUNK) fetch(bc + nstr, win, yv, hin);
#pragma unroll
        for (int k = 0; k < 8; ++k) { const int t = tg * 8 + k; const float xb = cb + cw[0] * wf[k] + cw[1] * wf[k + 1] + cw[2] * wf[k + 2] + cw[3] * wf[k + 3];
            XF[t * 64 + j] = xb; XB[t * 72 + j] = f2bf(xb); }
        __syncthreads();
        {
            const int set = wid >> 1;
#pragma unroll
            for (int tti = 0; tti < 2; ++tti) { const int tt = (wid & 1) * 2 + tti;
                const bf16x8 y0 = *(const LAS bf16x8*)(XB + (16 * tt + fr) * 72 + 8 * fq), y1 = *(const LAS bf16x8*)(XB + (16 * tt + fr) * 72 + 8 * fq + 32);
#pragma unroll
                for (int jt = 0; jt < 4; ++jt) { f32x4 acc = (f32x4){0.f, 0.f, 0.f, 0.f}; acc = mfma16(wx[jt][0], y0, acc); acc = mfma16(wx[jt][1], y1, acc); settle(acc);
                    *(LAS f32x4*)(PRE + (set * 64 + 16 * tt + fr) * 68 + 16 * jt + 4 * fq) = acc; } }
        }
        __syncthreads();
#pragma unroll
        for (int dir = 0; dir < 2; ++dir) {
#pragma unroll
            for (int k = 0; k < 8; ++k) { const int t = tg * 8 + k; LAS float* pa = PRE + ((dir * 2 + 0) * 64 + t) * 68 + j; LAS float* pb = PRE + ((dir * 2 + 1) * 64 + t) * 68 + j;
                const float r = sigm(*pa + gbr[dir]), ig = sigm(*pb + gbi[dir]), la = -8.f * r * gsp[dir];
                const float a = __expf(la), x2 = 2.f * la;
                const float ser = -x2 * (1.f + x2 * (0.5f + x2 * (0.16666667f + x2 * (0.041666668f + x2 * (0.008333334f + x2 * 0.0013888889f)))));
                const float om = x2 > -0.5f ? ser : 1.f - a * a;
                *pa = a; *pb = __builtin_amdgcn_sqrtf(om) * (ig * XF[t * 64 + j]); } }
        __syncthreads();
        if (tid < 128) {
            const int dir = tid >> 6; const size_t sidx = ((size_t)(dir * 2 + b) * NCHUNK + c) * 512 + ch;
            float h = OUT ? hcur : 0.f, P = 1.f;
#pragma unroll 8
            for (int s2 = 0; s2 < 64; ++s2) { const int t = dir ? 63 - s2 : s2; const float a = PRE[((dir * 2 + 0) * 64 + t) * 68 + j], bt = PRE[((dir * 2 + 1) * 64 + t) * 68 + j];
                h = a * h + bt; if (OUT) PRE[((dir * 2 + 1) * 64 + t) * 68 + j] = h; else P *= a; }
            if (!OUT) { RA[sidx] = P; RB[sidx] = h; }
        }
        if (OUT) { __syncthreads();
#pragma unroll
            for (int k = 0; k < 8; ++k) { const int t = tg * 8 + k; const size_t r = rb + p0 + t;
                YS[r * 512 + ch] = f2bf(gelu_tanh(bf2f(ycur[k])) * (PRE[((0 * 2 + 1) * 64 + t) * 68 + j] + PRE[((1 * 2 + 1) * 64 + t) * 68 + j])); } }
        __syncthreads();
    }
}
__device__ __forceinline__ void phase_rg_carry(const PP& p) {
    const int g = blockIdx.x * 512 + otid(p.swid); if (g >= 2048) return;
    const int dir = g >> 10, b = (g >> 9) & 1, ch = g & 511;
    const float* RA = (const float*)(p.ws + WS_SMALL + SM_RGA); const float* RB = (const float*)(p.ws + WS_SMALL + SM_RGB); float* RH = (float*)(p.ws + WS_SMALL + SM_RGH);
    float h = 0.f;
    for (int ci0 = 0; ci0 < NCHUNK; ci0 += 6) { float a[6], bb[6]; size_t idx[6];
#pragma unroll
        for (int k = 0; k < 6; ++k) { idx[k] = ((size_t)(dir * 2 + b) * NCHUNK + chain_chunk(dir, ci0 + k)) * 512 + ch; a[k] = RA[idx[k]]; bb[k] = RB[idx[k]]; }
#pragma unroll
        for (int k = 0; k < 6; ++k) { RH[idx[k]] = h; h = a[k] * h + bb[k]; } }
}

template <int BR> struct GlChan {
    float w[16]; float bias; float lb; int dir, h, d, l;
    __device__ __forceinline__ void init(const PP& p, int l_, int dir_, int h_, int d_) { l = l_; dir = dir_; h = h_; d = d_;
        if (BR == 1) {
#pragma unroll
            for (int r = 0; r < 16; ++r) w[r] = p.in[I_GLAWLR][((size_t)(l * 2 + dir) * 16 + r) * 256 + h * 64 + d];
            bias = p.in[I_GLABLR][(l * 2 + dir) * 256 + h * 64 + d]; lb = 0.f;
        } else { lb = 0.f; if (l == 1) { const float l0 = p.in[I_HGLB][(0 * 2 + dir) * 512 + h * 128 + d], l1 = p.in[I_HGLB][(1 * 2 + dir) * 512 + h * 128 + d]; lb = 1.f / (1.f + __expf(l0 - l1)); } bias = 0.f; }
    }
    __device__ __forceinline__ bf16_t raw(const bf16_t* zrow) const { return BR == 1 ? zrow[GK + h * 64 + d] : zrow[HF + dir * 512 + h * 128 + d]; }
    __device__ __forceinline__ void gk_raw(bf16_t rw, const LAS float* lr, float& g, float& k) const {
        if (BR == 1) { float pre = bias;
#pragma unroll
            for (int r4 = 0; r4 < 4; ++r4) { const f32x4 x = *(const LAS f32x4*)(lr + 4 * r4); pre += x[0] * w[4 * r4] + x[1] * w[4 * r4 + 1] + x[2] * w[4 * r4 + 2] + x[3] * w[4 * r4 + 3]; }
            g = logsig(pre) * (1.f / 16.f); k = bf2f(rw);
        } else { const float f = bf2f(rw); const float e = __expf(-f), sg = frcp(1.f + e);
            g = __logf(lb + (1.f - lb) * sg); k = (1.f - lb) * (e * sg); }
    }
    __device__ __forceinline__ void gk(const bf16_t* zrow, const LAS float* lr, float& g, float& k) const {
        if (BR == 1) { float pre = bias;
#pragma unroll
            for (int r4 = 0; r4 < 4; ++r4) { const f32x4 x = *(const LAS f32x4*)(lr + 4 * r4); pre += x[0] * w[4 * r4] + x[1] * w[4 * r4 + 1] + x[2] * w[4 * r4 + 2] + x[3] * w[4 * r4 + 3]; }
            g = logsig(pre) * (1.f / 16.f); k = bf2f(zrow[GK + h * 64 + d]);
        } else { const float f = bf2f(zrow[HF + dir * 512 + h * 128 + d]); const float e = __expf(-f), sg = frcp(1.f + e);
            g = __logf(lb + (1.f - lb) * sg); k = (1.f - lb) * (e * sg); }
    }
};
__device__ __forceinline__ int krow(int d) { return (d & ~31) + 16 * ((d >> 2) & 1) + 4 * ((d & 31) >> 3) + (d & 3); }
template <int BR> __device__ __forceinline__ void phase_gl_local(const PP& p, int l, LAS unsigned char* L) {
    constexpr int DK = BR == 1 ? 64 : 128, NSEG = 512 / DK, NT = 64 / NSEG;
    const int tid = otid(p.swid), lane = tid & 63, wid = p.swid, fr = lane & 15, fq = lane >> 4;
    LAS bf16_t* KT = (LAS bf16_t*)L;
    LAS bf16_t* VT = KT + 2 * DK * 72;
    LAS float* SEG = (LAS float*)(VT + 128 * 72);
    LAS float* LR = SEG + 1024;
    const bf16_t* Z = (const bf16_t*)(p.ws + WS_BIG + BIG_Z); const float* MISC = (const float*)(p.ws + WS_MISC);
    bf16_t* ST = (bf16_t*)(p.ws + WS_BIG + BIG_ST); float* DEC = (float*)(p.ws + WS_SMALL + SM_DEC);
    constexpr int VOFF = BR == 1 ? GV : HI;
    const int d = tid % DK, sg = tid / DK;
    for (int u = blockIdx.x; u < 8 * NCHUNK; u += gridDim.x) {
        const int c = u % NCHUNK, bh = u / NCHUNK, h = bh & 3, b = bh >> 2; const size_t r0 = (size_t)b * NTOK + c * 64;
        if (BR == 1) { for (int i = tid; i < 2048; i += 512) LR[i] = MISC[(r0 + (i >> 5)) * 64 + MISC_LR + (i & 31)]; }
        { const int v = tid & 127;
#pragma unroll
          for (int gi = 0; gi < 2; ++gi) { const int grp = (tid >> 7) + 4 * gi; unsigned short x[8];
#pragma unroll
            for (int e = 0; e < 8; ++e) x[e] = Z[(r0 + grp * 8 + e) * ZLD + VOFF + h * 128 + v];
            *(LAS u32x4*)(VT + v * 72 + grp * 8) = (u32x4){x[0] | ((unsigned)x[1] << 16), x[2] | ((unsigned)x[3] << 16), x[4] | ((unsigned)x[5] << 16), x[6] | ((unsigned)x[7] << 16)}; } }
        if (BR == 1) __syncthreads();
        float cs[2][NT], kk[2][NT];
#pragma unroll
        for (int dir = 0; dir < 2; ++dir) { GlChan<BR> G; G.init(p, l, dir, h, d); float run = 0.f;
#pragma unroll
            for (int q = 0; q < NT; ++q) { const int n = dir ? NT - 1 - q : q, t = sg * NT + n; float g; G.gk(Z + (r0 + t) * ZLD, LR + t * 32 + dir * 16, g, kk[dir][n]); run += g; cs[dir][n] = run; }
            SEG[(dir * NSEG + sg) * DK + d] = run; }
        __syncthreads();
#pragma unroll
        for (int dir = 0; dir < 2; ++dir) { float before = 0.f, tot = 0.f;
#pragma unroll
            for (int s2 = 0; s2 < NSEG; ++s2) { const float x = SEG[(dir * NSEG + s2) * DK + d]; tot += x; const bool earlier = dir ? (s2 > sg) : (s2 < sg); before += earlier ? x : 0.f; }
            float val[NT];
#pragma unroll
            for (int n = 0; n < NT; ++n) val[n] = kk[dir][n] * __expf(tot - (before + cs[dir][n]));
#pragma unroll
            for (int n8 = 0; n8 < NT / 8; ++n8)
                *(LAS u32x4*)(KT + (dir * DK + krow(d)) * 72 + sg * NT + 8 * n8) = (u32x4){pack2(val[8 * n8], val[8 * n8 + 1]), pack2(val[8 * n8 + 2], val[8 * n8 + 3]), pack2(val[8 * n8 + 4], val[8 * n8 + 5]), pack2(val[8 * n8 + 6], val[8 * n8 + 7])};
            if (sg == 0) DEC[((size_t)((dir * 2 + b) * 4 + h) * NCHUNK + c) * 128 + d] = __expf(tot); }
        __syncthreads();
        { const int dir = wid >> 2; const size_t sbase = ((size_t)((dir * 2 + b) * 4 + h) * NCHUNK + c) * 128 * DK;
            constexpr int NVT = DK == 64 ? 4 : 8; const int A = DK == 64 ? (wid & 1) : (wid & 3), vt0 = DK == 64 ? ((wid >> 1) & 1) * 4 : 0;
            bf16x8 x[2][2];
#pragma unroll
            for (int n = 0; n < 2; ++n) { x[n][0] = *(const LAS bf16x8*)(KT + (dir * DK + 16 * (2 * A + n) + fr) * 72 + 8 * fq); x[n][1] = *(const LAS bf16x8*)(KT + (dir * DK + 16 * (2 * A + n) + fr) * 72 + 8 * fq + 32); }
#pragma unroll
            for (int vi = 0; vi < NVT; ++vi) { const int vt = vt0 + vi; const bf16x8 y0 = *(const LAS bf16x8*)(VT + (16 * vt + fr) * 72 + 8 * fq), y1 = *(const LAS bf16x8*)(VT + (16 * vt + fr) * 72 + 8 * fq + 32);
                f32x4 a0 = (f32x4){0.f, 0.f, 0.f, 0.f}, a1 = (f32x4){0.f, 0.f, 0.f, 0.f};
                a0 = mfma16(x[0][0], y0, a0); a0 = mfma16(x[0][1], y1, a0); a1 = mfma16(x[1][0], y0, a1); a1 = mfma16(x[1][1], y1, a1); settle(a0, a1);
                *(uint4*)(ST + sbase + (size_t)(16 * vt + fr) * DK + 32 * A + 8 * fq) = make_uint4(pack2(a0[0], a0[1]), pack2(a0[2], a0[3]), pack2(a1[0], a1[1]), pack2(a1[2], a1[3])); } }
        __syncthreads();
    }
}
template <int BR> __device__ __forceinline__ void phase_gl_carry(const PP& p) {
    constexpr int DK = BR == 1 ? 64 : 128, D4 = DK / 4, TOTAL = 16 * 128 * D4, NB = 6;
    const int g = blockIdx.x * 512 + otid(p.swid);
    bf16_t* ST = (bf16_t*)(p.ws + WS_BIG + BIG_ST); const float* DEC = (const float*)(p.ws + WS_SMALL + SM_DEC);
    const float* BE = (const float*)(p.ws + WS_SMALL + SM_MLBE); const float* MLOC = (const float*)(p.ws + WS_SMALL + SM_MLML); float* MIN_ = (float*)(p.ws + WS_SMALL + SM_MLMIN); float* DN = (float*)(p.ws + WS_SMALL + SM_MLDN);
    if (g < TOTAL) {
        const int d4 = g % D4, v = (g / D4) % 128, chain = g / (D4 * 128), dir = chain >> 3;
        float S[4] = {0.f, 0.f, 0.f, 0.f}; float m = 0.f;
        for (int ci0 = 0; ci0 < NCHUNK; ci0 += NB) { uint2 ds[NB]; f32x4 da[NB]; size_t off[NB];
#pragma unroll
            for (int k = 0; k < NB; ++k) { const int c = chain_chunk(dir, ci0 + k); off[k] = (((size_t)chain * NCHUNK + c) * 128 + v) * DK + d4 * 4; ds[k] = *(const uint2*)(ST + off[k]);
                if (BR == 3) { da[k][0] = BE[chain * NCHUNK + c]; da[k][1] = MLOC[chain * NCHUNK + c]; da[k][2] = 0.f; da[k][3] = 0.f; }
                else da[k] = *(const f32x4*)(DEC + ((size_t)chain * NCHUNK + c) * 128 + d4 * 4); }
#pragma unroll
            for (int k = 0; k < NB; ++k) {
                *(uint2*)(ST + off[k]) = make_uint2(pack2(S[0], S[1]), pack2(S[2], S[3]));
                float al[4], be[4];
                if (BR == 3) { const float mn = fmaxf(da[k][0] + m, da[k][1]), a = __expf(da[k][0] + m - mn), bb = __expf(da[k][1] - mn); m = mn;
#pragma unroll
                    for (int e = 0; e < 4; ++e) { al[e] = a; be[e] = bb; } }
                else {
#pragma unroll
                    for (int e = 0; e < 4; ++e) { al[e] = da[k][e]; be[e] = 1.f; } }
                S[0] = al[0] * S[0] + be[0] * bf2f((bf16_t)(ds[k].x & 0xffff)); S[1] = al[1] * S[1] + be[1] * bf2f((bf16_t)(ds[k].x >> 16));
                S[2] = al[2] * S[2] + be[2] * bf2f((bf16_t)(ds[k].y & 0xffff)); S[3] = al[3] * S[3] + be[3] * bf2f((bf16_t)(ds[k].y >> 16)); } }
    } else if (BR == 3 && g < TOTAL + 16 * 128) {
        const int q = g - TOTAL, d = q & 127, chain = q >> 7, dir = chain >> 3; float n = 0.f, m = 0.f;
        for (int ci0 = 0; ci0 < NCHUNK; ci0 += NB) { float be[NB], ml[NB], dn[NB]; size_t o[NB];
#pragma unroll
            for (int k = 0; k < NB; ++k) { const int c = chain_chunk(dir, ci0 + k); be[k] = BE[chain * NCHUNK + c]; ml[k] = MLOC[chain * NCHUNK + c]; o[k] = ((size_t)chain * NCHUNK + c) * 128 + d; dn[k] = DN[o[k]]; }
#pragma unroll
            for (int k = 0; k < NB; ++k) { DN[o[k]] = n; if (d == 0) MIN_[chain * NCHUNK + chain_chunk(dir, ci0 + k)] = m;
                const float mn = fmaxf(be[k] + m, ml[k]); n = __expf(be[k] + m - mn) * n + __expf(ml[k] - mn) * dn[k]; m = mn; } }
    }
}
template <int BR> __device__ __forceinline__ void phase_gl_out(const PP& p, int l, LAS unsigned char* L) {
    constexpr int DK = BR == 1 ? 64 : 128, PQ = DK + 8, NSEG = 512 / DK, NT = 64 / NSEG;
    const int tid = otid(p.swid), lane = tid & 63, wid = p.swid, fr = lane & 15, fq = lane >> 4;
    LAS bf16_t* QP = (LAS bf16_t*)L;
    LAS bf16_t* KP = QP + 2 * 64 * PQ;
    LAS bf16_t* QT = KP + 2 * 64 * PQ;
    LAS bf16_t* VT = QT + 2 * 64 * PQ;
    LAS bf16_t* PS = VT + 128 * 72;
    LAS float* SEG = (LAS float*)(PS + 2 * 64 * 72);
    LAS float* RED = SEG;
    LAS float* LR = SEG + 1024;
    const bf16_t* Z = (const bf16_t*)(p.ws + WS_BIG + BIG_Z); const float* MISC = (const float*)(p.ws + WS_MISC);
    const bf16_t* ST = (const bf16_t*)(p.ws + WS_BIG + BIG_ST); bf16_t* YS = (bf16_t*)(p.ws + WS_BIG + BIG_YS) + (size_t)BR * TT * 512;
    const float* gain = (BR == 1 ? p.in[I_GLANG] : p.in[I_HGNG]) + l * 128;
    constexpr int VOFF = BR == 1 ? GV : HI, QOFF = BR == 1 ? GQ : HQ, GOFF = BR == 1 ? GG : HGT;
    const int d = tid % DK, sg = tid / DK;
    bf16_t rq[NT], rk[2][NT], rv[16]; float rlr[4];
    auto fetch = [&](int u2, bf16_t (&q_)[NT], bf16_t (&k_)[2][NT], bf16_t (&v_)[16], float (&lr_)[4]) {
        const int c2 = u2 % NCHUNK, bh2 = u2 / NCHUNK, h2 = bh2 & 3, b2 = bh2 >> 2; const size_t rr0 = (size_t)b2 * NTOK + c2 * 64;
#pragma unroll
        for (int n = 0; n < NT; ++n) { const bf16_t* zr = Z + (rr0 + sg * NT + n) * ZLD; q_[n] = zr[QOFF + h2 * DK + d];
            if (BR == 1) { k_[0][n] = zr[GK + h2 * 64 + d]; k_[1][n] = k_[0][n]; } else { k_[0][n] = zr[HF + h2 * 128 + d]; k_[1][n] = zr[HF + 512 + h2 * 128 + d]; } }
#pragma unroll
        for (int gi = 0; gi < 2; ++gi)
#pragma unroll
            for (int e = 0; e < 8; ++e) v_[gi * 8 + e] = Z[(rr0 + ((tid >> 7) + 4 * gi) * 8 + e) * ZLD + VOFF + h2 * 128 + (tid & 127)];
        if (BR == 1) {
#pragma unroll
            for (int i = 0; i < 4; ++i) { const int ix = tid + 512 * i; lr_[i] = MISC[(rr0 + (ix >> 5)) * 64 + MISC_LR + (ix & 31)]; } }
    };
    if ((int)blockIdx.x < 8 * NCHUNK) fetch(blockIdx.x, rq, rk, rv, rlr);
    for (int u = blockIdx.x; u < 8 * NCHUNK; u += gridDim.x) {
        const int c = u % NCHUNK, bh = u / NCHUNK, h = bh & 3, b = bh >> 2; const size_t r0 = (size_t)b * NTOK + c * 64;
        if (BR == 1) {
#pragma unroll
            for (int i = 0; i < 4; ++i) LR[tid + 512 * i] = rlr[i]; }
        uint2 gtv[4];
#pragma unroll
        for (int it = 0; it < 4; ++it) gtv[it] = *(const uint2*)(Z + (r0 + 16 * it + fr) * ZLD + GOFF + h * 128 + 16 * wid + 4 * fq);
        { const int v = tid & 127;
#pragma unroll
          for (int gi = 0; gi < 2; ++gi) { const int grp = (tid >> 7) + 4 * gi;
            *(LAS u32x4*)(VT + v * 72 + grp * 8) = (u32x4){rv[gi * 8] | ((unsigned)rv[gi * 8 + 1] << 16), rv[gi * 8 + 2] | ((unsigned)rv[gi * 8 + 3] << 16), rv[gi * 8 + 4] | ((unsigned)rv[gi * 8 + 5] << 16), rv[gi * 8 + 6] | ((unsigned)rv[gi * 8 + 7] << 16)}; } }
        float qv[NT];
#pragma unroll
        for (int n = 0; n < NT; ++n) { const float qraw = bf2f(rq[n]); qv[n] = BR == 1 ? qraw * 0.125f : siluf(qraw) * 0.08838834764831845f; }
        if (BR == 1) __syncthreads();
        float cs[2][NT], kk[2][NT];
#pragma unroll
        for (int dir = 0; dir < 2; ++dir) { GlChan<BR> G; G.init(p, l, dir, h, d); float run = 0.f;
#pragma unroll
            for (int q = 0; q < NT; ++q) { const int n = dir ? NT - 1 - q : q, t = sg * NT + n; float g; G.gk_raw(rk[dir][n], LR + t * 32 + dir * 16, g, kk[dir][n]); run += g; cs[dir][n] = run; }
            SEG[(dir * NSEG + sg) * DK + d] = run; }
        __syncthreads();
#pragma unroll
        for (int dir = 0; dir < 2; ++dir) { float before = 0.f, beta = 0.f;
#pragma unroll
            for (int s2 = 0; s2 < NSEG; ++s2) { const float x = SEG[(dir * NSEG + s2) * DK + d]; const int rank = dir ? NSEG - 1 - s2 : s2; const int myrank = dir ? NSEG - 1 - sg : sg;
                before += rank < myrank ? x : 0.f; beta += rank < NSEG / 2 ? x : 0.f; }
            const float ebeta = __expf(beta);
#pragma unroll
            for (int n = 0; n < NT; ++n) { const int t = sg * NT + n; const float e1 = __expf(before + cs[dir][n] - beta), qe = qv[n] * e1;
                QP[(dir * 64 + t) * PQ + d] = f2bf(qe); QT[(dir * 64 + t) * PQ + d] = f2bf(qe * ebeta); KP[(dir * 64 + t) * PQ + d] = f2bf(kk[dir][n] * frcp(e1)); } }
        if (u + (int)gridDim.x < 8 * NCHUNK) fetch(u + gridDim.x, rq, rk, rv, rlr);
        bf16x8 xs[2][DK / 32];
#pragma unroll
        for (int dir = 0; dir < 2; ++dir) { const bf16_t* sp = ST + (((size_t)((dir * 2 + b) * 4 + h) * NCHUNK + c) * 128 + 16 * wid + fr) * DK + 8 * fq;
#pragma unroll
            for (int kq = 0; kq < DK / 32; ++kq) xs[dir][kq] = *(const bf16x8*)(sp + 32 * kq); }
        __syncthreads();
        {
            const int dir = wid >> 2, it = wid & 3;
#pragma unroll
            for (int jt = 0; jt < 4; ++jt) {
                f32x4 sa = (f32x4){0.f, 0.f, 0.f, 0.f};
#pragma unroll
                for (int kq = 0; kq < DK / 32; ++kq) sa = mfma16(*(const LAS bf16x8*)(KP + (dir * 64 + 16 * jt + fr) * PQ + 8 * fq + 32 * kq), *(const LAS bf16x8*)(QP + (dir * 64 + 16 * it + fr) * PQ + 8 * fq + 32 * kq), sa);
                settle(sa);
#pragma unroll
                for (int jj = 0; jj < 4; ++jj) { const int jg = 16 * jt + 4 * fq + jj, ig = 16 * it + fr; const bool keep = dir == 0 ? (jg <= ig) : (jg >= ig); sa[jj] = keep ? sa[jj] : 0.f; }
                *(LAS u32x2*)(PS + (dir * 64 + 16 * it + fr) * 72 + 16 * jt + 4 * fq) = (u32x2){pack2(sa[0], sa[1]), pack2(sa[2], sa[3])}; }
        }
        __syncthreads();
        f32x4 acc[4];
        {
#pragma unroll
            for (int it = 0; it < 4; ++it) acc[it] = (f32x4){0.f, 0.f, 0.f, 0.f};
            const bf16x8 xv0 = *(const LAS bf16x8*)(VT + (16 * wid + fr) * 72 + 8 * fq), xv1 = *(const LAS bf16x8*)(VT + (16 * wid + fr) * 72 + 8 * fq + 32);
#pragma unroll
            for (int dir = 0; dir < 2; ++dir)
#pragma unroll
                for (int it = 0; it < 4; ++it) {
                    acc[it] = mfma16(xv0, *(const LAS bf16x8*)(PS + (dir * 64 + 16 * it + fr) * 72 + 8 * fq), acc[it]);
                    acc[it] = mfma16(xv1, *(const LAS bf16x8*)(PS + (dir * 64 + 16 * it + fr) * 72 + 8 * fq + 32), acc[it]);
#pragma unroll
                    for (int kq = 0; kq < DK / 32; ++kq) acc[it] = mfma16(xs[dir][kq], *(const LAS bf16x8*)(QT + (dir * 64 + 16 * it + fr) * PQ + 8 * fq + 32 * kq), acc[it]); }
            settle(acc[0], acc[1], acc[2], acc[3]);
        }
#pragma unroll
        for (int it = 0; it < 4; ++it) { float ss = acc[it][0] * acc[it][0] + acc[it][1] * acc[it][1] + acc[it][2] * acc[it][2] + acc[it][3] * acc[it][3];
            ss += __shfl_xor(ss, 16); ss += __shfl_xor(ss, 32); if (fq == 0) RED[wid * 64 + 16 * it + fr] = ss; }
        __syncthreads();
        const f32x4 gn = *(const f32x4*)(gain + 16 * wid + 4 * fq);
#pragma unroll
        for (int it = 0; it < 4; ++it) { float tot = 0.f;
#pragma unroll
            for (int w2 = 0; w2 < 8; ++w2) tot += RED[w2 * 64 + 16 * it + fr];
            const float rs = rsqrtf(tot * (1.f / 128.f) + EPS); const size_t row = r0 + 16 * it + fr;
            const uint2 gt = gtv[it];
            const float y0 = acc[it][0] * rs * gn[0] * siluf(bf2f((bf16_t)(gt.x & 0xffff))), y1 = acc[it][1] * rs * gn[1] * siluf(bf2f((bf16_t)(gt.x >> 16)));
            const float y2 = acc[it][2] * rs * gn[2] * siluf(bf2f((bf16_t)(gt.y & 0xffff))), y3 = acc[it][3] * rs * gn[3] * siluf(bf2f((bf16_t)(gt.y >> 16)));
            *(uint2*)(YS + row * 512 + h * 128 + 16 * wid + 4 * fq) = make_uint2(pack2(y0, y1), pack2(y2, y3)); }
        __syncthreads();
    }
}

__device__ __forceinline__ float wave_incl_scan_add(float x, int lane) {
#pragma unroll
    for (int o = 1; o < 64; o <<= 1) { const float y = __shfl_up(x, o); x = lane >= o ? x + y : x; }
    return x;
}
__device__ __forceinline__ float wave_incl_scan_max(float x, int lane) {
#pragma unroll
    for (int o = 1; o < 64; o <<= 1) { const float y = __shfl_up(x, o); x = lane >= o ? fmaxf(x, y) : x; }
    return x;
}
__device__ __forceinline__ float wave_max(float v) {
#pragma unroll
    for (int o = 32; o > 0; o >>= 1) v = fmaxf(v, __shfl_xor(v, o));
    return v;
}
__device__ __forceinline__ void phase_ml_local(const PP& p, int l, LAS unsigned char* L) {
    const int tid = otid(p.swid), lane = tid & 63, wid = p.swid, fr = lane & 15, fq = lane >> 4;
    LAS bf16_t* KT = (LAS bf16_t*)L;
    LAS bf16_t* VT = KT + 2 * 128 * 72;
    LAS float* WE = (LAS float*)(VT + 128 * 72);
    LAS float* DNP = WE + 128;
    const bf16_t* Z = (const bf16_t*)(p.ws + WS_BIG + BIG_Z); const float* MISC = (const float*)(p.ws + WS_MISC);
    bf16_t* ST = (bf16_t*)(p.ws + WS_BIG + BIG_ST);
    float* BE = (float*)(p.ws + WS_SMALL + SM_MLBE); float* MLOC = (float*)(p.ws + WS_SMALL + SM_MLML); float* DN = (float*)(p.ws + WS_SMALL + SM_MLDN);
    for (int u = blockIdx.x; u < 8 * NCHUNK; u += gridDim.x) {
        const int c = u % NCHUNK, bh = u / NCHUNK, h = bh & 3, b = bh >> 2, p0 = c * 64; const size_t rb = (size_t)b * NTOK, r0 = rb + p0;
        const int lo = p0 < CTXL ? 0 : CTXL, hi = p0 < CTXL ? CTXL : NTOK;
        const int d = tid & 127, sg = tid >> 7, ch = h * 128 + d;
        float kv[16];
        {
            float cw[4];
#pragma unroll
            for (int q = 0; q < 4; ++q) cw[q] = p.in[I_MLCW][(l * 4 + q) * 1024 + 512 + ch];
            const float cb = p.in[I_MLCB][l * 1024 + 512 + ch];
            float win[19];
#pragma unroll
            for (int k = 0; k < 19; ++k) { const int q = p0 + sg * 16 - 2 + k; win[k] = (q >= lo && q < hi) ? bf2f(Z[(rb + q) * ZLD + MK + ch]) : 0.f; }
#pragma unroll
            for (int n = 0; n < 16; ++n) kv[n] = siluf(cb + cw[0] * win[n] + cw[1] * win[n + 1] + cw[2] * win[n + 2] + cw[3] * win[n + 3]);
        }
        { const int v = tid & 127;
#pragma unroll
          for (int gi = 0; gi < 2; ++gi) { const int grp = (tid >> 7) + 4 * gi; unsigned short x[8];
#pragma unroll
            for (int e = 0; e < 8; ++e) x[e] = Z[(r0 + grp * 8 + e) * ZLD + MV + h * 128 + v];
            *(LAS u32x4*)(VT + v * 72 + grp * 8) = (u32x4){x[0] | ((unsigned)x[1] << 16), x[2] | ((unsigned)x[3] << 16), x[4] | ((unsigned)x[5] << 16), x[6] | ((unsigned)x[7] << 16)}; } }
        if (wid < 2) {
            const int dir = wid, t = dir == 0 ? lane : 63 - lane; const size_t r = r0 + t; const int chain = (dir * 2 + b) * 4 + h;
            const float ii = MISC[r * 64 + MISC_IF + dir * 8 + h] + p.in[I_MLGB][(l * 2 + dir) * 8 + h];
            const float lf = logsig(MISC[r * 64 + MISC_IF + dir * 8 + 4 + h] + p.in[I_MLGB][(l * 2 + dir) * 8 + 4 + h]);
            const float bc = wave_incl_scan_add(lf, lane), bend = __shfl(bc, 63), mloc = bend + wave_max(ii - bc);
            WE[dir * 64 + t] = __expf(bend - bc + ii - mloc);
            if (lane == 0) { BE[chain * NCHUNK + c] = bend; MLOC[chain * NCHUNK + c] = mloc; }
        }
        __syncthreads();
#pragma unroll
        for (int dir = 0; dir < 2; ++dir) { float val[16], dn = 0.f;
#pragma unroll
            for (int n = 0; n < 16; ++n) { val[n] = kv[n] * WE[dir * 64 + sg * 16 + n]; dn += val[n]; }
            *(LAS u32x4*)(KT + (dir * 128 + krow(d)) * 72 + sg * 16) = (u32x4){pack2(val[0], val[1]), pack2(val[2], val[3]), pack2(val[4], val[5]), pack2(val[6], val[7])};
            *(LAS u32x4*)(KT + (dir * 128 + krow(d)) * 72 + sg * 16 + 8) = (u32x4){pack2(val[8], val[9]), pack2(val[10], val[11]), pack2(val[12], val[13]), pack2(val[14], val[15])};
            DNP[(sg * 2 + dir) * 128 + d] = dn; }
        __syncthreads();
        if (tid < 256) { const int dir = tid >> 7; DN[((size_t)((dir * 2 + b) * 4 + h) * NCHUNK + c) * 128 + d] = DNP[(0 * 2 + dir) * 128 + d] + DNP[(1 * 2 + dir) * 128 + d] + DNP[(2 * 2 + dir) * 128 + d] + DNP[(3 * 2 + dir) * 128 + d]; }
        { const int dir = wid >> 2, A = wid & 3; const size_t sbase = ((size_t)((dir * 2 + b) * 4 + h) * NCHUNK + c) * 128 * 128;
            bf16x8 x[2][2];
#pragma unroll
            for (int n = 0; n < 2; ++n) { x[n][0] = *(const LAS bf16x8*)(KT + (dir * 128 + 16 * (2 * A + n) + fr) * 72 + 8 * fq); x[n][1] = *(const LAS bf16x8*)(KT + (dir * 128 + 16 * (2 * A + n) + fr) * 72 + 8 * fq + 32); }
#pragma unroll
            for (int vt = 0; vt < 8; ++vt) { const bf16x8 y0 = *(const LAS bf16x8*)(VT + (16 * vt + fr) * 72 + 8 * fq), y1 = *(const LAS bf16x8*)(VT + (16 * vt + fr) * 72 + 8 * fq + 32);
                f32x4 a0 = (f32x4){0.f, 0.f, 0.f, 0.f}, a1 = (f32x4){0.f, 0.f, 0.f, 0.f};
                a0 = mfma16(x[0][0], y0, a0); a0 = mfma16(x[0][1], y1, a0); a1 = mfma16(x[1][0], y0, a1); a1 = mfma16(x[1][1], y1, a1); settle(a0, a1);
                *(uint4*)(ST + sbase + (size_t)(16 * vt + fr) * 128 + 32 * A + 8 * fq) = make_uint4(pack2(a0[0], a0[1]), pack2(a0[2], a0[3]), pack2(a1[0], a1[1]), pack2(a1[2], a1[3])); } }
        __syncthreads();
    }
}
__device__ __forceinline__ void phase_ml_out(const PP& p, int l, LAS unsigned char* L) {
    constexpr int PQ = 136;
    const int tid = otid(p.swid), lane = tid & 63, wid = p.swid, fr = lane & 15, fq = lane >> 4;
    LAS bf16_t* QL = (LAS bf16_t*)L;
    LAS bf16_t* KL = QL + 64 * PQ;
    LAS bf16_t* VT = KL + 64 * PQ;
    LAS bf16_t* PS = VT + 128 * 72;
    LAS float* SC = (LAS float*)(PS + 2 * 64 * 72);
    LAS float* NV = SC + 2 * 576;
    LAS float* RED = NV + 256;
    const bf16_t* Z = (const bf16_t*)(p.ws + WS_BIG + BIG_Z); const float* MISC = (const float*)(p.ws + WS_MISC);
    const bf16_t* ST = (const bf16_t*)(p.ws + WS_BIG + BIG_ST); bf16_t* YS = (bf16_t*)(p.ws + WS_BIG + BIG_YS) + (size_t)3 * TT * 512;
    const float* MIN_ = (const float*)(p.ws + WS_SMALL + SM_MLMIN); const float* DN = (const float*)(p.ws + WS_SMALL + SM_MLDN);
    const float* gain = p.in[I_MLNG] + l * 128;
    for (int u = blockIdx.x; u < 8 * NCHUNK; u += gridDim.x) {
        const int c = u % NCHUNK, bh = u / NCHUNK, h = bh & 3, b = bh >> 2, p0 = c * 64; const size_t rb = (size_t)b * NTOK, r0 = rb + p0;
        const int lo = p0 < CTXL ? 0 : CTXL, hi = p0 < CTXL ? CTXL : NTOK;
        const int d = tid & 127, sg = tid >> 7, ch = h * 128 + d;
        uint2 gtv[4];
#pragma unroll
        for (int it = 0; it < 4; ++it) gtv[it] = *(const uint2*)(Z + (r0 + 16 * it + fr) * ZLD + MO + h * 128 + 16 * wid + 4 * fq);
#pragma unroll
        for (int which = 0; which < 2; ++which) {
            const int zc = (which ? MK : MQ) + ch;
            float cw[4];
#pragma unroll
            for (int q = 0; q < 4; ++q) cw[q] = p.in[I_MLCW][(l * 4 + q) * 1024 + which * 512 + ch];
            const float cb = p.in[I_MLCB][l * 1024 + which * 512 + ch], scl = which ? 1.f : 0.08838834764831845f;
            float win[19];
#pragma unroll
            for (int k = 0; k < 19; ++k) { const int q = p0 + sg * 16 - 2 + k; win[k] = (q >= lo && q < hi) ? bf2f(Z[(rb + q) * ZLD + zc]) : 0.f; }
            LAS bf16_t* dst = (which ? KL : QL) + (sg * 16) * PQ + d;
#pragma unroll
            for (int n = 0; n < 16; ++n) dst[n * PQ] = f2bf(siluf(cb + cw[0] * win[n] + cw[1] * win[n + 1] + cw[2] * win[n + 2] + cw[3] * win[n + 3]) * scl);
        }
        { const int v = tid & 127;
#pragma unroll
          for (int gi = 0; gi < 2; ++gi) { const int grp = (tid >> 7) + 4 * gi; unsigned short x[8];
#pragma unroll
            for (int e = 0; e < 8; ++e) x[e] = Z[(r0 + grp * 8 + e) * ZLD + MV + h * 128 + v];
            *(LAS u32x4*)(VT + v * 72 + grp * 8) = (u32x4){x[0] | ((unsigned)x[1] << 16), x[2] | ((unsigned)x[3] << 16), x[4] | ((unsigned)x[5] << 16), x[6] | ((unsigned)x[7] << 16)}; } }
        if (tid < 256) NV[tid] = DN[((size_t)(((tid >> 7) * 2 + b) * 4 + h) * NCHUNK + c) * 128 + (tid & 127)];
        if (wid < 2) {
            const int dir = wid, t = dir == 0 ? lane : 63 - lane; const size_t r = r0 + t; const int chain = (dir * 2 + b) * 4 + h;
            const float ii = MISC[r * 64 + MISC_IF + dir * 8 + h] + p.in[I_MLGB][(l * 2 + dir) * 8 + h];
            const float lf = logsig(MISC[r * 64 + MISC_IF + dir * 8 + 4 + h] + p.in[I_MLGB][(l * 2 + dir) * 8 + 4 + h]);
            const float bc = wave_incl_scan_add(lf, lane), a = ii - bc, arun = wave_incl_scan_max(a, lane), mprev = MIN_[chain * NCHUNK + c];
            const float m = bc + fmaxf(mprev, arun);
            LAS float* S = SC + dir * 576;
            S[t] = bc - m; S[64 + t] = a; S[128 + t] = __expf(bc + mprev - m); S[192 + t] = __expf(-m);
        }
        __syncthreads();
        bf16x8 xs[2][4];
#pragma unroll
        for (int dir = 0; dir < 2; ++dir) { const bf16_t* sp = ST + (((size_t)((dir * 2 + b) * 4 + h) * NCHUNK + c) * 128 + 16 * wid + fr) * 128 + 8 * fq;
#pragma unroll
            for (int kk = 0; kk < 4; ++kk) xs[dir][kk] = *(const bf16x8*)(sp + 32 * kk); }
        {
            const int dir = tid >> 8, i = (tid >> 2) & 63, part = tid & 3; float sacc = 0.f;
#pragma unroll 8
            for (int d = part * 32; d < part * 32 + 32; ++d) sacc += bf2f(QL[i * PQ + d]) * NV[dir * 128 + d];
            sacc += __shfl_xor(sacc, 1); sacc += __shfl_xor(sacc, 2);
            if (part == 0) SC[dir * 576 + 256 + i] = sacc;
        }
        {
            const int it = wid & 3;
#pragma unroll
            for (int jh = 0; jh < 2; ++jh) { const int jt = (wid >> 2) * 2 + jh;
                f32x4 acc = (f32x4){0.f, 0.f, 0.f, 0.f};
#pragma unroll
                for (int kk = 0; kk < 4; ++kk) acc = mfma16(*(const LAS bf16x8*)(KL + (16 * jt + fr) * PQ + 8 * fq + 32 * kk), *(const LAS bf16x8*)(QL + (16 * it + fr) * PQ + 8 * fq + 32 * kk), acc);
                settle(acc);
                const int ig = 16 * it + fr;
#pragma unroll
                for (int dir = 0; dir < 2; ++dir) { const LAS float* S = SC + dir * 576; const float ui = S[ig]; float sv[4];
#pragma unroll
                    for (int jj = 0; jj < 4; ++jj) { const int jg = 16 * jt + 4 * fq + jj; const bool keep = dir == 0 ? (jg <= ig) : (jg >= ig);
                        const float wgt = __expf(fminf(ui + S[64 + jg], 0.f)); sv[jj] = keep ? acc[jj] * wgt : 0.f; }
                    *(LAS u32x2*)(PS + (dir * 64 + ig) * 72 + 16 * jt + 4 * fq) = (u32x2){pack2(sv[0], sv[1]), pack2(sv[2], sv[3])};
                    float rsum = sv[0] + sv[1] + sv[2] + sv[3]; rsum += __shfl_xor(rsum, 16); rsum += __shfl_xor(rsum, 32);
                    if (fq == 0) SC[dir * 576 + 320 + jt * 64 + ig] = rsum; } }
        }
        __syncthreads();
        {
            f32x4 o[4];
#pragma unroll
            for (int it = 0; it < 4; ++it) o[it] = (f32x4){0.f, 0.f, 0.f, 0.f};
            const bf16x8 xv0 = *(const LAS bf16x8*)(VT + (16 * wid + fr) * 72 + 8 * fq), xv1 = *(const LAS bf16x8*)(VT + (16 * wid + fr) * 72 + 8 * fq + 32);
#pragma unroll
            for (int dir = 0; dir < 2; ++dir) {
                const LAS float* S = SC + dir * 576;
#pragma unroll
                for (int it = 0; it < 4; ++it) { const int ig = 16 * it + fr;
                    f32x4 ap = (f32x4){0.f, 0.f, 0.f, 0.f}, ac = (f32x4){0.f, 0.f, 0.f, 0.f};
                    ap = mfma16(xv0, *(const LAS bf16x8*)(PS + (dir * 64 + ig) * 72 + 8 * fq), ap);
                    ap = mfma16(xv1, *(const LAS bf16x8*)(PS + (dir * 64 + ig) * 72 + 8 * fq + 32), ap);
#pragma unroll
                    for (int kk = 0; kk < 4; ++kk) ac = mfma16(xs[dir][kk], *(const LAS bf16x8*)(QL + ig * PQ + 8 * fq + 32 * kk), ac);
                    settle(ap, ac);
                    const float wi = S[128 + ig], den = S[320 + ig] + S[384 + ig] + S[448 + ig] + S[512 + ig] + wi * S[256 + ig];
                    const float inv = frcp(fmaxf(fabsf(den), S[192 + ig]));
#pragma unroll
                    for (int jj = 0; jj < 4; ++jj) o[it][jj] += (ap[jj] + wi * ac[jj]) * inv; } }
#pragma unroll
            for (int it = 0; it < 4; ++it) { float ss = o[it][0] * o[it][0] + o[it][1] * o[it][1] + o[it][2] * o[it][2] + o[it][3] * o[it][3];
                ss += __shfl_xor(ss, 16); ss += __shfl_xor(ss, 32); if (fq == 0) RED[wid * 64 + 16 * it + fr] = ss; }
            __syncthreads();
            const f32x4 gn = *(const f32x4*)(gain + 16 * wid + 4 * fq);
#pragma unroll
            for (int it = 0; it < 4; ++it) { float tot = 0.f;
#pragma unroll
                for (int w2 = 0; w2 < 8; ++w2) tot += RED[w2 * 64 + 16 * it + fr];
                const float rs = rsqrtf(tot * (1.f / 128.f) + EPS); const size_t row = r0 + 16 * it + fr;
                const uint2 gt = gtv[it];
                const float y0 = o[it][0] * rs * gn[0] * sigm(bf2f((bf16_t)(gt.x & 0xffff))), y1 = o[it][1] * rs * gn[1] * sigm(bf2f((bf16_t)(gt.x >> 16)));
                const float y2 = o[it][2] * rs * gn[2] * sigm(bf2f((bf16_t)(gt.y & 0xffff))), y3 = o[it][3] * rs * gn[3] * sigm(bf2f((bf16_t)(gt.y >> 16)));
                *(uint2*)(YS + row * 512 + h * 128 + 16 * wid + 4 * fq) = make_uint2(pack2(y0, y1), pack2(y2, y3)); }
        }
        __syncthreads();
    }
}

#ifndef CH_GLA
#define CH_GLA 1
#endif
#ifndef CH_HG
#define CH_HG 1
#endif
#ifndef CH_ML
#define CH_ML 1
#endif
#if CH_GLA
#define GLA_LOCAL(p, l) phase_gl_local<1>(p, l, L)
#define GLA_CARRY(p, l) phase_gl_carry<1>(p)
#define GLA_OUT(p, l) phase_gl_out<1>(p, l, L)
#else
#define GLA_LOCAL(p, l) phase_seq_gl<1>(p, l, (LAS float*)L)
#define GLA_CARRY(p, l)
#define GLA_OUT(p, l) phase_epi_norm<1>(p, l)
#endif
#if CH_HG
#define HG_LOCAL(p, l) phase_gl_local<2>(p, l, L)
#define HG_CARRY(p, l) phase_gl_carry<2>(p)
#define HG_OUT(p, l) phase_gl_out<2>(p, l, L)
#else
#define HG_LOCAL(p, l) phase_seq_gl<2>(p, l, (LAS float*)L)
#define HG_CARRY(p, l)
#define HG_OUT(p, l) phase_epi_norm<2>(p, l)
#endif
#if CH_ML
#define ML_LOCAL(p, l) phase_ml_local(p, l, L)
#define ML_CARRY(p, l) phase_gl_carry<3>(p)
#define ML_OUT(p, l) phase_ml_out(p, l, L)
#else
#define ML_LOCAL(p, l) phase_seq_ml(p, l, (LAS float*)L)
#define ML_CARRY(p, l)
#define ML_OUT(p, l) phase_epi_norm<3>(p, l)
#endif
constexpr int LDS_BYTES = 147456, NPH_LAYER = 22, NPH = 1 + 2 * NPH_LAYER;
__global__ void __launch_bounds__(512, 2) mega(P p_unused) {
    extern __shared__ __attribute__((aligned(16))) unsigned char lds[];
    LAS unsigned char* L = (LAS unsigned char*)lds;
    LAS int* tbl = (LAS int*)(L + 131072 + 1024);
    const int swid = __builtin_amdgcn_readfirstlane((int)(threadIdx.x >> 6));
    int lo, hi; unsigned* barw;
    { const PP p = load_args(swid); lo = p.ph_lo; hi = p.ph_hi; barw = (unsigned*)(p.ws + WS_CTL); }
    { const int t0 = (int)threadIdx.x; if (t0 < 4) ((LAS unsigned*)(L + LDS_BYTES - 16))[t0] = 0u; }
    __syncthreads();
    XcdBarrier bar; bar.bar = barw; bar.x = 0; bar.st = nullptr; bar.swid = swid;
    if (hi - lo > 1) bar = xcd_barrier_post(barw, (volatile LAS unsigned*)(L + LDS_BYTES - 16), swid);
#ifndef PHSEL
#define PHSEL(k) 1
#endif
#define IN(k) (PHSEL(k) && lo <= (k) && (k) < hi)
#define SEAM(k) do { if (IN((k) + 1)) xcd_barrier(bar); } while (0)
#define PHASE(k, ...) if (IN(k)) { const PP p = load_args(swid); unsigned char* ws = p.ws; unsigned char* wb = ws + WS_WB; unsigned char* big = ws + WS_BIG; (void)wb; (void)big; __VA_ARGS__ SEAM(k); }
    PHASE(0, phase_mods(p, (LAS float*)L); phase_convert(p, 0, (LAS float*)L, 0, 9824, 0);)
#define LAYER_BODY(l) { constexpr int pb = 1 + NPH_LAYER * (l); \
    if ((l) == 1) { PHASE(pb + 0, phase_convert(p, 1, (LAS float*)L, 0, 3648, 0); phase_convert(p, 1, (LAS float*)L, 9792, 9824, 0);) } \
    if ((l) == 0) { PHASE(pb + 1, phase_norm1(p, l);) } \
    PHASE(pb + 2, Gemm g{(const bf16_t*)(ws + WS_U), (const bf16_t*)(wb + WB_WIN), DM, DM, p.swid}; OrderPlain S; S.init(MT, 11, gridDim.x, blockIdx.x); S.skipctx = 0; \
        EpiZ E{(bf16_t*)(big + BIG_Z), (float*)(ws + WS_MISC), 10}; GEMM_RUN(EpiZ, OrderPlain, g, S, E);) \
    PHASE(pb + 3, phase_rg<false>(p, l, L); GLA_LOCAL(p, l);) \
    PHASE(pb + 4, phase_rg_carry(p); GLA_CARRY(p, l); if ((l) == 0) phase_convert(p, 1, (LAS float*)L, 3648, 5696, 136);) \
    PHASE(pb + 5, phase_rg<true>(p, l, L); GLA_OUT(p, l);) \
    PHASE(pb + 6, Gemm g{(const bf16_t*)(ws + WS_U), (const bf16_t*)(wb + WB_WIN) + (size_t)2816 * DM, DM, DM, p.swid}; OrderPlain S; S.init(MT, 10, gridDim.x, blockIdx.x); S.skipctx = 0; \
        EpiZ E{(bf16_t*)(big + BIG_Z), (float*)(ws + WS_MISC), -1}; GEMM_RUN(EpiZ, OrderPlain, g, S, E);) \
    PHASE(pb + 7, HG_LOCAL(p, l);) \
    PHASE(pb + 8, HG_CARRY(p, l); if ((l) == 0) phase_convert(p, 1, (LAS float*)L, 5696, 7744, 136);) \
    PHASE(pb + 9, HG_OUT(p, l);) \
    PHASE(pb + 10, Gemm g{(const bf16_t*)(ws + WS_U), (const bf16_t*)(wb + WB_WIN) + (size_t)5376 * DM, DM, DM, p.swid}; OrderPlain S; S.init(MT, 8, gridDim.x, blockIdx.x); S.skipctx = 0; \
        EpiZ E{(bf16_t*)(big + BIG_Z), (float*)(ws + WS_MISC), -1}; GEMM_RUN(EpiZ, OrderPlain, g, S, E);) \
    PHASE(pb + 11, ML_LOCAL(p, l);) \
    PHASE(pb + 12, ML_CARRY(p, l); if ((l) == 0) phase_convert(p, 1, (LAS float*)L, 7744, 9792, 136);) \
    PHASE(pb + 13, ML_OUT(p, l);) \
    PHASE(pb + 14, Gemm g{(const bf16_t*)(big + BIG_YS), (const bf16_t*)(wb + WB_WB), 512, 512, p.swid}; OrderBranch S; S.init((l) ? 64 : MT, 16, gridDim.x, blockIdx.x); S.skipctx = (l); \
        EpiBO E{(bf16_t*)(big + BIG_BO)}; GEMM_RUN(EpiBO, OrderBranch, g, S, E);) \
    PHASE(pb + 15, Gemm g{(const bf16_t*)(ws + WS_U), (const bf16_t*)(wb + WB_WM), DM, DM, p.swid}; OrderPlain S; S.init((l) ? 64 : MT, 16, gridDim.x, blockIdx.x); S.skipctx = (l); \
        EpiMerge E{(const bf16_t*)(big + BIG_BO), p.in[I_BMERGE] + (size_t)(l) * 4096, (bf16_t*)(big + BIG_MERGED)}; GEMM_RUN(EpiMerge, OrderPlain, g, S, E);) \
    PHASE(pb + 16, Gemm g{(const bf16_t*)(big + BIG_MERGED), (const bf16_t*)(wb + WB_WO), DM, DM, p.swid}; OrderPlain S; S.init((l) ? 64 : MT, 4, gridDim.x, blockIdx.x); S.skipctx = (l); \
        EpiOut E{(l) == 0 ? p.in[I_X] : p.out, (l) == 0 ? p.in[I_CTX] : (const float*)(ws + WS_HCTX), p.out, (float*)(ws + WS_HCTX), (const float*)(ws + WS_MOD) + (size_t)(l) * 3 * 6144}; \
        GEMM_RUN(EpiOut, OrderPlain, g, S, E);) \
    PHASE(pb + 17, phase_route(p, l, L);) \
    PHASE(pb + 18, phase_dispatch(p, l, tbl);) \
    PHASE(pb + 19, const int nblk = moe_tables(p, l, tbl); Gemm g{(const bf16_t*)(big + BIG_XS), (l) ? (const bf16_t*)(ws + WS_WB2) : (const bf16_t*)(wb + WB_W13), DM, DM, p.swid}; OrderMoe S; S.init(nblk, 4, gridDim.x, blockIdx.x); S.blk_e = tbl + 32; \
        EpiH E{(bf16_t*)(big + BIG_HS)}; GEMM_RUN(EpiH, OrderMoe, g, S, E);) \
    PHASE(pb + 20, const int nblk = moe_tables(p, l, tbl); Gemm g{(const bf16_t*)(big + BIG_HS), (l) ? (const bf16_t*)(ws + WS_WB2 + 33554432) : (const bf16_t*)(wb + WB_W2), 512, 512, p.swid}; OrderMoe S; S.init(nblk, 4, gridDim.x, blockIdx.x); S.blk_e = tbl + 32; \
        EpiY E{(bf16_t*)(big + BIG_YM)}; GEMM_RUN(EpiY, OrderMoe, g, S, E);) \
    PHASE(pb + 21, phase_combine(p, l);) }
    LAYER_BODY(0)
    LAYER_BODY(1)
#undef LAYER_BODY
#undef PHASE
#undef SEAM
#undef IN
}

#ifndef N_LAUNCHES
#define N_LAUNCHES 1
#endif
extern "C" void kernel_launch(void* const* d_in, const int* in_sizes, int n_in, void* d_out, int out_size, void* d_ws, size_t ws_size, hipStream_t stream) {
    static int grid = 0;
    if (grid == 0) {
        if (n_in != N_IN || out_size != NBATCH * SEQL * DM || ws_size < WS_END) { fprintf(stderr, "kernel_launch: unexpected shapes (n_in %d out %d ws %zu need %zu)\n", n_in, out_size, ws_size, (size_t)WS_END); grid = -1; return; }
        int dev = 0, cus = 0, per_cu = 0;
        if (hipGetDevice(&dev) != hipSuccess || hipDeviceGetAttribute(&cus, hipDeviceAttributeMultiprocessorCount, dev) != hipSuccess) { grid = -1; return; }
        if (hipFuncSetAttribute((const void*)mega, hipFuncAttributeMaxDynamicSharedMemorySize, LDS_BYTES) != hipSuccess) { grid = -1; return; }
        if (hipOccupancyMaxActiveBlocksPerMultiprocessor(&per_cu, (const void*)mega, 512, LDS_BYTES) != hipSuccess || per_cu < 1) { fprintf(stderr, "kernel_launch: occupancy query says %d\n", per_cu); }
        (void)hipGetLastError();
        grid = cus;
    }
    if (grid < 0) return;
    (void)hipMemsetAsync((char*)d_ws + WS_CTL, 0, 65536, stream);
    P p{};
    for (int i = 0; i < N_IN; ++i) p.in[i] = (const float*)d_in[i];
    p.out = (float*)d_out; p.ws = (unsigned char*)d_ws;
    if (N_LAUNCHES == 1) { p.ph_lo = 0; p.ph_hi = NPH; hipLaunchKernelGGL(mega, dim3(grid), dim3(512), LDS_BYTES, stream, p); }
    else for (int k = 0; k < NPH; ++k) { p.ph_lo = k; p.ph_hi = k + 1; hipLaunchKernelGGL(mega, dim3(grid), dim3(512), LDS_BYTES, stream, p); }
}
```

```cpp
#include <hip/hip_runtime.h>
#include <cstdio>
#include <cstdint>

#define LAS __attribute__((address_space(3)))
typedef unsigned short bf16_t;
typedef short bf16x8 __attribute__((ext_vector_type(8)));
typedef float f32x4 __attribute__((ext_vector_type(4)));
typedef unsigned u32x4 __attribute__((ext_vector_type(4)));
typedef unsigned u32x2 __attribute__((ext_vector_type(2)));

#define XB_TMO      128
#define XB_XCNT(j)  (256  + 64 * (j))
#define XB_XSUB(j)  (1280 + 64 * (j))
#define XB_XGEN(j)  (2304 + 64 * (j))
#define XB_TOP      3328
#define XB_TOPGEN   3392
#define XCD_BAR_WORDS 3456
#define XB_SPIN_CAP (1u << 18)

__device__ __forceinline__ unsigned xb_ld(unsigned* p)              { return __hip_atomic_load(p, __ATOMIC_RELAXED, __HIP_MEMORY_SCOPE_AGENT); }
__device__ __forceinline__ unsigned xb_add(unsigned* p, unsigned v) { return __hip_atomic_fetch_add(p, v, __ATOMIC_RELAXED, __HIP_MEMORY_SCOPE_AGENT); }
__device__ __forceinline__ unsigned xb_xcc_id() { return (unsigned)__builtin_amdgcn_s_getreg((3 << 11) | 20) & 0xFu; }
#define XB_SPIN(cond, bar) do { unsigned _sp = 0; while (cond) { __builtin_amdgcn_s_sleep(1); \
    if ((++_sp & 255u) == 0u) { if (xb_ld(&(bar)[XB_TMO])) break; if (_sp > XB_SPIN_CAP) { atomicAdd(&(bar)[XB_TMO], 1u); break; } } } } while (0)

struct XcdBarrier {
    unsigned* bar; unsigned x;
    int swid;
    volatile LAS unsigned* st;
};

__device__ __forceinline__ XcdBarrier xcd_barrier_post(unsigned* bar, volatile LAS unsigned* st, int swid) {
    XcdBarrier b; b.bar = bar; b.x = xb_xcc_id(); b.st = st; b.swid = swid;
    if (swid == 0 && __builtin_amdgcn_mbcnt_hi(~0u, __builtin_amdgcn_mbcnt_lo(~0u, 0u)) == 0u) (void)xb_add(&bar[XB_XCNT(b.x)], 1u);
    return b;
}
__device__ __forceinline__ void xcd_barrier_complete(unsigned* bar, unsigned x, unsigned& nloc, unsigned& nx) {
    const unsigned G = gridDim.x * gridDim.y * gridDim.z;
    unsigned sum, cnt, mine, sp = 0u;
    for (;;) {
        sum = 0u; cnt = 0u; mine = 0u;
#pragma unroll
        for (unsigned j = 0; j < 16; ++j) { const unsigned c = xb_ld(&bar[XB_XCNT(j)]); sum += c; cnt += (c > 0u) ? 1u : 0u; mine = (j == x) ? c : mine; }
        if (sum == G) break;
        __builtin_amdgcn_s_sleep(1);
        if ((++sp & 255u) == 0u) { if (xb_ld(&bar[XB_TMO])) break; if (sp > XB_SPIN_CAP) { atomicAdd(&bar[XB_TMO], 1u); break; } }
    }
    nloc = mine > 0u ? mine : 1u; nx = cnt > 0u ? cnt : 1u;
}

__device__ __forceinline__ void xcd_barrier(const XcdBarrier& b) {
    asm volatile("s_waitcnt vmcnt(0)" ::: "memory");
    __syncthreads();
    if (b.swid == 0 && __builtin_amdgcn_mbcnt_hi(~0u, __builtin_amdgcn_mbcnt_lo(~0u, 0u)) == 0u) {
        unsigned* bar = b.bar;
        __builtin_amdgcn_s_waitcnt(0);
        unsigned nloc = b.st[0], nx = b.st[1];
        if (nloc == 0u) { xcd_barrier_complete(bar, b.x, nloc, nx); b.st[0] = nloc; b.st[1] = nx; }
        const unsigned old = xb_add(&bar[XB_XSUB(b.x)], 1u);
        const unsigned gen = old / nloc;
        if (old + 1u == (gen + 1u) * nloc) {
            __builtin_amdgcn_fence(__ATOMIC_RELEASE, "agent");
            asm volatile("s_waitcnt vmcnt(0)" ::: "memory");
            const unsigned og = xb_add(&bar[XB_TOP], 1u);
            const unsigned tg = og / nx;
            if (og + 1u == (tg + 1u) * nx) xb_add(&bar[XB_TOPGEN], 1u);
            else XB_SPIN(xb_ld(&bar[XB_TOPGEN]) == tg, bar);
            __builtin_amdgcn_fence(__ATOMIC_ACQUIRE, "agent");
            xb_add(&bar[XB_XGEN(b.x)], 1u);
            asm volatile("s_waitcnt vmcnt(0)" ::: "memory");
        } else {
            XB_SPIN(xb_ld(&bar[XB_XGEN(b.x)]) == gen, bar);
            __builtin_amdgcn_fence(__ATOMIC_ACQUIRE, "agent");
            asm volatile("s_waitcnt vmcnt(0)" ::: "memory");
        }
    }
    __syncthreads();
}


constexpr int DM = 1024, NBATCH = 2, SEQL = 8192, CTXL = 256, NTOK = 8448, TT = 16896, NCHUNK = 132, MT = 66;
constexpr int ZLD = 2560;
constexpr float EPS = 1e-6f;
constexpr int RGX = 0, RGY = 512, GQ = 1024, GK = 1280, GV = 1536, GG = 2048;
constexpr int HQ = 0, HI = 512, HF = 1024, HGT = 2048;
constexpr int MQ = 0, MK = 512, MV = 1024, MO = 1536;
constexpr int MISC_LR = 0, MISC_IF = 32;
constexpr int NSLOT_MAX = 37888;

enum { I_X = 0, I_C, I_CTX, I_CCTX, I_ADAW, I_ADAB, I_NMIXG, I_NFFNG, I_WIN, I_RGCW, I_RGCB, I_RGGW, I_RGGB, I_RGLAM, I_GLAWLR, I_GLABLR, I_GLANG,
       I_HGLB, I_HGNG, I_MLCW, I_MLCB, I_MLGB, I_MLNG, I_WBR, I_WMERGE, I_BMERGE, I_WOUT, I_MWG, I_MBG, I_MWE, I_MBE, I_MW1, I_MW3, I_MW2, I_FNG, N_IN };

constexpr size_t WS_CTL = 0;
constexpr size_t WS_MOD = 65536;
constexpr size_t WS_HCTX = 262144;
constexpr size_t WS_ROUTE = WS_HCTX + 2097152;
constexpr size_t WS_MISC = WS_ROUTE + 1048576;
constexpr size_t WS_SMALL = WS_MISC + 4325376;
constexpr size_t WS_WB = WS_SMALL + 8388608;
constexpr size_t WB_WIN = 0, WB_WM = WB_WIN + 15204352, WB_WB = WB_WM + 8388608, WB_WO = WB_WB + 4194304, WB_W13 = WB_WO + 2097152,
                 WB_W2 = WB_W13 + 33554432, WB_GW = WB_W2 + 16777216, WB_END = WB_GW + 262144;
constexpr size_t WS_U = WS_WB + WB_END;
constexpr size_t WS_BIG = WS_U + 34603008;
constexpr size_t BIG_Z = 0, BIG_ST = 86507520, BIG_YS = BIG_ST + 69206016 + 65536, BIG_END = BIG_YS + 69206016;
constexpr size_t WS_WB2 = WS_BIG + BIG_END;
constexpr size_t WS_END = WS_WB2;
constexpr size_t BIG_BO = 0;
constexpr size_t BIG_MERGED = BIG_YS;
constexpr size_t BIG_XS = 0;
constexpr size_t BIG_HS = 77594624;
constexpr size_t BIG_YM = BIG_HS + 38797312;
static_assert(BIG_YM + 77594624 <= BIG_END, "moe alias");
static_assert(138412032 <= BIG_YS, "BO alias");
constexpr int CW_CNT = 4096;

struct P { const float* in[N_IN]; float* out; unsigned char* ws; int ph_lo, ph_hi; };
struct PP : P { int swid; };

__device__ __forceinline__ float bf2f(bf16_t b) { return __uint_as_float(((unsigned)b) << 16); }
typedef float f32x2_t __attribute__((ext_vector_type(2)));
typedef __bf16 bf16x2_t __attribute__((ext_vector_type(2)));
__device__ __forceinline__ unsigned pack2(float lo, float hi) { const f32x2_t v = {lo, hi}; const bf16x2_t b = __builtin_convertvector(v, bf16x2_t); return __builtin_bit_cast(unsigned, b); }
__device__ __forceinline__ bf16_t f2bf(float f) { return (bf16_t)(pack2(f, 0.f) & 0xffffu); }
__device__ __forceinline__ float frcp(float x) { return __builtin_amdgcn_rcpf(x); }
__device__ __forceinline__ float sigm(float x) { return frcp(1.f + __expf(-x)); }
__device__ __forceinline__ float siluf(float x) { return x * sigm(x); }
__device__ __forceinline__ float logsig(float x) { return fminf(x, 0.f) - __logf(1.f + __expf(-fabsf(x))); }
__device__ __forceinline__ float softplusf(float x) { return fmaxf(x, 0.f) + __logf(1.f + __expf(-fabsf(x))); }
__device__ __forceinline__ float gelu_tanh(float x) { const float y = 0.7978845608028654f * (x + 0.044715f * x * x * x); const float t = 1.f - 2.f * frcp(__expf(2.f * y) + 1.f); return 0.5f * x * (1.f + t); }
__device__ __forceinline__ float wave_sum(float v) {
#pragma unroll
    for (int o = 32; o > 0; o >>= 1) v += __shfl_xor(v, o);
    return v;
}
__device__ __forceinline__ int lane_id() { return (int)__builtin_amdgcn_mbcnt_hi(~0u, __builtin_amdgcn_mbcnt_lo(~0u, 0u)); }
__device__ __forceinline__ int otid(int swid) { int t = swid * 64 + lane_id(); asm volatile("" : "+v"(t)); return t; }
__device__ __forceinline__ const float* hrow_c(const float* HL, const float* HC, int r) { const int b = r / NTOK, p = r - b * NTOK; return p < CTXL ? HC + ((size_t)b * CTXL + p) * DM : HL + ((size_t)b * SEQL + (p - CTXL)) * DM; }
__device__ __forceinline__ float* hrow_m(float* HL, float* HC, int r) { const int b = r / NTOK, p = r - b * NTOK; return p < CTXL ? HC + ((size_t)b * CTXL + p) * DM : HL + ((size_t)b * SEQL + (p - CTXL)) * DM; }
__device__ __forceinline__ int mod_idx(int r) { const int b = r / NTOK, p = r - b * NTOK; return p < CTXL ? 2 : b; }

typedef const __attribute__((address_space(4))) P* KP;
__device__ __forceinline__ PP load_args(int swid) { unsigned long long a = (unsigned long long)__builtin_amdgcn_kernarg_segment_ptr(); asm volatile("" : "+s"(a)); KP k = (KP)a; PP r; r.swid = swid;
#pragma unroll
    for (int i = 0; i < N_IN; ++i) r.in[i] = k->in[i];
    r.out = k->out; r.ws = k->ws; r.ph_lo = k->ph_lo; r.ph_hi = k->ph_hi; return r; }
struct Unit { int pm, pn; };
struct Gemm { const bf16_t* A; const bf16_t* Bt; int lda; int K; int swid; };

struct TileOrder {
    int nM, nN, G, c;
    __device__ __forceinline__ void a_ready(const Unit&) const {}
    __device__ __forceinline__ void done(const Unit&) const {}
    __device__ void init(int nM_, int nN_, int G_, int c_) { nM = nM_; nN = nN_; G = G_; c = c_; }
    __device__ __forceinline__ bool base(int i, Unit& u) const { const long L = (long)i * G + c; const int nwg = nM * nN; if (L >= (long)nwg) return false;
        int wgid = (int)L; { const int q = nwg / 8, r = nwg % 8, xcd = wgid % 8, off = wgid / 8; wgid = (xcd < r ? xcd * (q + 1) : r * (q + 1) + (xcd - r) * q) + off; }
        const int nig = 8 * nN, gid = wgid / nig, fm = gid * 8, gsz = (nM - fm) < 8 ? (nM - fm) : 8;
        u.pm = fm + ((wgid % nig) % gsz); u.pn = (wgid % nig) / gsz; return true; }
};
struct OrderPlain : TileOrder { int skipctx; __device__ __forceinline__ bool next(int i, Unit& u) const { if (!base(i, u)) return false; if (skipctx) u.pm = u.pm < 32 ? u.pm + 1 : u.pm + 2; return true; } };
struct OrderBranch : TileOrder { int skipctx; __device__ __forceinline__ bool next(int i, Unit& u) const { if (!base(i, u)) return false; int pm = u.pm; if (skipctx) pm = pm < 32 ? pm + 1 : pm + 2; u.pm = (u.pn >> 2) * MT + pm; return true; } };
struct OrderMoe : TileOrder { const LAS int* blk_e; __device__ __forceinline__ bool next(int i, Unit& u) const { if (!base(i, u)) return false; u.pn = blk_e[u.pm] * 4 + u.pn; return true; } };

#define PG8_LAS __attribute__((address_space(3)))
constexpr int BM = 256, BK = 64, HALF = 128, HTB = HALF * BK * 2  , STAGE_BYTES = 8 * HTB;
__host__ __device__ __forceinline__ int lds_byte(int r, int c) { const int st = (r >> 4) * 2 + (c >> 5), rr = r & 15, cc = c & 31, ob = rr * 64 + cc * 2; return st * 1024 + (ob ^ (((ob >> 9) & 1) << 5)); }
__host__ __device__ __forceinline__ void stage_rc(int b, int& R, int& C) { const int st = b / 1024, sb = b % 1024, swz = sb ^ (((sb >> 9) & 1) << 5); R = (st >> 1) * 16 + swz / 64; C = (st & 1) * 32 + (swz % 64) / 2; }
__host__ __device__ __forceinline__ int perm32(int rho) { const int n = rho >> 4, i = rho & 15; return 8 * (i >> 2) + 4 * n + (i & 3); }
template <class Epi, class Sched, bool STAMP = false>
__device__ __forceinline__ void gemm_phase(PG8_LAS unsigned char* lds, const Gemm g, const Sched& S, const Epi& E, unsigned long long* stamps = nullptr) {
    const int tid = otid(g.swid), wid = g.swid, lane = tid & 63, wr = wid >> 2, wc = wid & 3, fr = lane & 15, fq = lane >> 4;
    const int K = g.K, nt = K / BK;
    int ts_lo = 0, ts_hi = 0, nts = 0; const unsigned long long rt_entry = STAMP ? (unsigned long long)wall_clock64() : 0ull;
#define PG8_STAMP() do { if (STAMP && wid == 0 && nts < 64) { const unsigned long long _c = (unsigned long long)clock64(); \
        ts_lo = (lane == nts) ? (int)(unsigned)_c : ts_lo; ts_hi = (lane == nts) ? (int)(unsigned)(_c >> 32) : ts_hi; ++nts; } } while (0)
    PG8_STAMP();
    unsigned voffA[2], voffB[2];
#pragma unroll
    for (int i = 0; i < 2; ++i) { int R, C; stage_rc(tid * 16 + i * 8192, R, C); const int Rb = Epi::PERM ? ((R & ~31) + perm32(R & 31)) : R;
        voffA[i] = (unsigned)(R * K + C) * 2u; voffB[i] = (unsigned)(Rb * K + C) * 2u; }
    const size_t kstep = (size_t)(BK * 2);
    const size_t hstep = (size_t)HALF * K * 2;
    const size_t tstep = 2 * hstep;
    const unsigned ldsw = (unsigned)wid * 1024u;
    const int aoff = lds_byte(wr * 64 + fr, fq * 8), boff = lds_byte(wc * 32 + fr, fq * 8);
#define PG8_SA(b, h) (((b) * 2 + (h)) * HTB)
#define PG8_SB(b, h) ((4 + (b) * 2 + (h)) * HTB)
#define PG8_STAGE(bufoff, gbase, voff) do { _Pragma("unroll") for (int _i = 0; _i < 2; ++_i) \
        __builtin_amdgcn_global_load_lds((const unsigned*)((const char*)(gbase) + (voff)[_i]), (PG8_LAS unsigned*)(lds + (bufoff) + ldsw + _i * 8192), 16, 0, 0); } while (0)
#define PG8_LDA(dst, b, h) do { _Pragma("unroll") for (int m = 0; m < 4; ++m) _Pragma("unroll") for (int k = 0; k < 2; ++k) dst[m][k] = *(const PG8_LAS bf16x8*)(lds + PG8_SA(b, h) + aoff + m * 2048 + k * 1024); } while (0)
#define PG8_LDB(dst, b, h) do { _Pragma("unroll") for (int n = 0; n < 2; ++n) _Pragma("unroll") for (int k = 0; k < 2; ++k) dst[n][k] = *(const PG8_LAS bf16x8*)(lds + PG8_SB(b, h) + boff + n * 2048 + k * 1024); } while (0)
#define PG8_MMA(ai, bj, At, Bt) do { __builtin_amdgcn_s_setprio(1); _Pragma("unroll") for (int m = 0; m < 4; ++m) _Pragma("unroll") for (int n = 0; n < 2; ++n) _Pragma("unroll") for (int k = 0; k < 2; ++k) \
        acc[ai][bj][m][n] = __builtin_amdgcn_mfma_f32_16x16x32_bf16(Bt[n][k], At[m][k], acc[ai][bj][m][n], 0, 0, 0); __builtin_amdgcn_s_setprio(0); } while (0)
#define PG8_WAIT_V(n) asm volatile("s_waitcnt vmcnt(" #n ")" ::: "memory")
#define PG8_WAIT_L(n) asm volatile("s_waitcnt lgkmcnt(" #n ")" ::: "memory")
#define PG8_BAR __builtin_amdgcn_s_barrier()
#define PG8_SCHED __builtin_amdgcn_sched_barrier(0)
    Unit cur, nxt; int ui = 0;
    if (!S.next(0, cur)) return;
    f32x4 acc[2][2][4][2];
#pragma unroll
    for (int a = 0; a < 2; ++a)
#pragma unroll
        for (int b = 0; b < 2; ++b)
#pragma unroll
            for (int m = 0; m < 4; ++m)
#pragma unroll
                for (int n = 0; n < 2; ++n) acc[a][b][m][n] = (f32x4){0.f, 0.f, 0.f, 0.f};
    bf16x8 At[4][2], B0[2][2], B1[2][2];
    const char* cA = (const char*)g.A + (size_t)cur.pm * tstep; const char* cB = (const char*)g.Bt + (size_t)cur.pn * tstep;
    S.a_ready(cur);
    PG8_STAGE(PG8_SB(0, 0), cB, voffB); PG8_STAGE(PG8_SA(0, 0), cA, voffA); PG8_STAGE(PG8_SB(0, 1), cB + hstep, voffB); PG8_STAGE(PG8_SA(0, 1), cA + hstep, voffA);
    if (wr == 1) PG8_BAR;
    PG8_WAIT_V(4); PG8_BAR;
    PG8_STAGE(PG8_SB(1, 0), cB + kstep, voffB); PG8_STAGE(PG8_SA(1, 0), cA + kstep, voffA); PG8_STAGE(PG8_SB(1, 1), cB + hstep + kstep, voffB);
    PG8_WAIT_V(6); PG8_BAR;
    PG8_STAMP();
    for (;;) {
        const bool has_next = S.next(ui + 1, nxt);
        const char* nA = has_next ? (const char*)g.A + (size_t)nxt.pm * tstep : cA; const char* nB = has_next ? (const char*)g.Bt + (size_t)nxt.pn * tstep : cB;
        for (int t = 0; t < nt; t += 2) {
            const bool last = (t == nt - 2);
            const char* a1 = cA + (size_t)(t + 1) * kstep;
            const char* a2 = last ? nA : cA + (size_t)(t + 2) * kstep; const char* b2 = last ? nB : cB + (size_t)(t + 2) * kstep;
            const char* a3 = a2 + kstep; const char* b3 = b2 + kstep;
            if (last && has_next) S.a_ready(nxt);
            PG8_LDB(B0, 0, 0); PG8_SCHED; PG8_LDA(At, 0, 0); PG8_STAGE(PG8_SA(1, 1), a1 + hstep, voffA);
            PG8_WAIT_L(8); PG8_BAR; PG8_WAIT_L(0); PG8_MMA(0, 0, At, B0); PG8_BAR; PG8_SCHED;
            PG8_LDB(B1, 0, 1); PG8_STAGE(PG8_SB(0, 0), b2, voffB);
            PG8_BAR; PG8_WAIT_L(0); PG8_MMA(0, 1, At, B1); PG8_BAR;
            PG8_LDA(At, 0, 1); PG8_STAGE(PG8_SA(0, 0), a2, voffA);
            PG8_BAR; PG8_WAIT_L(0); PG8_MMA(1, 0, At, B0); PG8_BAR; PG8_SCHED;
            PG8_STAGE(PG8_SB(0, 1), b2 + hstep, voffB);
            PG8_WAIT_V(6); PG8_BAR; PG8_MMA(1, 1, At, B1); PG8_BAR;
            PG8_LDB(B0, 1, 0); PG8_SCHED; PG8_LDA(At, 1, 0); PG8_STAGE(PG8_SA(0, 1), a2 + hstep, voffA);
            PG8_WAIT_L(8); PG8_BAR; PG8_WAIT_L(0); PG8_MMA(0, 0, At, B0); PG8_BAR; PG8_SCHED;
            PG8_LDB(B1, 1, 1); PG8_STAGE(PG8_SB(1, 0), b3, voffB);
            PG8_BAR; PG8_WAIT_L(0); PG8_MMA(0, 1, At, B1); PG8_BAR;
            PG8_LDA(At, 1, 1); PG8_STAGE(PG8_SA(1, 0), a3, voffA);
            PG8_BAR; PG8_WAIT_L(0); PG8_MMA(1, 0, At, B0); PG8_BAR; PG8_SCHED;
            PG8_STAGE(PG8_SB(1, 1), b3 + hstep, voffB);
            PG8_WAIT_V(6); PG8_BAR; PG8_MMA(1, 1, At, B1); PG8_BAR;
        }
        PG8_STAMP();
        if constexpr (!Epi::AFTER_DRAIN) { E(acc, cur, wr, wc, fr, fq); S.done(cur); }
        PG8_STAMP();
        if (!has_next) break;
#pragma unroll
        for (int a = 0; a < 2; ++a)
#pragma unroll
            for (int b = 0; b < 2; ++b)
#pragma unroll
                for (int m = 0; m < 4; ++m)
#pragma unroll
                    for (int n = 0; n < 2; ++n) acc[a][b][m][n] = (f32x4){0.f, 0.f, 0.f, 0.f};
        cur = nxt; cA = nA; cB = nB; ++ui;
    }
    PG8_WAIT_V(0);
    if (wr == 0) PG8_BAR;
    PG8_BAR;
    if constexpr (Epi::AFTER_DRAIN) { E.fused(acc, cur, wr, wc, fr, fq, lds, wid, lane); S.done(cur); }
    PG8_STAMP();
    if (STAMP && wid == 0) { stamps[lane] = lane < nts ? (((unsigned long long)(unsigned)ts_hi << 32) | (unsigned)ts_lo) : 0ull;
        if (lane == 62) stamps[62] = rt_entry; if (lane == 63) stamps[63] = (unsigned long long)wall_clock64(); }
#undef PG8_STAMP
#undef PG8_SA
#undef PG8_SB
#undef PG8_STAGE
#undef PG8_LDA
#undef PG8_LDB
#undef PG8_MMA
#undef PG8_WAIT_V
#undef PG8_WAIT_L
#undef PG8_BAR
#undef PG8_SCHED
}

#define GEMM_RUN(EpiT, SchedT, g, S, E) gemm_phase<EpiT, SchedT>(L, g, S, E)


struct EpiZ {
    static constexpr bool PERM = true, AFTER_DRAIN = false;
    bf16_t* Z; float* MISC; int misc_pn;
    __device__ __forceinline__ void operator()(const f32x4 (&acc)[2][2][4][2], const Unit& u, int wr, int wc, int fr, int fq) const {
        const int row0 = u.pm * 256 + wr * 64 + fr, col0 = u.pn * 256 + wc * 32 + 8 * fq;
        if (u.pn == misc_pn) {
            if (wc < 2) {
#pragma unroll
                for (int ai = 0; ai < 2; ++ai)
#pragma unroll
                    for (int m = 0; m < 4; ++m) { const int row = row0 + ai * 128 + m * 16; float* mp = MISC + (size_t)row * 64 + wc * 32 + 8 * fq;
                        *(f32x4*)mp = acc[ai][0][m][0]; *(f32x4*)(mp + 4) = acc[ai][0][m][1]; } }
        } else {
#pragma unroll
            for (int ai = 0; ai < 2; ++ai)
#pragma unroll
                for (int m = 0; m < 4; ++m) { const int row = row0 + ai * 128 + m * 16;
#pragma unroll
                    for (int bj = 0; bj < 2; ++bj) { const f32x4 v0 = acc[ai][bj][m][0], v1 = acc[ai][bj][m][1];
                        *(uint4*)(Z + (size_t)row * ZLD + col0 + bj * 128) = make_uint4(pack2(v0[0], v0[1]), pack2(v0[2], v0[3]), pack2(v1[0], v1[1]), pack2(v1[2], v1[3])); } }
        }
    }
};
struct EpiBO {
    static constexpr bool PERM = true, AFTER_DRAIN = false;
    bf16_t* BO;
    __device__ __forceinline__ void operator()(const f32x4 (&acc)[2][2][4][2], const Unit& u, int wr, int wc, int fr, int fq) const {
        const int kb = u.pn >> 2, pm = u.pm - kb * MT, pn = u.pn & 3;
        const int row0 = pm * 256 + wr * 64 + fr, col0 = pn * 256 + wc * 32 + 8 * fq;
        bf16_t* base = BO + (size_t)kb * TT * DM;
#pragma unroll
        for (int ai = 0; ai < 2; ++ai)
#pragma unroll
            for (int m = 0; m < 4; ++m) { const int row = row0 + ai * 128 + m * 16;
#pragma unroll
                for (int bj = 0; bj < 2; ++bj) { const f32x4 v0 = acc[ai][bj][m][0], v1 = acc[ai][bj][m][1];
                    *(uint4*)(base + (size_t)row * DM + col0 + bj * 128) = make_uint4(pack2(v0[0], v0[1]), pack2(v0[2], v0[3]), pack2(v1[0], v1[1]), pack2(v1[2], v1[3])); } }
    }
};
struct EpiMerge {
    static constexpr bool PERM = false, AFTER_DRAIN = false;
    const bf16_t* __restrict__ BO; const float* __restrict__ bm; bf16_t* __restrict__ MG;
    __device__ __forceinline__ void operator()(const f32x4 (&acc)[2][2][4][2], const Unit& u, int wr, int wc, int fr, int fq) const {
        const int row0 = u.pm * 256 + wr * 64 + fr, c0 = u.pn * 64 + wc * 16 + 4 * fq;
        f32x4 bb[4];
#pragma unroll
        for (int kb = 0; kb < 4; ++kb) bb[kb] = *(const f32x4*)(bm + kb * DM + c0);
#pragma unroll
        for (int ai = 0; ai < 2; ++ai) {
            uint2 bo[4][4];
#pragma unroll
            for (int m = 0; m < 4; ++m)
#pragma unroll
                for (int kb = 0; kb < 4; ++kb) bo[m][kb] = *(const uint2*)(BO + ((size_t)kb * TT + row0 + ai * 128 + m * 16) * DM + c0);
#pragma unroll
            for (int m = 0; m < 4; ++m) { const int row = row0 + ai * 128 + m * 16; f32x4 s = (f32x4){0.f, 0.f, 0.f, 0.f};
#pragma unroll
                for (int bj = 0; bj < 2; ++bj)
#pragma unroll
                    for (int n = 0; n < 2; ++n) { const int kb = 2 * bj + n; const f32x4 a = acc[ai][bj][m][n]; const uint2 bv = bo[m][kb];
                        s[0] += sigm(a[0] + bb[kb][0]) * bf2f((bf16_t)(bv.x & 0xffff)); s[1] += sigm(a[1] + bb[kb][1]) * bf2f((bf16_t)(bv.x >> 16));
                        s[2] += sigm(a[2] + bb[kb][2]) * bf2f((bf16_t)(bv.y & 0xffff)); s[3] += sigm(a[3] + bb[kb][3]) * bf2f((bf16_t)(bv.y >> 16)); }
                *(uint2*)(MG + (size_t)row * DM + c0) = make_uint2(pack2(s[0], s[1]), pack2(s[2], s[3])); } }
    }
};
struct EpiOut {
    static constexpr bool PERM = false, AFTER_DRAIN = false;
    const float* sL; const float* sC; float* dL; float* dC; const float* mod;
    __device__ __forceinline__ void operator()(const f32x4 (&acc)[2][2][4][2], const Unit& u, int wr, int wc, int fr, int fq) const {
        const int row0 = u.pm * 256 + wr * 64 + fr, col0 = u.pn * 256 + wc * 32 + 4 * fq;
        const int mv = mod_idx(u.pm * 256);
        const float* g1 = mod + mv * 6144 + 2 * DM;
        f32x4 gg[2][2];
#pragma unroll
        for (int bj = 0; bj < 2; ++bj)
#pragma unroll
            for (int n = 0; n < 2; ++n) gg[bj][n] = *(const f32x4*)(g1 + col0 + bj * 128 + n * 16);
#pragma unroll
        for (int ai = 0; ai < 2; ++ai) {
            f32x4 hv[4][2][2];
#pragma unroll
            for (int m = 0; m < 4; ++m) { const float* src = hrow_c(sL, sC, row0 + ai * 128 + m * 16);
#pragma unroll
                for (int bj = 0; bj < 2; ++bj)
#pragma unroll
                    for (int n = 0; n < 2; ++n) hv[m][bj][n] = *(const f32x4*)(src + col0 + bj * 128 + n * 16); }
#pragma unroll
            for (int m = 0; m < 4; ++m) { float* dst = hrow_m(dL, dC, row0 + ai * 128 + m * 16);
#pragma unroll
                for (int bj = 0; bj < 2; ++bj)
#pragma unroll
                    for (int n = 0; n < 2; ++n) *(f32x4*)(dst + col0 + bj * 128 + n * 16) = hv[m][bj][n] + gg[bj][n] * acc[ai][bj][m][n]; } }
    }
};
struct EpiH {
    static constexpr bool PERM = false, AFTER_DRAIN = false;
    bf16_t* HS;
    __device__ __forceinline__ void operator()(const f32x4 (&acc)[2][2][4][2], const Unit& u, int wr, int wc, int fr, int fq) const {
        const int pn = u.pn & 3, row0 = u.pm * 256 + wr * 64 + fr, hc0 = pn * 128 + wc * 16 + 4 * fq;
#pragma unroll
        for (int ai = 0; ai < 2; ++ai)
#pragma unroll
            for (int m = 0; m < 4; ++m) { const int row = row0 + ai * 128 + m * 16;
#pragma unroll
                for (int bj = 0; bj < 2; ++bj) { const f32x4 a = acc[ai][bj][m][0], c = acc[ai][bj][m][1];
                    *(uint2*)(HS + (size_t)row * 512 + hc0 + bj * 64) = make_uint2(pack2(siluf(a[0]) * c[0], siluf(a[1]) * c[1]), pack2(siluf(a[2]) * c[2], siluf(a[3]) * c[3])); } }
    }
};
struct EpiY {
    static constexpr bool PERM = true, AFTER_DRAIN = false;
    bf16_t* YM;
    __device__ __forceinline__ void operator()(const f32x4 (&acc)[2][2][4][2], const Unit& u, int wr, int wc, int fr, int fq) const {
        const int pn = u.pn & 3, row0 = u.pm * 256 + wr * 64 + fr, col0 = pn * 256 + wc * 32 + 8 * fq;
#pragma unroll
        for (int ai = 0; ai < 2; ++ai)
#pragma unroll
            for (int m = 0; m < 4; ++m) { const int row = row0 + ai * 128 + m * 16;
#pragma unroll
                for (int bj = 0; bj < 2; ++bj) { const f32x4 v0 = acc[ai][bj][m][0], v1 = acc[ai][bj][m][1];
                    *(uint4*)(YM + (size_t)row * DM + col0 + bj * 128) = make_uint4(pack2(v0[0], v0[1]), pack2(v0[2], v0[3]), pack2(v1[0], v1[1]), pack2(v1[2], v1[3])); } }
    }
};

__device__ __forceinline__ void phase_mods(const PP& p, LAS float* lds) {
    const int tid = otid(p.swid);
    float* MOD = (float*)(p.ws + WS_MOD);
    LAS float* sc = lds;
    LAS float* red = lds + 3072;
    for (int i = tid; i < 3072; i += 512) { const int v = i >> 10, k = i & 1023; const float x = v < 2 ? p.in[I_C][v * DM + k] : p.in[I_CCTX][k]; sc[i] = siluf(x); }
    __syncthreads();
    for (int u = blockIdx.x; u < 96; u += gridDim.x) {
        const int l = u / 48, cg = u % 48, col = cg * 128 + (tid & 127), kp = tid >> 7;
        const float* W = p.in[I_ADAW] + (size_t)l * DM * 6144 + col;
        float s0 = 0.f, s1 = 0.f, s2 = 0.f;
        for (int k = kp * 256; k < kp * 256 + 256; ++k) { const float w = W[(size_t)k * 6144]; s0 += sc[k] * w; s1 += sc[1024 + k] * w; s2 += sc[2048 + k] * w; }
        red[(kp * 3 + 0) * 128 + (tid & 127)] = s0; red[(kp * 3 + 1) * 128 + (tid & 127)] = s1; red[(kp * 3 + 2) * 128 + (tid & 127)] = s2;
        __syncthreads();
        if (tid < 384) { const int v = tid >> 7, cc = tid & 127; const float s = red[(0 * 3 + v) * 128 + cc] + red[(1 * 3 + v) * 128 + cc] + red[(2 * 3 + v) * 128 + cc] + red[(3 * 3 + v) * 128 + cc];
            MOD[((size_t)l * 3 + v) * 6144 + cg * 128 + cc] = s + p.in[I_ADAB][l * 6144 + cg * 128 + cc]; }
        __syncthreads();
    }
}

__device__ __forceinline__ const float* conv_src(const PP& p, int l, int mat, int sub, int n, int& ld) {
    switch (mat) {
    case 0: { ld = 7216; int c; if (n < 2592) c = n; else if (n < 2608) c = 7200 + (n - 2592); else if (n < 2816) return nullptr; else if (n < 5376) c = 2592 + (n - 2816); else c = 5152 + (n - 5376);
              return p.in[I_WIN] + (size_t)l * DM * 7216 + c; }
    case 1: { ld = 4096; const int pn = n >> 8, ct = n & 255, bj = ct >> 7, wc = (ct >> 5) & 3, nn = (ct >> 4) & 1, i = ct & 15; const int kb = 2 * bj + nn, c = 64 * pn + 16 * wc + i;
              return p.in[I_WMERGE] + (size_t)l * DM * 4096 + kb * DM + c; }
    case 2: { ld = 1024; return p.in[I_WBR] + ((size_t)l * 4 + sub) * 512 * DM + n; }
    case 3: { ld = 1024; return p.in[I_WOUT] + (size_t)l * DM * DM + n; }
    case 4: { ld = 512; const int g = n >> 5, nn = (n >> 4) & 1, i = n & 15, hc = 16 * g + i; return (nn ? p.in[I_MW3] : p.in[I_MW1]) + ((size_t)l * 16 + sub) * DM * 512 + hc; }
    case 5: { ld = 1024; return p.in[I_MW2] + ((size_t)l * 16 + sub) * 512 * DM + n; }
    default: { ld = 64; return p.in[I_RGGW] + ((size_t)l * 32 + sub) * 4096 + n; }
    }
}
__device__ __forceinline__ void conv_unit(int u, int& mat, int& sub, int& nt, int& kt, int& K, size_t& dstoff) {
    if (u < 1856) { mat = 0; sub = 0; nt = u >> 4; kt = u & 15; K = 1024; dstoff = WB_WIN; }
    else if (u < 2880) { const int v = u - 1856; mat = 1; sub = 0; nt = v >> 4; kt = v & 15; K = 1024; dstoff = WB_WM; }
    else if (u < 3392) { const int v = u - 2880; mat = 2; sub = v >> 7; nt = (v & 127) >> 3; kt = v & 7; K = 512; dstoff = WB_WB + (size_t)sub * 1024 * 512 * 2; }
    else if (u < 3648) { const int v = u - 3392; mat = 3; sub = 0; nt = v >> 4; kt = v & 15; K = 1024; dstoff = WB_WO; }
    else if (u < 7744) { const int v = u - 3648; mat = 4; sub = v >> 8; nt = (v & 255) >> 4; kt = v & 15; K = 1024; dstoff = WB_W13 + (size_t)sub * 1024 * 1024 * 2; }
    else if (u < 9792) { const int v = u - 7744; mat = 5; sub = v >> 7; nt = (v & 127) >> 3; kt = v & 7; K = 512; dstoff = WB_W2 + (size_t)sub * 1024 * 512 * 2; }
    else { mat = 6; sub = u - 9792; nt = 0; kt = 0; K = 64; dstoff = WB_GW + (size_t)sub * 4096 * 2; }
}
__device__ __forceinline__ void phase_convert(const PP& p, int l, LAS float* tile  , int u_lo, int u_hi, int wg_lo) {
    const int tid = otid(p.swid);
    unsigned char* wb = p.ws + WS_WB;
    if ((int)blockIdx.x < wg_lo) return;
    for (int u0 = u_lo + ((int)blockIdx.x - wg_lo) * 4; u0 < u_hi; u0 += ((int)gridDim.x - wg_lo) * 4) {
        float val[4][8];
#pragma unroll
        for (int q = 0; q < 4; ++q) { int mat, sub, nt, kt, K; size_t dstoff; conv_unit(u0 + q, mat, sub, nt, kt, K, dstoff);
            int ld; const float* sp = conv_src(p, l, mat, sub, nt * 64 + (tid & 63), ld);
#pragma unroll
            for (int i = 0; i < 8; ++i) { const int kk = (tid >> 6) + 8 * i; val[q][i] = sp ? sp[(size_t)(kt * 64 + kk) * ld] : 0.f; } }
#pragma unroll
        for (int q = 0; q < 4; ++q)
#pragma unroll
            for (int i = 0; i < 8; ++i) tile[q * 4160 + ((tid >> 6) + 8 * i) * 65 + (tid & 63)] = val[q][i];
        __syncthreads();
#pragma unroll
        for (int q = 0; q < 4; ++q) { int mat, sub, nt, kt, K; size_t dstoff; conv_unit(u0 + q, mat, sub, nt, kt, K, dstoff);
            const int nn = tid >> 3, ks = (tid & 7) * 8; unsigned w[4];
#pragma unroll
            for (int j = 0; j < 4; ++j) w[j] = pack2(tile[q * 4160 + (ks + 2 * j) * 65 + nn], tile[q * 4160 + (ks + 2 * j + 1) * 65 + nn]);
            unsigned char* dbase = wb + dstoff;
            *(uint4*)((bf16_t*)dbase + (size_t)(nt * 64 + nn) * K + kt * 64 + ks) = make_uint4(w[0], w[1], w[2], w[3]); }
        __syncthreads();
    }
}

__device__ __forceinline__ void norm_row(const PP& p, int l, int which, const float* src, int mv, int lane, float (&u)[4][4]) {
    const float* MOD = (const float*)(p.ws + WS_MOD) + ((size_t)l * 3 + mv) * 6144;
    const float* gain = (which ? p.in[I_NFFNG] : p.in[I_NMIXG]) + l * DM;
    const float* sh = MOD + (which ? 3 : 0) * DM; const float* sc = MOD + (which ? 4 : 1) * DM;
    float ss = 0.f;
#pragma unroll
    for (int i = 0; i < 4; ++i) { const f32x4 v = *(const f32x4*)(src + 256 * i + 4 * lane); u[i][0] = v[0]; u[i][1] = v[1]; u[i][2] = v[2]; u[i][3] = v[3]; ss += v[0] * v[0] + v[1] * v[1] + v[2] * v[2] + v[3] * v[3]; }
    ss = wave_sum(ss);
    const float rs = rsqrtf(ss * (1.f / DM) + EPS);
#pragma unroll
    for (int i = 0; i < 4; ++i) { const int col = 256 * i + 4 * lane; const f32x4 g = *(const f32x4*)(gain + col), a = *(const f32x4*)(sc + col), b = *(const f32x4*)(sh + col);
#pragma unroll
        for (int j = 0; j < 4; ++j) u[i][j] = u[i][j] * rs * g[j] * (1.f + a[j]) + b[j]; }
}
__device__ __forceinline__ void norm_row_pre(const PP& p, int l, int which, const f32x4 (&v)[4], int mv, int lane, float (&u)[4][4]) {
    const float* MOD = (const float*)(p.ws + WS_MOD) + ((size_t)l * 3 + mv) * 6144;
    const float* gain = (which ? p.in[I_NFFNG] : p.in[I_NMIXG]) + l * DM;
    const float* sh = MOD + (which ? 3 : 0) * DM; const float* sc = MOD + (which ? 4 : 1) * DM;
    float ss = 0.f;
#pragma unroll
    for (int i = 0; i < 4; ++i) { u[i][0] = v[i][0]; u[i][1] = v[i][1]; u[i][2] = v[i][2]; u[i][3] = v[i][3]; ss += v[i][0] * v[i][0] + v[i][1] * v[i][1] + v[i][2] * v[i][2] + v[i][3] * v[i][3]; }
    ss = wave_sum(ss);
    const float rs = rsqrtf(ss * (1.f / DM) + EPS);
#pragma unroll
    for (int i = 0; i < 4; ++i) { const int col = 256 * i + 4 * lane; const f32x4 g = *(const f32x4*)(gain + col), a = *(const f32x4*)(sc + col), b = *(const f32x4*)(sh + col);
#pragma unroll
        for (int j = 0; j < 4; ++j) u[i][j] = u[i][j] * rs * g[j] * (1.f + a[j]) + b[j]; }
}
__device__ __forceinline__ void load_row(const float* src, int lane, f32x4 (&v)[4]) {
#pragma unroll
    for (int i = 0; i < 4; ++i) v[i] = *(const f32x4*)(src + 256 * i + 4 * lane);
}
__device__ __forceinline__ void phase_norm1(const PP& p, int l) {
    const int tid_ = otid(p.swid), lane = tid_ & 63, gw = blockIdx.x * 8 + (tid_ >> 6), nw = gridDim.x * 8;
    const float* sL = l == 0 ? p.in[I_X] : p.out; const float* sC = l == 0 ? p.in[I_CTX] : (const float*)(p.ws + WS_HCTX);
    bf16_t* U = (bf16_t*)(p.ws + WS_U);
    f32x4 cur[4], nxt[4];
    if (gw < TT) load_row(hrow_c(sL, sC, gw), lane, cur);
    for (int r = gw; r < TT; r += nw) {
        if (r + nw < TT) load_row(hrow_c(sL, sC, r + nw), lane, nxt);
        float u[4][4]; norm_row_pre(p, l, 0, cur, mod_idx(r), lane, u);
#pragma unroll
        for (int i = 0; i < 4; ++i) *(uint2*)(U + (size_t)r * DM + 256 * i + 4 * lane) = make_uint2(pack2(u[i][0], u[i][1]), pack2(u[i][2], u[i][3]));
#pragma unroll
        for (int i = 0; i < 4; ++i) cur[i] = nxt[i];
    }
}

__device__ __forceinline__ void phase_route(const PP& p, int l, LAS unsigned char* L) {
    const int tid_ = otid(p.swid), lane = tid_ & 63, wid = p.swid;
    LAS int* lcnt = (LAS int*)L;
    LAS int* rex = lcnt + 32;
    LAS int* rpos = rex + 132;
    if (tid_ < 32) lcnt[tid_] = 0;
    __syncthreads();
    const float* sL = p.out; const float* sC = (const float*)(p.ws + WS_HCTX);
    int* tok_e = (int*)(p.ws + WS_ROUTE); float* tok_w = (float*)(p.ws + WS_ROUTE + 262144); int* tok_pos = (int*)(p.ws + WS_ROUTE + 524288);
    unsigned* cnt = (unsigned*)(p.ws + WS_CTL) + CW_CNT + l * 16 * 32;
    const float* wg = p.in[I_MWG] + (size_t)l * DM * 4; const float* we = p.in[I_MWE] + (size_t)l * DM * 16;
    const int rbase = blockIdx.x * 66;
    const float* gain = p.in[I_NFFNG] + l * DM;
    LAS float* WT = (LAS float*)(L + 4096);
    for (int k = tid_; k < DM; k += 512) { const f32x4 g = *(const f32x4*)(wg + (size_t)k * 4); WT[0 * DM + k] = g[0]; WT[1 * DM + k] = g[1]; WT[2 * DM + k] = g[2]; WT[3 * DM + k] = g[3];
#pragma unroll
        for (int q = 0; q < 4; ++q) { const f32x4 e = *(const f32x4*)(we + (size_t)k * 16 + 4 * q); WT[(4 + 4 * q) * DM + k] = e[0]; WT[(5 + 4 * q) * DM + k] = e[1]; WT[(6 + 4 * q) * DM + k] = e[2]; WT[(7 + 4 * q) * DM + k] = e[3]; } }
    __syncthreads();
    for (int rp = wid; rp < 33; rp += 8) {
        const int rr0 = 2 * rp, r0 = rbase + rr0, r1 = r0 + 1;
        if (l == 1 && (r0 % NTOK) < CTXL) { if (lane == 0) { rex[2 * rr0] = -1; rex[2 * rr0 + 1] = -1; rex[2 * rr0 + 2] = -1; rex[2 * rr0 + 3] = -1; } continue; }
        const float* s0 = hrow_c(sL, sC, r0); const float* s1 = hrow_c(sL, sC, r1); const int mv = mod_idx(r0);
        const float* MOD = (const float*)(p.ws + WS_MOD) + ((size_t)l * 3 + mv) * 6144; const float* sh = MOD + 3 * DM; const float* sc = MOD + 4 * DM;
        f32x4 xa[4], xb[4], gm[4], bs[4]; float ssa = 0.f, ssb = 0.f;
#pragma unroll
        for (int i = 0; i < 4; ++i) { const int col0 = 256 * i + 4 * lane; xa[i] = *(const f32x4*)(s0 + col0); xb[i] = *(const f32x4*)(s1 + col0);
            const f32x4 g = *(const f32x4*)(gain + col0), a = *(const f32x4*)(sc + col0); bs[i] = *(const f32x4*)(sh + col0); gm[i] = g * (a + 1.f); }
#pragma unroll
        for (int i = 0; i < 4; ++i) { ssa += xa[i][0] * xa[i][0] + xa[i][1] * xa[i][1] + xa[i][2] * xa[i][2] + xa[i][3] * xa[i][3]; ssb += xb[i][0] * xb[i][0] + xb[i][1] * xb[i][1] + xb[i][2] * xb[i][2] + xb[i][3] * xb[i][3]; }
        ssa = wave_sum(ssa); ssb = wave_sum(ssb);
        const float rsa = rsqrtf(ssa * (1.f / DM) + EPS), rsb = rsqrtf(ssb * (1.f / DM) + EPS);
#pragma unroll
        for (int i = 0; i < 4; ++i) { xa[i] = xa[i] * rsa * gm[i] + bs[i]; xb[i] = xb[i] * rsb * gm[i] + bs[i]; }
        float acca[20], accb[20];
#pragma unroll
        for (int q = 0; q < 20; ++q) { float sa2 = 0.f, sb2 = 0.f;
#pragma unroll
            for (int i = 0; i < 4; ++i) { const f32x4 w = *(const LAS f32x4*)(WT + q * DM + 256 * i + 4 * lane);
                sa2 += xa[i][0] * w[0] + xa[i][1] * w[1] + xa[i][2] * w[2] + xa[i][3] * w[3]; sb2 += xb[i][0] * w[0] + xb[i][1] * w[1] + xb[i][2] * w[2] + xb[i][3] * w[3]; }
            acca[q] = sa2; accb[q] = sb2; }
#pragma unroll
        for (int q = 0; q < 20; ++q) { acca[q] = wave_sum(acca[q]); accb[q] = wave_sum(accb[q]); }
        if (lane < 2) {
            const int rr = rr0 + lane, r = r0 + lane; float acc[20];
#pragma unroll
            for (int q = 0; q < 20; ++q) acc[q] = lane ? accb[q] : acca[q];
            float gl[4];
#pragma unroll
            for (int q = 0; q < 4; ++q) gl[q] = acc[q] + p.in[I_MBG][l * 4 + q];
            int grp = 0; float gm = gl[0];
#pragma unroll
            for (int q = 1; q < 4; ++q) if (gl[q] > gm) { gm = gl[q]; grp = q; }
            float se = 0.f;
#pragma unroll
            for (int q = 0; q < 4; ++q) se += __expf(gl[q] - gm);
            const float pg = 1.f / se;
            float el[4];
#pragma unroll
            for (int q = 0; q < 4; ++q) { float v = 0.f;
#pragma unroll
                for (int gg = 0; gg < 4; ++gg) v = (gg == grp) ? acc[4 + gg * 4 + q] : v;
                el[q] = v + p.in[I_MBE][l * 16 + grp * 4 + q]; }
            int i0 = 0; float m0 = el[0];
#pragma unroll
            for (int q = 1; q < 4; ++q) if (el[q] > m0) { m0 = el[q]; i0 = q; }
            int i1 = -1; float m1 = -3.4e38f;
#pragma unroll
            for (int q = 0; q < 4; ++q) if (q != i0 && el[q] > m1) { m1 = el[q]; i1 = q; }
            const float e1 = __expf(m1 - m0), w0 = pg / (1.f + e1), w1 = pg * e1 / (1.f + e1);
            const int ex0 = grp * 4 + i0, ex1 = grp * 4 + i1;
            rex[2 * rr] = ex0; rex[2 * rr + 1] = ex1; rpos[2 * rr] = __hip_atomic_fetch_add(&lcnt[ex0], 1, __ATOMIC_RELAXED, __HIP_MEMORY_SCOPE_WORKGROUP); rpos[2 * rr + 1] = __hip_atomic_fetch_add(&lcnt[ex1], 1, __ATOMIC_RELAXED, __HIP_MEMORY_SCOPE_WORKGROUP);
            tok_e[2 * r] = ex0; tok_e[2 * r + 1] = ex1; tok_w[2 * r] = w0; tok_w[2 * r + 1] = w1;
        }
    }
    __syncthreads();
    if (tid_ < 16) { const int c = lcnt[tid_]; lcnt[16 + tid_] = c ? (int)atomicAdd(&cnt[32 * tid_], (unsigned)c) : 0; }
    __syncthreads();
    for (int i = tid_; i < 132; i += 512) { const int r = rbase + (i >> 1); const int e = rex[i]; if (r < TT && e >= 0) tok_pos[2 * r + (i & 1)] = lcnt[16 + e] + rpos[i]; }
    __syncthreads();
}
__device__ __forceinline__ int moe_tables(const PP& p, int l, LAS int* tbl  ) {
    const unsigned* cnt = (const unsigned*)(p.ws + WS_CTL) + CW_CNT + l * 16 * 32;
    __syncthreads();
    if (otid(p.swid) == 0) { int s = 0;
        for (int e = 0; e < 16; ++e) { const int c = (int)__hip_atomic_load(cnt + 32 * e, __ATOMIC_RELAXED, __HIP_MEMORY_SCOPE_AGENT); const int nb = (c + 255) >> 8; tbl[e] = s * 256; for (int b = 0; b < nb; ++b) tbl[32 + s + b] = e; s += nb; }
        tbl[16] = s; }
    __syncthreads();
    return tbl[16];
}
__device__ __forceinline__ void phase_dispatch(const PP& p, int l, LAS int* tbl) {
    const int tid_ = otid(p.swid), lane = tid_ & 63, gw = blockIdx.x * 8 + (tid_ >> 6), nw = gridDim.x * 8;
    moe_tables(p, l, tbl);
    const float* sL = p.out; const float* sC = (const float*)(p.ws + WS_HCTX);
    const int* tok_e = (const int*)(p.ws + WS_ROUTE); const int* tok_pos = (const int*)(p.ws + WS_ROUTE + 524288); int* tok_slot = (int*)(p.ws + WS_ROUTE + 786432);
    bf16_t* XS = (bf16_t*)(p.ws + WS_BIG + BIG_XS);
    f32x4 cur[4], nxt[4]; int ce0 = 0, ce1 = 0, cp0 = 0, cp1 = 0, ne0 = 0, ne1 = 0, np0 = 0, np1 = 0;
    if (gw < TT) { load_row(hrow_c(sL, sC, gw), lane, cur); ce0 = tok_e[2 * gw]; ce1 = tok_e[2 * gw + 1]; cp0 = tok_pos[2 * gw]; cp1 = tok_pos[2 * gw + 1]; }
    for (int r = gw; r < TT; r += nw) {
        if (r + nw < TT) { const int rn = r + nw; load_row(hrow_c(sL, sC, rn), lane, nxt); ne0 = tok_e[2 * rn]; ne1 = tok_e[2 * rn + 1]; np0 = tok_pos[2 * rn]; np1 = tok_pos[2 * rn + 1]; }
        f32x4 me[4]; const int e0 = ce0, e1 = ce1, q0 = cp0, q1 = cp1;
#pragma unroll
        for (int i = 0; i < 4; ++i) { me[i] = cur[i]; cur[i] = nxt[i]; }
        ce0 = ne0; ce1 = ne1; cp0 = np0; cp1 = np1;
        if (l == 1 && (r % NTOK) < CTXL) continue;
        float u[4][4]; norm_row_pre(p, l, 1, me, mod_idx(r), lane, u);
        const int s0 = tbl[e0 & 15] + q0, s1 = tbl[e1 & 15] + q1;
        if (lane == 0) { tok_slot[2 * r] = s0; tok_slot[2 * r + 1] = s1; }
#pragma unroll
        for (int i = 0; i < 4; ++i) { const uint2 v = make_uint2(pack2(u[i][0], u[i][1]), pack2(u[i][2], u[i][3]));
            *(uint2*)(XS + (size_t)s0 * DM + 256 * i + 4 * lane) = v; *(uint2*)(XS + (size_t)s1 * DM + 256 * i + 4 * lane) = v; }
    }
}
__device__ __forceinline__ void phase_combine(const PP& p, int l) {
    const int tid_ = otid(p.swid), lane = tid_ & 63, gw = blockIdx.x * 8 + (tid_ >> 6), nw = gridDim.x * 8;
    float* HL = p.out; float* HC = (float*)(p.ws + WS_HCTX);
    const float* tok_w = (const float*)(p.ws + WS_ROUTE + 262144); const int* tok_slot = (const int*)(p.ws + WS_ROUTE + 786432);
    const bf16_t* YM = (const bf16_t*)(p.ws + WS_BIG + BIG_YM);
    f32x4 cur[4], nxt[4]; int cs0 = 0, cs1 = 0, ns0 = 0, ns1 = 0; float cw0 = 0.f, cw1 = 0.f, nw0 = 0.f, nw1 = 0.f;
    if (gw < TT) { load_row(hrow_c(HL, HC, gw), lane, cur); cs0 = tok_slot[2 * gw]; cs1 = tok_slot[2 * gw + 1]; cw0 = tok_w[2 * gw]; cw1 = tok_w[2 * gw + 1]; }
    for (int r = gw; r < TT; r += nw) {
        if (r + nw < TT) { const int rn = r + nw; load_row(hrow_c(HL, HC, rn), lane, nxt); ns0 = tok_slot[2 * rn]; ns1 = tok_slot[2 * rn + 1]; nw0 = tok_w[2 * rn]; nw1 = tok_w[2 * rn + 1]; }
        f32x4 me[4]; const int s0 = cs0, s1 = cs1; const float w0 = cw0, w1 = cw1;
#pragma unroll
        for (int i = 0; i < 4; ++i) { me[i] = cur[i]; cur[i] = nxt[i]; }
        cs0 = ns0; cs1 = ns1; cw0 = nw0; cw1 = nw1;
        if (l == 1 && (r % NTOK) < CTXL) continue;
        const float* g2 = (const float*)(p.ws + WS_MOD) + ((size_t)l * 3 + mod_idx(r)) * 6144 + 5 * DM;
        float* hp = hrow_m(HL, HC, r);
        float x[4][4]; float ss = 0.f;
#pragma unroll
        for (int i = 0; i < 4; ++i) { const int col = 256 * i + 4 * lane; const f32x4 h = me[i], g = *(const f32x4*)(g2 + col);
            const uint2 a = *(const uint2*)(YM + (size_t)s0 * DM + col), b = *(const uint2*)(YM + (size_t)s1 * DM + col);
            x[i][0] = h[0] + g[0] * (w0 * bf2f((bf16_t)(a.x & 0xffff)) + w1 * bf2f((bf16_t)(b.x & 0xffff)));
            x[i][1] = h[1] + g[1] * (w0 * bf2f((bf16_t)(a.x >> 16)) + w1 * bf2f((bf16_t)(b.x >> 16)));
            x[i][2] = h[2] + g[2] * (w0 * bf2f((bf16_t)(a.y & 0xffff)) + w1 * bf2f((bf16_t)(b.y & 0xffff)));
            x[i][3] = h[3] + g[3] * (w0 * bf2f((bf16_t)(a.y >> 16)) + w1 * bf2f((bf16_t)(b.y >> 16)));
            ss += x[i][0] * x[i][0] + x[i][1] * x[i][1] + x[i][2] * x[i][2] + x[i][3] * x[i][3]; }
        if (l == 1) {
            ss = wave_sum(ss); const float rs = rsqrtf(ss * (1.f / DM) + EPS);
#pragma unroll
            for (int i = 0; i < 4; ++i) { const int col = 256 * i + 4 * lane; const f32x4 g = *(const f32x4*)(p.in[I_FNG] + col);
                *(f32x4*)(hp + col) = (f32x4){x[i][0] * rs * g[0], x[i][1] * rs * g[1], x[i][2] * rs * g[2], x[i][3] * rs * g[3]}; }
        } else {
#pragma unroll
            for (int i = 0; i < 4; ++i) *(f32x4*)(hp + 256 * i + 4 * lane) = (f32x4){x[i][0], x[i][1], x[i][2], x[i][3]};
            ss = wave_sum(ss); const float rs = rsqrtf(ss * (1.f / DM) + EPS);
            const float* MOD1 = (const float*)(p.ws + WS_MOD) + ((size_t)1 * 3 + mod_idx(r)) * 6144; bf16_t* U = (bf16_t*)(p.ws + WS_U);
#pragma unroll
            for (int i = 0; i < 4; ++i) { const int col = 256 * i + 4 * lane; const f32x4 g = *(const f32x4*)(p.in[I_NMIXG] + DM + col), a = *(const f32x4*)(MOD1 + DM + col), bsh = *(const f32x4*)(MOD1 + col);
                float y[4];
#pragma unroll
                for (int j2 = 0; j2 < 4; ++j2) y[j2] = x[i][j2] * rs * g[j2] * (1.f + a[j2]) + bsh[j2];
                *(uint2*)(U + (size_t)r * DM + col) = make_uint2(pack2(y[0], y[1]), pack2(y[2], y[3])); }
        }
    }
}

__device__ __forceinline__ int chain_chunk(int dir, int ci) { return dir == 0 ? ci : (ci < 4 ? 3 - ci : 135 - ci); }

constexpr size_t SM_RGA = 0, SM_RGB = 1081344, SM_RGH = 2162688, SM_DEC = 3244032, SM_MLBE = 4325376, SM_MLML = SM_MLBE + 8448, SM_MLMIN = SM_MLML + 8448, SM_MLDN = 4350720;
__device__ __forceinline__ f32x4 mfma16(bf16x8 x, bf16x8 y, f32x4 c) { const f32x4 d = __builtin_amdgcn_mfma_f32_16x16x32_bf16(x, y, c, 0, 0, 0); asm volatile("" :: "v"(x), "v"(y), "v"(d)); return d; }

__device__ __forceinline__ void settle(f32x4& a) { asm volatile("s_nop 11" : "+v"(a)); }
__device__ __forceinline__ void settle(f32x4& a, f32x4& b) { asm volatile("s_nop 11" : "+v"(a), "+v"(b)); }
__device__ __forceinline__ void settle(f32x4& a, f32x4& b, f32x4& c, f32x4& d) { asm volatile("s_nop 11" : "+v"(a), "+v"(b), "+v"(c), "+v"(d)); }
template <bool OUT> __device__ __forceinline__ void phase_rg(const PP& p, int l, LAS unsigned char* L) {
    const int tid = otid(p.swid), lane = tid & 63, wid = p.swid, fr = lane & 15, fq = lane >> 4;
    LAS bf16_t* XB = (LAS bf16_t*)L;
    LAS float* XF = (LAS float*)(L + 9216);
    LAS float* PRE = (LAS float*)(L + 9216 + 16384);
    const bf16_t* Z = (const bf16_t*)(p.ws + WS_BIG + BIG_Z); const bf16_t* GWT = (const bf16_t*)(p.ws + WS_WB + WB_GW);
    float* RA = (float*)(p.ws + WS_SMALL + SM_RGA); float* RB = (float*)(p.ws + WS_SMALL + SM_RGB); const float* RH = (const float*)(p.ws + WS_SMALL + SM_RGH);
    bf16_t* YS = (bf16_t*)(p.ws + WS_BIG + BIG_YS);
    const int blk = blockIdx.x & 7, nstr = gridDim.x >> 3, j = tid & 63, tg = tid >> 6, ch = blk * 64 + j;
    float cw[4];
#pragma unroll
    for (int q = 0; q < 4; ++q) cw[q] = p.in[I_RGCW][(l * 4 + q) * 512 + ch];
    const float cb = p.in[I_RGCB][l * 512 + ch];
    float gbr[2], gbi[2], gsp[2];
#pragma unroll
    for (int dir = 0; dir < 2; ++dir) { gbr[dir] = p.in[I_RGGB][((l * 2 + dir) * 2 + 0) * 512 + ch]; gbi[dir] = p.in[I_RGGB][((l * 2 + dir) * 2 + 1) * 512 + ch]; gsp[dir] = softplusf(-p.in[I_RGLAM][(l * 2 + dir) * 512 + ch]); }
    bf16x8 wx[4][2];
    { const int set = wid >> 1; const bf16_t* W = GWT + ((size_t)set * 8 + blk) * 4096;
#pragma unroll
      for (int jt = 0; jt < 4; ++jt) { wx[jt][0] = *(const bf16x8*)(W + (16 * jt + fr) * 64 + 8 * fq); wx[jt][1] = *(const bf16x8*)(W + (16 * jt + fr) * 64 + 8 * fq + 32); } }
    unsigned short win[11], yv[8]; float hin = 0.f;
    auto fetch = [&](int bc, unsigned short (&w_)[11], unsigned short (&y_)[8], float& h_) {
        const int c = bc % NCHUNK, b = bc / NCHUNK, p0 = c * 64; const size_t rb = (size_t)b * NTOK; const int lo = p0 < CTXL ? 0 : CTXL, hi = p0 < CTXL ? CTXL : NTOK;
#pragma unroll
        for (int k = 0; k < 11; ++k) { const int q = p0 + tg * 8 - 2 + k, qc = q < lo ? lo : (q >= hi ? hi - 1 : q); const unsigned short zv = Z[(rb + qc) * ZLD + RGX + ch]; w_[k] = (q >= lo && q < hi) ? zv : (unsigned short)0; }
        if (OUT) {
#pragma unroll
            for (int k = 0; k < 8; ++k) y_[k] = Z[(rb + p0 + tg * 8 + k) * ZLD + RGY + ch];
            if (tid < 128) h_ = RH[((size_t)((tid >> 6) * 2 + b) * NCHUNK + c) * 512 + ch]; }
    };
    int bc = blockIdx.x >> 3;
    if (bc < 2 * NCHUNK) fetch(bc, win, yv, hin);
    for (; bc < 2 * NCHUNK; bc += nstr) {
        const int c = bc % NCHUNK, b = bc / NCHUNK, p0 = c * 64; const size_t rb = (size_t)b * NTOK;
        float wf[11]; unsigned short ycur[8]; const float hcur = hin;
#pragma unroll
        for (int k = 0; k < 11; ++k) wf[k] = bf2f(win[k]);
#pragma unroll
        for (int k = 0; k < 8; ++k) ycur[k] = yv[k];
        if (bc + nstr < 2 * NCHUNK) fetch(bc + nstr, win, yv, hin);
#pragma unroll
        for (int k = 0; k < 8; ++k) { const int t = tg * 8 + k; const float xb = cb + cw[0] * wf[k] + cw[1] * wf[k + 1] + cw[2] * wf[k + 2] + cw[3] * wf[k + 3];
            XF[t * 64 + j] = xb; XB[t * 72 + j] = f2bf(xb); }
        __syncthreads();
        {
            const int set = wid >> 1;
#pragma unroll
            for (int tti = 0; tti < 2; ++tti) { const int tt = (wid & 1) * 2 + tti;
                const bf16x8 y0 = *(const LAS bf16x8*)(XB + (16 * tt + fr) * 72 + 8 * fq), y1 = *(const LAS bf16x8*)(XB + (16 * tt + fr) * 72 + 8 * fq + 32);
#pragma unroll
                for (int jt = 0; jt < 4; ++jt) { f32x4 acc = (f32x4){0.f, 0.f, 0.f, 0.f}; acc = mfma16(wx[jt][0], y0, acc); acc = mfma16(wx[jt][1], y1, acc); settle(acc);
                    *(LAS f32x4*)(PRE + (set * 64 + 16 * tt + fr) * 68 + 16 * jt + 4 * fq) = acc; } }
        }
        __syncthreads();
#pragma unroll
        for (int dir = 0; dir < 2; ++dir) {
#pragma unroll
            for (int k = 0; k < 8; ++k) { const int t = tg * 8 + k; LAS float* pa = PRE + ((dir * 2 + 0) * 64 + t) * 68 + j; LAS float* pb = PRE + ((dir * 2 + 1) * 64 + t) * 68 + j;
                const float r = sigm(*pa + gbr[dir]), ig = sigm(*pb + gbi[dir]), la = -8.f * r * gsp[dir];
                const float a = __expf(la), x2 = 2.f * la;
                const float ser = -x2 * (1.f + x2 * (0.5f + x2 * (0.16666667f + x2 * (0.041666668f + x2 * (0.008333334f + x2 * 0.0013888889f)))));
                const float om = x2 > -0.5f ? ser : 1.f - a * a;
                *pa = a; *pb = __builtin_amdgcn_sqrtf(om) * (ig * XF[t * 64 + j]); } }
        __syncthreads();
        if (tid < 128) {
            const int dir = tid >> 6; const size_t sidx = ((size_t)(dir * 2 + b) * NCHUNK + c) * 512 + ch;
            float h = OUT ? hcur : 0.f, P = 1.f;
#pragma unroll 8
            for (int s2 = 0; s2 < 64; ++s2) { const int t = dir ? 63 - s2 : s2; const float a = PRE[((dir * 2 + 0) * 64 + t) * 68 + j], bt = PRE[((dir * 2 + 1) * 64 + t) * 68 + j];
                h = a * h + bt; if (OUT) PRE[((dir * 2 + 1) * 64 + t) * 68 + j] = h; else P *= a; }
            if (!OUT) { RA[sidx] = P; RB[sidx] = h; }
        }
        if (OUT) { __syncthreads();
#pragma unroll
            for (int k = 0; k < 8; ++k) { const int t = tg * 8 + k; const size_t r = rb + p0 + t;
                YS[r * 512 + ch] = f2bf(gelu_tanh(bf2f(ycur[k])) * (PRE[((0 * 2 + 1) * 64 + t) * 68 + j] + PRE[((1 * 2 + 1) * 64 + t) * 68 + j])); } }
        __syncthreads();
    }
}
__device__ __forceinline__ void phase_rg_carry(const PP& p) {
    const int g = blockIdx.x * 512 + otid(p.swid); if (g >= 2048) return;
    const int dir = g >> 10, b = (g >> 9) & 1, ch = g & 511;
    const float* RA = (const float*)(p.ws + WS_SMALL + SM_RGA); const float* RB = (const float*)(p.ws + WS_SMALL + SM_RGB); float* RH = (float*)(p.ws + WS_SMALL + SM_RGH);
    float h = 0.f;
    for (int ci0 = 0; ci0 < NCHUNK; ci0 += 6) { float a[6], bb[6]; size_t idx[6];
#pragma unroll
        for (int k = 0; k < 6; ++k) { idx[k] = ((size_t)(dir * 2 + b) * NCHUNK + chain_chunk(dir, ci0 + k)) * 512 + ch; a[k] = RA[idx[k]]; bb[k] = RB[idx[k]]; }
#pragma unroll
        for (int k = 0; k < 6; ++k) { RH[idx[k]] = h; h = a[k] * h + bb[k]; } }
}

template <int BR> struct GlChan {
    float w[16]; float bias; float lb; int dir, h, d, l;
    __device__ __forceinline__ void init(const PP& p, int l_, int dir_, int h_, int d_) { l = l_; dir = dir_; h = h_; d = d_;
        if (BR == 1) {
#pragma unroll
            for (int r = 0; r < 16; ++r) w[r] = p.in[I_GLAWLR][((size_t)(l * 2 + dir) * 16 + r) * 256 + h * 64 + d];
            bias = p.in[I_GLABLR][(l * 2 + dir) * 256 + h * 64 + d]; lb = 0.f;
        } else { lb = 0.f; if (l == 1) { const float l0 = p.in[I_HGLB][(0 * 2 + dir) * 512 + h * 128 + d], l1 = p.in[I_HGLB][(1 * 2 + dir) * 512 + h * 128 + d]; lb = 1.f / (1.f + __expf(l0 - l1)); } bias = 0.f; }
    }
    __device__ __forceinline__ bf16_t raw(const bf16_t* zrow) const { return BR == 1 ? zrow[GK + h * 64 + d] : zrow[HF + dir * 512 + h * 128 + d]; }
    __device__ __forceinline__ void gk_raw(bf16_t rw, const LAS float* lr, float& g, float& k) const {
        if (BR == 1) { float pre = bias;
#pragma unroll
            for (int r4 = 0; r4 < 4; ++r4) { const f32x4 x = *(const LAS f32x4*)(lr + 4 * r4); pre += x[0] * w[4 * r4] + x[1] * w[4 * r4 + 1] + x[2] * w[4 * r4 + 2] + x[3] * w[4 * r4 + 3]; }
            g = logsig(pre) * (1.f / 16.f); k = bf2f(rw);
        } else { const float f = bf2f(rw); const float e = __expf(-f), sg = frcp(1.f + e);
            g = __logf(lb + (1.f - lb) * sg); k = (1.f - lb) * (e * sg); }
    }
    __device__ __forceinline__ void gk(const bf16_t* zrow, const LAS float* lr, float& g, float& k) const {
        if (BR == 1) { float pre = bias;
#pragma unroll
            for (int r4 = 0; r4 < 4; ++r4) { const f32x4 x = *(const LAS f32x4*)(lr + 4 * r4); pre += x[0] * w[4 * r4] + x[1] * w[4 * r4 + 1] + x[2] * w[4 * r4 + 2] + x[3] * w[4 * r4 + 3]; }
            g = logsig(pre) * (1.f / 16.f); k = bf2f(zrow[GK + h * 64 + d]);
        } else { const float f = bf2f(zrow[HF + dir * 512 + h * 128 + d]); const float e = __expf(-f), sg = frcp(1.f + e);
            g = __logf(lb + (1.f - lb) * sg); k = (1.f - lb) * (e * sg); }
    }
};
__device__ __forceinline__ int krow(int d) { return (d & ~31) + 16 * ((d >> 2) & 1) + 4 * ((d & 31) >> 3) + (d & 3); }
template <int BR> __device__ __forceinline__ void phase_gl_local(const PP& p, int l, LAS unsigned char* L) {
    constexpr int DK = BR == 1 ? 64 : 128, NSEG = 512 / DK, NT = 64 / NSEG;
    const int tid = otid(p.swid), lane = tid & 63, wid = p.swid, fr = lane & 15, fq = lane >> 4;
    LAS bf16_t* KT = (LAS bf16_t*)L;
    LAS bf16_t* VT = KT + 2 * DK * 72;
    LAS float* SEG = (LAS float*)(VT + 128 * 72);
    LAS float* LR = SEG + 1024;
    const bf16_t* Z = (const bf16_t*)(p.ws + WS_BIG + BIG_Z); const float* MISC = (const float*)(p.ws + WS_MISC);
    bf16_t* ST = (bf16_t*)(p.ws + WS_BIG + BIG_ST); float* DEC = (float*)(p.ws + WS_SMALL + SM_DEC);
    constexpr int VOFF = BR == 1 ? GV : HI;
    const int d = tid % DK, sg = tid / DK;
    for (int u = blockIdx.x; u < 8 * NCHUNK; u += gridDim.x) {
        const int c = u % NCHUNK, bh = u / NCHUNK, h = bh & 3, b = bh >> 2; const size_t r0 = (size_t)b * NTOK + c * 64;
        if (BR == 1) { for (int i = tid; i < 2048; i += 512) LR[i] = MISC[(r0 + (i >> 5)) * 64 + MISC_LR + (i & 31)]; }
        { const int v = tid & 127;
#pragma unroll
          for (int gi = 0; gi < 2; ++gi) { const int grp = (tid >> 7) + 4 * gi; unsigned short x[8];
#pragma unroll
            for (int e = 0; e < 8; ++e) x[e] = Z[(r0 + grp * 8 + e) * ZLD + VOFF + h * 128 + v];
            *(LAS u32x4*)(VT + v * 72 + grp * 8) = (u32x4){x[0] | ((unsigned)x[1] << 16), x[2] | ((unsigned)x[3] << 16), x[4] | ((unsigned)x[5] << 16), x[6] | ((unsigned)x[7] << 16)}; } }
        if (BR == 1) __syncthreads();
        float cs[2][NT], kk[2][NT];
#pragma unroll
        for (int dir = 0; dir < 2; ++dir) { GlChan<BR> G; G.init(p, l, dir, h, d); float run = 0.f;
#pragma unroll
            for (int q = 0; q < NT; ++q) { const int n = dir ? NT - 1 - q : q, t = sg * NT + n; float g; G.gk(Z + (r0 + t) * ZLD, LR + t * 32 + dir * 16, g, kk[dir][n]); run += g; cs[dir][n] = run; }
            SEG[(dir * NSEG + sg) * DK + d] = run; }
        __syncthreads();
#pragma unroll
        for (int dir = 0; dir < 2; ++dir) { float before = 0.f, tot = 0.f;
#pragma unroll
            for (int s2 = 0; s2 < NSEG; ++s2) { const float x = SEG[(dir * NSEG + s2) * DK + d]; tot += x; const bool earlier = dir ? (s2 > sg) : (s2 < sg); before += earlier ? x : 0.f; }
            float val[NT];
#pragma unroll
            for (int n = 0; n < NT; ++n) val[n] = kk[dir][n] * __expf(tot - (before + cs[dir][n]));
#pragma unroll
            for (int n8 = 0; n8 < NT / 8; ++n8)
                *(LAS u32x4*)(KT + (dir * DK + krow(d)) * 72 + sg * NT + 8 * n8) = (u32x4){pack2(val[8 * n8], val[8 * n8 + 1]), pack2(val[8 * n8 + 2], val[8 * n8 + 3]), pack2(val[8 * n8 + 4], val[8 * n8 + 5]), pack2(val[8 * n8 + 6], val[8 * n8 + 7])};
            if (sg == 0) DEC[((size_t)((dir * 2 + b) * 4 + h) * NCHUNK + c) * 128 + d] = __expf(tot); }
        __syncthreads();
        { const int dir = wid >> 2; const size_t sbase = ((size_t)((dir * 2 + b) * 4 + h) * NCHUNK + c) * 128 * DK;
            constexpr int NVT = DK == 64 ? 4 : 8; const int A = DK == 64 ? (wid & 1) : (wid & 3), vt0 = DK == 64 ? ((wid >> 1) & 1) * 4 : 0;
            bf16x8 x[2][2];
#pragma unroll
            for (int n = 0; n < 2; ++n) { x[n][0] = *(const LAS bf16x8*)(KT + (dir * DK + 16 * (2 * A + n) + fr) * 72 + 8 * fq); x[n][1] = *(const LAS bf16x8*)(KT + (dir * DK + 16 * (2 * A + n) + fr) * 72 + 8 * fq + 32); }
#pragma unroll
            for (int vi = 0; vi < NVT; ++vi) { const int vt = vt0 + vi; const bf16x8 y0 = *(const LAS bf16x8*)(VT + (16 * vt + fr) * 72 + 8 * fq), y1 = *(const LAS bf16x8*)(VT + (16 * vt + fr) * 72 + 8 * fq + 32);
                f32x4 a0 = (f32x4){0.f, 0.f, 0.f, 0.f}, a1 = (f32x4){0.f, 0.f, 0.f, 0.f};
                a0 = mfma16(x[0][0], y0, a0); a0 = mfma16(x[0][1], y1, a0); a1 = mfma16(x[1][0], y0, a1); a1 = mfma16(x[1][1], y1, a1); settle(a0, a1);
                *(uint4*)(ST + sbase + (size_t)(16 * vt + fr) * DK + 32 * A + 8 * fq) = make_uint4(pack2(a0[0], a0[1]), pack2(a0[2], a0[3]), pack2(a1[0], a1[1]), pack2(a1[2], a1[3])); } }
        __syncthreads();
    }
}
template <int BR> __device__ __forceinline__ void phase_gl_carry(const PP& p) {
    constexpr int DK = BR == 1 ? 64 : 128, D4 = DK / 4, TOTAL = 16 * 128 * D4, NB = 12;
    const int g = blockIdx.x * 512 + otid(p.swid);
    bf16_t* ST = (bf16_t*)(p.ws + WS_BIG + BIG_ST); const float* DEC = (const float*)(p.ws + WS_SMALL + SM_DEC);
    const float* BE = (const float*)(p.ws + WS_SMALL + SM_MLBE); const float* MLOC = (const float*)(p.ws + WS_SMALL + SM_MLML); float* MIN_ = (float*)(p.ws + WS_SMALL + SM_MLMIN); float* DN = (float*)(p.ws + WS_SMALL + SM_MLDN);
    if (g < TOTAL) {
        const int d4 = g % D4, v = (g / D4) % 128, chain = g / (D4 * 128), dir = chain >> 3;
        float S[4] = {0.f, 0.f, 0.f, 0.f}; float m = 0.f;
        for (int ci0 = 0; ci0 < NCHUNK; ci0 += NB) { uint2 ds[NB]; f32x4 da[NB]; size_t off[NB];
#pragma unroll
            for (int k = 0; k < NB; ++k) { const int c = chain_chunk(dir, ci0 + k); off[k] = (((size_t)chain * NCHUNK + c) * 128 + v) * DK + d4 * 4; ds[k] = *(const uint2*)(ST + off[k]);
                if (BR == 3) { da[k][0] = BE[chain * NCHUNK + c]; da[k][1] = MLOC[chain * NCHUNK + c]; da[k][2] = 0.f; da[k][3] = 0.f; }
                else da[k] = *(const f32x4*)(DEC + ((size_t)chain * NCHUNK + c) * 128 + d4 * 4); }
#pragma unroll
            for (int k = 0; k < NB; ++k) {
                *(uint2*)(ST + off[k]) = make_uint2(pack2(S[0], S[1]), pack2(S[2], S[3]));
                float al[4], be[4];
                if (BR == 3) { const float mn = fmaxf(da[k][0] + m, da[k][1]), a = __expf(da[k][0] + m - mn), bb = __expf(da[k][1] - mn); m = mn;
#pragma unroll
                    for (int e = 0; e < 4; ++e) { al[e] = a; be[e] = bb; } }
                else {
#pragma unroll
                    for (int e = 0; e < 4; ++e) { al[e] = da[k][e]; be[e] = 1.f; } }
                S[0] = al[0] * S[0] + be[0] * bf2f((bf16_t)(ds[k].x & 0xffff)); S[1] = al[1] * S[1] + be[1] * bf2f((bf16_t)(ds[k].x >> 16));
                S[2] = al[2] * S[2] + be[2] * bf2f((bf16_t)(ds[k].y & 0xffff)); S[3] = al[3] * S[3] + be[3] * bf2f((bf16_t)(ds[k].y >> 16)); } }
    } else if (BR == 3 && g < TOTAL + 16 * 128) {
        const int q = g - TOTAL, d = q & 127, chain = q >> 7, dir = chain >> 3; float n = 0.f, m = 0.f;
        for (int ci0 = 0; ci0 < NCHUNK; ci0 += NB) { float be[NB], ml[NB], dn[NB]; size_t o[NB];
#pragma unroll
            for (int k = 0; k < NB; ++k) { const int c = chain_chunk(dir, ci0 + k); be[k] = BE[chain * NCHUNK + c]; ml[k] = MLOC[chain * NCHUNK + c]; o[k] = ((size_t)chain * NCHUNK + c) * 128 + d; dn[k] = DN[o[k]]; }
#pragma unroll
            for (int k = 0; k < NB; ++k) { DN[o[k]] = n; if (d == 0) MIN_[chain * NCHUNK + chain_chunk(dir, ci0 + k)] = m;
                const float mn = fmaxf(be[k] + m, ml[k]); n = __expf(be[k] + m - mn) * n + __expf(ml[k] - mn) * dn[k]; m = mn; } }
    }
}
template <int BR> __device__ __forceinline__ void phase_gl_out(const PP& p, int l, LAS unsigned char* L) {
    constexpr int DK = BR == 1 ? 64 : 128, PQ = DK + 8, NSEG = 512 / DK, NT = 64 / NSEG;
    const int tid = otid(p.swid), lane = tid & 63, wid = p.swid, fr = lane & 15, fq = lane >> 4;
    LAS bf16_t* QP = (LAS bf16_t*)L;
    LAS bf16_t* KP = QP + 2 * 64 * PQ;
    LAS bf16_t* QT = KP + 2 * 64 * PQ;
    LAS bf16_t* VT = QT + 2 * 64 * PQ;
    LAS bf16_t* PS = VT + 128 * 72;
    LAS float* SEG = (LAS float*)(PS + 2 * 64 * 72);
    LAS float* RED = SEG;
    LAS float* LR = SEG + 1024;
    const bf16_t* Z = (const bf16_t*)(p.ws + WS_BIG + BIG_Z); const float* MISC = (const float*)(p.ws + WS_MISC);
    const bf16_t* ST = (const bf16_t*)(p.ws + WS_BIG + BIG_ST); bf16_t* YS = (bf16_t*)(p.ws + WS_BIG + BIG_YS) + (size_t)BR * TT * 512;
    const float* gain = (BR == 1 ? p.in[I_GLANG] : p.in[I_HGNG]) + l * 128;
    constexpr int VOFF = BR == 1 ? GV : HI, QOFF = BR == 1 ? GQ : HQ, GOFF = BR == 1 ? GG : HGT;
    const int d = tid % DK, sg = tid / DK;
    bf16_t rq[NT], rk[2][NT], rv[16]; float rlr[4];
    auto fetch = [&](int u2, bf16_t (&q_)[NT], bf16_t (&k_)[2][NT], bf16_t (&v_)[16], float (&lr_)[4]) {
        const int c2 = u2 % NCHUNK, bh2 = u2 / NCHUNK, h2 = bh2 & 3, b2 = bh2 >> 2; const size_t rr0 = (size_t)b2 * NTOK + c2 * 64;
#pragma unroll
        for (int n = 0; n < NT; ++n) { const bf16_t* zr = Z + (rr0 + sg * NT + n) * ZLD; q_[n] = zr[QOFF + h2 * DK + d];
            if (BR == 1) { k_[0][n] = zr[GK + h2 * 64 + d]; k_[1][n] = k_[0][n]; } else { k_[0][n] = zr[HF + h2 * 128 + d]; k_[1][n] = zr[HF + 512 + h2 * 128 + d]; } }
#pragma unroll
        for (int gi = 0; gi < 2; ++gi)
#pragma unroll
            for (int e = 0; e < 8; ++e) v_[gi * 8 + e] = Z[(rr0 + ((tid >> 7) + 4 * gi) * 8 + e) * ZLD + VOFF + h2 * 128 + (tid & 127)];
        if (BR == 1) {
#pragma unroll
            for (int i = 0; i < 4; ++i) { const int ix = tid + 512 * i; lr_[i] = MISC[(rr0 + (ix >> 5)) * 64 + MISC_LR + (ix & 31)]; } }
    };
    if ((int)blockIdx.x < 8 * NCHUNK) fetch(blockIdx.x, rq, rk, rv, rlr);
    for (int u = blockIdx.x; u < 8 * NCHUNK; u += gridDim.x) {
        const int c = u % NCHUNK, bh = u / NCHUNK, h = bh & 3, b = bh >> 2; const size_t r0 = (size_t)b * NTOK + c * 64;
        if (BR == 1) {
#pragma unroll
            for (int i = 0; i < 4; ++i) LR[tid + 512 * i] = rlr[i]; }
        uint2 gtv[4];
#pragma unroll
        for (int it = 0; it < 4; ++it) gtv[it] = *(const uint2*)(Z + (r0 + 16 * it + fr) * ZLD + GOFF + h * 128 + 16 * wid + 4 * fq);
        { const int v = tid & 127;
#pragma unroll
          for (int gi = 0; gi < 2; ++gi) { const int grp = (tid >> 7) + 4 * gi;
            *(LAS u32x4*)(VT + v * 72 + grp * 8) = (u32x4){rv[gi * 8] | ((unsigned)rv[gi * 8 + 1] << 16), rv[gi * 8 + 2] | ((unsigned)rv[gi * 8 + 3] << 16), rv[gi * 8 + 4] | ((unsigned)rv[gi * 8 + 5] << 16), rv[gi * 8 + 6] | ((unsigned)rv[gi * 8 + 7] << 16)}; } }
        float qv[NT];
#pragma unroll
        for (int n = 0; n < NT; ++n) { const float qraw = bf2f(rq[n]); qv[n] = BR == 1 ? qraw * 0.125f : siluf(qraw) * 0.08838834764831845f; }
        if (BR == 1) __syncthreads();
        float cs[2][NT], kk[2][NT];
#pragma unroll
        for (int dir = 0; dir < 2; ++dir) { GlChan<BR> G; G.init(p, l, dir, h, d); float run = 0.f;
#pragma unroll
            for (int q = 0; q < NT; ++q) { const int n = dir ? NT - 1 - q : q, t = sg * NT + n; float g; G.gk_raw(rk[dir][n], LR + t * 32 + dir * 16, g, kk[dir][n]); run += g; cs[dir][n] = run; }
            SEG[(dir * NSEG + sg) * DK + d] = run; }
        __syncthreads();
#pragma unroll
        for (int dir = 0; dir < 2; ++dir) { float before = 0.f, beta = 0.f;
#pragma unroll
            for (int s2 = 0; s2 < NSEG; ++s2) { const float x = SEG[(dir * NSEG + s2) * DK + d]; const int rank = dir ? NSEG - 1 - s2 : s2; const int myrank = dir ? NSEG - 1 - sg : sg;
                before += rank < myrank ? x : 0.f; beta += rank < NSEG / 2 ? x : 0.f; }
            const float ebeta = __expf(beta);
#pragma unroll
            for (int n = 0; n < NT; ++n) { const int t = sg * NT + n; const float e1 = __expf(before + cs[dir][n] - beta), qe = qv[n] * e1;
                QP[(dir * 64 + t) * PQ + d] = f2bf(qe); QT[(dir * 64 + t) * PQ + d] = f2bf(qe * ebeta); KP[(dir * 64 + t) * PQ + d] = f2bf(kk[dir][n] * frcp(e1)); } }
        if (u + (int)gridDim.x < 8 * NCHUNK) fetch(u + gridDim.x, rq, rk, rv, rlr);
        bf16x8 xs[2][DK / 32];
#pragma unroll
        for (int dir = 0; dir < 2; ++dir) { const bf16_t* sp = ST + (((size_t)((dir * 2 + b) * 4 + h) * NCHUNK + c) * 128 + 16 * wid + fr) * DK + 8 * fq;
#pragma unroll
            for (int kq = 0; kq < DK / 32; ++kq) xs[dir][kq] = *(const bf16x8*)(sp + 32 * kq); }
        __syncthreads();
        {
            const int dir = wid >> 2, it = wid & 3;
#pragma unroll
            for (int jt = 0; jt < 4; ++jt) {
                f32x4 sa = (f32x4){0.f, 0.f, 0.f, 0.f};
#pragma unroll
                for (int kq = 0; kq < DK / 32; ++kq) sa = mfma16(*(const LAS bf16x8*)(KP + (dir * 64 + 16 * jt + fr) * PQ + 8 * fq + 32 * kq), *(const LAS bf16x8*)(QP + (dir * 64 + 16 * it + fr) * PQ + 8 * fq + 32 * kq), sa);
                settle(sa);
#pragma unroll
                for (int jj = 0; jj < 4; ++jj) { const int jg = 16 * jt + 4 * fq + jj, ig = 16 * it + fr; const bool keep = dir == 0 ? (jg <= ig) : (jg >= ig); sa[jj] = keep ? sa[jj] : 0.f; }
                *(LAS u32x2*)(PS + (dir * 64 + 16 * it + fr) * 72 + 16 * jt + 4 * fq) = (u32x2){pack2(sa[0], sa[1]), pack2(sa[2], sa[3])}; }
        }
        __syncthreads();
        f32x4 acc[4];
        {
#pragma unroll
            for (int it = 0; it < 4; ++it) acc[it] = (f32x4){0.f, 0.f, 0.f, 0.f};
            const bf16x8 xv0 = *(const LAS bf16x8*)(VT + (16 * wid + fr) * 72 + 8 * fq), xv1 = *(const LAS bf16x8*)(VT + (16 * wid + fr) * 72 + 8 * fq + 32);
#pragma unroll
            for (int dir = 0; dir < 2; ++dir)
#pragma unroll
                for (int it = 0; it < 4; ++it) {
                    acc[it] = mfma16(xv0, *(const LAS bf16x8*)(PS + (dir * 64 + 16 * it + fr) * 72 + 8 * fq), acc[it]);
                    acc[it] = mfma16(xv1, *(const LAS bf16x8*)(PS + (dir * 64 + 16 * it + fr) * 72 + 8 * fq + 32), acc[it]);
#pragma unroll
                    for (int kq = 0; kq < DK / 32; ++kq) acc[it] = mfma16(xs[dir][kq], *(const LAS bf16x8*)(QT + (dir * 64 + 16 * it + fr) * PQ + 8 * fq + 32 * kq), acc[it]); }
            settle(acc[0], acc[1], acc[2], acc[3]);
        }
#pragma unroll
        for (int it = 0; it < 4; ++it) { float ss = acc[it][0] * acc[it][0] + acc[it][1] * acc[it][1] + acc[it][2] * acc[it][2] + acc[it][3] * acc[it][3];
            ss += __shfl_xor(ss, 16); ss += __shfl_xor(ss, 32); if (fq == 0) RED[wid * 64 + 16 * it + fr] = ss; }
        __syncthreads();
        const f32x4 gn = *(const f32x4*)(gain + 16 * wid + 4 * fq);
#pragma unroll
        for (int it = 0; it < 4; ++it) { float tot = 0.f;
#pragma unroll
            for (int w2 = 0; w2 < 8; ++w2) tot += RED[w2 * 64 + 16 * it + fr];
            const float rs = rsqrtf(tot * (1.f / 128.f) + EPS); const size_t row = r0 + 16 * it + fr;
            const uint2 gt = gtv[it];
            const float y0 = acc[it][0] * rs * gn[0] * siluf(bf2f((bf16_t)(gt.x & 0xffff))), y1 = acc[it][1] * rs * gn[1] * siluf(bf2f((bf16_t)(gt.x >> 16)));
            const float y2 = acc[it][2] * rs * gn[2] * siluf(bf2f((bf16_t)(gt.y & 0xffff))), y3 = acc[it][3] * rs * gn[3] * siluf(bf2f((bf16_t)(gt.y >> 16)));
            *(uint2*)(YS + row * 512 + h * 128 + 16 * wid + 4 * fq) = make_uint2(pack2(y0, y1), pack2(y2, y3)); }
        __syncthreads();
    }
}

__device__ __forceinline__ float wave_incl_scan_add(float x, int lane) {
#pragma unroll
    for (int o = 1; o < 64; o <<= 1) { const float y = __shfl_up(x, o); x = lane >= o ? x + y : x; }
    return x;
}
__device__ __forceinline__ float wave_incl_scan_max(float x, int lane) {
#pragma unroll
    for (int o = 1; o < 64; o <<= 1) { const float y = __shfl_up(x, o); x = lane >= o ? fmaxf(x, y) : x; }
    return x;
}
__device__ __forceinline__ float wave_max(float v) {
#pragma unroll
    for (int o = 32; o > 0; o >>= 1) v = fmaxf(v, __shfl_xor(v, o));
    return v;
}
__device__ __forceinline__ void phase_ml_local(const PP& p, int l, LAS unsigned char* L) {
    const int tid = otid(p.swid), lane = tid & 63, wid = p.swid, fr = lane & 15, fq = lane >> 4;
    LAS bf16_t* KT = (LAS bf16_t*)L;
    LAS bf16_t* VT = KT + 2 * 128 * 72;
    LAS float* WE = (LAS float*)(VT + 128 * 72);
    LAS float* DNP = WE + 128;
    const bf16_t* Z = (const bf16_t*)(p.ws + WS_BIG + BIG_Z); const float* MISC = (const float*)(p.ws + WS_MISC);
    bf16_t* ST = (bf16_t*)(p.ws + WS_BIG + BIG_ST);
    float* BE = (float*)(p.ws + WS_SMALL + SM_MLBE); float* MLOC = (float*)(p.ws + WS_SMALL + SM_MLML); float* DN = (float*)(p.ws + WS_SMALL + SM_MLDN);
    for (int u = blockIdx.x; u < 8 * NCHUNK; u += gridDim.x) {
        const int c = u % NCHUNK, bh = u / NCHUNK, h = bh & 3, b = bh >> 2, p0 = c * 64; const size_t rb = (size_t)b * NTOK, r0 = rb + p0;
        const int lo = p0 < CTXL ? 0 : CTXL, hi = p0 < CTXL ? CTXL : NTOK;
        const int d = tid & 127, sg = tid >> 7, ch = h * 128 + d;
        float kv[16];
        {
            float cw[4];
#pragma unroll
            for (int q = 0; q < 4; ++q) cw[q] = p.in[I_MLCW][(l * 4 + q) * 1024 + 512 + ch];
            const float cb = p.in[I_MLCB][l * 1024 + 512 + ch];
            float win[19];
#pragma unroll
            for (int k = 0; k < 19; ++k) { const int q = p0 + sg * 16 - 2 + k, qc = q < lo ? lo : (q >= hi ? hi - 1 : q); const float zv = bf2f(Z[(rb + qc) * ZLD + MK + ch]); win[k] = (q >= lo && q < hi) ? zv : 0.f; }
#pragma unroll
            for (int n = 0; n < 16; ++n) kv[n] = siluf(cb + cw[0] * win[n] + cw[1] * win[n + 1] + cw[2] * win[n + 2] + cw[3] * win[n + 3]);
        }
        { const int v = tid & 127;
#pragma unroll
          for (int gi = 0; gi < 2; ++gi) { const int grp = (tid >> 7) + 4 * gi; unsigned short x[8];
#pragma unroll
            for (int e = 0; e < 8; ++e) x[e] = Z[(r0 + grp * 8 + e) * ZLD + MV + h * 128 + v];
            *(LAS u32x4*)(VT + v * 72 + grp * 8) = (u32x4){x[0] | ((unsigned)x[1] << 16), x[2] | ((unsigned)x[3] << 16), x[4] | ((unsigned)x[5] << 16), x[6] | ((unsigned)x[7] << 16)}; } }
        if (wid < 2) {
            const int dir = wid, t = dir == 0 ? lane : 63 - lane; const size_t r = r0 + t; const int chain = (dir * 2 + b) * 4 + h;
            const float ii = MISC[r * 64 + MISC_IF + dir * 8 + h] + p.in[I_MLGB][(l * 2 + dir) * 8 + h];
            const float lf = logsig(MISC[r * 64 + MISC_IF + dir * 8 + 4 + h] + p.in[I_MLGB][(l * 2 + dir) * 8 + 4 + h]);
            const float bc = wave_incl_scan_add(lf, lane), bend = __shfl(bc, 63), mloc = bend + wave_max(ii - bc);
            WE[dir * 64 + t] = __expf(bend - bc + ii - mloc);
            if (lane == 0) { BE[chain * NCHUNK + c] = bend; MLOC[chain * NCHUNK + c] = mloc; }
        }
        __syncthreads();
#pragma unroll
        for (int dir = 0; dir < 2; ++dir) { float val[16], dn = 0.f;
#pragma unroll
            for (int n = 0; n < 16; ++n) { val[n] = kv[n] * WE[dir * 64 + sg * 16 + n]; dn += val[n]; }
            *(LAS u32x4*)(KT + (dir * 128 + krow(d)) * 72 + sg * 16) = (u32x4){pack2(val[0], val[1]), pack2(val[2], val[3]), pack2(val[4], val[5]), pack2(val[6], val[7])};
            *(LAS u32x4*)(KT + (dir * 128 + krow(d)) * 72 + sg * 16 + 8) = (u32x4){pack2(val[8], val[9]), pack2(val[10], val[11]), pack2(val[12], val[13]), pack2(val[14], val[15])};
            DNP[(sg * 2 + dir) * 128 + d] = dn; }
        __syncthreads();
        if (tid < 256) { const int dir = tid >> 7; DN[((size_t)((dir * 2 + b) * 4 + h) * NCHUNK + c) * 128 + d] = DNP[(0 * 2 + dir) * 128 + d] + DNP[(1 * 2 + dir) * 128 + d] + DNP[(2 * 2 + dir) * 128 + d] + DNP[(3 * 2 + dir) * 128 + d]; }
        { const int dir = wid >> 2, A = wid & 3; const size_t sbase = ((size_t)((dir * 2 + b) * 4 + h) * NCHUNK + c) * 128 * 128;
            bf16x8 x[2][2];
#pragma unroll
            for (int n = 0; n < 2; ++n) { x[n][0] = *(const LAS bf16x8*)(KT + (dir * 128 + 16 * (2 * A + n) + fr) * 72 + 8 * fq); x[n][1] = *(const LAS bf16x8*)(KT + (dir * 128 + 16 * (2 * A + n) + fr) * 72 + 8 * fq + 32); }
#pragma unroll
            for (int vt = 0; vt < 8; ++vt) { const bf16x8 y0 = *(const LAS bf16x8*)(VT + (16 * vt + fr) * 72 + 8 * fq), y1 = *(const LAS bf16x8*)(VT + (16 * vt + fr) * 72 + 8 * fq + 32);
                f32x4 a0 = (f32x4){0.f, 0.f, 0.f, 0.f}, a1 = (f32x4){0.f, 0.f, 0.f, 0.f};
                a0 = mfma16(x[0][0], y0, a0); a0 = mfma16(x[0][1], y1, a0); a1 = mfma16(x[1][0], y0, a1); a1 = mfma16(x[1][1], y1, a1); settle(a0, a1);
                *(uint4*)(ST + sbase + (size_t)(16 * vt + fr) * 128 + 32 * A + 8 * fq) = make_uint4(pack2(a0[0], a0[1]), pack2(a0[2], a0[3]), pack2(a1[0], a1[1]), pack2(a1[2], a1[3])); } }
        __syncthreads();
    }
}
__device__ __forceinline__ void phase_ml_out(const PP& p, int l, LAS unsigned char* L) {
    constexpr int PQ = 136;
    const int tid = otid(p.swid), lane = tid & 63, wid = p.swid, fr = lane & 15, fq = lane >> 4;
    LAS bf16_t* QL = (LAS bf16_t*)L;
    LAS bf16_t* KL = QL + 64 * PQ;
    LAS bf16_t* VT = KL + 64 * PQ;
    LAS bf16_t* PS = VT + 128 * 72;
    LAS float* SC = (LAS float*)(PS + 2 * 64 * 72);
    LAS float* NV = SC + 2 * 576;
    LAS float* RED = NV + 256;
    const bf16_t* Z = (const bf16_t*)(p.ws + WS_BIG + BIG_Z); const float* MISC = (const float*)(p.ws + WS_MISC);
    const bf16_t* ST = (const bf16_t*)(p.ws + WS_BIG + BIG_ST); bf16_t* YS = (bf16_t*)(p.ws + WS_BIG + BIG_YS) + (size_t)3 * TT * 512;
    const float* MIN_ = (const float*)(p.ws + WS_SMALL + SM_MLMIN); const float* DN = (const float*)(p.ws + WS_SMALL + SM_MLDN);
    const float* gain = p.in[I_MLNG] + l * 128;
    for (int u = blockIdx.x; u < 8 * NCHUNK; u += gridDim.x) {
        const int c = u % NCHUNK, bh = u / NCHUNK, h = bh & 3, b = bh >> 2, p0 = c * 64; const size_t rb = (size_t)b * NTOK, r0 = rb + p0;
        const int lo = p0 < CTXL ? 0 : CTXL, hi = p0 < CTXL ? CTXL : NTOK;
        const int d = tid & 127, sg = tid >> 7, ch = h * 128 + d;
        uint2 gtv[4];
#pragma unroll
        for (int it = 0; it < 4; ++it) gtv[it] = *(const uint2*)(Z + (r0 + 16 * it + fr) * ZLD + MO + h * 128 + 16 * wid + 4 * fq);
#pragma unroll
        for (int which = 0; which < 2; ++which) {
            const int zc = (which ? MK : MQ) + ch;
            float cw[4];
#pragma unroll
            for (int q = 0; q < 4; ++q) cw[q] = p.in[I_MLCW][(l * 4 + q) * 1024 + which * 512 + ch];
            const float cb = p.in[I_MLCB][l * 1024 + which * 512 + ch], scl = which ? 1.f : 0.08838834764831845f;
            float win[19];
#pragma unroll
            for (int k = 0; k < 19; ++k) { const int q = p0 + sg * 16 - 2 + k, qc = q < lo ? lo : (q >= hi ? hi - 1 : q); const float zv = bf2f(Z[(rb + qc) * ZLD + zc]); win[k] = (q >= lo && q < hi) ? zv : 0.f; }
            LAS bf16_t* dst = (which ? KL : QL) + (sg * 16) * PQ + d;
#pragma unroll
            for (int n = 0; n < 16; ++n) dst[n * PQ] = f2bf(siluf(cb + cw[0] * win[n] + cw[1] * win[n + 1] + cw[2] * win[n + 2] + cw[3] * win[n + 3]) * scl);
        }
        { const int v = tid & 127;
#pragma unroll
          for (int gi = 0; gi < 2; ++gi) { const int grp = (tid >> 7) + 4 * gi; unsigned short x[8];
#pragma unroll
            for (int e = 0; e < 8; ++e) x[e] = Z[(r0 + grp * 8 + e) * ZLD + MV + h * 128 + v];
            *(LAS u32x4*)(VT + v * 72 + grp * 8) = (u32x4){x[0] | ((unsigned)x[1] << 16), x[2] | ((unsigned)x[3] << 16), x[4] | ((unsigned)x[5] << 16), x[6] | ((unsigned)x[7] << 16)}; } }
        if (tid < 256) NV[tid] = DN[((size_t)(((tid >> 7) * 2 + b) * 4 + h) * NCHUNK + c) * 128 + (tid & 127)];
        if (wid < 2) {
            const int dir = wid, t = dir == 0 ? lane : 63 - lane; const size_t r = r0 + t; const int chain = (dir * 2 + b) * 4 + h;
            const float ii = MISC[r * 64 + MISC_IF + dir * 8 + h] + p.in[I_MLGB][(l * 2 + dir) * 8 + h];
            const float lf = logsig(MISC[r * 64 + MISC_IF + dir * 8 + 4 + h] + p.in[I_MLGB][(l * 2 + dir) * 8 + 4 + h]);
            const float bc = wave_incl_scan_add(lf, lane), a = ii - bc, arun = wave_incl_scan_max(a, lane), mprev = MIN_[chain * NCHUNK + c];
            const float m = bc + fmaxf(mprev, arun);
            LAS float* S = SC + dir * 576;
            S[t] = bc - m; S[64 + t] = a; S[128 + t] = __expf(bc + mprev - m); S[192 + t] = __expf(-m);
        }
        __syncthreads();
        bf16x8 xs[2][4];
#pragma unroll
        for (int dir = 0; dir < 2; ++dir) { const bf16_t* sp = ST + (((size_t)((dir * 2 + b) * 4 + h) * NCHUNK + c) * 128 + 16 * wid + fr) * 128 + 8 * fq;
#pragma unroll
            for (int kk = 0; kk < 4; ++kk) xs[dir][kk] = *(const bf16x8*)(sp + 32 * kk); }
        {
            const int dir = tid >> 8, i = (tid >> 2) & 63, part = tid & 3; float sacc = 0.f;
#pragma unroll 8
            for (int d = part * 32; d < part * 32 + 32; ++d) sacc += bf2f(QL[i * PQ + d]) * NV[dir * 128 + d];
            sacc += __shfl_xor(sacc, 1); sacc += __shfl_xor(sacc, 2);
            if (part == 0) SC[dir * 576 + 256 + i] = sacc;
        }
        {
            const int it = wid & 3;
#pragma unroll
            for (int jh = 0; jh < 2; ++jh) { const int jt = (wid >> 2) * 2 + jh;
                f32x4 acc = (f32x4){0.f, 0.f, 0.f, 0.f};
#pragma unroll
                for (int kk = 0; kk < 4; ++kk) acc = mfma16(*(const LAS bf16x8*)(KL + (16 * jt + fr) * PQ + 8 * fq + 32 * kk), *(const LAS bf16x8*)(QL + (16 * it + fr) * PQ + 8 * fq + 32 * kk), acc);
                settle(acc);
                const int ig = 16 * it + fr;
#pragma unroll
                for (int dir = 0; dir < 2; ++dir) { const LAS float* S = SC + dir * 576; const float ui = S[ig]; float sv[4];
#pragma unroll
                    for (int jj = 0; jj < 4; ++jj) { const int jg = 16 * jt + 4 * fq + jj; const bool keep = dir == 0 ? (jg <= ig) : (jg >= ig);
                        const float wgt = __expf(fminf(ui + S[64 + jg], 0.f)); sv[jj] = keep ? acc[jj] * wgt : 0.f; }
                    *(LAS u32x2*)(PS + (dir * 64 + ig) * 72 + 16 * jt + 4 * fq) = (u32x2){pack2(sv[0], sv[1]), pack2(sv[2], sv[3])};
                    float rsum = sv[0] + sv[1] + sv[2] + sv[3]; rsum += __shfl_xor(rsum, 16); rsum += __shfl_xor(rsum, 32);
                    if (fq == 0) SC[dir * 576 + 320 + jt * 64 + ig] = rsum; } }
        }
        __syncthreads();
        {
            f32x4 o[4];
#pragma unroll
            for (int it = 0; it < 4; ++it) o[it] = (f32x4){0.f, 0.f, 0.f, 0.f};
            const bf16x8 xv0 = *(const LAS bf16x8*)(VT + (16 * wid + fr) * 72 + 8 * fq), xv1 = *(const LAS bf16x8*)(VT + (16 * wid + fr) * 72 + 8 * fq + 32);
#pragma unroll
            for (int dir = 0; dir < 2; ++dir) {
                const LAS float* S = SC + dir * 576;
#pragma unroll
                for (int it = 0; it < 4; ++it) { const int ig = 16 * it + fr;
                    f32x4 ap = (f32x4){0.f, 0.f, 0.f, 0.f}, ac = (f32x4){0.f, 0.f, 0.f, 0.f};
                    ap = mfma16(xv0, *(const LAS bf16x8*)(PS + (dir * 64 + ig) * 72 + 8 * fq), ap);
                    ap = mfma16(xv1, *(const LAS bf16x8*)(PS + (dir * 64 + ig) * 72 + 8 * fq + 32), ap);
#pragma unroll
                    for (int kk = 0; kk < 4; ++kk) ac = mfma16(xs[dir][kk], *(const LAS bf16x8*)(QL + ig * PQ + 8 * fq + 32 * kk), ac);
                    settle(ap, ac);
                    const float wi = S[128 + ig], den = S[320 + ig] + S[384 + ig] + S[448 + ig] + S[512 + ig] + wi * S[256 + ig];
                    const float inv = frcp(fmaxf(fabsf(den), S[192 + ig]));
#pragma unroll
                    for (int jj = 0; jj < 4; ++jj) o[it][jj] += (ap[jj] + wi * ac[jj]) * inv; } }
#pragma unroll
            for (int it = 0; it < 4; ++it) { float ss = o[it][0] * o[it][0] + o[it][1] * o[it][1] + o[it][2] * o[it][2] + o[it][3] * o[it][3];
                ss += __shfl_xor(ss, 16); ss += __shfl_xor(ss, 32); if (fq == 0) RED[wid * 64 + 16 * it + fr] = ss; }
            __syncthreads();
            const f32x4 gn = *(const f32x4*)(gain + 16 * wid + 4 * fq);
#pragma unroll
            for (int it = 0; it < 4; ++it) { float tot = 0.f;
#pragma unroll
                for (int w2 = 0; w2 < 8; ++w2) tot += RED[w2 * 64 + 16 * it + fr];
                const float rs = rsqrtf(tot * (1.f / 128.f) + EPS); const size_t row = r0 + 16 * it + fr;
                const uint2 gt = gtv[it];
                const float y0 = o[it][0] * rs * gn[0] * sigm(bf2f((bf16_t)(gt.x & 0xffff))), y1 = o[it][1] * rs * gn[1] * sigm(bf2f((bf16_t)(gt.x >> 16)));
                const float y2 = o[it][2] * rs * gn[2] * sigm(bf2f((bf16_t)(gt.y & 0xffff))), y3 = o[it][3] * rs * gn[3] * sigm(bf2f((bf16_t)(gt.y >> 16)));
                *(uint2*)(YS + row * 512 + h * 128 + 16 * wid + 4 * fq) = make_uint2(pack2(y0, y1), pack2(y2, y3)); }
        }
        __syncthreads();
    }
}

#define GLA_LOCAL(p, l) phase_gl_local<1>(p, l, L)
#define GLA_CARRY(p, l) phase_gl_carry<1>(p)
#define GLA_OUT(p, l) phase_gl_out<1>(p, l, L)
#define HG_LOCAL(p, l) phase_gl_local<2>(p, l, L)
#define HG_CARRY(p, l) phase_gl_carry<2>(p)
#define HG_OUT(p, l) phase_gl_out<2>(p, l, L)
#define ML_LOCAL(p, l) phase_ml_local(p, l, L)
#define ML_CARRY(p, l) phase_gl_carry<3>(p)
#define ML_OUT(p, l) phase_ml_out(p, l, L)
constexpr int LDS_BYTES = 147456, NPH_LAYER = 22, NPH = 1 + 2 * NPH_LAYER;
__global__ void __launch_bounds__(512, 2) mega(P p_unused) {
    extern __shared__ __attribute__((aligned(16))) unsigned char lds[];
    LAS unsigned char* L = (LAS unsigned char*)lds;
    LAS int* tbl = (LAS int*)(L + 131072 + 1024);
    const int swid = __builtin_amdgcn_readfirstlane((int)(threadIdx.x >> 6));
    int lo, hi; unsigned* barw;
    { const PP p = load_args(swid); lo = p.ph_lo; hi = p.ph_hi; barw = (unsigned*)(p.ws + WS_CTL); }
    { const int t0 = (int)threadIdx.x; if (t0 < 4) ((LAS unsigned*)(L + LDS_BYTES - 16))[t0] = 0u; }
    __syncthreads();
    XcdBarrier bar; bar.bar = barw; bar.x = 0; bar.st = nullptr; bar.swid = swid;
    if (hi - lo > 1) bar = xcd_barrier_post(barw, (volatile LAS unsigned*)(L + LDS_BYTES - 16), swid);
#ifndef PHSEL
#define PHSEL(k) 1
#endif
#define IN(k) (PHSEL(k) && lo <= (k) && (k) < hi)
#define SEAM(k) do { if (IN((k) + 1)) xcd_barrier(bar); } while (0)
#define PHASE(k, ...) if (IN(k)) { const PP p = load_args(swid); unsigned char* ws = p.ws; unsigned char* wb = ws + WS_WB; unsigned char* big = ws + WS_BIG; (void)wb; (void)big; __VA_ARGS__ SEAM(k); }
    PHASE(0, phase_mods(p, (LAS float*)L); phase_convert(p, 0, (LAS float*)L, 0, 9824, 0);)
#define LAYER_BODY(l) { constexpr int pb = 1 + NPH_LAYER * (l); \
    if ((l) == 1) { PHASE(pb + 0, phase_convert(p, 1, (LAS float*)L, 0, 9824, 0);) } \
    if ((l) == 0) { PHASE(pb + 1, phase_norm1(p, l);) } \
    PHASE(pb + 2, Gemm g{(const bf16_t*)(ws + WS_U), (const bf16_t*)(wb + WB_WIN), DM, DM, p.swid}; OrderPlain S; S.init(MT, 11, gridDim.x, blockIdx.x); S.skipctx = 0; \
        EpiZ E{(bf16_t*)(big + BIG_Z), (float*)(ws + WS_MISC), 10}; GEMM_RUN(EpiZ, OrderPlain, g, S, E);) \
    PHASE(pb + 3, phase_rg<false>(p, l, L); GLA_LOCAL(p, l);) \
    PHASE(pb + 4, phase_rg_carry(p); GLA_CARRY(p, l);) \
    PHASE(pb + 5, phase_rg<true>(p, l, L); GLA_OUT(p, l);) \
    PHASE(pb + 6, Gemm g{(const bf16_t*)(ws + WS_U), (const bf16_t*)(wb + WB_WIN) + (size_t)2816 * DM, DM, DM, p.swid}; OrderPlain S; S.init(MT, 10, gridDim.x, blockIdx.x); S.skipctx = 0; \
        EpiZ E{(bf16_t*)(big + BIG_Z), (float*)(ws + WS_MISC), -1}; GEMM_RUN(EpiZ, OrderPlain, g, S, E);) \
    PHASE(pb + 7, HG_LOCAL(p, l);) \
    PHASE(pb + 8, HG_CARRY(p, l);) \
    PHASE(pb + 9, HG_OUT(p, l);) \
    PHASE(pb + 10, Gemm g{(const bf16_t*)(ws + WS_U), (const bf16_t*)(wb + WB_WIN) + (size_t)5376 * DM, DM, DM, p.swid}; OrderPlain S; S.init(MT, 8, gridDim.x, blockIdx.x); S.skipctx = 0; \
        EpiZ E{(bf16_t*)(big + BIG_Z), (float*)(ws + WS_MISC), -1}; GEMM_RUN(EpiZ, OrderPlain, g, S, E);) \
    PHASE(pb + 11, ML_LOCAL(p, l);) \
    PHASE(pb + 12, ML_CARRY(p, l);) \
    PHASE(pb + 13, ML_OUT(p, l);) \
    PHASE(pb + 14, Gemm g{(const bf16_t*)(big + BIG_YS), (const bf16_t*)(wb + WB_WB), 512, 512, p.swid}; OrderBranch S; S.init((l) ? 64 : MT, 16, gridDim.x, blockIdx.x); S.skipctx = (l); \
        EpiBO E{(bf16_t*)(big + BIG_BO)}; GEMM_RUN(EpiBO, OrderBranch, g, S, E);) \
    PHASE(pb + 15, Gemm g{(const bf16_t*)(ws + WS_U), (const bf16_t*)(wb + WB_WM), DM, DM, p.swid}; OrderPlain S; S.init((l) ? 64 : MT, 16, gridDim.x, blockIdx.x); S.skipctx = (l); \
        EpiMerge E{(const bf16_t*)(big + BIG_BO), p.in[I_BMERGE] + (size_t)(l) * 4096, (bf16_t*)(big + BIG_MERGED)}; GEMM_RUN(EpiMerge, OrderPlain, g, S, E);) \
    PHASE(pb + 16, Gemm g{(const bf16_t*)(big + BIG_MERGED), (const bf16_t*)(wb + WB_WO), DM, DM, p.swid}; OrderPlain S; S.init((l) ? 64 : MT, 4, gridDim.x, blockIdx.x); S.skipctx = (l); \
        EpiOut E{(l) == 0 ? p.in[I_X] : p.out, (l) == 0 ? p.in[I_CTX] : (const float*)(ws + WS_HCTX), p.out, (float*)(ws + WS_HCTX), (const float*)(ws + WS_MOD) + (size_t)(l) * 3 * 6144}; \
        GEMM_RUN(EpiOut, OrderPlain, g, S, E);) \
    PHASE(pb + 17, phase_route(p, l, L);) \
    PHASE(pb + 18, phase_dispatch(p, l, tbl);) \
    PHASE(pb + 19, const int nblk = moe_tables(p, l, tbl); Gemm g{(const bf16_t*)(big + BIG_XS), (const bf16_t*)(wb + WB_W13), DM, DM, p.swid}; OrderMoe S; S.init(nblk, 4, gridDim.x, blockIdx.x); S.blk_e = tbl + 32; \
        EpiH E{(bf16_t*)(big + BIG_HS)}; GEMM_RUN(EpiH, OrderMoe, g, S, E);) \
    PHASE(pb + 20, const int nblk = moe_tables(p, l, tbl); Gemm g{(const bf16_t*)(big + BIG_HS), (const bf16_t*)(wb + WB_W2), 512, 512, p.swid}; OrderMoe S; S.init(nblk, 4, gridDim.x, blockIdx.x); S.blk_e = tbl + 32; \
        EpiY E{(bf16_t*)(big + BIG_YM)}; GEMM_RUN(EpiY, OrderMoe, g, S, E);) \
    PHASE(pb + 21, phase_combine(p, l);) }
    LAYER_BODY(0)
    LAYER_BODY(1)
#undef LAYER_BODY
#undef PHASE
#undef SEAM
#undef IN
}

#ifndef N_LAUNCHES
#define N_LAUNCHES 1
#endif
extern "C" void kernel_launch(void* const* d_in, const int* in_sizes, int n_in, void* d_out, int out_size, void* d_ws, size_t ws_size, hipStream_t stream) {
    static int grid = 0;
    if (grid == 0) {
        if (n_in != N_IN || out_size != NBATCH * SEQL * DM || ws_size < WS_END) { fprintf(stderr, "kernel_launch: unexpected shapes (n_in %d out %d ws %zu need %zu)\n", n_in, out_size, ws_size, (size_t)WS_END); grid = -1; return; }
        int dev = 0, cus = 0, per_cu = 0;
        if (hipGetDevice(&dev) != hipSuccess || hipDeviceGetAttribute(&cus, hipDeviceAttributeMultiprocessorCount, dev) != hipSuccess) { grid = -1; return; }
        if (hipFuncSetAttribute((const void*)mega, hipFuncAttributeMaxDynamicSharedMemorySize, LDS_BYTES) != hipSuccess) { grid = -1; return; }
        if (hipOccupancyMaxActiveBlocksPerMultiprocessor(&per_cu, (const void*)mega, 512, LDS_BYTES) != hipSuccess || per_cu < 1) { fprintf(stderr, "kernel_launch: occupancy query says %d\n", per_cu); }
        (void)hipGetLastError();
        grid = cus;
    }
    if (grid < 0) return;
    (void)hipMemsetAsync((char*)d_ws + WS_CTL, 0, 65536, stream);
    P p{};
    for (int i = 0; i < N_IN; ++i) p.in[i] = (const float*)d_in[i];
    p.out = (float*)d_out; p.ws = (unsigned char*)d_ws;
    if (N_LAUNCHES == 1) { p.ph_lo = 0; p.ph_hi = NPH; hipLaunchKernelGGL(mega, dim3(grid), dim3(512), LDS_BYTES, stream, p); }
    else for (int k = 0; k < NPH; ++k) { p.ph_lo = k; p.ph_hi = k + 1; hipLaunchKernelGGL(mega, dim3(grid), dim3(512), LDS_BYTES, stream, p); }
}
```

```cpp
#include <hip/hip_runtime.h>
#include <cstdio>
#include <cstdint>

#define LAS __attribute__((address_space(3)))
typedef unsigned short bf16_t;
typedef short bf16x8 __attribute__((ext_vector_type(8)));
typedef float f32x4 __attribute__((ext_vector_type(4)));
typedef unsigned u32x4 __attribute__((ext_vector_type(4)));
typedef unsigned u32x2 __attribute__((ext_vector_type(2)));

#define XB_TMO      128
#define XB_XCNT(j)  (256  + 64 * (j))
#define XB_XSUB(j)  (1280 + 64 * (j))
#define XB_XGEN(j)  (2304 + 64 * (j))
#define XB_TOP      3328
#define XB_TOPGEN   3392
#define XCD_BAR_WORDS 3456
#define XB_SPIN_CAP (1u << 18)

__device__ __forceinline__ unsigned xb_ld(unsigned* p)              { return __hip_atomic_load(p, __ATOMIC_RELAXED, __HIP_MEMORY_SCOPE_AGENT); }
__device__ __forceinline__ unsigned xb_add(unsigned* p, unsigned v) { return __hip_atomic_fetch_add(p, v, __ATOMIC_RELAXED, __HIP_MEMORY_SCOPE_AGENT); }
__device__ __forceinline__ unsigned xb_xcc_id() { return (unsigned)__builtin_amdgcn_s_getreg((3 << 11) | 20) & 0xFu; }
#define XB_SPIN(cond, bar) do { unsigned _sp = 0; while (cond) { __builtin_amdgcn_s_sleep(1); \
    if ((++_sp & 255u) == 0u) { if (xb_ld(&(bar)[XB_TMO])) break; if (_sp > XB_SPIN_CAP) { atomicAdd(&(bar)[XB_TMO], 1u); break; } } } } while (0)

struct XcdBarrier {
    unsigned* bar; unsigned x;
    int swid;
    volatile LAS unsigned* st;
};

__device__ __forceinline__ XcdBarrier xcd_barrier_post(unsigned* bar, volatile LAS unsigned* st, int swid) {
    XcdBarrier b; b.bar = bar; b.x = xb_xcc_id(); b.st = st; b.swid = swid;
    if (swid == 0 && __builtin_amdgcn_mbcnt_hi(~0u, __builtin_amdgcn_mbcnt_lo(~0u, 0u)) == 0u) (void)xb_add(&bar[XB_XCNT(b.x)], 1u);
    return b;
}
__device__ __forceinline__ void xcd_barrier_complete(unsigned* bar, unsigned x, unsigned& nloc, unsigned& nx) {
    const unsigned G = gridDim.x * gridDim.y * gridDim.z;
    unsigned sum, cnt, mine, sp = 0u;
    for (;;) {
        sum = 0u; cnt = 0u; mine = 0u;
#pragma unroll
        for (unsigned j = 0; j < 16; ++j) { const unsigned c = xb_ld(&bar[XB_XCNT(j)]); sum += c; cnt += (c > 0u) ? 1u : 0u; mine = (j == x) ? c : mine; }
        if (sum == G) break;
        __builtin_amdgcn_s_sleep(1);
        if ((++sp & 255u) == 0u) { if (xb_ld(&bar[XB_TMO])) break; if (sp > XB_SPIN_CAP) { atomicAdd(&bar[XB_TMO], 1u); break; } }
    }
    nloc = mine > 0u ? mine : 1u; nx = cnt > 0u ? cnt : 1u;
}

__device__ __forceinline__ void xcd_barrier(const XcdBarrier& b) {
    asm volatile("s_waitcnt vmcnt(0)" ::: "memory");
    __syncthreads();
    if (b.swid == 0 && __builtin_amdgcn_mbcnt_hi(~0u, __builtin_amdgcn_mbcnt_lo(~0u, 0u)) == 0u) {
        unsigned* bar = b.bar;
        __builtin_amdgcn_s_waitcnt(0);
        unsigned nloc = b.st[0], nx = b.st[1];
        if (nloc == 0u) { xcd_barrier_complete(bar, b.x, nloc, nx); b.st[0] = nloc; b.st[1] = nx; }
        const unsigned old = xb_add(&bar[XB_XSUB(b.x)], 1u);
        const unsigned gen = old / nloc;
        if (old + 1u == (gen + 1u) * nloc) {
            __builtin_amdgcn_fence(__ATOMIC_RELEASE, "agent");
            asm volatile("s_waitcnt vmcnt(0)" ::: "memory");
            const unsigned og = xb_add(&bar[XB_TOP], 1u);
            const unsigned tg = og / nx;
            if (og + 1u == (tg + 1u) * nx) xb_add(&bar[XB_TOPGEN], 1u);
            else XB_SPIN(xb_ld(&bar[XB_TOPGEN]) == tg, bar);
            __builtin_amdgcn_fence(__ATOMIC_ACQUIRE, "agent");
            xb_add(&bar[XB_XGEN(b.x)], 1u);
            asm volatile("s_waitcnt vmcnt(0)" ::: "memory");
        } else {
            XB_SPIN(xb_ld(&bar[XB_XGEN(b.x)]) == gen, bar);
            __builtin_amdgcn_fence(__ATOMIC_ACQUIRE, "agent");
            asm volatile("s_waitcnt vmcnt(0)" ::: "memory");
        }
    }
    __syncthreads();
}


constexpr int DM = 1024, NBATCH = 2, SEQL = 8192, CTXL = 256, NTOK = 8448, TT = 16896, NCHUNK = 132, MT = 66;
constexpr int ZLD = 3584;
constexpr float EPS = 1e-6f;
constexpr int HQ = 0, HI = 512, HF = 1024, HGT = 2048, RGX = 2560, RGY = 3072;
constexpr int GQ = 0, GK = 256, GV = 512, GG = 1024, MQ = 1536, MK = 2048, MV = 2560, MO = 3072;
constexpr int MISC_LR = 0, MISC_IF = 32;
constexpr int NSLOT_MAX = 37888;

enum { I_X = 0, I_C, I_CTX, I_CCTX, I_ADAW, I_ADAB, I_NMIXG, I_NFFNG, I_WIN, I_RGCW, I_RGCB, I_RGGW, I_RGGB, I_RGLAM, I_GLAWLR, I_GLABLR, I_GLANG,
       I_HGLB, I_HGNG, I_MLCW, I_MLCB, I_MLGB, I_MLNG, I_WBR, I_WMERGE, I_BMERGE, I_WOUT, I_MWG, I_MBG, I_MWE, I_MBE, I_MW1, I_MW3, I_MW2, I_FNG, N_IN };

constexpr size_t WS_CTL = 0;
constexpr size_t WS_MOD = 65536;
constexpr size_t WS_HCTX = 262144;
constexpr size_t WS_ROUTE = WS_HCTX + 2097152;
constexpr size_t WS_MISC = WS_ROUTE + 1048576;
constexpr size_t WS_SMALL = WS_MISC + 4325376;
constexpr size_t WS_WB = WS_SMALL + 8388608;
constexpr size_t WB_WIN = 0, WB_WM = WB_WIN + 15204352, WB_WB = WB_WM + 8388608, WB_WO = WB_WB + 4194304, WB_W13 = WB_WO + 2097152,
                 WB_W2 = WB_W13 + 33554432, WB_GW = WB_W2 + 16777216, WB_END = WB_GW + 262144;
constexpr size_t WS_U = WS_WB + WB_END;
constexpr size_t WS_BIG = WS_U + 34603008;
constexpr size_t BIG_Z = 0, BIG_ST = 121110528, ST_ML_OFF = 34603008, BIG_YS = BIG_ST + ST_ML_OFF + 69206016 + 65536, BIG_END = BIG_YS + 69206016;
constexpr size_t WS_WB2 = WS_BIG + BIG_END;
constexpr size_t WS_END = WS_WB2;
constexpr size_t BIG_BO = 0;
constexpr size_t BIG_MERGED = BIG_YS;
constexpr size_t BIG_XS = 0;
constexpr size_t BIG_HS = 77594624;
constexpr size_t BIG_YM = BIG_HS + 38797312;
static_assert(BIG_YM + 77594624 <= BIG_END, "moe alias");
static_assert(138412032 <= BIG_YS, "BO alias");
constexpr int CW_CNT = 4096;

struct P { const float* in[N_IN]; float* out; unsigned char* ws; int ph_lo, ph_hi; };
struct PP : P { int swid; };

__device__ __forceinline__ float bf2f(bf16_t b) { return __uint_as_float(((unsigned)b) << 16); }
typedef float f32x2_t __attribute__((ext_vector_type(2)));
typedef __bf16 bf16x2_t __attribute__((ext_vector_type(2)));
__device__ __forceinline__ unsigned pack2(float lo, float hi) { const f32x2_t v = {lo, hi}; const bf16x2_t b = __builtin_convertvector(v, bf16x2_t); return __builtin_bit_cast(unsigned, b); }
__device__ __forceinline__ bf16_t f2bf(float f) { return (bf16_t)(pack2(f, 0.f) & 0xffffu); }
__device__ __forceinline__ float frcp(float x) { return __builtin_amdgcn_rcpf(x); }
__device__ __forceinline__ float sigm(float x) { return frcp(1.f + __expf(-x)); }
__device__ __forceinline__ float siluf(float x) { return x * sigm(x); }
__device__ __forceinline__ float logsig(float x) { return fminf(x, 0.f) - __logf(1.f + __expf(-fabsf(x))); }
__device__ __forceinline__ float softplusf(float x) { return fmaxf(x, 0.f) + __logf(1.f + __expf(-fabsf(x))); }
__device__ __forceinline__ float gelu_tanh(float x) { const float y = 0.7978845608028654f * (x + 0.044715f * x * x * x); const float t = 1.f - 2.f * frcp(__expf(2.f * y) + 1.f); return 0.5f * x * (1.f + t); }
__device__ __forceinline__ float wave_sum(float v) {
#pragma unroll
    for (int o = 32; o > 0; o >>= 1) v += __shfl_xor(v, o);
    return v;
}
__device__ __forceinline__ int lane_id() { return (int)__builtin_amdgcn_mbcnt_hi(~0u, __builtin_amdgcn_mbcnt_lo(~0u, 0u)); }
__device__ __forceinline__ int otid(int swid) { int t = swid * 64 + lane_id(); asm volatile("" : "+v"(t)); return t; }
__device__ __forceinline__ const float* hrow_c(const float* HL, const float* HC, int r) { const int b = r / NTOK, p = r - b * NTOK; return p < CTXL ? HC + ((size_t)b * CTXL + p) * DM : HL + ((size_t)b * SEQL + (p - CTXL)) * DM; }
__device__ __forceinline__ float* hrow_m(float* HL, float* HC, int r) { const int b = r / NTOK, p = r - b * NTOK; return p < CTXL ? HC + ((size_t)b * CTXL + p) * DM : HL + ((size_t)b * SEQL + (p - CTXL)) * DM; }
__device__ __forceinline__ int mod_idx(int r) { const int b = r / NTOK, p = r - b * NTOK; return p < CTXL ? 2 : b; }

typedef const __attribute__((address_space(4))) P* KP;
__device__ __forceinline__ PP load_args(int swid) { unsigned long long a = (unsigned long long)__builtin_amdgcn_kernarg_segment_ptr(); asm volatile("" : "+s"(a)); KP k = (KP)a; PP r; r.swid = swid;
#pragma unroll
    for (int i = 0; i < N_IN; ++i) r.in[i] = k->in[i];
    r.out = k->out; r.ws = k->ws; r.ph_lo = k->ph_lo; r.ph_hi = k->ph_hi; return r; }
struct Unit { int pm, pn; };
struct Gemm { const bf16_t* A; const bf16_t* Bt; int lda; int K; int swid; };

struct TileOrder {
    int nM, nN, G, c;
    __device__ __forceinline__ void a_ready(const Unit&) const {}
    __device__ __forceinline__ void done(const Unit&) const {}
    __device__ void init(int nM_, int nN_, int G_, int c_) { nM = nM_; nN = nN_; G = G_; c = c_; }
    __device__ __forceinline__ bool base(int i, Unit& u) const { const long L = (long)i * G + c; const int nwg = nM * nN; if (L >= (long)nwg) return false;
        int wgid = (int)L; { const int q = nwg / 8, r = nwg % 8, xcd = wgid % 8, off = wgid / 8; wgid = (xcd < r ? xcd * (q + 1) : r * (q + 1) + (xcd - r) * q) + off; }
        const int nig = 8 * nN, gid = wgid / nig, fm = gid * 8, gsz = (nM - fm) < 8 ? (nM - fm) : 8;
        u.pm = fm + ((wgid % nig) % gsz); u.pn = (wgid % nig) / gsz; return true; }
};
struct OrderPlain : TileOrder { int skipctx; __device__ __forceinline__ bool next(int i, Unit& u) const { if (!base(i, u)) return false; if (skipctx) u.pm = u.pm < 32 ? u.pm + 1 : u.pm + 2; return true; } };
struct OrderBranch : TileOrder { int skipctx; __device__ __forceinline__ bool next(int i, Unit& u) const { if (!base(i, u)) return false; int pm = u.pm; if (skipctx) pm = pm < 32 ? pm + 1 : pm + 2; u.pm = (u.pn >> 2) * MT + pm; return true; } };
struct OrderMoe : TileOrder { const LAS int* blk_e; __device__ __forceinline__ bool next(int i, Unit& u) const { if (!base(i, u)) return false; u.pn = blk_e[u.pm] * 4 + u.pn; return true; } };

#define PG8_LAS __attribute__((address_space(3)))
constexpr int BM = 256, BK = 64, HALF = 128, HTB = HALF * BK * 2  , STAGE_BYTES = 8 * HTB;
__host__ __device__ __forceinline__ int lds_byte(int r, int c) { const int st = (r >> 4) * 2 + (c >> 5), rr = r & 15, cc = c & 31, ob = rr * 64 + cc * 2; return st * 1024 + (ob ^ (((ob >> 9) & 1) << 5)); }
__host__ __device__ __forceinline__ void stage_rc(int b, int& R, int& C) { const int st = b / 1024, sb = b % 1024, swz = sb ^ (((sb >> 9) & 1) << 5); R = (st >> 1) * 16 + swz / 64; C = (st & 1) * 32 + (swz % 64) / 2; }
__host__ __device__ __forceinline__ int perm32(int rho) { const int n = rho >> 4, i = rho & 15; return 8 * (i >> 2) + 4 * n + (i & 3); }
template <class Epi, class Sched, bool STAMP = false>
__device__ __forceinline__ void gemm_phase(PG8_LAS unsigned char* lds, const Gemm g, const Sched& S, const Epi& E, unsigned long long* stamps = nullptr) {
    const int tid = otid(g.swid), wid = g.swid, lane = tid & 63, wr = wid >> 2, wc = wid & 3, fr = lane & 15, fq = lane >> 4;
    const int K = g.K, nt = K / BK;
    int ts_lo = 0, ts_hi = 0, nts = 0; const unsigned long long rt_entry = STAMP ? (unsigned long long)wall_clock64() : 0ull;
#define PG8_STAMP() do { if (STAMP && wid == 0 && nts < 64) { const unsigned long long _c = (unsigned long long)clock64(); \
        ts_lo = (lane == nts) ? (int)(unsigned)_c : ts_lo; ts_hi = (lane == nts) ? (int)(unsigned)(_c >> 32) : ts_hi; ++nts; } } while (0)
    PG8_STAMP();
    unsigned voffA[2], voffB[2];
#pragma unroll
    for (int i = 0; i < 2; ++i) { int R, C; stage_rc(tid * 16 + i * 8192, R, C); const int Rb = Epi::PERM ? ((R & ~31) + perm32(R & 31)) : R;
        voffA[i] = (unsigned)(R * K + C) * 2u; voffB[i] = (unsigned)(Rb * K + C) * 2u; }
    const size_t kstep = (size_t)(BK * 2);
    const size_t hstep = (size_t)HALF * K * 2;
    const size_t tstep = 2 * hstep;
    const unsigned ldsw = (unsigned)wid * 1024u;
    const int aoff = lds_byte(wr * 64 + fr, fq * 8), boff = lds_byte(wc * 32 + fr, fq * 8);
#define PG8_SA(b, h) (((b) * 2 + (h)) * HTB)
#define PG8_SB(b, h) ((4 + (b) * 2 + (h)) * HTB)
#define PG8_STAGE(bufoff, gbase, voff) do { _Pragma("unroll") for (int _i = 0; _i < 2; ++_i) \
        __builtin_amdgcn_global_load_lds((const unsigned*)((const char*)(gbase) + (voff)[_i]), (PG8_LAS unsigned*)(lds + (bufoff) + ldsw + _i * 8192), 16, 0, 0); } while (0)
#define PG8_LDA(dst, b, h) do { _Pragma("unroll") for (int m = 0; m < 4; ++m) _Pragma("unroll") for (int k = 0; k < 2; ++k) dst[m][k] = *(const PG8_LAS bf16x8*)(lds + PG8_SA(b, h) + aoff + m * 2048 + k * 1024); } while (0)
#define PG8_LDB(dst, b, h) do { _Pragma("unroll") for (int n = 0; n < 2; ++n) _Pragma("unroll") for (int k = 0; k < 2; ++k) dst[n][k] = *(const PG8_LAS bf16x8*)(lds + PG8_SB(b, h) + boff + n * 2048 + k * 1024); } while (0)
#define PG8_MMA(ai, bj, At, Bt) do { __builtin_amdgcn_s_setprio(1); _Pragma("unroll") for (int m = 0; m < 4; ++m) _Pragma("unroll") for (int n = 0; n < 2; ++n) _Pragma("unroll") for (int k = 0; k < 2; ++k) \
        acc[ai][bj][m][n] = __builtin_amdgcn_mfma_f32_16x16x32_bf16(Bt[n][k], At[m][k], acc[ai][bj][m][n], 0, 0, 0); __builtin_amdgcn_s_setprio(0); } while (0)
#define PG8_WAIT_V(n) asm volatile("s_waitcnt vmcnt(" #n ")" ::: "memory")
#define PG8_WAIT_L(n) asm volatile("s_waitcnt lgkmcnt(" #n ")" ::: "memory")
#define PG8_BAR __builtin_amdgcn_s_barrier()
#define PG8_SCHED __builtin_amdgcn_sched_barrier(0)
    Unit cur, nxt; int ui = 0;
    if (!S.next(0, cur)) return;
    f32x4 acc[2][2][4][2];
#pragma unroll
    for (int a = 0; a < 2; ++a)
#pragma unroll
        for (int b = 0; b < 2; ++b)
#pragma unroll
            for (int m = 0; m < 4; ++m)
#pragma unroll
                for (int n = 0; n < 2; ++n) acc[a][b][m][n] = (f32x4){0.f, 0.f, 0.f, 0.f};
    bf16x8 At[4][2], B0[2][2], B1[2][2];
    const char* cA = (const char*)g.A + (size_t)cur.pm * tstep; const char* cB = (const char*)g.Bt + (size_t)cur.pn * tstep;
    S.a_ready(cur);
    PG8_STAGE(PG8_SB(0, 0), cB, voffB); PG8_STAGE(PG8_SA(0, 0), cA, voffA); PG8_STAGE(PG8_SB(0, 1), cB + hstep, voffB); PG8_STAGE(PG8_SA(0, 1), cA + hstep, voffA);
    if (wr == 1) PG8_BAR;
    PG8_WAIT_V(4); PG8_BAR;
    PG8_STAGE(PG8_SB(1, 0), cB + kstep, voffB); PG8_STAGE(PG8_SA(1, 0), cA + kstep, voffA); PG8_STAGE(PG8_SB(1, 1), cB + hstep + kstep, voffB);
    PG8_WAIT_V(6); PG8_BAR;
    PG8_STAMP();
    for (;;) {
        const bool has_next = S.next(ui + 1, nxt);
        const char* nA = has_next ? (const char*)g.A + (size_t)nxt.pm * tstep : cA; const char* nB = has_next ? (const char*)g.Bt + (size_t)nxt.pn * tstep : cB;
        for (int t = 0; t < nt; t += 2) {
            const bool last = (t == nt - 2);
            const char* a1 = cA + (size_t)(t + 1) * kstep;
            const char* a2 = last ? nA : cA + (size_t)(t + 2) * kstep; const char* b2 = last ? nB : cB + (size_t)(t + 2) * kstep;
            const char* a3 = a2 + kstep; const char* b3 = b2 + kstep;
            if (last && has_next) S.a_ready(nxt);
            PG8_LDB(B0, 0, 0); PG8_SCHED; PG8_LDA(At, 0, 0); PG8_STAGE(PG8_SA(1, 1), a1 + hstep, voffA);
            PG8_WAIT_L(8); PG8_BAR; PG8_WAIT_L(0); PG8_MMA(0, 0, At, B0); PG8_BAR; PG8_SCHED;
            PG8_LDB(B1, 0, 1); PG8_STAGE(PG8_SB(0, 0), b2, voffB);
            PG8_BAR; PG8_WAIT_L(0); PG8_MMA(0, 1, At, B1); PG8_BAR;
            PG8_LDA(At, 0, 1); PG8_STAGE(PG8_SA(0, 0), a2, voffA);
            PG8_BAR; PG8_WAIT_L(0); PG8_MMA(1, 0, At, B0); PG8_BAR; PG8_SCHED;
            PG8_STAGE(PG8_SB(0, 1), b2 + hstep, voffB);
            PG8_WAIT_V(6); PG8_BAR; PG8_MMA(1, 1, At, B1); PG8_BAR;
            PG8_LDB(B0, 1, 0); PG8_SCHED; PG8_LDA(At, 1, 0); PG8_STAGE(PG8_SA(0, 1), a2 + hstep, voffA);
            PG8_WAIT_L(8); PG8_BAR; PG8_WAIT_L(0); PG8_MMA(0, 0, At, B0); PG8_BAR; PG8_SCHED;
            PG8_LDB(B1, 1, 1); PG8_STAGE(PG8_SB(1, 0), b3, voffB);
            PG8_BAR; PG8_WAIT_L(0); PG8_MMA(0, 1, At, B1); PG8_BAR;
            PG8_LDA(At, 1, 1); PG8_STAGE(PG8_SA(1, 0), a3, voffA);
            PG8_BAR; PG8_WAIT_L(0); PG8_MMA(1, 0, At, B0); PG8_BAR; PG8_SCHED;
            PG8_STAGE(PG8_SB(1, 1), b3 + hstep, voffB);
            PG8_WAIT_V(6); PG8_BAR; PG8_MMA(1, 1, At, B1); PG8_BAR;
        }
        PG8_STAMP();
        if constexpr (!Epi::AFTER_DRAIN) { E(acc, cur, wr, wc, fr, fq); S.done(cur); }
        PG8_STAMP();
        if (!has_next) break;
#pragma unroll
        for (int a = 0; a < 2; ++a)
#pragma unroll
            for (int b = 0; b < 2; ++b)
#pragma unroll
                for (int m = 0; m < 4; ++m)
#pragma unroll
                    for (int n = 0; n < 2; ++n) acc[a][b][m][n] = (f32x4){0.f, 0.f, 0.f, 0.f};
        cur = nxt; cA = nA; cB = nB; ++ui;
    }
    PG8_WAIT_V(0);
    if (wr == 0) PG8_BAR;
    PG8_BAR;
    if constexpr (Epi::AFTER_DRAIN) { E.fused(acc, cur, wr, wc, fr, fq, lds, wid, lane); S.done(cur); }
    PG8_STAMP();
    if (STAMP && wid == 0) { stamps[lane] = lane < nts ? (((unsigned long long)(unsigned)ts_hi << 32) | (unsigned)ts_lo) : 0ull;
        if (lane == 62) stamps[62] = rt_entry; if (lane == 63) stamps[63] = (unsigned long long)wall_clock64(); }
#undef PG8_STAMP
#undef PG8_SA
#undef PG8_SB
#undef PG8_STAGE
#undef PG8_LDA
#undef PG8_LDB
#undef PG8_MMA
#undef PG8_WAIT_V
#undef PG8_WAIT_L
#undef PG8_BAR
#undef PG8_SCHED
}

#define GEMM_RUN(EpiT, SchedT, g, S, E) gemm_phase<EpiT, SchedT>(L, g, S, E)


struct EpiZ {
    static constexpr bool PERM = true, AFTER_DRAIN = false;
    bf16_t* Z; float* MISC; int misc_pn;
    __device__ __forceinline__ void operator()(const f32x4 (&acc)[2][2][4][2], const Unit& u, int wr, int wc, int fr, int fq) const {
        const int row0 = u.pm * 256 + wr * 64 + fr, col0 = u.pn * 256 + wc * 32 + 8 * fq;
        if (u.pn == misc_pn) {
            if (wc < 2) {
#pragma unroll
                for (int ai = 0; ai < 2; ++ai)
#pragma unroll
                    for (int m = 0; m < 4; ++m) { const int row = row0 + ai * 128 + m * 16; float* mp = MISC + (size_t)row * 64 + wc * 32 + 8 * fq;
                        *(f32x4*)mp = acc[ai][0][m][0]; *(f32x4*)(mp + 4) = acc[ai][0][m][1]; } }
        } else {
#pragma unroll
            for (int ai = 0; ai < 2; ++ai)
#pragma unroll
                for (int m = 0; m < 4; ++m) { const int row = row0 + ai * 128 + m * 16;
#pragma unroll
                    for (int bj = 0; bj < 2; ++bj) { const f32x4 v0 = acc[ai][bj][m][0], v1 = acc[ai][bj][m][1];
                        *(uint4*)(Z + (size_t)row * ZLD + col0 + bj * 128) = make_uint4(pack2(v0[0], v0[1]), pack2(v0[2], v0[3]), pack2(v1[0], v1[1]), pack2(v1[2], v1[3])); } }
        }
    }
};
struct EpiBO {
    static constexpr bool PERM = true, AFTER_DRAIN = false;
    bf16_t* BO;
    __device__ __forceinline__ void operator()(const f32x4 (&acc)[2][2][4][2], const Unit& u, int wr, int wc, int fr, int fq) const {
        const int kb = u.pn >> 2, pm = u.pm - kb * MT, pn = u.pn & 3;
        const int row0 = pm * 256 + wr * 64 + fr, col0 = pn * 256 + wc * 32 + 8 * fq;
        bf16_t* base = BO + (size_t)kb * TT * DM;
#pragma unroll
        for (int ai = 0; ai < 2; ++ai)
#pragma unroll
            for (int m = 0; m < 4; ++m) { const int row = row0 + ai * 128 + m * 16;
#pragma unroll
                for (int bj = 0; bj < 2; ++bj) { const f32x4 v0 = acc[ai][bj][m][0], v1 = acc[ai][bj][m][1];
                    *(uint4*)(base + (size_t)row * DM + col0 + bj * 128) = make_uint4(pack2(v0[0], v0[1]), pack2(v0[2], v0[3]), pack2(v1[0], v1[1]), pack2(v1[2], v1[3])); } }
    }
};
struct EpiMerge {
    static constexpr bool PERM = false, AFTER_DRAIN = false;
    const bf16_t* __restrict__ BO; const float* __restrict__ bm; bf16_t* __restrict__ MG;
    __device__ __forceinline__ void operator()(const f32x4 (&acc)[2][2][4][2], const Unit& u, int wr, int wc, int fr, int fq) const {
        const int row0 = u.pm * 256 + wr * 64 + fr, c0 = u.pn * 64 + wc * 16 + 4 * fq;
        f32x4 bb[4];
#pragma unroll
        for (int kb = 0; kb < 4; ++kb) bb[kb] = *(const f32x4*)(bm + kb * DM + c0);
#pragma unroll
        for (int ai = 0; ai < 2; ++ai) {
            uint2 bo[4][4];
#pragma unroll
            for (int m = 0; m < 4; ++m)
#pragma unroll
                for (int kb = 0; kb < 4; ++kb) bo[m][kb] = *(const uint2*)(BO + ((size_t)kb * TT + row0 + ai * 128 + m * 16) * DM + c0);
#pragma unroll
            for (int m = 0; m < 4; ++m) { const int row = row0 + ai * 128 + m * 16; f32x4 s = (f32x4){0.f, 0.f, 0.f, 0.f};
#pragma unroll
                for (int bj = 0; bj < 2; ++bj)
#pragma unroll
                    for (int n = 0; n < 2; ++n) { const int kb = 2 * bj + n; const f32x4 a = acc[ai][bj][m][n]; const uint2 bv = bo[m][kb];
                        s[0] += sigm(a[0] + bb[kb][0]) * bf2f((bf16_t)(bv.x & 0xffff)); s[1] += sigm(a[1] + bb[kb][1]) * bf2f((bf16_t)(bv.x >> 16));
                        s[2] += sigm(a[2] + bb[kb][2]) * bf2f((bf16_t)(bv.y & 0xffff)); s[3] += sigm(a[3] + bb[kb][3]) * bf2f((bf16_t)(bv.y >> 16)); }
                *(uint2*)(MG + (size_t)row * DM + c0) = make_uint2(pack2(s[0], s[1]), pack2(s[2], s[3])); } }
    }
};
struct EpiOut {
    static constexpr bool PERM = false, AFTER_DRAIN = false;
    const float* sL; const float* sC; float* dL; float* dC; const float* mod;
    __device__ __forceinline__ void operator()(const f32x4 (&acc)[2][2][4][2], const Unit& u, int wr, int wc, int fr, int fq) const {
        const int row0 = u.pm * 256 + wr * 64 + fr, col0 = u.pn * 256 + wc * 32 + 4 * fq;
        const int mv = mod_idx(u.pm * 256);
        const float* g1 = mod + mv * 6144 + 2 * DM;
        f32x4 gg[2][2];
#pragma unroll
        for (int bj = 0; bj < 2; ++bj)
#pragma unroll
            for (int n = 0; n < 2; ++n) gg[bj][n] = *(const f32x4*)(g1 + col0 + bj * 128 + n * 16);
#pragma unroll
        for (int ai = 0; ai < 2; ++ai) {
            f32x4 hv[4][2][2];
#pragma unroll
            for (int m = 0; m < 4; ++m) { const float* src = hrow_c(sL, sC, row0 + ai * 128 + m * 16);
#pragma unroll
                for (int bj = 0; bj < 2; ++bj)
#pragma unroll
                    for (int n = 0; n < 2; ++n) hv[m][bj][n] = *(const f32x4*)(src + col0 + bj * 128 + n * 16); }
#pragma unroll
            for (int m = 0; m < 4; ++m) { float* dst = hrow_m(dL, dC, row0 + ai * 128 + m * 16);
#pragma unroll
                for (int bj = 0; bj < 2; ++bj)
#pragma unroll
                    for (int n = 0; n < 2; ++n) *(f32x4*)(dst + col0 + bj * 128 + n * 16) = hv[m][bj][n] + gg[bj][n] * acc[ai][bj][m][n]; } }
    }
};
struct EpiH {
    static constexpr bool PERM = false, AFTER_DRAIN = false;
    bf16_t* HS;
    __device__ __forceinline__ void operator()(const f32x4 (&acc)[2][2][4][2], const Unit& u, int wr, int wc, int fr, int fq) const {
        const int pn = u.pn & 3, row0 = u.pm * 256 + wr * 64 + fr, hc0 = pn * 128 + wc * 16 + 4 * fq;
#pragma unroll
        for (int ai = 0; ai < 2; ++ai)
#pragma unroll
            for (int m = 0; m < 4; ++m) { const int row = row0 + ai * 128 + m * 16;
#pragma unroll
                for (int bj = 0; bj < 2; ++bj) { const f32x4 a = acc[ai][bj][m][0], c = acc[ai][bj][m][1];
                    *(uint2*)(HS + (size_t)row * 512 + hc0 + bj * 64) = make_uint2(pack2(siluf(a[0]) * c[0], siluf(a[1]) * c[1]), pack2(siluf(a[2]) * c[2], siluf(a[3]) * c[3])); } }
    }
};
struct EpiY {
    static constexpr bool PERM = true, AFTER_DRAIN = false;
    bf16_t* YM;
    __device__ __forceinline__ void operator()(const f32x4 (&acc)[2][2][4][2], const Unit& u, int wr, int wc, int fr, int fq) const {
        const int pn = u.pn & 3, row0 = u.pm * 256 + wr * 64 + fr, col0 = pn * 256 + wc * 32 + 8 * fq;
#pragma unroll
        for (int ai = 0; ai < 2; ++ai)
#pragma unroll
            for (int m = 0; m < 4; ++m) { const int row = row0 + ai * 128 + m * 16;
#pragma unroll
                for (int bj = 0; bj < 2; ++bj) { const f32x4 v0 = acc[ai][bj][m][0], v1 = acc[ai][bj][m][1];
                    *(uint4*)(YM + (size_t)row * DM + col0 + bj * 128) = make_uint4(pack2(v0[0], v0[1]), pack2(v0[2], v0[3]), pack2(v1[0], v1[1]), pack2(v1[2], v1[3])); } }
    }
};

__device__ __forceinline__ void phase_mods(const PP& p, LAS float* lds) {
    const int tid = otid(p.swid);
    float* MOD = (float*)(p.ws + WS_MOD);
    LAS float* sc = lds;
    LAS float* red = lds + 3072;
    for (int i = tid; i < 3072; i += 512) { const int v = i >> 10, k = i & 1023; const float x = v < 2 ? p.in[I_C][v * DM + k] : p.in[I_CCTX][k]; sc[i] = siluf(x); }
    __syncthreads();
    for (int u = blockIdx.x; u < 96; u += gridDim.x) {
        const int l = u / 48, cg = u % 48, col = cg * 128 + (tid & 127), kp = tid >> 7;
        const float* W = p.in[I_ADAW] + (size_t)l * DM * 6144 + col;
        float s0 = 0.f, s1 = 0.f, s2 = 0.f;
        for (int k = kp * 256; k < kp * 256 + 256; ++k) { const float w = W[(size_t)k * 6144]; s0 += sc[k] * w; s1 += sc[1024 + k] * w; s2 += sc[2048 + k] * w; }
        red[(kp * 3 + 0) * 128 + (tid & 127)] = s0; red[(kp * 3 + 1) * 128 + (tid & 127)] = s1; red[(kp * 3 + 2) * 128 + (tid & 127)] = s2;
        __syncthreads();
        if (tid < 384) { const int v = tid >> 7, cc = tid & 127; const float s = red[(0 * 3 + v) * 128 + cc] + red[(1 * 3 + v) * 128 + cc] + red[(2 * 3 + v) * 128 + cc] + red[(3 * 3 + v) * 128 + cc];
            MOD[((size_t)l * 3 + v) * 6144 + cg * 128 + cc] = s + p.in[I_ADAB][l * 6144 + cg * 128 + cc]; }
        __syncthreads();
    }
}

__device__ __forceinline__ const float* conv_src(const PP& p, int l, int mat, int sub, int n, int& ld) {
    switch (mat) {
    case 0: { ld = 7216; int c;
              if (n < 2560) c = 2592 + n; else if (n < 3584) c = n - 2560; else if (n < 5120) c = 1024 + (n - 3584); else if (n < 7168) c = 5152 + (n - 5120);
              else if (n < 7200) c = 2560 + (n - 7168); else if (n < 7216) c = 7200 + (n - 7200); else return nullptr;
              return p.in[I_WIN] + (size_t)l * DM * 7216 + c; }
    case 1: { ld = 4096; const int pn = n >> 8, ct = n & 255, bj = ct >> 7, wc = (ct >> 5) & 3, nn = (ct >> 4) & 1, i = ct & 15; const int kb = 2 * bj + nn, c = 64 * pn + 16 * wc + i;
              return p.in[I_WMERGE] + (size_t)l * DM * 4096 + kb * DM + c; }
    case 2: { ld = 1024; return p.in[I_WBR] + ((size_t)l * 4 + sub) * 512 * DM + n; }
    case 3: { ld = 1024; return p.in[I_WOUT] + (size_t)l * DM * DM + n; }
    case 4: { ld = 512; const int g = n >> 5, nn = (n >> 4) & 1, i = n & 15, hc = 16 * g + i; return (nn ? p.in[I_MW3] : p.in[I_MW1]) + ((size_t)l * 16 + sub) * DM * 512 + hc; }
    case 5: { ld = 1024; return p.in[I_MW2] + ((size_t)l * 16 + sub) * 512 * DM + n; }
    default: { ld = 64; return p.in[I_RGGW] + ((size_t)l * 32 + sub) * 4096 + n; }
    }
}
__device__ __forceinline__ void conv_unit(int u, int& mat, int& sub, int& nt, int& kt, int& K, size_t& dstoff) {
    if (u < 1856) { mat = 0; sub = 0; nt = u >> 4; kt = u & 15; K = 1024; dstoff = WB_WIN; }
    else if (u < 2880) { const int v = u - 1856; mat = 1; sub = 0; nt = v >> 4; kt = v & 15; K = 1024; dstoff = WB_WM; }
    else if (u < 3392) { const int v = u - 2880; mat = 2; sub = v >> 7; nt = (v & 127) >> 3; kt = v & 7; K = 512; dstoff = WB_WB + (size_t)sub * 1024 * 512 * 2; }
    else if (u < 3648) { const int v = u - 3392; mat = 3; sub = 0; nt = v >> 4; kt = v & 15; K = 1024; dstoff = WB_WO; }
    else if (u < 7744) { const int v = u - 3648; mat = 4; sub = v >> 8; nt = (v & 255) >> 4; kt = v & 15; K = 1024; dstoff = WB_W13 + (size_t)sub * 1024 * 1024 * 2; }
    else if (u < 9792) { const int v = u - 7744; mat = 5; sub = v >> 7; nt = (v & 127) >> 3; kt = v & 7; K = 512; dstoff = WB_W2 + (size_t)sub * 1024 * 512 * 2; }
    else { mat = 6; sub = u - 9792; nt = 0; kt = 0; K = 64; dstoff = WB_GW + (size_t)sub * 4096 * 2; }
}
__device__ __forceinline__ void phase_convert(const PP& p, int l, LAS float* tile  , int u_lo, int u_hi, int wg_lo) {
    const int tid = otid(p.swid);
    unsigned char* wb = p.ws + WS_WB;
    if ((int)blockIdx.x < wg_lo) return;
    for (int u0 = u_lo + ((int)blockIdx.x - wg_lo) * 4; u0 < u_hi; u0 += ((int)gridDim.x - wg_lo) * 4) {
        float val[4][8];
#pragma unroll
        for (int q = 0; q < 4; ++q) { int mat, sub, nt, kt, K; size_t dstoff; conv_unit(u0 + q, mat, sub, nt, kt, K, dstoff);
            int ld; const float* sp = conv_src(p, l, mat, sub, nt * 64 + (tid & 63), ld);
#pragma unroll
            for (int i = 0; i < 8; ++i) { const int kk = (tid >> 6) + 8 * i; val[q][i] = sp ? sp[(size_t)(kt * 64 + kk) * ld] : 0.f; } }
#pragma unroll
        for (int q = 0; q < 4; ++q)
#pragma unroll
            for (int i = 0; i < 8; ++i) tile[q * 4160 + ((tid >> 6) + 8 * i) * 65 + (tid & 63)] = val[q][i];
        __syncthreads();
#pragma unroll
        for (int q = 0; q < 4; ++q) { int mat, sub, nt, kt, K; size_t dstoff; conv_unit(u0 + q, mat, sub, nt, kt, K, dstoff);
            const int nn = tid >> 3, ks = (tid & 7) * 8; unsigned w[4];
#pragma unroll
            for (int j = 0; j < 4; ++j) w[j] = pack2(tile[q * 4160 + (ks + 2 * j) * 65 + nn], tile[q * 4160 + (ks + 2 * j + 1) * 65 + nn]);
            unsigned char* dbase = wb + dstoff;
            *(uint4*)((bf16_t*)dbase + (size_t)(nt * 64 + nn) * K + kt * 64 + ks) = make_uint4(w[0], w[1], w[2], w[3]); }
        __syncthreads();
    }
}

__device__ __forceinline__ void norm_row(const PP& p, int l, int which, const float* src, int mv, int lane, float (&u)[4][4]) {
    const float* MOD = (const float*)(p.ws + WS_MOD) + ((size_t)l * 3 + mv) * 6144;
    const float* gain = (which ? p.in[I_NFFNG] : p.in[I_NMIXG]) + l * DM;
    const float* sh = MOD + (which ? 3 : 0) * DM; const float* sc = MOD + (which ? 4 : 1) * DM;
    float ss = 0.f;
#pragma unroll
    for (int i = 0; i < 4; ++i) { const f32x4 v = *(const f32x4*)(src + 256 * i + 4 * lane); u[i][0] = v[0]; u[i][1] = v[1]; u[i][2] = v[2]; u[i][3] = v[3]; ss += v[0] * v[0] + v[1] * v[1] + v[2] * v[2] + v[3] * v[3]; }
    ss = wave_sum(ss);
    const float rs = rsqrtf(ss * (1.f / DM) + EPS);
#pragma unroll
    for (int i = 0; i < 4; ++i) { const int col = 256 * i + 4 * lane; const f32x4 g = *(const f32x4*)(gain + col), a = *(const f32x4*)(sc + col), b = *(const f32x4*)(sh + col);
#pragma unroll
        for (int j = 0; j < 4; ++j) u[i][j] = u[i][j] * rs * g[j] * (1.f + a[j]) + b[j]; }
}
__device__ __forceinline__ void norm_row_pre(const PP& p, int l, int which, const f32x4 (&v)[4], int mv, int lane, float (&u)[4][4]) {
    const float* MOD = (const float*)(p.ws + WS_MOD) + ((size_t)l * 3 + mv) * 6144;
    const float* gain = (which ? p.in[I_NFFNG] : p.in[I_NMIXG]) + l * DM;
    const float* sh = MOD + (which ? 3 : 0) * DM; const float* sc = MOD + (which ? 4 : 1) * DM;
    float ss = 0.f;
#pragma unroll
    for (int i = 0; i < 4; ++i) { u[i][0] = v[i][0]; u[i][1] = v[i][1]; u[i][2] = v[i][2]; u[i][3] = v[i][3]; ss += v[i][0] * v[i][0] + v[i][1] * v[i][1] + v[i][2] * v[i][2] + v[i][3] * v[i][3]; }
    ss = wave_sum(ss);
    const float rs = rsqrtf(ss * (1.f / DM) + EPS);
#pragma unroll
    for (int i = 0; i < 4; ++i) { const int col = 256 * i + 4 * lane; const f32x4 g = *(const f32x4*)(gain + col), a = *(const f32x4*)(sc + col), b = *(const f32x4*)(sh + col);
#pragma unroll
        for (int j = 0; j < 4; ++j) u[i][j] = u[i][j] * rs * g[j] * (1.f + a[j]) + b[j]; }
}
__device__ __forceinline__ void load_row(const float* src, int lane, f32x4 (&v)[4]) {
#pragma unroll
    for (int i = 0; i < 4; ++i) v[i] = *(const f32x4*)(src + 256 * i + 4 * lane);
}
__device__ __forceinline__ void phase_norm1(const PP& p, int l) {
    const int tid_ = otid(p.swid), lane = tid_ & 63, gw = blockIdx.x * 8 + (tid_ >> 6), nw = gridDim.x * 8;
    const float* sL = l == 0 ? p.in[I_X] : p.out; const float* sC = l == 0 ? p.in[I_CTX] : (const float*)(p.ws + WS_HCTX);
    bf16_t* U = (bf16_t*)(p.ws + WS_U);
    f32x4 cur[4], nxt[4];
    if (gw < TT) load_row(hrow_c(sL, sC, gw), lane, cur);
    for (int r = gw; r < TT; r += nw) {
        if (r + nw < TT) load_row(hrow_c(sL, sC, r + nw), lane, nxt);
        float u[4][4]; norm_row_pre(p, l, 0, cur, mod_idx(r), lane, u);
#pragma unroll
        for (int i = 0; i < 4; ++i) *(uint2*)(U + (size_t)r * DM + 256 * i + 4 * lane) = make_uint2(pack2(u[i][0], u[i][1]), pack2(u[i][2], u[i][3]));
#pragma unroll
        for (int i = 0; i < 4; ++i) cur[i] = nxt[i];
    }
}

__device__ __forceinline__ void phase_route(const PP& p, int l, LAS unsigned char* L) {
    const int tid_ = otid(p.swid), lane = tid_ & 63, wid = p.swid;
    LAS int* lcnt = (LAS int*)L;
    LAS int* rex = lcnt + 32;
    LAS int* rpos = rex + 132;
    if (tid_ < 32) lcnt[tid_] = 0;
    __syncthreads();
    const float* sL = p.out; const float* sC = (const float*)(p.ws + WS_HCTX);
    int* tok_e = (int*)(p.ws + WS_ROUTE); float* tok_w = (float*)(p.ws + WS_ROUTE + 262144); int* tok_pos = (int*)(p.ws + WS_ROUTE + 524288);
    unsigned* cnt = (unsigned*)(p.ws + WS_CTL) + CW_CNT + l * 16 * 32;
    const float* wg = p.in[I_MWG] + (size_t)l * DM * 4; const float* we = p.in[I_MWE] + (size_t)l * DM * 16;
    const int rbase = blockIdx.x * 66;
    const float* gain = p.in[I_NFFNG] + l * DM;
    LAS float* WT = (LAS float*)(L + 4096);
    for (int k = tid_; k < DM; k += 512) { const f32x4 g = *(const f32x4*)(wg + (size_t)k * 4); WT[0 * DM + k] = g[0]; WT[1 * DM + k] = g[1]; WT[2 * DM + k] = g[2]; WT[3 * DM + k] = g[3];
#pragma unroll
        for (int q = 0; q < 4; ++q) { const f32x4 e = *(const f32x4*)(we + (size_t)k * 16 + 4 * q); WT[(4 + 4 * q) * DM + k] = e[0]; WT[(5 + 4 * q) * DM + k] = e[1]; WT[(6 + 4 * q) * DM + k] = e[2]; WT[(7 + 4 * q) * DM + k] = e[3]; } }
    __syncthreads();
    for (int rp = wid; rp < 33; rp += 8) {
        const int rr0 = 2 * rp, r0 = rbase + rr0, r1 = r0 + 1;
        if (l == 1 && (r0 % NTOK) < CTXL) { if (lane == 0) { rex[2 * rr0] = -1; rex[2 * rr0 + 1] = -1; rex[2 * rr0 + 2] = -1; rex[2 * rr0 + 3] = -1; } continue; }
        const float* s0 = hrow_c(sL, sC, r0); const float* s1 = hrow_c(sL, sC, r1); const int mv = mod_idx(r0);
        const float* MOD = (const float*)(p.ws + WS_MOD) + ((size_t)l * 3 + mv) * 6144; const float* sh = MOD + 3 * DM; const float* sc = MOD + 4 * DM;
        f32x4 xa[4], xb[4], gm[4], bs[4]; float ssa = 0.f, ssb = 0.f;
#pragma unroll
        for (int i = 0; i < 4; ++i) { const int col0 = 256 * i + 4 * lane; xa[i] = *(const f32x4*)(s0 + col0); xb[i] = *(const f32x4*)(s1 + col0);
            const f32x4 g = *(const f32x4*)(gain + col0), a = *(const f32x4*)(sc + col0); bs[i] = *(const f32x4*)(sh + col0); gm[i] = g * (a + 1.f); }
#pragma unroll
        for (int i = 0; i < 4; ++i) { ssa += xa[i][0] * xa[i][0] + xa[i][1] * xa[i][1] + xa[i][2] * xa[i][2] + xa[i][3] * xa[i][3]; ssb += xb[i][0] * xb[i][0] + xb[i][1] * xb[i][1] + xb[i][2] * xb[i][2] + xb[i][3] * xb[i][3]; }
        ssa = wave_sum(ssa); ssb = wave_sum(ssb);
        const float rsa = rsqrtf(ssa * (1.f / DM) + EPS), rsb = rsqrtf(ssb * (1.f / DM) + EPS);
#pragma unroll
        for (int i = 0; i < 4; ++i) { xa[i] = xa[i] * rsa * gm[i] + bs[i]; xb[i] = xb[i] * rsb * gm[i] + bs[i]; }
        float acca[20], accb[20];
#pragma unroll
        for (int q = 0; q < 20; ++q) { float sa2 = 0.f, sb2 = 0.f;
#pragma unroll
            for (int i = 0; i < 4; ++i) { const f32x4 w = *(const LAS f32x4*)(WT + q * DM + 256 * i + 4 * lane);
                sa2 += xa[i][0] * w[0] + xa[i][1] * w[1] + xa[i][2] * w[2] + xa[i][3] * w[3]; sb2 += xb[i][0] * w[0] + xb[i][1] * w[1] + xb[i][2] * w[2] + xb[i][3] * w[3]; }
            acca[q] = sa2; accb[q] = sb2; }
#pragma unroll
        for (int q = 0; q < 20; ++q) { acca[q] = wave_sum(acca[q]); accb[q] = wave_sum(accb[q]); }
        if (lane < 2) {
            const int rr = rr0 + lane, r = r0 + lane; float acc[20];
#pragma unroll
            for (int q = 0; q < 20; ++q) acc[q] = lane ? accb[q] : acca[q];
            float gl[4];
#pragma unroll
            for (int q = 0; q < 4; ++q) gl[q] = acc[q] + p.in[I_MBG][l * 4 + q];
            int grp = 0; float gm = gl[0];
#pragma unroll
            for (int q = 1; q < 4; ++q) if (gl[q] > gm) { gm = gl[q]; grp = q; }
            float se = 0.f;
#pragma unroll
            for (int q = 0; q < 4; ++q) se += __expf(gl[q] - gm);
            const float pg = 1.f / se;
            float el[4];
#pragma unroll
            for (int q = 0; q < 4; ++q) { float v = 0.f;
#pragma unroll
                for (int gg = 0; gg < 4; ++gg) v = (gg == grp) ? acc[4 + gg * 4 + q] : v;
                el[q] = v + p.in[I_MBE][l * 16 + grp * 4 + q]; }
            int i0 = 0; float m0 = el[0];
#pragma unroll
            for (int q = 1; q < 4; ++q) if (el[q] > m0) { m0 = el[q]; i0 = q; }
            int i1 = -1; float m1 = -3.4e38f;
#pragma unroll
            for (int q = 0; q < 4; ++q) if (q != i0 && el[q] > m1) { m1 = el[q]; i1 = q; }
            const float e1 = __expf(m1 - m0), w0 = pg / (1.f + e1), w1 = pg * e1 / (1.f + e1);
            const int ex0 = grp * 4 + i0, ex1 = grp * 4 + i1;
            rex[2 * rr] = ex0; rex[2 * rr + 1] = ex1; rpos[2 * rr] = __hip_atomic_fetch_add(&lcnt[ex0], 1, __ATOMIC_RELAXED, __HIP_MEMORY_SCOPE_WORKGROUP); rpos[2 * rr + 1] = __hip_atomic_fetch_add(&lcnt[ex1], 1, __ATOMIC_RELAXED, __HIP_MEMORY_SCOPE_WORKGROUP);
            tok_e[2 * r] = ex0; tok_e[2 * r + 1] = ex1; tok_w[2 * r] = w0; tok_w[2 * r + 1] = w1;
        }
    }
    __syncthreads();
    if (tid_ < 16) { const int c = lcnt[tid_]; lcnt[16 + tid_] = c ? (int)atomicAdd(&cnt[32 * tid_], (unsigned)c) : 0; }
    __syncthreads();
    for (int i = tid_; i < 132; i += 512) { const int r = rbase + (i >> 1); const int e = rex[i]; if (r < TT && e >= 0) tok_pos[2 * r + (i & 1)] = lcnt[16 + e] + rpos[i]; }
    __syncthreads();
}
__device__ __forceinline__ int moe_tables(const PP& p, int l, LAS int* tbl  ) {
    const unsigned* cnt = (const unsigned*)(p.ws + WS_CTL) + CW_CNT + l * 16 * 32;
    __syncthreads();
    if (otid(p.swid) == 0) { int s = 0;
        for (int e = 0; e < 16; ++e) { const int c = (int)__hip_atomic_load(cnt + 32 * e, __ATOMIC_RELAXED, __HIP_MEMORY_SCOPE_AGENT); const int nb = (c + 255) >> 8; tbl[e] = s * 256; for (int b = 0; b < nb; ++b) tbl[32 + s + b] = e; s += nb; }
        tbl[16] = s; }
    __syncthreads();
    return tbl[16];
}
__device__ __forceinline__ void phase_dispatch(const PP& p, int l, LAS int* tbl) {
    const int tid_ = otid(p.swid), lane = tid_ & 63, gw = blockIdx.x * 8 + (tid_ >> 6), nw = gridDim.x * 8;
    moe_tables(p, l, tbl);
    const float* sL = p.out; const float* sC = (const float*)(p.ws + WS_HCTX);
    const int* tok_e = (const int*)(p.ws + WS_ROUTE); const int* tok_pos = (const int*)(p.ws + WS_ROUTE + 524288); int* tok_slot = (int*)(p.ws + WS_ROUTE + 786432);
    bf16_t* XS = (bf16_t*)(p.ws + WS_BIG + BIG_XS);
    f32x4 cur[4], nxt[4]; int ce0 = 0, ce1 = 0, cp0 = 0, cp1 = 0, ne0 = 0, ne1 = 0, np0 = 0, np1 = 0;
    if (gw < TT) { load_row(hrow_c(sL, sC, gw), lane, cur); ce0 = tok_e[2 * gw]; ce1 = tok_e[2 * gw + 1]; cp0 = tok_pos[2 * gw]; cp1 = tok_pos[2 * gw + 1]; }
    for (int r = gw; r < TT; r += nw) {
        if (r + nw < TT) { const int rn = r + nw; load_row(hrow_c(sL, sC, rn), lane, nxt); ne0 = tok_e[2 * rn]; ne1 = tok_e[2 * rn + 1]; np0 = tok_pos[2 * rn]; np1 = tok_pos[2 * rn + 1]; }
        f32x4 me[4]; const int e0 = ce0, e1 = ce1, q0 = cp0, q1 = cp1;
#pragma unroll
        for (int i = 0; i < 4; ++i) { me[i] = cur[i]; cur[i] = nxt[i]; }
        ce0 = ne0; ce1 = ne1; cp0 = np0; cp1 = np1;
        if (l == 1 && (r % NTOK) < CTXL) continue;
        float u[4][4]; norm_row_pre(p, l, 1, me, mod_idx(r), lane, u);
        const int s0 = tbl[e0 & 15] + q0, s1 = tbl[e1 & 15] + q1;
        if (lane == 0) { tok_slot[2 * r] = s0; tok_slot[2 * r + 1] = s1; }
#pragma unroll
        for (int i = 0; i < 4; ++i) { const uint2 v = make_uint2(pack2(u[i][0], u[i][1]), pack2(u[i][2], u[i][3]));
            *(uint2*)(XS + (size_t)s0 * DM + 256 * i + 4 * lane) = v; *(uint2*)(XS + (size_t)s1 * DM + 256 * i + 4 * lane) = v; }
    }
}
__device__ __forceinline__ void phase_combine(const PP& p, int l) {
    const int tid_ = otid(p.swid), lane = tid_ & 63, gw = blockIdx.x * 8 + (tid_ >> 6), nw = gridDim.x * 8;
    float* HL = p.out; float* HC = (float*)(p.ws + WS_HCTX);
    const float* tok_w = (const float*)(p.ws + WS_ROUTE + 262144); const int* tok_slot = (const int*)(p.ws + WS_ROUTE + 786432);
    const bf16_t* YM = (const bf16_t*)(p.ws + WS_BIG + BIG_YM);
    f32x4 cur[4], nxt[4]; int cs0 = 0, cs1 = 0, ns0 = 0, ns1 = 0; float cw0 = 0.f, cw1 = 0.f, nw0 = 0.f, nw1 = 0.f;
    if (gw < TT) { load_row(hrow_c(HL, HC, gw), lane, cur); cs0 = tok_slot[2 * gw]; cs1 = tok_slot[2 * gw + 1]; cw0 = tok_w[2 * gw]; cw1 = tok_w[2 * gw + 1]; }
    for (int r = gw; r < TT; r += nw) {
        if (r + nw < TT) { const int rn = r + nw; load_row(hrow_c(HL, HC, rn), lane, nxt); ns0 = tok_slot[2 * rn]; ns1 = tok_slot[2 * rn + 1]; nw0 = tok_w[2 * rn]; nw1 = tok_w[2 * rn + 1]; }
        f32x4 me[4]; const int s0 = cs0, s1 = cs1; const float w0 = cw0, w1 = cw1;
#pragma unroll
        for (int i = 0; i < 4; ++i) { me[i] = cur[i]; cur[i] = nxt[i]; }
        cs0 = ns0; cs1 = ns1; cw0 = nw0; cw1 = nw1;
        if (l == 1 && (r % NTOK) < CTXL) continue;
        const float* g2 = (const float*)(p.ws + WS_MOD) + ((size_t)l * 3 + mod_idx(r)) * 6144 + 5 * DM;
        float* hp = hrow_m(HL, HC, r);
        float x[4][4]; float ss = 0.f;
#pragma unroll
        for (int i = 0; i < 4; ++i) { const int col = 256 * i + 4 * lane; const f32x4 h = me[i], g = *(const f32x4*)(g2 + col);
            const uint2 a = *(const uint2*)(YM + (size_t)s0 * DM + col), b = *(const uint2*)(YM + (size_t)s1 * DM + col);
            x[i][0] = h[0] + g[0] * (w0 * bf2f((bf16_t)(a.x & 0xffff)) + w1 * bf2f((bf16_t)(b.x & 0xffff)));
            x[i][1] = h[1] + g[1] * (w0 * bf2f((bf16_t)(a.x >> 16)) + w1 * bf2f((bf16_t)(b.x >> 16)));
            x[i][2] = h[2] + g[2] * (w0 * bf2f((bf16_t)(a.y & 0xffff)) + w1 * bf2f((bf16_t)(b.y & 0xffff)));
            x[i][3] = h[3] + g[3] * (w0 * bf2f((bf16_t)(a.y >> 16)) + w1 * bf2f((bf16_t)(b.y >> 16)));
            ss += x[i][0] * x[i][0] + x[i][1] * x[i][1] + x[i][2] * x[i][2] + x[i][3] * x[i][3]; }
        if (l == 1) {
            ss = wave_sum(ss); const float rs = rsqrtf(ss * (1.f / DM) + EPS);
#pragma unroll
            for (int i = 0; i < 4; ++i) { const int col = 256 * i + 4 * lane; const f32x4 g = *(const f32x4*)(p.in[I_FNG] + col);
                *(f32x4*)(hp + col) = (f32x4){x[i][0] * rs * g[0], x[i][1] * rs * g[1], x[i][2] * rs * g[2], x[i][3] * rs * g[3]}; }
        } else {
#pragma unroll
            for (int i = 0; i < 4; ++i) *(f32x4*)(hp + 256 * i + 4 * lane) = (f32x4){x[i][0], x[i][1], x[i][2], x[i][3]};
            ss = wave_sum(ss); const float rs = rsqrtf(ss * (1.f / DM) + EPS);
            const float* MOD1 = (const float*)(p.ws + WS_MOD) + ((size_t)1 * 3 + mod_idx(r)) * 6144; bf16_t* U = (bf16_t*)(p.ws + WS_U);
#pragma unroll
            for (int i = 0; i < 4; ++i) { const int col = 256 * i + 4 * lane; const f32x4 g = *(const f32x4*)(p.in[I_NMIXG] + DM + col), a = *(const f32x4*)(MOD1 + DM + col), bsh = *(const f32x4*)(MOD1 + col);
                float y[4];
#pragma unroll
                for (int j2 = 0; j2 < 4; ++j2) y[j2] = x[i][j2] * rs * g[j2] * (1.f + a[j2]) + bsh[j2];
                *(uint2*)(U + (size_t)r * DM + col) = make_uint2(pack2(y[0], y[1]), pack2(y[2], y[3])); }
        }
    }
}

__device__ __forceinline__ int chain_chunk(int dir, int ci) { return dir == 0 ? ci : (ci < 4 ? 3 - ci : 135 - ci); }

constexpr size_t SM_RGA = 0, SM_RGB = 1081344, SM_RGH = 2162688, SM_DEC = 3244032, SM_MLBE = 4325376, SM_MLML = SM_MLBE + 8448, SM_MLMIN = SM_MLML + 8448, SM_MLDN = 4350720;
__device__ __forceinline__ f32x4 mfma16(bf16x8 x, bf16x8 y, f32x4 c) { const f32x4 d = __builtin_amdgcn_mfma_f32_16x16x32_bf16(x, y, c, 0, 0, 0); asm volatile("" :: "v"(x), "v"(y), "v"(d)); return d; }

__device__ __forceinline__ void settle(f32x4& a) { asm volatile("s_nop 11" : "+v"(a)); }
__device__ __forceinline__ void settle(f32x4& a, f32x4& b) { asm volatile("s_nop 11" : "+v"(a), "+v"(b)); }
__device__ __forceinline__ void settle(f32x4& a, f32x4& b, f32x4& c, f32x4& d) { asm volatile("s_nop 11" : "+v"(a), "+v"(b), "+v"(c), "+v"(d)); }
template <bool OUT> __device__ __forceinline__ void phase_rg(const PP& p, int l, LAS unsigned char* L) {
    const int tid = otid(p.swid), lane = tid & 63, wid = p.swid, fr = lane & 15, fq = lane >> 4;
    LAS bf16_t* XB = (LAS bf16_t*)L;
    LAS float* XF = (LAS float*)(L + 9216);
    LAS float* PRE = (LAS float*)(L + 9216 + 16384);
    const bf16_t* Z = (const bf16_t*)(p.ws + WS_BIG + BIG_Z); const bf16_t* GWT = (const bf16_t*)(p.ws + WS_WB + WB_GW);
    float* RA = (float*)(p.ws + WS_SMALL + SM_RGA); float* RB = (float*)(p.ws + WS_SMALL + SM_RGB); const float* RH = (const float*)(p.ws + WS_SMALL + SM_RGH);
    bf16_t* YS = (bf16_t*)(p.ws + WS_BIG + BIG_YS);
    const int blk = blockIdx.x & 7, nstr = gridDim.x >> 3, j = tid & 63, tg = tid >> 6, ch = blk * 64 + j;
    float cw[4];
#pragma unroll
    for (int q = 0; q < 4; ++q) cw[q] = p.in[I_RGCW][(l * 4 + q) * 512 + ch];
    const float cb = p.in[I_RGCB][l * 512 + ch];
    float gbr[2], gbi[2], gsp[2];
#pragma unroll
    for (int dir = 0; dir < 2; ++dir) { gbr[dir] = p.in[I_RGGB][((l * 2 + dir) * 2 + 0) * 512 + ch]; gbi[dir] = p.in[I_RGGB][((l * 2 + dir) * 2 + 1) * 512 + ch]; gsp[dir] = softplusf(-p.in[I_RGLAM][(l * 2 + dir) * 512 + ch]); }
    bf16x8 wx[4][2];
    { const int set = wid >> 1; const bf16_t* W = GWT + ((size_t)set * 8 + blk) * 4096;
#pragma unroll
      for (int jt = 0; jt < 4; ++jt) { wx[jt][0] = *(const bf16x8*)(W + (16 * jt + fr) * 64 + 8 * fq); wx[jt][1] = *(const bf16x8*)(W + (16 * jt + fr) * 64 + 8 * fq + 32); } }
    unsigned short win[11], yv[8]; float hin = 0.f;
    auto fetch = [&](int bc, unsigned short (&w_)[11], unsigned short (&y_)[8], float& h_) {
        const int c = bc % NCHUNK, b = bc / NCHUNK, p0 = c * 64; const size_t rb = (size_t)b * NTOK; const int lo = p0 < CTXL ? 0 : CTXL, hi = p0 < CTXL ? CTXL : NTOK;
#pragma unroll
        for (int k = 0; k < 11; ++k) { const int q = p0 + tg * 8 - 2 + k, qc = q < lo ? lo : (q >= hi ? hi - 1 : q); const unsigned short zv = Z[(rb + qc) * ZLD + RGX + ch]; w_[k] = (q >= lo && q < hi) ? zv : (unsigned short)0; }
        if (OUT) {
#pragma unroll
            for (int k = 0; k < 8; ++k) y_[k] = Z[(rb + p0 + tg * 8 + k) * ZLD + RGY + ch];
            if (tid < 128) h_ = RH[((size_t)((tid >> 6) * 2 + b) * NCHUNK + c) * 512 + ch]; }
    };
    int bc = blockIdx.x >> 3;
    if (bc < 2 * NCHUNK) fetch(bc, win, yv, hin);
    for (; bc < 2 * NCHUNK; bc += nstr) {
        const int c = bc % NCHUNK, b = bc / NCHUNK, p0 = c * 64; const size_t rb = (size_t)b * NTOK;
        float wf[11]; unsigned short ycur[8]; const float hcur = hin;
#pragma unroll
        for (int k = 0; k < 11; ++k) wf[k] = bf2f(win[k]);
#pragma unroll
        for (int k = 0; k < 8; ++k) ycur[k] = yv[k];
        if (bc + nstr < 2 * NCHUNK) fetch(bc + nstr, win, yv, hin);
#pragma unroll
        for (int k = 0; k < 8; ++k) { const int t = tg * 8 + k; const float xb = cb + cw[0] * wf[k] + cw[1] * wf[k + 1] + cw[2] * wf[k + 2] + cw[3] * wf[k + 3];
            XF[t * 64 + j] = xb; XB[t * 72 + j] = f2bf(xb); }
        __syncthreads();
        {
            const int set = wid >> 1;
#pragma unroll
            for (int tti = 0; tti < 2; ++tti) { const int tt = (wid & 1) * 2 + tti;
                const bf16x8 y0 = *(const LAS bf16x8*)(XB + (16 * tt + fr) * 72 + 8 * fq), y1 = *(const LAS bf16x8*)(XB + (16 * tt + fr) * 72 + 8 * fq + 32);
#pragma unroll
                for (int jt = 0; jt < 4; ++jt) { f32x4 acc = (f32x4){0.f, 0.f, 0.f, 0.f}; acc = mfma16(wx[jt][0], y0, acc); acc = mfma16(wx[jt][1], y1, acc); settle(acc);
                    *(LAS f32x4*)(PRE + (set * 64 + 16 * tt + fr) * 68 + 16 * jt + 4 * fq) = acc; } }
        }
        __syncthreads();
#pragma unroll
        for (int dir = 0; dir < 2; ++dir) {
#pragma unroll
            for (int k = 0; k < 8; ++k) { const int t = tg * 8 + k; LAS float* pa = PRE + ((dir * 2 + 0) * 64 + t) * 68 + j; LAS float* pb = PRE + ((dir * 2 + 1) * 64 + t) * 68 + j;
                const float r = sigm(*pa + gbr[dir]), ig = sigm(*pb + gbi[dir]), la = -8.f * r * gsp[dir];
                const float a = __expf(la), x2 = 2.f * la;
                const float ser = -x2 * (1.f + x2 * (0.5f + x2 * (0.16666667f + x2 * (0.041666668f + x2 * (0.008333334f + x2 * 0.0013888889f)))));
                const float om = x2 > -0.5f ? ser : 1.f - a * a;
                *pa = a; *pb = __builtin_amdgcn_sqrtf(om) * (ig * XF[t * 64 + j]); } }
        __syncthreads();
        if (tid < 128) {
            const int dir = tid >> 6; const size_t sidx = ((size_t)(dir * 2 + b) * NCHUNK + c) * 512 + ch;
            float h = OUT ? hcur : 0.f, P = 1.f;
#pragma unroll 8
            for (int s2 = 0; s2 < 64; ++s2) { const int t = dir ? 63 - s2 : s2; const float a = PRE[((dir * 2 + 0) * 64 + t) * 68 + j], bt = PRE[((dir * 2 + 1) * 64 + t) * 68 + j];
                h = a * h + bt; if (OUT) PRE[((dir * 2 + 1) * 64 + t) * 68 + j] = h; else P *= a; }
            if (!OUT) { RA[sidx] = P; RB[sidx] = h; }
        }
        if (OUT) { __syncthreads();
#pragma unroll
            for (int k = 0; k < 8; ++k) { const int t = tg * 8 + k; const size_t r = rb + p0 + t;
                YS[r * 512 + ch] = f2bf(gelu_tanh(bf2f(ycur[k])) * (PRE[((0 * 2 + 1) * 64 + t) * 68 + j] + PRE[((1 * 2 + 1) * 64 + t) * 68 + j])); } }
        __syncthreads();
    }
}
__device__ __forceinline__ void phase_rg_carry(const PP& p) {
    const int g = blockIdx.x * 512 + otid(p.swid); if (g >= 2048) return;
    const int dir = g >> 10, b = (g >> 9) & 1, ch = g & 511;
    const float* RA = (const float*)(p.ws + WS_SMALL + SM_RGA); const float* RB = (const float*)(p.ws + WS_SMALL + SM_RGB); float* RH = (float*)(p.ws + WS_SMALL + SM_RGH);
    float h = 0.f;
    for (int ci0 = 0; ci0 < NCHUNK; ci0 += 6) { float a[6], bb[6]; size_t idx[6];
#pragma unroll
        for (int k = 0; k < 6; ++k) { idx[k] = ((size_t)(dir * 2 + b) * NCHUNK + chain_chunk(dir, ci0 + k)) * 512 + ch; a[k] = RA[idx[k]]; bb[k] = RB[idx[k]]; }
#pragma unroll
        for (int k = 0; k < 6; ++k) { RH[idx[k]] = h; h = a[k] * h + bb[k]; } }
}

template <int BR> struct GlChan {
    float w[16]; float bias; float lb; int dir, h, d, l;
    __device__ __forceinline__ void init(const PP& p, int l_, int dir_, int h_, int d_) { l = l_; dir = dir_; h = h_; d = d_;
        if (BR == 1) {
#pragma unroll
            for (int r = 0; r < 16; ++r) w[r] = p.in[I_GLAWLR][((size_t)(l * 2 + dir) * 16 + r) * 256 + h * 64 + d];
            bias = p.in[I_GLABLR][(l * 2 + dir) * 256 + h * 64 + d]; lb = 0.f;
        } else { lb = 0.f; if (l == 1) { const float l0 = p.in[I_HGLB][(0 * 2 + dir) * 512 + h * 128 + d], l1 = p.in[I_HGLB][(1 * 2 + dir) * 512 + h * 128 + d]; lb = 1.f / (1.f + __expf(l0 - l1)); } bias = 0.f; }
    }
    __device__ __forceinline__ bf16_t raw(const bf16_t* zrow) const { return BR == 1 ? zrow[GK + h * 64 + d] : zrow[HF + dir * 512 + h * 128 + d]; }
    __device__ __forceinline__ void gk_raw(bf16_t rw, const LAS float* lr, float& g, float& k) const {
        if (BR == 1) { float pre = bias;
#pragma unroll
            for (int r4 = 0; r4 < 4; ++r4) { const f32x4 x = *(const LAS f32x4*)(lr + 4 * r4); pre += x[0] * w[4 * r4] + x[1] * w[4 * r4 + 1] + x[2] * w[4 * r4 + 2] + x[3] * w[4 * r4 + 3]; }
            g = logsig(pre) * (1.f / 16.f); k = bf2f(rw);
        } else { const float f = bf2f(rw); const float e = __expf(-f), sg = frcp(1.f + e);
            g = __logf(lb + (1.f - lb) * sg); k = (1.f - lb) * (e * sg); }
    }
    __device__ __forceinline__ void gk(const bf16_t* zrow, const LAS float* lr, float& g, float& k) const {
        if (BR == 1) { float pre = bias;
#pragma unroll
            for (int r4 = 0; r4 < 4; ++r4) { const f32x4 x = *(const LAS f32x4*)(lr + 4 * r4); pre += x[0] * w[4 * r4] + x[1] * w[4 * r4 + 1] + x[2] * w[4 * r4 + 2] + x[3] * w[4 * r4 + 3]; }
            g = logsig(pre) * (1.f / 16.f); k = bf2f(zrow[GK + h * 64 + d]);
        } else { const float f = bf2f(zrow[HF + dir * 512 + h * 128 + d]); const float e = __expf(-f), sg = frcp(1.f + e);
            g = __logf(lb + (1.f - lb) * sg); k = (1.f - lb) * (e * sg); }
    }
};
__device__ __forceinline__ int krow(int d) { return (d & ~31) + 16 * ((d >> 2) & 1) + 4 * ((d & 31) >> 3) + (d & 3); }
template <int BR> __device__ __forceinline__ void phase_gl_local(const PP& p, int l, LAS unsigned char* L) {
    constexpr int DK = BR == 1 ? 64 : 128, NSEG = 512 / DK, NT = 64 / NSEG;
    const int tid = otid(p.swid), lane = tid & 63, wid = p.swid, fr = lane & 15, fq = lane >> 4;
    LAS bf16_t* KT = (LAS bf16_t*)L;
    LAS bf16_t* VT = KT + 2 * DK * 72;
    LAS float* SEG = (LAS float*)(VT + 128 * 72);
    LAS float* LR = SEG + 1024;
    const bf16_t* Z = (const bf16_t*)(p.ws + WS_BIG + BIG_Z); const float* MISC = (const float*)(p.ws + WS_MISC);
    bf16_t* ST = (bf16_t*)(p.ws + WS_BIG + BIG_ST); float* DEC = (float*)(p.ws + WS_SMALL + SM_DEC);
    constexpr int VOFF = BR == 1 ? GV : HI;
    const int d = tid % DK, sg = tid / DK;
    for (int u = (blockIdx.x + (BR == 2 ? 128 : 0)) % gridDim.x; u < 8 * NCHUNK; u += gridDim.x) {
        const int c = u % NCHUNK, bh = u / NCHUNK, h = bh & 3, b = bh >> 2; const size_t r0 = (size_t)b * NTOK + c * 64;
        if (BR == 1) { for (int i = tid; i < 2048; i += 512) LR[i] = MISC[(r0 + (i >> 5)) * 64 + MISC_LR + (i & 31)]; }
        { const int v = tid & 127;
#pragma unroll
          for (int gi = 0; gi < 2; ++gi) { const int grp = (tid >> 7) + 4 * gi; unsigned short x[8];
#pragma unroll
            for (int e = 0; e < 8; ++e) x[e] = Z[(r0 + grp * 8 + e) * ZLD + VOFF + h * 128 + v];
            *(LAS u32x4*)(VT + v * 72 + grp * 8) = (u32x4){x[0] | ((unsigned)x[1] << 16), x[2] | ((unsigned)x[3] << 16), x[4] | ((unsigned)x[5] << 16), x[6] | ((unsigned)x[7] << 16)}; } }
        if (BR == 1) __syncthreads();
        float cs[2][NT], kk[2][NT];
#pragma unroll
        for (int dir = 0; dir < 2; ++dir) { GlChan<BR> G; G.init(p, l, dir, h, d); float run = 0.f;
#pragma unroll
            for (int q = 0; q < NT; ++q) { const int n = dir ? NT - 1 - q : q, t = sg * NT + n; float g; G.gk(Z + (r0 + t) * ZLD, LR + t * 32 + dir * 16, g, kk[dir][n]); run += g; cs[dir][n] = run; }
            SEG[(dir * NSEG + sg) * DK + d] = run; }
        __syncthreads();
#pragma unroll
        for (int dir = 0; dir < 2; ++dir) { float before = 0.f, tot = 0.f;
#pragma unroll
            for (int s2 = 0; s2 < NSEG; ++s2) { const float x = SEG[(dir * NSEG + s2) * DK + d]; tot += x; const bool earlier = dir ? (s2 > sg) : (s2 < sg); before += earlier ? x : 0.f; }
            float val[NT];
#pragma unroll
            for (int n = 0; n < NT; ++n) val[n] = kk[dir][n] * __expf(tot - (before + cs[dir][n]));
#pragma unroll
            for (int n8 = 0; n8 < NT / 8; ++n8)
                *(LAS u32x4*)(KT + (dir * DK + krow(d)) * 72 + sg * NT + 8 * n8) = (u32x4){pack2(val[8 * n8], val[8 * n8 + 1]), pack2(val[8 * n8 + 2], val[8 * n8 + 3]), pack2(val[8 * n8 + 4], val[8 * n8 + 5]), pack2(val[8 * n8 + 6], val[8 * n8 + 7])};
            if (sg == 0) DEC[((size_t)((dir * 2 + b) * 4 + h) * NCHUNK + c) * 128 + d] = __expf(tot); }
        __syncthreads();
        { const int dir = wid >> 2; const size_t sbase = ((size_t)((dir * 2 + b) * 4 + h) * NCHUNK + c) * 128 * DK;
            constexpr int NVT = DK == 64 ? 4 : 8; const int A = DK == 64 ? (wid & 1) : (wid & 3), vt0 = DK == 64 ? ((wid >> 1) & 1) * 4 : 0;
            bf16x8 x[2][2];
#pragma unroll
            for (int n = 0; n < 2; ++n) { x[n][0] = *(const LAS bf16x8*)(KT + (dir * DK + 16 * (2 * A + n) + fr) * 72 + 8 * fq); x[n][1] = *(const LAS bf16x8*)(KT + (dir * DK + 16 * (2 * A + n) + fr) * 72 + 8 * fq + 32); }
#pragma unroll
            for (int vi = 0; vi < NVT; ++vi) { const int vt = vt0 + vi; const bf16x8 y0 = *(const LAS bf16x8*)(VT + (16 * vt + fr) * 72 + 8 * fq), y1 = *(const LAS bf16x8*)(VT + (16 * vt + fr) * 72 + 8 * fq + 32);
                f32x4 a0 = (f32x4){0.f, 0.f, 0.f, 0.f}, a1 = (f32x4){0.f, 0.f, 0.f, 0.f};
                a0 = mfma16(x[0][0], y0, a0); a0 = mfma16(x[0][1], y1, a0); a1 = mfma16(x[1][0], y0, a1); a1 = mfma16(x[1][1], y1, a1); settle(a0, a1);
                *(uint4*)(ST + sbase + (size_t)(16 * vt + fr) * DK + 32 * A + 8 * fq) = make_uint4(pack2(a0[0], a0[1]), pack2(a0[2], a0[3]), pack2(a1[0], a1[1]), pack2(a1[2], a1[3])); } }
        __syncthreads();
    }
}
template <int BR> __device__ __forceinline__ void phase_gl_carry(const PP& p) {
    constexpr int DK = BR == 1 ? 64 : 128, D4 = DK / 4, TOTAL = 16 * 128 * D4, NB = 12;
    const int g = (int)((blockIdx.x + (BR == 1 ? gridDim.x - 132 : 0)) % gridDim.x) * 512 + otid(p.swid);
    bf16_t* ST = (bf16_t*)(p.ws + WS_BIG + BIG_ST + (BR == 3 ? ST_ML_OFF : 0)); const float* DEC = (const float*)(p.ws + WS_SMALL + SM_DEC);
    const float* BE = (const float*)(p.ws + WS_SMALL + SM_MLBE); const float* MLOC = (const float*)(p.ws + WS_SMALL + SM_MLML); float* MIN_ = (float*)(p.ws + WS_SMALL + SM_MLMIN); float* DN = (float*)(p.ws + WS_SMALL + SM_MLDN);
    if (g < TOTAL) {
        const int d4 = g % D4, v = (g / D4) % 128, chain = g / (D4 * 128), dir = chain >> 3;
        float S[4] = {0.f, 0.f, 0.f, 0.f}; float m = 0.f;
        for (int ci0 = 0; ci0 < NCHUNK; ci0 += NB) { uint2 ds[NB]; f32x4 da[NB]; size_t off[NB];
#pragma unroll
            for (int k = 0; k < NB; ++k) { const int c = chain_chunk(dir, ci0 + k); off[k] = (((size_t)chain * NCHUNK + c) * 128 + v) * DK + d4 * 4; ds[k] = *(const uint2*)(ST + off[k]);
                if (BR == 3) { da[k][0] = BE[chain * NCHUNK + c]; da[k][1] = MLOC[chain * NCHUNK + c]; da[k][2] = 0.f; da[k][3] = 0.f; }
                else da[k] = *(const f32x4*)(DEC + ((size_t)chain * NCHUNK + c) * 128 + d4 * 4); }
#pragma unroll
            for (int k = 0; k < NB; ++k) {
                *(uint2*)(ST + off[k]) = make_uint2(pack2(S[0], S[1]), pack2(S[2], S[3]));
                float al[4], be[4];
                if (BR == 3) { const float mn = fmaxf(da[k][0] + m, da[k][1]), a = __expf(da[k][0] + m - mn), bb = __expf(da[k][1] - mn); m = mn;
#pragma unroll
                    for (int e = 0; e < 4; ++e) { al[e] = a; be[e] = bb; } }
                else {
#pragma unroll
                    for (int e = 0; e < 4; ++e) { al[e] = da[k][e]; be[e] = 1.f; } }
                S[0] = al[0] * S[0] + be[0] * bf2f((bf16_t)(ds[k].x & 0xffff)); S[1] = al[1] * S[1] + be[1] * bf2f((bf16_t)(ds[k].x >> 16));
                S[2] = al[2] * S[2] + be[2] * bf2f((bf16_t)(ds[k].y & 0xffff)); S[3] = al[3] * S[3] + be[3] * bf2f((bf16_t)(ds[k].y >> 16)); } }
    } else if (BR == 3 && g < TOTAL + 16 * 128) {
        const int q = g - TOTAL, d = q & 127, chain = q >> 7, dir = chain >> 3; float n = 0.f, m = 0.f;
        for (int ci0 = 0; ci0 < NCHUNK; ci0 += NB) { float be[NB], ml[NB], dn[NB]; size_t o[NB];
#pragma unroll
            for (int k = 0; k < NB; ++k) { const int c = chain_chunk(dir, ci0 + k); be[k] = BE[chain * NCHUNK + c]; ml[k] = MLOC[chain * NCHUNK + c]; o[k] = ((size_t)chain * NCHUNK + c) * 128 + d; dn[k] = DN[o[k]]; }
#pragma unroll
            for (int k = 0; k < NB; ++k) { DN[o[k]] = n; if (d == 0) MIN_[chain * NCHUNK + chain_chunk(dir, ci0 + k)] = m;
                const float mn = fmaxf(be[k] + m, ml[k]); n = __expf(be[k] + m - mn) * n + __expf(ml[k] - mn) * dn[k]; m = mn; } }
    }
}
template <int BR> __device__ __forceinline__ void phase_gl_out(const PP& p, int l, LAS unsigned char* L) {
    constexpr int DK = BR == 1 ? 64 : 128, PQ = DK + 8, NSEG = 512 / DK, NT = 64 / NSEG;
    const int tid = otid(p.swid), lane = tid & 63, wid = p.swid, fr = lane & 15, fq = lane >> 4;
    LAS bf16_t* QP = (LAS bf16_t*)L;
    LAS bf16_t* KP = QP + 2 * 64 * PQ;
    LAS bf16_t* QT = KP + 2 * 64 * PQ;
    LAS bf16_t* VT = QT + 2 * 64 * PQ;
    LAS bf16_t* PS = VT + 128 * 72;
    LAS float* SEG = (LAS float*)(PS + 2 * 64 * 72);
    LAS float* RED = SEG;
    LAS float* LR = SEG + 1024;
    const bf16_t* Z = (const bf16_t*)(p.ws + WS_BIG + BIG_Z); const float* MISC = (const float*)(p.ws + WS_MISC);
    const bf16_t* ST = (const bf16_t*)(p.ws + WS_BIG + BIG_ST); bf16_t* YS = (bf16_t*)(p.ws + WS_BIG + BIG_YS) + (size_t)BR * TT * 512;
    const float* gain = (BR == 1 ? p.in[I_GLANG] : p.in[I_HGNG]) + l * 128;
    constexpr int VOFF = BR == 1 ? GV : HI, QOFF = BR == 1 ? GQ : HQ, GOFF = BR == 1 ? GG : HGT;
    const int d = tid % DK, sg = tid / DK;
    bf16_t rq[NT], rk[2][NT], rv[16]; float rlr[4];
    auto fetch = [&](int u2, bf16_t (&q_)[NT], bf16_t (&k_)[2][NT], bf16_t (&v_)[16], float (&lr_)[4]) {
        const int c2 = u2 % NCHUNK, bh2 = u2 / NCHUNK, h2 = bh2 & 3, b2 = bh2 >> 2; const size_t rr0 = (size_t)b2 * NTOK + c2 * 64;
#pragma unroll
        for (int n = 0; n < NT; ++n) { const bf16_t* zr = Z + (rr0 + sg * NT + n) * ZLD; q_[n] = zr[QOFF + h2 * DK + d];
            if (BR == 1) { k_[0][n] = zr[GK + h2 * 64 + d]; k_[1][n] = k_[0][n]; } else { k_[0][n] = zr[HF + h2 * 128 + d]; k_[1][n] = zr[HF + 512 + h2 * 128 + d]; } }
#pragma unroll
        for (int gi = 0; gi < 2; ++gi)
#pragma unroll
            for (int e = 0; e < 8; ++e) v_[gi * 8 + e] = Z[(rr0 + ((tid >> 7) + 4 * gi) * 8 + e) * ZLD + VOFF + h2 * 128 + (tid & 127)];
        if (BR == 1) {
#pragma unroll
            for (int i = 0; i < 4; ++i) { const int ix = tid + 512 * i; lr_[i] = MISC[(rr0 + (ix >> 5)) * 64 + MISC_LR + (ix & 31)]; } }
    };
    const int ustart = (blockIdx.x + (BR == 2 ? 128 : 0)) % gridDim.x;
    if (ustart < 8 * NCHUNK) fetch(ustart, rq, rk, rv, rlr);
    for (int u = ustart; u < 8 * NCHUNK; u += gridDim.x) {
        const int c = u % NCHUNK, bh = u / NCHUNK, h = bh & 3, b = bh >> 2; const size_t r0 = (size_t)b * NTOK + c * 64;
        if (BR == 1) {
#pragma unroll
            for (int i = 0; i < 4; ++i) LR[tid + 512 * i] = rlr[i]; }
        uint2 gtv[4];
#pragma unroll
        for (int it = 0; it < 4; ++it) gtv[it] = *(const uint2*)(Z + (r0 + 16 * it + fr) * ZLD + GOFF + h * 128 + 16 * wid + 4 * fq);
        { const int v = tid & 127;
#pragma unroll
          for (int gi = 0; gi < 2; ++gi) { const int grp = (tid >> 7) + 4 * gi;
            *(LAS u32x4*)(VT + v * 72 + grp * 8) = (u32x4){rv[gi * 8] | ((unsigned)rv[gi * 8 + 1] << 16), rv[gi * 8 + 2] | ((unsigned)rv[gi * 8 + 3] << 16), rv[gi * 8 + 4] | ((unsigned)rv[gi * 8 + 5] << 16), rv[gi * 8 + 6] | ((unsigned)rv[gi * 8 + 7] << 16)}; } }
        float qv[NT];
#pragma unroll
        for (int n = 0; n < NT; ++n) { const float qraw = bf2f(rq[n]); qv[n] = BR == 1 ? qraw * 0.125f : siluf(qraw) * 0.08838834764831845f; }
        if (BR == 1) __syncthreads();
        float cs[2][NT], kk[2][NT];
#pragma unroll
        for (int dir = 0; dir < 2; ++dir) { GlChan<BR> G; G.init(p, l, dir, h, d); float run = 0.f;
#pragma unroll
            for (int q = 0; q < NT; ++q) { const int n = dir ? NT - 1 - q : q, t = sg * NT + n; float g; G.gk_raw(rk[dir][n], LR + t * 32 + dir * 16, g, kk[dir][n]); run += g; cs[dir][n] = run; }
            SEG[(dir * NSEG + sg) * DK + d] = run; }
        __syncthreads();
#pragma unroll
        for (int dir = 0; dir < 2; ++dir) { float before = 0.f, beta = 0.f;
#pragma unroll
            for (int s2 = 0; s2 < NSEG; ++s2) { const float x = SEG[(dir * NSEG + s2) * DK + d]; const int rank = dir ? NSEG - 1 - s2 : s2; const int myrank = dir ? NSEG - 1 - sg : sg;
                before += rank < myrank ? x : 0.f; beta += rank < NSEG / 2 ? x : 0.f; }
            const float ebeta = __expf(beta);
#pragma unroll
            for (int n = 0; n < NT; ++n) { const int t = sg * NT + n; const float e1 = __expf(before + cs[dir][n] - beta), qe = qv[n] * e1;
                QP[(dir * 64 + t) * PQ + d] = f2bf(qe); QT[(dir * 64 + t) * PQ + d] = f2bf(qe * ebeta); KP[(dir * 64 + t) * PQ + d] = f2bf(kk[dir][n] * frcp(e1)); } }
        if (u + (int)gridDim.x < 8 * NCHUNK) fetch(u + gridDim.x, rq, rk, rv, rlr);
        bf16x8 xs[2][DK / 32];
#pragma unroll
        for (int dir = 0; dir < 2; ++dir) { const bf16_t* sp = ST + (((size_t)((dir * 2 + b) * 4 + h) * NCHUNK + c) * 128 + 16 * wid + fr) * DK + 8 * fq;
#pragma unroll
            for (int kq = 0; kq < DK / 32; ++kq) xs[dir][kq] = *(const bf16x8*)(sp + 32 * kq); }
        __syncthreads();
        {
            const int dir = wid >> 2, it = wid & 3;
#pragma unroll
            for (int jt = 0; jt < 4; ++jt) {
                f32x4 sa = (f32x4){0.f, 0.f, 0.f, 0.f};
#pragma unroll
                for (int kq = 0; kq < DK / 32; ++kq) sa = mfma16(*(const LAS bf16x8*)(KP + (dir * 64 + 16 * jt + fr) * PQ + 8 * fq + 32 * kq), *(const LAS bf16x8*)(QP + (dir * 64 + 16 * it + fr) * PQ + 8 * fq + 32 * kq), sa);
                settle(sa);
#pragma unroll
                for (int jj = 0; jj < 4; ++jj) { const int jg = 16 * jt + 4 * fq + jj, ig = 16 * it + fr; const bool keep = dir == 0 ? (jg <= ig) : (jg >= ig); sa[jj] = keep ? sa[jj] : 0.f; }
                *(LAS u32x2*)(PS + (dir * 64 + 16 * it + fr) * 72 + 16 * jt + 4 * fq) = (u32x2){pack2(sa[0], sa[1]), pack2(sa[2], sa[3])}; }
        }
        __syncthreads();
        f32x4 acc[4];
        {
#pragma unroll
            for (int it = 0; it < 4; ++it) acc[it] = (f32x4){0.f, 0.f, 0.f, 0.f};
            const bf16x8 xv0 = *(const LAS bf16x8*)(VT + (16 * wid + fr) * 72 + 8 * fq), xv1 = *(const LAS bf16x8*)(VT + (16 * wid + fr) * 72 + 8 * fq + 32);
#pragma unroll
            for (int dir = 0; dir < 2; ++dir)
#pragma unroll
                for (int it = 0; it < 4; ++it) {
                    acc[it] = mfma16(xv0, *(const LAS bf16x8*)(PS + (dir * 64 + 16 * it + fr) * 72 + 8 * fq), acc[it]);
                    acc[it] = mfma16(xv1, *(const LAS bf16x8*)(PS + (dir * 64 + 16 * it + fr) * 72 + 8 * fq + 32), acc[it]);
#pragma unroll
                    for (int kq = 0; kq < DK / 32; ++kq) acc[it] = mfma16(xs[dir][kq], *(const LAS bf16x8*)(QT + (dir * 64 + 16 * it + fr) * PQ + 8 * fq + 32 * kq), acc[it]); }
            settle(acc[0], acc[1], acc[2], acc[3]);
        }
#pragma unroll
        for (int it = 0; it < 4; ++it) { float ss = acc[it][0] * acc[it][0] + acc[it][1] * acc[it][1] + acc[it][2] * acc[it][2] + acc[it][3] * acc[it][3];
            ss += __shfl_xor(ss, 16); ss += __shfl_xor(ss, 32); if (fq == 0) RED[wid * 64 + 16 * it + fr] = ss; }
        __syncthreads();
        const f32x4 gn = *(const f32x4*)(gain + 16 * wid + 4 * fq);
#pragma unroll
        for (int it = 0; it < 4; ++it) { float tot = 0.f;
#pragma unroll
            for (int w2 = 0; w2 < 8; ++w2) tot += RED[w2 * 64 + 16 * it + fr];
            const float rs = rsqrtf(tot * (1.f / 128.f) + EPS); const size_t row = r0 + 16 * it + fr;
            const uint2 gt = gtv[it];
            const float y0 = acc[it][0] * rs * gn[0] * siluf(bf2f((bf16_t)(gt.x & 0xffff))), y1 = acc[it][1] * rs * gn[1] * siluf(bf2f((bf16_t)(gt.x >> 16)));
            const float y2 = acc[it][2] * rs * gn[2] * siluf(bf2f((bf16_t)(gt.y & 0xffff))), y3 = acc[it][3] * rs * gn[3] * siluf(bf2f((bf16_t)(gt.y >> 16)));
            *(uint2*)(YS + row * 512 + h * 128 + 16 * wid + 4 * fq) = make_uint2(pack2(y0, y1), pack2(y2, y3)); }
        __syncthreads();
    }
}

__device__ __forceinline__ float wave_incl_scan_add(float x, int lane) {
#pragma unroll
    for (int o = 1; o < 64; o <<= 1) { const float y = __shfl_up(x, o); x = lane >= o ? x + y : x; }
    return x;
}
__device__ __forceinline__ float wave_incl_scan_max(float x, int lane) {
#pragma unroll
    for (int o = 1; o < 64; o <<= 1) { const float y = __shfl_up(x, o); x = lane >= o ? fmaxf(x, y) : x; }
    return x;
}
__device__ __forceinline__ float wave_max(float v) {
#pragma unroll
    for (int o = 32; o > 0; o >>= 1) v = fmaxf(v, __shfl_xor(v, o));
    return v;
}
__device__ __forceinline__ void phase_ml_local(const PP& p, int l, LAS unsigned char* L) {
    const int tid = otid(p.swid), lane = tid & 63, wid = p.swid, fr = lane & 15, fq = lane >> 4;
    LAS bf16_t* KT = (LAS bf16_t*)L;
    LAS bf16_t* VT = KT + 2 * 128 * 72;
    LAS float* WE = (LAS float*)(VT + 128 * 72);
    LAS float* DNP = WE + 128;
    const bf16_t* Z = (const bf16_t*)(p.ws + WS_BIG + BIG_Z); const float* MISC = (const float*)(p.ws + WS_MISC);
    bf16_t* ST = (bf16_t*)(p.ws + WS_BIG + BIG_ST + ST_ML_OFF);
    float* BE = (float*)(p.ws + WS_SMALL + SM_MLBE); float* MLOC = (float*)(p.ws + WS_SMALL + SM_MLML); float* DN = (float*)(p.ws + WS_SMALL + SM_MLDN);
    for (int u = (blockIdx.x + 128) % gridDim.x; u < 8 * NCHUNK; u += gridDim.x) {
        const int c = u % NCHUNK, bh = u / NCHUNK, h = bh & 3, b = bh >> 2, p0 = c * 64; const size_t rb = (size_t)b * NTOK, r0 = rb + p0;
        const int lo = p0 < CTXL ? 0 : CTXL, hi = p0 < CTXL ? CTXL : NTOK;
        const int d = tid & 127, sg = tid >> 7, ch = h * 128 + d;
        float kv[16];
        {
            float cw[4];
#pragma unroll
            for (int q = 0; q < 4; ++q) cw[q] = p.in[I_MLCW][(l * 4 + q) * 1024 + 512 + ch];
            const float cb = p.in[I_MLCB][l * 1024 + 512 + ch];
            float win[19];
#pragma unroll
            for (int k = 0; k < 19; ++k) { const int q = p0 + sg * 16 - 2 + k, qc = q < lo ? lo : (q >= hi ? hi - 1 : q); const float zv = bf2f(Z[(rb + qc) * ZLD + MK + ch]); win[k] = (q >= lo && q < hi) ? zv : 0.f; }
#pragma unroll
            for (int n = 0; n < 16; ++n) kv[n] = siluf(cb + cw[0] * win[n] + cw[1] * win[n + 1] + cw[2] * win[n + 2] + cw[3] * win[n + 3]);
        }
        { const int v = tid & 127;
#pragma unroll
          for (int gi = 0; gi < 2; ++gi) { const int grp = (tid >> 7) + 4 * gi; unsigned short x[8];
#pragma unroll
            for (int e = 0; e < 8; ++e) x[e] = Z[(r0 + grp * 8 + e) * ZLD + MV + h * 128 + v];
            *(LAS u32x4*)(VT + v * 72 + grp * 8) = (u32x4){x[0] | ((unsigned)x[1] << 16), x[2] | ((unsigned)x[3] << 16), x[4] | ((unsigned)x[5] << 16), x[6] | ((unsigned)x[7] << 16)}; } }
        if (wid < 2) {
            const int dir = wid, t = dir == 0 ? lane : 63 - lane; const size_t r = r0 + t; const int chain = (dir * 2 + b) * 4 + h;
            const float ii = MISC[r * 64 + MISC_IF + dir * 8 + h] + p.in[I_MLGB][(l * 2 + dir) * 8 + h];
            const float lf = logsig(MISC[r * 64 + MISC_IF + dir * 8 + 4 + h] + p.in[I_MLGB][(l * 2 + dir) * 8 + 4 + h]);
            const float bc = wave_incl_scan_add(lf, lane), bend = __shfl(bc, 63), mloc = bend + wave_max(ii - bc);
            WE[dir * 64 + t] = __expf(bend - bc + ii - mloc);
            if (lane == 0) { BE[chain * NCHUNK + c] = bend; MLOC[chain * NCHUNK + c] = mloc; }
        }
        __syncthreads();
#pragma unroll
        for (int dir = 0; dir < 2; ++dir) { float val[16], dn = 0.f;
#pragma unroll
            for (int n = 0; n < 16; ++n) { val[n] = kv[n] * WE[dir * 64 + sg * 16 + n]; dn += val[n]; }
            *(LAS u32x4*)(KT + (dir * 128 + krow(d)) * 72 + sg * 16) = (u32x4){pack2(val[0], val[1]), pack2(val[2], val[3]), pack2(val[4], val[5]), pack2(val[6], val[7])};
            *(LAS u32x4*)(KT + (dir * 128 + krow(d)) * 72 + sg * 16 + 8) = (u32x4){pack2(val[8], val[9]), pack2(val[10], val[11]), pack2(val[12], val[13]), pack2(val[14], val[15])};
            DNP[(sg * 2 + dir) * 128 + d] = dn; }
        __syncthreads();
        if (tid < 256) { const int dir = tid >> 7; DN[((size_t)((dir * 2 + b) * 4 + h) * NCHUNK + c) * 128 + d] = DNP[(0 * 2 + dir) * 128 + d] + DNP[(1 * 2 + dir) * 128 + d] + DNP[(2 * 2 + dir) * 128 + d] + DNP[(3 * 2 + dir) * 128 + d]; }
        { const int dir = wid >> 2, A = wid & 3; const size_t sbase = ((size_t)((dir * 2 + b) * 4 + h) * NCHUNK + c) * 128 * 128;
            bf16x8 x[2][2];
#pragma unroll
            for (int n = 0; n < 2; ++n) { x[n][0] = *(const LAS bf16x8*)(KT + (dir * 128 + 16 * (2 * A + n) + fr) * 72 + 8 * fq); x[n][1] = *(const LAS bf16x8*)(KT + (dir * 128 + 16 * (2 * A + n) + fr) * 72 + 8 * fq + 32); }
#pragma unroll
            for (int vt = 0; vt < 8; ++vt) { const bf16x8 y0 = *(const LAS bf16x8*)(VT + (16 * vt + fr) * 72 + 8 * fq), y1 = *(const LAS bf16x8*)(VT + (16 * vt + fr) * 72 + 8 * fq + 32);
                f32x4 a0 = (f32x4){0.f, 0.f, 0.f, 0.f}, a1 = (f32x4){0.f, 0.f, 0.f, 0.f};
                a0 = mfma16(x[0][0], y0, a0); a0 = mfma16(x[0][1], y1, a0); a1 = mfma16(x[1][0], y0, a1); a1 = mfma16(x[1][1], y1, a1); settle(a0, a1);
                *(uint4*)(ST + sbase + (size_t)(16 * vt + fr) * 128 + 32 * A + 8 * fq) = make_uint4(pack2(a0[0], a0[1]), pack2(a0[2], a0[3]), pack2(a1[0], a1[1]), pack2(a1[2], a1[3])); } }
        __syncthreads();
    }
}
__device__ __forceinline__ void phase_ml_out(const PP& p, int l, LAS unsigned char* L) {
    constexpr int PQ = 136;
    const int tid = otid(p.swid), lane = tid & 63, wid = p.swid, fr = lane & 15, fq = lane >> 4;
    LAS bf16_t* QL = (LAS bf16_t*)L;
    LAS bf16_t* KL = QL + 64 * PQ;
    LAS bf16_t* VT = KL + 64 * PQ;
    LAS bf16_t* PS = VT + 128 * 72;
    LAS float* SC = (LAS float*)(PS + 2 * 64 * 72);
    LAS float* NV = SC + 2 * 576;
    LAS float* RED = NV + 256;
    const bf16_t* Z = (const bf16_t*)(p.ws + WS_BIG + BIG_Z); const float* MISC = (const float*)(p.ws + WS_MISC);
    const bf16_t* ST = (const bf16_t*)(p.ws + WS_BIG + BIG_ST + ST_ML_OFF); bf16_t* YS = (bf16_t*)(p.ws + WS_BIG + BIG_YS) + (size_t)3 * TT * 512;
    const float* MIN_ = (const float*)(p.ws + WS_SMALL + SM_MLMIN); const float* DN = (const float*)(p.ws + WS_SMALL + SM_MLDN);
    const float* gain = p.in[I_MLNG] + l * 128;
    for (int u = (blockIdx.x + 128) % gridDim.x; u < 8 * NCHUNK; u += gridDim.x) {
        const int c = u % NCHUNK, bh = u / NCHUNK, h = bh & 3, b = bh >> 2, p0 = c * 64; const size_t rb = (size_t)b * NTOK, r0 = rb + p0;
        const int lo = p0 < CTXL ? 0 : CTXL, hi = p0 < CTXL ? CTXL : NTOK;
        const int d = tid & 127, sg = tid >> 7, ch = h * 128 + d;
        uint2 gtv[4];
#pragma unroll
        for (int it = 0; it < 4; ++it) gtv[it] = *(const uint2*)(Z + (r0 + 16 * it + fr) * ZLD + MO + h * 128 + 16 * wid + 4 * fq);
#pragma unroll
        for (int which = 0; which < 2; ++which) {
            const int zc = (which ? MK : MQ) + ch;
            float cw[4];
#pragma unroll
            for (int q = 0; q < 4; ++q) cw[q] = p.in[I_MLCW][(l * 4 + q) * 1024 + which * 512 + ch];
            const float cb = p.in[I_MLCB][l * 1024 + which * 512 + ch], scl = which ? 1.f : 0.08838834764831845f;
            float win[19];
#pragma unroll
            for (int k = 0; k < 19; ++k) { const int q = p0 + sg * 16 - 2 + k, qc = q < lo ? lo : (q >= hi ? hi - 1 : q); const float zv = bf2f(Z[(rb + qc) * ZLD + zc]); win[k] = (q >= lo && q < hi) ? zv : 0.f; }
            LAS bf16_t* dst = (which ? KL : QL) + (sg * 16) * PQ + d;
#pragma unroll
            for (int n = 0; n < 16; ++n) dst[n * PQ] = f2bf(siluf(cb + cw[0] * win[n] + cw[1] * win[n + 1] + cw[2] * win[n + 2] + cw[3] * win[n + 3]) * scl);
        }
        { const int v = tid & 127;
#pragma unroll
          for (int gi = 0; gi < 2; ++gi) { const int grp = (tid >> 7) + 4 * gi; unsigned short x[8];
#pragma unroll
            for (int e = 0; e < 8; ++e) x[e] = Z[(r0 + grp * 8 + e) * ZLD + MV + h * 128 + v];
            *(LAS u32x4*)(VT + v * 72 + grp * 8) = (u32x4){x[0] | ((unsigned)x[1] << 16), x[2] | ((unsigned)x[3] << 16), x[4] | ((unsigned)x[5] << 16), x[6] | ((unsigned)x[7] << 16)}; } }
        if (tid < 256) NV[tid] = DN[((size_t)(((tid >> 7) * 2 + b) * 4 + h) * NCHUNK + c) * 128 + (tid & 127)];
        if (wid < 2) {
            const int dir = wid, t = dir == 0 ? lane : 63 - lane; const size_t r = r0 + t; const int chain = (dir * 2 + b) * 4 + h;
            const float ii = MISC[r * 64 + MISC_IF + dir * 8 + h] + p.in[I_MLGB][(l * 2 + dir) * 8 + h];
            const float lf = logsig(MISC[r * 64 + MISC_IF + dir * 8 + 4 + h] + p.in[I_MLGB][(l * 2 + dir) * 8 + 4 + h]);
            const float bc = wave_incl_scan_add(lf, lane), a = ii - bc, arun = wave_incl_scan_max(a, lane), mprev = MIN_[chain * NCHUNK + c];
            const float m = bc + fmaxf(mprev, arun);
            LAS float* S = SC + dir * 576;
            S[t] = bc - m; S[64 + t] = a; S[128 + t] = __expf(bc + mprev - m); S[192 + t] = __expf(-m);
        }
        __syncthreads();
        bf16x8 xs[2][4];
#pragma unroll
        for (int dir = 0; dir < 2; ++dir) { const bf16_t* sp = ST + (((size_t)((dir * 2 + b) * 4 + h) * NCHUNK + c) * 128 + 16 * wid + fr) * 128 + 8 * fq;
#pragma unroll
            for (int kk = 0; kk < 4; ++kk) xs[dir][kk] = *(const bf16x8*)(sp + 32 * kk); }
        {
            const int dir = tid >> 8, i = (tid >> 2) & 63, part = tid & 3; float sacc = 0.f;
#pragma unroll 8
            for (int d = part * 32; d < part * 32 + 32; ++d) sacc += bf2f(QL[i * PQ + d]) * NV[dir * 128 + d];
            sacc += __shfl_xor(sacc, 1); sacc += __shfl_xor(sacc, 2);
            if (part == 0) SC[dir * 576 + 256 + i] = sacc;
        }
        {
            const int it = wid & 3;
#pragma unroll
            for (int jh = 0; jh < 2; ++jh) { const int jt = (wid >> 2) * 2 + jh;
                f32x4 acc = (f32x4){0.f, 0.f, 0.f, 0.f};
#pragma unroll
                for (int kk = 0; kk < 4; ++kk) acc = mfma16(*(const LAS bf16x8*)(KL + (16 * jt + fr) * PQ + 8 * fq + 32 * kk), *(const LAS bf16x8*)(QL + (16 * it + fr) * PQ + 8 * fq + 32 * kk), acc);
                settle(acc);
                const int ig = 16 * it + fr;
#pragma unroll
                for (int dir = 0; dir < 2; ++dir) { const LAS float* S = SC + dir * 576; const float ui = S[ig]; float sv[4];
#pragma unroll
                    for (int jj = 0; jj < 4; ++jj) { const int jg = 16 * jt + 4 * fq + jj; const bool keep = dir == 0 ? (jg <= ig) : (jg >= ig);
                        const float wgt = __expf(fminf(ui + S[64 + jg], 0.f)); sv[jj] = keep ? acc[jj] * wgt : 0.f; }
                    *(LAS u32x2*)(PS + (dir * 64 + ig) * 72 + 16 * jt + 4 * fq) = (u32x2){pack2(sv[0], sv[1]), pack2(sv[2], sv[3])};
                    float rsum = sv[0] + sv[1] + sv[2] + sv[3]; rsum += __shfl_xor(rsum, 16); rsum += __shfl_xor(rsum, 32);
                    if (fq == 0) SC[dir * 576 + 320 + jt * 64 + ig] = rsum; } }
        }
        __syncthreads();
        {
            f32x4 o[4];
#pragma unroll
            for (int it = 0; it < 4; ++it) o[it] = (f32x4){0.f, 0.f, 0.f, 0.f};
            const bf16x8 xv0 = *(const LAS bf16x8*)(VT + (16 * wid + fr) * 72 + 8 * fq), xv1 = *(const LAS bf16x8*)(VT + (16 * wid + fr) * 72 + 8 * fq + 32);
#pragma unroll
            for (int dir = 0; dir < 2; ++dir) {
                const LAS float* S = SC + dir * 576;
#pragma unroll
                for (int it = 0; it < 4; ++it) { const int ig = 16 * it + fr;
                    f32x4 ap = (f32x4){0.f, 0.f, 0.f, 0.f}, ac = (f32x4){0.f, 0.f, 0.f, 0.f};
                    ap = mfma16(xv0, *(const LAS bf16x8*)(PS + (dir * 64 + ig) * 72 + 8 * fq), ap);
                    ap = mfma16(xv1, *(const LAS bf16x8*)(PS + (dir * 64 + ig) * 72 + 8 * fq + 32), ap);
#pragma unroll
                    for (int kk = 0; kk < 4; ++kk) ac = mfma16(xs[dir][kk], *(const LAS bf16x8*)(QL + ig * PQ + 8 * fq + 32 * kk), ac);
                    settle(ap, ac);
                    const float wi = S[128 + ig], den = S[320 + ig] + S[384 + ig] + S[448 + ig] + S[512 + ig] + wi * S[256 + ig];
                    const float inv = frcp(fmaxf(fabsf(den), S[192 + ig]));
#pragma unroll
                    for (int jj = 0; jj < 4; ++jj) o[it][jj] += (ap[jj] + wi * ac[jj]) * inv; } }
#pragma unroll
            for (int it = 0; it < 4; ++it) { float ss = o[it][0] * o[it][0] + o[it][1] * o[it][1] + o[it][2] * o[it][2] + o[it][3] * o[it][3];
                ss += __shfl_xor(ss, 16); ss += __shfl_xor(ss, 32); if (fq == 0) RED[wid * 64 + 16 * it + fr] = ss; }
            __syncthreads();
            const f32x4 gn = *(const f32x4*)(gain + 16 * wid + 4 * fq);
#pragma unroll
            for (int it = 0; it < 4; ++it) { float tot = 0.f;
#pragma unroll
                for (int w2 = 0; w2 < 8; ++w2) tot += RED[w2 * 64 + 16 * it + fr];
                const float rs = rsqrtf(tot * (1.f / 128.f) + EPS); const size_t row = r0 + 16 * it + fr;
                const uint2 gt = gtv[it];
                const float y0 = o[it][0] * rs * gn[0] * sigm(bf2f((bf16_t)(gt.x & 0xffff))), y1 = o[it][1] * rs * gn[1] * sigm(bf2f((bf16_t)(gt.x >> 16)));
                const float y2 = o[it][2] * rs * gn[2] * sigm(bf2f((bf16_t)(gt.y & 0xffff))), y3 = o[it][3] * rs * gn[3] * sigm(bf2f((bf16_t)(gt.y >> 16)));
                *(uint2*)(YS + row * 512 + h * 128 + 16 * wid + 4 * fq) = make_uint2(pack2(y0, y1), pack2(y2, y3)); }
        }
        __syncthreads();
    }
}

#define GLA_LOCAL(p, l) phase_gl_local<1>(p, l, L)
#define GLA_CARRY(p, l) phase_gl_carry<1>(p)
#define GLA_OUT(p, l) phase_gl_out<1>(p, l, L)
#define HG_LOCAL(p, l) phase_gl_local<2>(p, l, L)
#define HG_CARRY(p, l) phase_gl_carry<2>(p)
#define HG_OUT(p, l) phase_gl_out<2>(p, l, L)
#define ML_LOCAL(p, l) phase_ml_local(p, l, L)
#define ML_CARRY(p, l) phase_gl_carry<3>(p)
#define ML_OUT(p, l) phase_ml_out(p, l, L)
constexpr int LDS_BYTES = 147456, NPH_LAYER = 22, NPH = 1 + 2 * NPH_LAYER;
__global__ void __launch_bounds__(512, 2) mega(P p_unused) {
    extern __shared__ __attribute__((aligned(16))) unsigned char lds[];
    LAS unsigned char* L = (LAS unsigned char*)lds;
    LAS int* tbl = (LAS int*)(L + 131072 + 1024);
    const int swid = __builtin_amdgcn_readfirstlane((int)(threadIdx.x >> 6));
    int lo, hi; unsigned* barw;
    { const PP p = load_args(swid); lo = p.ph_lo; hi = p.ph_hi; barw = (unsigned*)(p.ws + WS_CTL); }
    { const int t0 = (int)threadIdx.x; if (t0 < 4) ((LAS unsigned*)(L + LDS_BYTES - 16))[t0] = 0u; }
    __syncthreads();
    XcdBarrier bar; bar.bar = barw; bar.x = 0; bar.st = nullptr; bar.swid = swid;
    if (hi - lo > 1) bar = xcd_barrier_post(barw, (volatile LAS unsigned*)(L + LDS_BYTES - 16), swid);
#ifndef PHSEL
#define PHSEL(k) 1
#endif
#define IN(k) (PHSEL(k) && lo <= (k) && (k) < hi)
#define SEAM(k) do { if (IN((k) + 1)) xcd_barrier(bar); } while (0)
#define PHASE(k, ...) if (IN(k)) { const PP p = load_args(swid); unsigned char* ws = p.ws; unsigned char* wb = ws + WS_WB; unsigned char* big = ws + WS_BIG; (void)wb; (void)big; __VA_ARGS__ SEAM(k); }
    PHASE(0, phase_mods(p, (LAS float*)L); phase_convert(p, 0, (LAS float*)L, 0, 9824, 0);)
#define LAYER_BODY(l) { constexpr int pb = 1 + NPH_LAYER * (l); \
    if ((l) == 1) { PHASE(pb + 0, phase_convert(p, 1, (LAS float*)L, 0, 9824, 0);) } \
    if ((l) == 0) { PHASE(pb + 1, phase_norm1(p, l);) } \
    PHASE(pb + 2, Gemm g{(const bf16_t*)(ws + WS_U), (const bf16_t*)(wb + WB_WIN), DM, DM, p.swid}; OrderPlain S; S.init(MT, 14, gridDim.x, blockIdx.x); S.skipctx = 0; \
        EpiZ E{(bf16_t*)(big + BIG_Z), (float*)(ws + WS_MISC), -1}; GEMM_RUN(EpiZ, OrderPlain, g, S, E);) \
    PHASE(pb + 3, phase_rg<false>(p, l, L); HG_LOCAL(p, l);) \
    PHASE(pb + 4, phase_rg_carry(p); HG_CARRY(p, l);) \
    PHASE(pb + 5, phase_rg<true>(p, l, L); HG_OUT(p, l);) \
    PHASE(pb + 6, Gemm g{(const bf16_t*)(ws + WS_U), (const bf16_t*)(wb + WB_WIN) + (size_t)3584 * DM, DM, DM, p.swid}; OrderPlain S; S.init(MT, 15, gridDim.x, blockIdx.x); S.skipctx = 0; \
        EpiZ E{(bf16_t*)(big + BIG_Z), (float*)(ws + WS_MISC), 14}; GEMM_RUN(EpiZ, OrderPlain, g, S, E);) \
    PHASE(pb + 7, GLA_LOCAL(p, l); ML_LOCAL(p, l);) \
    PHASE(pb + 8, GLA_CARRY(p, l); ML_CARRY(p, l);) \
    PHASE(pb + 9, GLA_OUT(p, l); ML_OUT(p, l);) \
    PHASE(pb + 14, Gemm g{(const bf16_t*)(big + BIG_YS), (const bf16_t*)(wb + WB_WB), 512, 512, p.swid}; OrderBranch S; S.init((l) ? 64 : MT, 16, gridDim.x, blockIdx.x); S.skipctx = (l); \
        EpiBO E{(bf16_t*)(big + BIG_BO)}; GEMM_RUN(EpiBO, OrderBranch, g, S, E);) \
    PHASE(pb + 15, Gemm g{(const bf16_t*)(ws + WS_U), (const bf16_t*)(wb + WB_WM), DM, DM, p.swid}; OrderPlain S; S.init((l) ? 64 : MT, 16, gridDim.x, blockIdx.x); S.skipctx = (l); \
        EpiMerge E{(const bf16_t*)(big + BIG_BO), p.in[I_BMERGE] + (size_t)(l) * 4096, (bf16_t*)(big + BIG_MERGED)}; GEMM_RUN(EpiMerge, OrderPlain, g, S, E);) \
    PHASE(pb + 16, Gemm g{(const bf16_t*)(big + BIG_MERGED), (const bf16_t*)(wb + WB_WO), DM, DM, p.swid}; OrderPlain S; S.init((l) ? 64 : MT, 4, gridDim.x, blockIdx.x); S.skipctx = (l); \
        EpiOut E{(l) == 0 ? p.in[I_X] : p.out, (l) == 0 ? p.in[I_CTX] : (const float*)(ws + WS_HCTX), p.out, (float*)(ws + WS_HCTX), (const float*)(ws + WS_MOD) + (size_t)(l) * 3 * 6144}; \
        GEMM_RUN(EpiOut, OrderPlain, g, S, E);) \
    PHASE(pb + 17, phase_route(p, l, L);) \
    PHASE(pb + 18, phase_dispatch(p, l, tbl);) \
    PHASE(pb + 19, const int nblk = moe_tables(p, l, tbl); Gemm g{(const bf16_t*)(big + BIG_XS), (const bf16_t*)(wb + WB_W13), DM, DM, p.swid}; OrderMoe S; S.init(nblk, 4, gridDim.x, blockIdx.x); S.blk_e = tbl + 32; \
        EpiH E{(bf16_t*)(big + BIG_HS)}; GEMM_RUN(EpiH, OrderMoe, g, S, E);) \
    PHASE(pb + 20, const int nblk = moe_tables(p, l, tbl); Gemm g{(const bf16_t*)(big + BIG_HS), (const bf16_t*)(wb + WB_W2), 512, 512, p.swid}; OrderMoe S; S.init(nblk, 4, gridDim.x, blockIdx.x); S.blk_e = tbl + 32; \
        EpiY E{(bf16_t*)(big + BIG_YM)}; GEMM_RUN(EpiY, OrderMoe, g, S, E);) \
    PHASE(pb + 21, phase_combine(p, l);) }
    LAYER_BODY(0)
    LAYER_BODY(1)
#undef LAYER_BODY
#undef PHASE
#undef SEAM
#undef IN
}

#ifndef N_LAUNCHES
#define N_LAUNCHES 1
#endif
extern "C" void kernel_launch(void* const* d_in, const int* in_sizes, int n_in, void* d_out, int out_size, void* d_ws, size_t ws_size, hipStream_t stream) {
    static int grid = 0;
    if (grid == 0) {
        if (n_in != N_IN || out_size != NBATCH * SEQL * DM || ws_size < WS_END) { fprintf(stderr, "kernel_launch: unexpected shapes (n_in %d out %d ws %zu need %zu)\n", n_in, out_size, ws_size, (size_t)WS_END); grid = -1; return; }
        int dev = 0, cus = 0, per_cu = 0;
        if (hipGetDevice(&dev) != hipSuccess || hipDeviceGetAttribute(&cus, hipDeviceAttributeMultiprocessorCount, dev) != hipSuccess) { grid = -1; return; }
        if (hipFuncSetAttribute((const void*)mega, hipFuncAttributeMaxDynamicSharedMemorySize, LDS_BYTES) != hipSuccess) { grid = -1; return; }
        if (hipOccupancyMaxActiveBlocksPerMultiprocessor(&per_cu, (const void*)mega, 512, LDS_BYTES) != hipSuccess || per_cu < 1) { fprintf(stderr, "kernel_launch: occupancy query says %d\n", per_cu); }
        (void)hipGetLastError();
        grid = cus;
    }
    if (grid < 0) return;
    (void)hipMemsetAsync((char*)d_ws + WS_CTL, 0, 65536, stream);
    P p{};
    for (int i = 0; i < N_IN; ++i) p.in[i] = (const float*)d_in[i];
    p.out = (float*)d_out; p.ws = (unsigned char*)d_ws;
    if (N_LAUNCHES == 1) { p.ph_lo = 0; p.ph_hi = NPH; hipLaunchKernelGGL(mega, dim3(grid), dim3(512), LDS_BYTES, stream, p); }
    else for (int k = 0; k < NPH; ++k) { p.ph_lo = k; p.ph_hi = k + 1; hipLaunchKernelGGL(mega, dim3(grid), dim3(512), LDS_BYTES, stream, p); }
}
```
